# Optimizing an MI355X kernel written in HIP

```python
import math
import jax, jax.numpy as jnp
from jax import lax
import numpy as np

D_MODEL = 1024
BATCH = 8
SEQ = 2048
DEPTH = 1
DEC_BATCH = 32
DEC_SEQ = 8
PAST_LEN = 16384
PAGE_SIZE = 128

N_HEADS_A = 12
HEAD_DIM_A = 64
D_ATTN = N_HEADS_A * HEAD_DIM_A
DILATED_GROUPS = ((128, 1), (512, 4), (2048, 16))
WINDOW_MAX = 2048
QUERY_BLOCK = 64
N_BUCKETS = 32
MAX_DISTANCE = WINDOW_MAX
D_SSM = 2 * D_MODEL
SSM_HEAD_DIM = 64
N_SSM_HEADS = D_SSM // SSM_HEAD_DIM
SSM_GROUPS = 8
D_STATE = 128
CONV_WIDTH = 4
D_CONV = D_SSM + 2 * SSM_GROUPS * D_STATE
SSD_CHUNK = 128
DT_MIN = 0.001
DT_MAX = 0.1
SPLIT_SIZES = (D_ATTN, D_ATTN, D_ATTN, D_ATTN, D_SSM, D_CONV, N_SSM_HEADS, D_MODEL, D_MODEL)
D_IN_PROJ = sum(SPLIT_SIZES)
SPLIT_POINTS = tuple(int(s) for s in np.cumsum(SPLIT_SIZES)[:-1])

kernel_name = 'hybrid_dilated_attn_mamba2_gated_decode_step'


def _rmsnorm(x, g, eps=1e-6):
    xf = x.astype(jnp.float32)
    y = xf * lax.rsqrt(jnp.mean(xf * xf, axis=-1, keepdims=True) + eps)
    return (y * g.astype(jnp.float32)).astype(x.dtype)


def _group_rmsnorm(y, g, eps=1e-5):
    shp = y.shape
    yg = y.reshape(shp[:-1] + (SSM_GROUPS, shp[-1] // SSM_GROUPS))
    yg = yg * lax.rsqrt(jnp.mean(yg * yg, axis=-1, keepdims=True) + eps)
    return yg.reshape(shp) * g.astype(jnp.float32)


def _t5_bucket(dist):
    max_exact = N_BUCKETS // 2
    d = np.maximum(dist, 1).astype(np.float32)
    large = max_exact + (np.log(d / max_exact) / math.log(MAX_DISTANCE / max_exact)
                         * (N_BUCKETS - max_exact)).astype(np.int32)
    large = np.minimum(large, N_BUCKETS - 1)
    return np.where(dist < max_exact, dist, large).astype(np.int32)


def _dilated_attention(q, k_all, v_all, rel_bias, q_pos0, k_pos0):
    bsz, lq, n_heads, head_dim = q.shape
    lk = k_all.shape[1]
    qb = QUERY_BLOCK if lq % QUERY_BLOCK == 0 else lq
    n_blocks = lq // qb
    scale = 1.0 / math.sqrt(head_dim)
    offsets = [np.arange(0, w + 1, d, dtype=np.int32) for (w, d) in DILATED_GROUPS]
    biases = [rel_bias[_t5_bucket(o)].T.astype(jnp.float32) for o in offsets]

    def one_block(blk):
        start = blk * qb
        qs = lax.dynamic_slice_in_dim(q, start, qb, axis=1).astype(jnp.float32) * scale
        qpos = q_pos0 + start + jnp.arange(qb, dtype=jnp.int32)
        lses, outs = [], []
        for off, bias in zip(offsets, biases):
            kpos = qpos[:, None] - off[None, :]
            idx = kpos - k_pos0
            valid = (kpos >= 0) & (idx >= 0)
            idx = jnp.clip(idx, 0, lk - 1)
            kg = jnp.take(k_all, idx, axis=1).astype(jnp.float32)
            vg = jnp.take(v_all, idx, axis=1).astype(jnp.float32)
            s = jnp.einsum('bqhe,bqjhe->bhqj', qs, kg) + bias[None, :, None, :]
            s = jnp.where(valid[None, None], s, -jnp.inf)
            lse = jax.nn.logsumexp(s, axis=-1)
            p = jnp.exp(s - lse[..., None])
            outs.append(jnp.einsum('bhqj,bqjhe->bqhe', p, vg))
            lses.append(lse)
        mix = jax.nn.softmax(jnp.stack(lses, axis=0), axis=0)
        o = jnp.einsum('gbhq,gbqhe->bqhe', mix, jnp.stack(outs, axis=0))
        return o.astype(q.dtype)

    out = lax.map(one_block, jnp.arange(n_blocks))
    return jnp.moveaxis(out, 0, 1).reshape(bsz, lq, n_heads, head_dim)


def _causal_dwconv(xbc, conv_past, conv_w, conv_b):
    xp = jnp.concatenate([conv_past.astype(xbc.dtype), xbc], axis=1)
    length = xbc.shape[1]
    y = conv_b
    for tap in range(CONV_WIDTH):
        y = y + xp[:, tap:tap + length] * conv_w[tap]
    return y, xp[:, -(CONV_WIDTH - 1):]


def _ssd(x, dt, a, bm, cm, h0):
    f32 = jnp.float32
    bsz, length, n_heads, p_dim = x.shape
    n_groups, n_state = bm.shape[2], bm.shape[3]
    r = n_heads // n_groups
    qc = SSD_CHUNK if length % SSD_CHUNK == 0 else length
    nc = length // qc
    xc = x.astype(f32).reshape(bsz, nc, qc, n_groups, r, p_dim)
    dtc = dt.astype(f32).reshape(bsz, nc, qc, n_groups, r)
    bc = bm.astype(f32).reshape(bsz, nc, qc, n_groups, n_state)
    cc = cm.astype(f32).reshape(bsz, nc, qc, n_groups, n_state)
    acum = jnp.cumsum(dtc * a.astype(f32).reshape(n_groups, r), axis=2)
    xdt = xc * dtc[..., None]
    causal = np.tril(np.ones((qc, qc), dtype=bool))[:, :, None, None]
    seg = acum[:, :, :, None] - acum[:, :, None, :]
    decay = jnp.exp(jnp.where(causal, seg, -jnp.inf))
    cb = jnp.einsum('bclgn,bcsgn->bclsg', cc, bc)
    y_diag = jnp.einsum('bclsgr,bcsgrp->bclgrp', cb[..., None] * decay, xdt)
    wx = xdt * jnp.exp(acum[:, :, -1:] - acum)[..., None]
    states = jnp.einsum('bclgn,bclgrp->bcgrpn', bc, wx)
    chunk_decay = jnp.exp(acum[:, :, -1])

    def step(h, inp):
        s_c, d_c = inp
        return d_c[..., None, None] * h + s_c, h

    h_init = h0.astype(f32).reshape(bsz, n_groups, r, p_dim, n_state)
    h_final, h_prev = lax.scan(step, h_init, (jnp.moveaxis(states, 1, 0), jnp.moveaxis(chunk_decay, 1, 0)))
    h_prev = jnp.moveaxis(h_prev, 0, 1)
    y_off = jnp.einsum('bclgn,bcgrpn->bclgrp', cc, h_prev) * jnp.exp(acum)[..., None]
    y = (y_diag + y_off).reshape(bsz, length, n_heads, p_dim)
    return y, h_final.reshape(bsz, n_heads, p_dim, n_state)


def _layer(x, k_past, v_past, conv_past, ssm_past, pos0,
           norm_g, w_in, conv_w, conv_b, dt_bias, a_log, d_skip, ssm_norm,
           w_branch_a, w_branch_b, w_out, rel_bias):
    f32 = jnp.float32
    bsz, length, _ = x.shape
    h = _rmsnorm(x, norm_g)
    proj = jnp.einsum('bld,dn->bln', h, w_in)
    q, k, v, g_attn, z, xbc, dt_raw, gate_a, gate_b = jnp.split(proj, SPLIT_POINTS, axis=-1)

    q = q.reshape(bsz, length, N_HEADS_A, HEAD_DIM_A)
    k = k.reshape(bsz, length, N_HEADS_A, HEAD_DIM_A)
    v = v.reshape(bsz, length, N_HEADS_A, HEAD_DIM_A)
    k_all = jnp.concatenate([k_past.astype(k.dtype), k], axis=1)
    v_all = jnp.concatenate([v_past.astype(v.dtype), v], axis=1)
    k_pos0 = pos0 - k_past.shape[1]
    y_a = _dilated_attention(q, k_all, v_all, rel_bias, pos0, k_pos0).reshape(bsz, length, D_ATTN)
    y_a = y_a * jax.nn.silu(g_attn)

    xbc_c, conv_new = _causal_dwconv(xbc, conv_past, conv_w, conv_b)
    xbc_c = jax.nn.silu(xbc_c)
    xs, bm, cm = jnp.split(xbc_c, [D_SSM, D_SSM + SSM_GROUPS * D_STATE], axis=-1)
    xs = xs.reshape(bsz, length, N_SSM_HEADS, SSM_HEAD_DIM)
    bm = bm.reshape(bsz, length, SSM_GROUPS, D_STATE)
    cm = cm.reshape(bsz, length, SSM_GROUPS, D_STATE)
    dt = jax.nn.softplus(dt_raw.astype(f32) + dt_bias.astype(f32))
    a = -jnp.exp(a_log.astype(f32))
    y_s, ssm_new = _ssd(xs, dt, a, bm, cm, ssm_past)
    y_s = y_s + d_skip.astype(f32)[:, None] * xs.astype(f32)
    y_s = y_s.reshape(bsz, length, D_SSM) * jax.nn.silu(z.astype(f32))
    y_s = _group_rmsnorm(y_s, ssm_norm).astype(x.dtype)

    merged = (jax.nn.sigmoid(gate_a) * jnp.einsum('blc,cd->bld', y_a, w_branch_a)
              + jax.nn.sigmoid(gate_b) * jnp.einsum('blc,cd->bld', y_s, w_branch_b))
    out = x + jnp.einsum('bld,de->ble', merged, w_out)
    return out, k, v, conv_new, ssm_new


def setup_inputs(seed: int = 0) -> dict:
    key = jax.random.key(seed)
    ks = jax.random.split(key, 20)
    f32 = jnp.float32
    kv_buf = min(WINDOW_MAX, PAST_LEN)

    def nrm(k, shape, s):
        return jax.random.normal(k, shape, f32) * s

    dt0 = jnp.exp(jax.random.uniform(ks[11], (DEPTH, N_SSM_HEADS), f32, math.log(DT_MIN), math.log(DT_MAX)))
    return {
        'x_prompt': nrm(ks[0], (BATCH, SEQ, D_MODEL), 1.0),
        'x_sample': nrm(ks[1], (DEC_BATCH, DEC_SEQ, D_MODEL), 1.0),
        'cache_k': nrm(ks[2], (DEPTH, DEC_BATCH, kv_buf, N_HEADS_A, HEAD_DIM_A), 1.0),
        'cache_v': nrm(ks[3], (DEPTH, DEC_BATCH, kv_buf, N_HEADS_A, HEAD_DIM_A), 1.0),
        'state_conv': nrm(ks[4], (DEPTH, DEC_BATCH, CONV_WIDTH - 1, D_CONV), 1.0),
        'state_ssm': nrm(ks[5], (DEPTH, DEC_BATCH, N_SSM_HEADS, SSM_HEAD_DIM, D_STATE), 0.3),
        'norm_g': 1.0 + nrm(ks[6], (DEPTH, D_MODEL), 0.05),
        'w_in': nrm(ks[7], (DEPTH, D_MODEL, D_IN_PROJ), D_MODEL ** -0.5),
        'conv_w': nrm(ks[8], (DEPTH, CONV_WIDTH, D_CONV), CONV_WIDTH ** -0.5),
        'conv_b': nrm(ks[9], (DEPTH, D_CONV), 0.02),
        'dt_bias': dt0 + jnp.log(-jnp.expm1(-dt0)),
        'a_log': jnp.log(jax.random.uniform(ks[10], (DEPTH, N_SSM_HEADS), f32, 1.0, 16.0)),
        'd_skip': 1.0 + nrm(ks[12], (DEPTH, N_SSM_HEADS), 0.1),
        'ssm_norm': 1.0 + nrm(ks[13], (DEPTH, D_SSM), 0.05),
        'w_branch_a': nrm(ks[14], (DEPTH, D_ATTN, D_MODEL), D_ATTN ** -0.5),
        'w_branch_b': nrm(ks[15], (DEPTH, D_SSM, D_MODEL), D_SSM ** -0.5),
        'w_out': nrm(ks[16], (DEPTH, D_MODEL, D_MODEL), D_MODEL ** -0.5),
        'rel_bias': nrm(ks[17], (N_BUCKETS, N_HEADS_A), 0.5),
        'final_norm': 1.0 + nrm(ks[18], (D_MODEL,), 0.05),
    }


def reference(x_prompt, x_sample, cache_k, cache_v, state_conv, state_ssm,
              norm_g, w_in, conv_w, conv_b, dt_bias, a_log, d_skip, ssm_norm,
              w_branch_a, w_branch_b, w_out, rel_bias, final_norm):
    bp, lp = x_prompt.shape[0], x_prompt.shape[1]
    keep = min(WINDOW_MAX, lp)
    yp, ys = x_prompt, x_sample
    nk_p, nv_p, nc_p, ns_p = [], [], [], []
    nk_s, nv_s, nc_s, ns_s = [], [], [], []
    for layer in range(DEPTH):
        wts = (norm_g[layer], w_in[layer], conv_w[layer], conv_b[layer], dt_bias[layer],
               a_log[layer], d_skip[layer], ssm_norm[layer], w_branch_a[layer],
               w_branch_b[layer], w_out[layer], rel_bias)
        k0 = jnp.zeros((bp, 0, N_HEADS_A, HEAD_DIM_A), x_prompt.dtype)
        c0 = jnp.zeros((bp, CONV_WIDTH - 1, D_CONV), x_prompt.dtype)
        s0 = jnp.zeros((bp, N_SSM_HEADS, SSM_HEAD_DIM, D_STATE), jnp.float32)
        yp, kp, vp, cp, sp = _layer(yp, k0, k0, c0, s0, 0, *wts)
        nk_p.append(kp[:, lp - keep:])
        nv_p.append(vp[:, lp - keep:])
        nc_p.append(cp)
        ns_p.append(sp)
        ys, ks_, vs_, cs_, ss_ = _layer(ys, cache_k[layer], cache_v[layer], state_conv[layer],
                                        state_ssm[layer], PAST_LEN, *wts)
        nk_s.append(ks_)
        nv_s.append(vs_)
        nc_s.append(cs_)
        ns_s.append(ss_)
    y_prompt = _rmsnorm(yp, final_norm)
    y_sample = _rmsnorm(ys, final_norm)
    return (y_prompt, y_sample,
            jnp.stack(nk_p), jnp.stack(nv_p), jnp.stack(nc_p), jnp.stack(ns_p),
            jnp.stack(nk_s), jnp.stack(nv_s), jnp.stack(nc_s), jnp.stack(ns_s))
```

```cpp
#include <hip/hip_runtime.h>
#include <hip/hip_cooperative_groups.h>
#include <cstdio>
#include <cstdint>
namespace cg = cooperative_groups;
namespace pg8 {
#define PG8_LAS __attribute__((address_space(3)))
typedef unsigned short bf16_t;
typedef short bf16x8 __attribute__((ext_vector_type(8)));
typedef float f32x4 __attribute__((ext_vector_type(4)));
typedef unsigned u32x4 __attribute__((ext_vector_type(4)));
constexpr int BM = 256, BK = 64, HALF = 128, HTB = HALF * BK * 2  , STAGE_BYTES = 8 * HTB, NXCD = 8, WGM = 8;

__host__ __device__ __forceinline__ int lds_byte(int r, int c) { const int st = (r >> 4) * 2 + (c >> 5), rr = r & 15, cc = c & 31, ob = rr * 64 + cc * 2; return st * 1024 + (ob ^ (((ob >> 9) & 1) << 5)); }
__host__ __device__ __forceinline__ void stage_rc(int b, int& R, int& C) { const int st = b / 1024, sb = b % 1024, swz = sb ^ (((sb >> 9) & 1) << 5); R = (st >> 1) * 16 + swz / 64; C = (st & 1) * 32 + (swz % 64) / 2; }
__host__ __device__ __forceinline__ int perm32(int rho) { const int n = rho >> 4, i = rho & 15; return 8 * (i >> 2) + 4 * n + (i & 3); }

struct Unit { int pm, pn; };
struct Gemm { const bf16_t* A; const bf16_t* Bt; int M, N, K; };

struct StaticOrder {
    int nM, nN, nwg, G, c;
    __host__ __device__ void init(int M, int N, int G_, int c_) { nM = M / BM; nN = N / BM; nwg = nM * nN; G = G_; c = c_; }
    __host__ __device__ bool next(int i, Unit& u) const {
        const long L = (long)i * G + c; if (L >= nwg) return false;
        int wgid = (int)L; { const int q = nwg / NXCD, r = nwg % NXCD, xcd = wgid % NXCD, off = wgid / NXCD; wgid = (xcd < r ? xcd * (q + 1) : r * (q + 1) + (xcd - r) * q) + off; }
        const int nig = WGM * nN, gid = wgid / nig, fm = gid * WGM, gsz = (nM - fm) < WGM ? (nM - fm) : WGM;
        u.pm = fm + ((wgid % nig) % gsz); u.pn = (wgid % nig) / gsz; return true;
    }
    __device__ __forceinline__ void a_ready(const Unit&) const {}
    __device__ __forceinline__ void done(const Unit&) const {}
};

__device__ __forceinline__ unsigned cvt_pk_bf16(float lo, float hi) { unsigned r; asm volatile("v_cvt_pk_bf16_f32 %0, %1, %2" : "=v"(r) : "v"(lo), "v"(hi)); return r; }
__device__ __forceinline__ float e_bf2f(unsigned short b) { return __uint_as_float(((unsigned)b) << 16); }
__device__ __forceinline__ float e_sigmoid(float x) { return 1.f / (1.f + __expf(-x)); }
__device__ __forceinline__ float e_softplus(float x) { return fmaxf(x, 0.f) + log1pf(__expf(-fabsf(x))); }

struct EpiInProj {
    static constexpr bool PERM = true, AFTER_DRAIN = false;
    bf16_t* proj; float* dt; const float* dt_bias; float* kp; float* vp; float* ks; float* vs;
    __device__ __forceinline__ void operator()(const f32x4 (&acc)[2][2][4][2], const Unit& u, int wr, int wc, int fr, int fq) const {
        const int row0 = u.pm * BM + wr * 64 + fr;
        if (u.pn < 44) {
            const int col0 = u.pn * BM + wc * 32 + 8 * fq;
            const bool isk = (u.pn >= 3 && u.pn < 6), isv = (u.pn >= 6 && u.pn < 9);
#pragma unroll
            for (int ai = 0; ai < 2; ++ai)
#pragma unroll
                for (int m = 0; m < 4; ++m) { const int row = row0 + ai * HALF + m * 16; bf16_t* rowp = proj + (size_t)row * 11264 + col0;
#pragma unroll
                    for (int bj = 0; bj < 2; ++bj) { const f32x4 v0 = acc[ai][bj][m][0], v1 = acc[ai][bj][m][1];
                        u32x4 w; w.x = cvt_pk_bf16(v0[0], v0[1]); w.y = cvt_pk_bf16(v0[2], v0[3]); w.z = cvt_pk_bf16(v1[0], v1[1]); w.w = cvt_pk_bf16(v1[2], v1[3]);
                        *(u32x4*)(rowp + bj * HALF) = w;
                        if (isk || isv) { const int c = col0 + bj * HALF - (isk ? 768 : 1536);
                            float* dst = (u.pm < 64) ? ((isk ? kp : vp) + (size_t)row * 768 + c) : ((isk ? ks : vs) + (size_t)(row - 16384) * 768 + c);
                            *(f32x4*)dst = v0; *(f32x4*)(dst + 4) = v1; } } }
        } else if (wc == 0) {
            const f32x4 b0 = *(const f32x4*)(dt_bias + 8 * fq), b1 = *(const f32x4*)(dt_bias + 8 * fq + 4);
#pragma unroll
            for (int ai = 0; ai < 2; ++ai)
#pragma unroll
                for (int m = 0; m < 4; ++m) { const int row = row0 + ai * HALF + m * 16; const f32x4 v0 = acc[ai][0][m][0] + b0, v1 = acc[ai][0][m][1] + b1;
                    f32x4 o0, o1;
#pragma unroll
                    for (int j = 0; j < 4; ++j) { o0[j] = e_softplus(v0[j]); o1[j] = e_softplus(v1[j]); }
                    float* dst = dt + (size_t)row * 32 + 8 * fq; *(f32x4*)dst = o0; *(f32x4*)(dst + 4) = o1; }
        }
    }
};
struct EpiGateA {
    static constexpr bool PERM = true, AFTER_DRAIN = false;
    const bf16_t* proj; float* tmp;
    __device__ __forceinline__ void operator()(const f32x4 (&acc)[2][2][4][2], const Unit& u, int wr, int wc, int fr, int fq) const {
        const int row0 = u.pm * BM + wr * 64 + fr, col0 = u.pn * BM + wc * 32 + 8 * fq;
#pragma unroll
        for (int ai = 0; ai < 2; ++ai)
#pragma unroll
            for (int m = 0; m < 4; ++m) { const int row = row0 + ai * HALF + m * 16;
#pragma unroll
                for (int bj = 0; bj < 2; ++bj) { const int c = col0 + bj * HALF; const u32x4 g = *(const u32x4*)(proj + (size_t)row * 11264 + 9216 + c);
                    const f32x4 v0 = acc[ai][bj][m][0], v1 = acc[ai][bj][m][1]; f32x4 o0, o1;
                    o0[0] = e_sigmoid(__uint_as_float(g.x << 16)) * v0[0]; o0[1] = e_sigmoid(__uint_as_float(g.x & 0xffff0000u)) * v0[1];
                    o0[2] = e_sigmoid(__uint_as_float(g.y << 16)) * v0[2]; o0[3] = e_sigmoid(__uint_as_float(g.y & 0xffff0000u)) * v0[3];
                    o1[0] = e_sigmoid(__uint_as_float(g.z << 16)) * v1[0]; o1[1] = e_sigmoid(__uint_as_float(g.z & 0xffff0000u)) * v1[1];
                    o1[2] = e_sigmoid(__uint_as_float(g.w << 16)) * v1[2]; o1[3] = e_sigmoid(__uint_as_float(g.w & 0xffff0000u)) * v1[3];
                    float* dst = tmp + (size_t)row * 1024 + c; *(f32x4*)dst = o0; *(f32x4*)(dst + 4) = o1; } }
    }
};
struct EpiGateB {
    static constexpr bool PERM = true, AFTER_DRAIN = false;
    const bf16_t* proj; const float* tmp; bf16_t* mrg;
    __device__ __forceinline__ void operator()(const f32x4 (&acc)[2][2][4][2], const Unit& u, int wr, int wc, int fr, int fq) const {
        const int row0 = u.pm * BM + wr * 64 + fr, col0 = u.pn * BM + wc * 32 + 8 * fq;
#pragma unroll
        for (int ai = 0; ai < 2; ++ai)
#pragma unroll
            for (int m = 0; m < 4; ++m) { const int row = row0 + ai * HALF + m * 16;
#pragma unroll
                for (int bj = 0; bj < 2; ++bj) { const int c = col0 + bj * HALF; const u32x4 g = *(const u32x4*)(proj + (size_t)row * 11264 + 10240 + c);
                    const float* src = tmp + (size_t)row * 1024 + c; const f32x4 t0 = *(const f32x4*)src, t1 = *(const f32x4*)(src + 4);
                    const f32x4 v0 = acc[ai][bj][m][0], v1 = acc[ai][bj][m][1]; f32x4 o0, o1;
                    o0[0] = t0[0] + e_sigmoid(__uint_as_float(g.x << 16)) * v0[0]; o0[1] = t0[1] + e_sigmoid(__uint_as_float(g.x & 0xffff0000u)) * v0[1];
                    o0[2] = t0[2] + e_sigmoid(__uint_as_float(g.y << 16)) * v0[2]; o0[3] = t0[3] + e_sigmoid(__uint_as_float(g.y & 0xffff0000u)) * v0[3];
                    o1[0] = t1[0] + e_sigmoid(__uint_as_float(g.z << 16)) * v1[0]; o1[1] = t1[1] + e_sigmoid(__uint_as_float(g.z & 0xffff0000u)) * v1[1];
                    o1[2] = t1[2] + e_sigmoid(__uint_as_float(g.w << 16)) * v1[2]; o1[3] = t1[3] + e_sigmoid(__uint_as_float(g.w & 0xffff0000u)) * v1[3];
                    u32x4 w; w.x = cvt_pk_bf16(o0[0], o0[1]); w.y = cvt_pk_bf16(o0[2], o0[3]); w.z = cvt_pk_bf16(o1[0], o1[1]); w.w = cvt_pk_bf16(o1[2], o1[3]);
                    *(u32x4*)(mrg + (size_t)row * 1024 + c) = w; } }
    }
};
struct EpiOut {
    static constexpr bool PERM = false, AFTER_DRAIN = false;
    const float* xp; const float* xs; float* out;
    __device__ __forceinline__ void operator()(const f32x4 (&acc)[2][2][4][2], const Unit& u, int wr, int wc, int fr, int fq) const {
        const int row0 = u.pm * BM + wr * 64 + fr, col0 = u.pn * BM + wc * 32 + 4 * fq;
#pragma unroll
        for (int ai = 0; ai < 2; ++ai)
#pragma unroll
            for (int m = 0; m < 4; ++m) { const int row = row0 + ai * HALF + m * 16;
                const float* xr = (u.pm < 64) ? xp + (size_t)row * 1024 : xs + (size_t)(row - 16384) * 1024; float* orow = out + (size_t)row * 1024;
#pragma unroll
                for (int bj = 0; bj < 2; ++bj)
#pragma unroll
                    for (int n = 0; n < 2; ++n) { const int c = col0 + bj * HALF + n * 16; *(f32x4*)(orow + c) = *(const f32x4*)(xr + c) + acc[ai][bj][m][n]; } }
    }
};

template <class Epi, class Sched, bool ALIGN_EPI = false, bool SP2 = false>
__device__ __forceinline__ void gemm_phase(PG8_LAS unsigned char* lds, const Gemm g, const Sched& S, const Epi& E) {
    const int tid = threadIdx.x, wid = __builtin_amdgcn_readfirstlane(tid >> 6), lane = tid & 63, wr = wid >> 2, wc = wid & 3, fr = lane & 15, fq = lane >> 4;
    const int K = g.K, nt = K / BK;
    unsigned voffA[2], voffB[2];
#pragma unroll
    for (int i = 0; i < 2; ++i) { int R, C; stage_rc(tid * 16 + i * 8192, R, C); const int Rb = Epi::PERM ? ((R & ~31) + perm32(R & 31)) : R;
        voffA[i] = (unsigned)(R * K + C) * 2u; voffB[i] = (unsigned)(Rb * K + C) * 2u; }
    const size_t kstep = (size_t)(BK * 2);
    const size_t hstep = (size_t)HALF * K * 2;
    const size_t tstep = 2 * hstep;
    const unsigned ldsw = (unsigned)wid * 1024u;
    const int aoff = lds_byte(wr * 64 + fr, fq * 8), boff = lds_byte(wc * 32 + fr, fq * 8);
#define PG8_SA(b, h) (((b) * 2 + (h)) * HTB)
#define PG8_SB(b, h) ((4 + (b) * 2 + (h)) * HTB)
#define PG8_STAGE(bufoff, gbase, voff) do { _Pragma("unroll") for (int _i = 0; _i < 2; ++_i) \
        __builtin_amdgcn_global_load_lds((const unsigned*)((const char*)(gbase) + (voff)[_i]), (PG8_LAS unsigned*)(lds + (bufoff) + ldsw + _i * 8192), 16, 0, 0); } while (0)
#define PG8_LDA(dst, b, h) do { _Pragma("unroll") for (int m = 0; m < 4; ++m) _Pragma("unroll") for (int k = 0; k < 2; ++k) dst[m][k] = *(const PG8_LAS bf16x8*)(lds + PG8_SA(b, h) + aoff + m * 2048 + k * 1024); } while (0)
#define PG8_LDB(dst, b, h) do { _Pragma("unroll") for (int n = 0; n < 2; ++n) _Pragma("unroll") for (int k = 0; k < 2; ++k) dst[n][k] = *(const PG8_LAS bf16x8*)(lds + PG8_SB(b, h) + boff + n * 2048 + k * 1024); } while (0)
#define PG8_MMA(ai, bj, At, Bt) do { __builtin_amdgcn_s_setprio(1); _Pragma("unroll") for (int m = 0; m < 4; ++m) _Pragma("unroll") for (int n = 0; n < 2; ++n) _Pragma("unroll") for (int k = 0; k < 2; ++k) \
        acc[ai][bj][m][n] = __builtin_amdgcn_mfma_f32_16x16x32_bf16(Bt[n][k], At[m][k], acc[ai][bj][m][n], 0, 0, 0); __builtin_amdgcn_s_setprio(0); } while (0)
#define PG8_WAIT_V(n) asm volatile("s_waitcnt vmcnt(" #n ")" ::: "memory")
#define PG8_WAIT_L(n) asm volatile("s_waitcnt lgkmcnt(" #n ")" ::: "memory")
#define PG8_BAR __builtin_amdgcn_s_barrier()
#define PG8_SCHED __builtin_amdgcn_sched_barrier(0)
    Unit cur, nxt; int ui = 0;
    if (!S.next(0, cur)) return;
    f32x4 acc[2][2][4][2];
#pragma unroll
    for (int a = 0; a < 2; ++a)
#pragma unroll
        for (int b = 0; b < 2; ++b)
#pragma unroll
            for (int m = 0; m < 4; ++m)
#pragma unroll
                for (int n = 0; n < 2; ++n) acc[a][b][m][n] = (f32x4){0.f, 0.f, 0.f, 0.f};
    bf16x8 At[4][2], B0[2][2], B1[2][2];
    const char* cA = (const char*)g.A + (size_t)cur.pm * tstep; const char* cB = (const char*)g.Bt + (size_t)cur.pn * tstep;
    S.a_ready(cur);
    if constexpr (SP2) {
        PG8_STAGE(PG8_SB(0, 0), cB, voffB); PG8_STAGE(PG8_SB(0, 1), cB + hstep, voffB); PG8_STAGE(PG8_SA(0, 0), cA, voffA); PG8_STAGE(PG8_SA(0, 1), cA + hstep, voffA);
        if (wr == 1) PG8_BAR;
        PG8_WAIT_V(2); PG8_BAR;
        PG8_STAGE(PG8_SB(1, 0), cB + kstep, voffB); PG8_STAGE(PG8_SA(1, 0), cA + kstep, voffA); PG8_STAGE(PG8_SB(1, 1), cB + hstep + kstep, voffB);
        PG8_WAIT_V(6); PG8_BAR;
    } else {
        PG8_STAGE(PG8_SB(0, 0), cB, voffB); PG8_STAGE(PG8_SA(0, 0), cA, voffA); PG8_STAGE(PG8_SB(0, 1), cB + hstep, voffB); PG8_STAGE(PG8_SA(0, 1), cA + hstep, voffA);
        if (wr == 1) PG8_BAR;
        PG8_WAIT_V(4); PG8_BAR;
        PG8_STAGE(PG8_SB(1, 0), cB + kstep, voffB); PG8_STAGE(PG8_SA(1, 0), cA + kstep, voffA); PG8_STAGE(PG8_SB(1, 1), cB + hstep + kstep, voffB);
        PG8_WAIT_V(6); PG8_BAR;
    }
    for (;;) {
        const bool has_next = S.next(ui + 1, nxt);
        const char* nA = has_next ? (const char*)g.A + (size_t)nxt.pm * tstep : cA; const char* nB = has_next ? (const char*)g.Bt + (size_t)nxt.pn * tstep : cB;
        for (int t = 0; t < nt; t += 2) {
            const bool last = (t == nt - 2);
            const char* a1 = cA + (size_t)(t + 1) * kstep;
            const char* a2 = last ? nA : cA + (size_t)(t + 2) * kstep; const char* b2 = last ? nB : cB + (size_t)(t + 2) * kstep;
            const char* a3 = a2 + kstep; const char* b3 = b2 + kstep;
            if (last && has_next) S.a_ready(nxt);
            if constexpr (SP2) {
            PG8_LDB(B0, 0, 0); PG8_LDB(B1, 0, 1); PG8_SCHED; PG8_LDA(At, 0, 0); PG8_STAGE(PG8_SA(1, 1), a1 + hstep, voffA);
            PG8_WAIT_V(8); PG8_WAIT_L(0); PG8_BAR; PG8_MMA(0, 0, At, B0); PG8_MMA(0, 1, At, B1); PG8_BAR; PG8_SCHED;
            PG8_LDA(At, 0, 1); PG8_STAGE(PG8_SB(0, 0), b2, voffB); PG8_STAGE(PG8_SB(0, 1), b2 + hstep, voffB); PG8_STAGE(PG8_SA(0, 0), a2, voffA);
            PG8_WAIT_V(8); PG8_WAIT_L(0); PG8_BAR; PG8_MMA(1, 0, At, B0); PG8_MMA(1, 1, At, B1); PG8_BAR; PG8_SCHED;
            PG8_LDB(B0, 1, 0); PG8_LDB(B1, 1, 1); PG8_SCHED; PG8_LDA(At, 1, 0); PG8_STAGE(PG8_SA(0, 1), a2 + hstep, voffA);
            PG8_WAIT_V(8); PG8_WAIT_L(0); PG8_BAR; PG8_MMA(0, 0, At, B0); PG8_MMA(0, 1, At, B1); PG8_BAR; PG8_SCHED;
            PG8_LDA(At, 1, 1); PG8_STAGE(PG8_SB(1, 0), b3, voffB); PG8_STAGE(PG8_SB(1, 1), b3 + hstep, voffB); PG8_STAGE(PG8_SA(1, 0), a3, voffA);
            PG8_WAIT_V(8); PG8_WAIT_L(0); PG8_BAR; PG8_MMA(1, 0, At, B0); PG8_MMA(1, 1, At, B1); PG8_BAR; PG8_SCHED;
            } else {
            PG8_LDB(B0, 0, 0); PG8_SCHED; PG8_LDA(At, 0, 0); PG8_STAGE(PG8_SA(1, 1), a1 + hstep, voffA);
            PG8_WAIT_L(8); PG8_BAR; PG8_WAIT_L(0); PG8_MMA(0, 0, At, B0); PG8_BAR; PG8_SCHED;
            PG8_LDB(B1, 0, 1); PG8_STAGE(PG8_SB(0, 0), b2, voffB);
            PG8_BAR; PG8_WAIT_L(0); PG8_MMA(0, 1, At, B1); PG8_BAR;
            PG8_LDA(At, 0, 1); PG8_STAGE(PG8_SA(0, 0), a2, voffA);
            PG8_BAR; PG8_WAIT_L(0); PG8_MMA(1, 0, At, B0); PG8_BAR; PG8_SCHED;
            PG8_STAGE(PG8_SB(0, 1), b2 + hstep, voffB);
            PG8_WAIT_V(6); PG8_BAR; PG8_MMA(1, 1, At, B1); PG8_BAR;
            PG8_LDB(B0, 1, 0); PG8_SCHED; PG8_LDA(At, 1, 0); PG8_STAGE(PG8_SA(0, 1), a2 + hstep, voffA);
            PG8_WAIT_L(8); PG8_BAR; PG8_WAIT_L(0); PG8_MMA(0, 0, At, B0); PG8_BAR; PG8_SCHED;
            PG8_LDB(B1, 1, 1); PG8_STAGE(PG8_SB(1, 0), b3, voffB);
            PG8_BAR; PG8_WAIT_L(0); PG8_MMA(0, 1, At, B1); PG8_BAR;
            PG8_LDA(At, 1, 1); PG8_STAGE(PG8_SA(1, 0), a3, voffA);
            PG8_BAR; PG8_WAIT_L(0); PG8_MMA(1, 0, At, B0); PG8_BAR; PG8_SCHED;
            PG8_STAGE(PG8_SB(1, 1), b3 + hstep, voffB);
            PG8_WAIT_V(6); PG8_BAR; PG8_MMA(1, 1, At, B1); PG8_BAR;
            }
        }
        if constexpr (ALIGN_EPI) { if (wr == 0) PG8_BAR; }
        if constexpr (!Epi::AFTER_DRAIN) { E(acc, cur, wr, wc, fr, fq); S.done(cur); }
        if (!has_next) break;
#pragma unroll
        for (int a = 0; a < 2; ++a)
#pragma unroll
            for (int b = 0; b < 2; ++b)
#pragma unroll
                for (int m = 0; m < 4; ++m)
#pragma unroll
                    for (int n = 0; n < 2; ++n) acc[a][b][m][n] = (f32x4){0.f, 0.f, 0.f, 0.f};
        cur = nxt; cA = nA; cB = nB; ++ui;
        if constexpr (ALIGN_EPI) { if (wr == 1) PG8_BAR; }
    }
    PG8_WAIT_V(0);
    if constexpr (!ALIGN_EPI) { if (wr == 0) PG8_BAR; }
    PG8_BAR;
    if constexpr (Epi::AFTER_DRAIN) { E.fused(acc, cur, wr, wc, fr, fq, lds, wid, lane); S.done(cur); }
#undef PG8_SA
#undef PG8_SB
#undef PG8_STAGE
#undef PG8_LDA
#undef PG8_LDB
#undef PG8_MMA
#undef PG8_WAIT_V
#undef PG8_WAIT_L
#undef PG8_BAR
#undef PG8_SCHED
}
}

#define LAS __attribute__((address_space(3)))
typedef unsigned short bf16;
typedef float f32x4 __attribute__((ext_vector_type(4)));
typedef unsigned u32x4 __attribute__((ext_vector_type(4)));
typedef unsigned u32x2 __attribute__((ext_vector_type(2)));
constexpr int NWAVES = 8, NTHR = 512;
constexpr int DM = 1024, NBATCH = 8, SEQ = 2048, MP = NBATCH * SEQ, DECB = 32, DECS = 8, MS = DECB * DECS, MT = MP + MS;
constexpr int NH = 12, HD = 64, DA = NH * HD;
constexpr int DSSM = 2048, NSH = 32, SHD = 64, NGRP = 8, DST = 128, DCONV = 4096;
constexpr int PAST = 16384, KVB = 2048;
constexpr int NIN = 11296, NPROJ = 11264, NPAD = 11520;
constexpr int C_Q = 0, C_K = 768, C_V = 1536, C_G = 2304, C_Z = 3072, C_XBC = 5120, C_GA = 9216, C_GB = 10240;
constexpr size_t MiB = 1u << 20;
constexpr size_t WS_ARGS = 1 * MiB - 4096, WS_PRM = 1 * MiB, WS_WIN = 2 * MiB, WS_WA = 26 * MiB, WS_WB = 28 * MiB, WS_WO = 32 * MiB, WS_HB = 36 * MiB, WS_DT = 70 * MiB, WS_PROJ = 74 * MiB,
                 WS_YA = 432 * MiB, WS_YS = 458 * MiB, WS_SSQ = 524 * MiB, WS_TMP = 528 * MiB, WS_MRG = 594 * MiB, WS_END = 628 * MiB;
constexpr size_t O_YP = 0, O_YS = O_YP + (size_t)MP * DM, O_KP = O_YS + (size_t)MS * DM, O_VP = O_KP + (size_t)MP * DA, O_CP = O_VP + (size_t)MP * DA,
                 O_SP = O_CP + (size_t)NBATCH * 3 * DCONV, O_KS = O_SP + (size_t)NBATCH * NSH * SHD * DST, O_VS = O_KS + (size_t)MS * DA, O_CS = O_VS + (size_t)MS * DA,
                 O_SS = O_CS + (size_t)DECB * 3 * DCONV, O_END = O_SS + (size_t)DECB * NSH * SHD * DST;
constexpr int LDS_BYTES = 147456;
constexpr int PR_CONVW = 0, PR_CONVB = 16384, PR_DTB = 20480, PR_ALOG = 20512, PR_DSKIP = 20544, PR_RELB = 20576, PR_FNORM = 20992, PR_END = 22016;

struct Args {
    const float *x_prompt, *x_sample, *cache_k, *cache_v, *state_conv, *state_ssm, *norm_g, *w_in, *conv_w, *conv_b, *dt_bias, *a_log, *d_skip, *ssm_norm, *w_a, *w_b, *w_out, *rel_bias, *final_norm;
    float* out; unsigned char* ws;
};

__device__ __forceinline__ float bf2f(bf16 b) { return __uint_as_float(((unsigned)b) << 16); }
__device__ __forceinline__ unsigned f2bf(float f) { unsigned u = __float_as_uint(f); return (u + 0x7fffu + ((u >> 16) & 1u)) >> 16; }
__device__ __forceinline__ unsigned pk2(float lo, float hi) { return f2bf(lo) | (f2bf(hi) << 16); }
__device__ __forceinline__ float sigmoidf_(float x) { return 1.f / (1.f + __expf(-x)); }
__device__ __forceinline__ float siluf_(float x) { return x / (1.f + __expf(-x)); }
__device__ __forceinline__ float softplusf_(float x) { return fmaxf(x, 0.f) + log1pf(__expf(-fabsf(x))); }
__device__ __forceinline__ float wave_sum(float v) {
#pragma unroll
    for (int o = 1; o < 64; o <<= 1) v += __shfl_xor(v, o);
    return v;
}
__device__ __forceinline__ float wave_max(float v) {
#pragma unroll
    for (int o = 1; o < 64; o <<= 1) v = fmaxf(v, __shfl_xor(v, o));
    return v;
}
__device__ __forceinline__ int t5_bucket(int off) {
    if (off < 16) return off;
    return 16 + (off >= 22) + (off >= 30) + (off >= 40) + (off >= 54) + (off >= 73) + (off >= 99) + (off >= 134) + (off >= 182) + (off >= 246) + (off >= 332) + (off >= 450) + (off >= 609) + (off >= 825) + (off >= 1117) + (off >= 1513);
}
__device__ __forceinline__ const float* ld_ptr(const unsigned char* ws, int idx) { const unsigned long long v = ((const unsigned long long*)(ws + WS_ARGS))[idx];
    const unsigned lo = __builtin_amdgcn_readfirstlane((unsigned)v), hi = __builtin_amdgcn_readfirstlane((unsigned)(v >> 32)); return (const float*)(((unsigned long long)hi << 32) | lo); }
#define LDS_WAIT() asm volatile("s_waitcnt lgkmcnt(0)" ::: "memory")
__device__ __forceinline__ void p0_transpose_item(const float* W, int K, int N, bf16* WT, int k0, int n0, int dst_row0, const float* kscale, LAS float* scr, int lane) {
#pragma unroll 8
    for (int i = 0; i < 32; ++i) { const int kk = 2 * i + (lane >> 5); float v = W[(size_t)(k0 + kk) * N + n0 + (lane & 31)]; if (kscale) v *= kscale[k0 + kk]; scr[kk * 33 + (lane & 31)] = v; }
    LDS_WAIT(); asm volatile("" ::: "memory");
    const int c = lane & 7;
#pragma unroll
    for (int j = 0; j < 4; ++j) { const int n = (lane >> 3) + 8 * j; const LAS float* s = scr + (8 * c) * 33 + n;
        u32x4 o; o.x = pk2(s[0 * 33], s[1 * 33]); o.y = pk2(s[2 * 33], s[3 * 33]); o.z = pk2(s[4 * 33], s[5 * 33]); o.w = pk2(s[6 * 33], s[7 * 33]);
        *(u32x4*)(WT + (size_t)(dst_row0 + n) * K + k0 + 8 * c) = o; }
    LDS_WAIT(); asm volatile("" ::: "memory");
}
__device__ __forceinline__ void p0_prologue(const Args& a, LAS unsigned char* lds, int gw, int NGW, int wave, int lane) {
    bf16* win_t = (bf16*)(a.ws + WS_WIN); bf16* wa_t = (bf16*)(a.ws + WS_WA); bf16* wb_t = (bf16*)(a.ws + WS_WB); bf16* wo_t = (bf16*)(a.ws + WS_WO); bf16* hb = (bf16*)(a.ws + WS_HB);
    LAS float* scr = (LAS float*)(lds + wave * 16384);
    constexpr int I_IN = (DM / 64) * (NIN / 32), I_A = (DA / 64) * (DM / 32), I_B = (DSSM / 64) * (DM / 32), I_O = (DM / 64) * (DM / 32);
    for (int it = gw; it < I_IN + I_A + I_B + I_O; it += NGW) {
        int r = it;
        if (r < I_IN) { const int nblk = NIN / 32, kb = r / nblk, nb = r % nblk, n0 = nb * 32; const int dst = (n0 < 9216) ? n0 : (n0 == 9216 ? 11264 : n0 - 32);
            p0_transpose_item(a.w_in, DM, NIN, win_t, kb * 64, n0, dst, nullptr, scr, lane); continue; } r -= I_IN;
        if (r < I_A) { const int nblk = DM / 32, kb = r / nblk, nb = r % nblk; p0_transpose_item(a.w_a, DA, DM, wa_t, kb * 64, nb * 32, nb * 32, nullptr, scr, lane); continue; } r -= I_A;
        if (r < I_B) { const int nblk = DM / 32, kb = r / nblk, nb = r % nblk; p0_transpose_item(a.w_b, DSSM, DM, wb_t, kb * 64, nb * 32, nb * 32, a.ssm_norm, scr, lane); continue; } r -= I_B;
        { const int nblk = DM / 32, kb = r / nblk, nb = r % nblk; p0_transpose_item(a.w_out, DM, DM, wo_t, kb * 64, nb * 32, nb * 32, nullptr, scr, lane); }
    }
    { float* prm = (float*)(a.ws + WS_PRM); const int gt = gw * 64 + lane, NGT = NGW * 64;
      for (int i = gt; i < PR_END; i += NGT) { float v = 0.f;
          if (i < PR_CONVB) v = a.conv_w[i]; else if (i < PR_DTB) v = a.conv_b[i - PR_CONVB]; else if (i < PR_ALOG) v = a.dt_bias[i - PR_DTB]; else if (i < PR_DSKIP) v = a.a_log[i - PR_ALOG];
          else if (i < PR_RELB) v = a.d_skip[i - PR_DSKIP]; else if (i < PR_RELB + 384) v = a.rel_bias[i - PR_RELB]; else if (i >= PR_FNORM) v = a.final_norm[i - PR_FNORM];
          prm[i] = v; } }
    { u32x4* z = (u32x4*)(win_t + (size_t)11296 * DM); const int n16 = 224 * DM * 2 / 16; for (int i = gw * 64 + lane; i < n16; i += NGW * 64) z[i] = (u32x4){0u, 0u, 0u, 0u}; }
    for (int m = gw; m < MT; m += NGW) {
        const float* xrow = (m < MP) ? a.x_prompt + (size_t)m * DM : a.x_sample + (size_t)(m - MP) * DM;
        const f32x4* xr = (const f32x4*)xrow + lane; const f32x4* gr = (const f32x4*)a.norm_g + lane;
        f32x4 v[4]; float s = 0.f;
#pragma unroll
        for (int j = 0; j < 4; ++j) { v[j] = xr[64 * j]; s += (v[j].x * v[j].x + v[j].y * v[j].y) + (v[j].z * v[j].z + v[j].w * v[j].w); }
        const float rstd = rsqrtf(wave_sum(s) * (1.f / DM) + 1e-6f);
        unsigned long long* o8 = (unsigned long long*)(hb + (size_t)m * DM) + lane;
#pragma unroll
        for (int j = 0; j < 4; ++j) { const f32x4 g = gr[64 * j]; o8[64 * j] = (unsigned long long)pk2(v[j].x * rstd * g.x, v[j].y * rstd * g.y) | ((unsigned long long)pk2(v[j].z * rstd * g.z, v[j].w * rstd * g.w) << 32); }
    }
}

template <bool SAMP> __device__ __forceinline__ const void* kv_ptr(const Args& a, const bf16* proj, int colkv, const float* cache, int seq, int tpos, int off, int h, bool& valid, bool& isf32) {
    if (!SAMP) { const int kt = tpos - off; valid = kt >= 0; isf32 = false; return proj + (size_t)(seq * SEQ + (valid ? kt : 0)) * NPROJ + colkv + h * HD; }
    const int idx = KVB + tpos - off; valid = true;
    if (idx >= KVB) { isf32 = false; return proj + (size_t)(MP + seq * DECS + (idx - KVB)) * NPROJ + colkv + h * HD; }
    isf32 = true; return cache + ((size_t)(seq * KVB + idx) * NH + h) * HD;
}
template <bool SAMP> __device__ __forceinline__ void attn_slow_item(const Args& a, const bf16* proj, bf16* ya, LAS float* sl, int row, int h, int lane) {
    const float* prm = (const float*)(a.ws + WS_PRM);
    const int seq = SAMP ? (row - MP) / DECS : row / SEQ, tpos = SAMP ? (row - MP) % DECS : row % SEQ;
    float q[64];
    { const u32x4* qp = (const u32x4*)(proj + (size_t)row * NPROJ + C_Q + h * HD);
#pragma unroll
      for (int i = 0; i < 8; ++i) { const u32x4 w = qp[i]; q[8 * i + 0] = __uint_as_float(w.x << 16); q[8 * i + 1] = __uint_as_float(w.x & 0xffff0000u); q[8 * i + 2] = __uint_as_float(w.y << 16); q[8 * i + 3] = __uint_as_float(w.y & 0xffff0000u);
          q[8 * i + 4] = __uint_as_float(w.z << 16); q[8 * i + 5] = __uint_as_float(w.z & 0xffff0000u); q[8 * i + 6] = __uint_as_float(w.w << 16); q[8 * i + 7] = __uint_as_float(w.w & 0xffff0000u); } }
    float mx = -INFINITY;
#pragma unroll 1
    for (int e = lane; e < 387; e += 64) {
        float sc = -INFINITY;
        const int g = e / 129, j = e - g * 129, off = j << (2 * g); bool valid, isf32;
        const void* kp = kv_ptr<SAMP>(a, proj, C_K, a.cache_k, seq, tpos, off, h, valid, isf32);
        if (valid) { float d = 0.f;
            if (isf32) { const f32x4* k4 = (const f32x4*)kp;
#pragma unroll
                for (int i = 0; i < 16; ++i) { const f32x4 kk = k4[i]; d += q[4 * i] * kk.x + q[4 * i + 1] * kk.y + q[4 * i + 2] * kk.z + q[4 * i + 3] * kk.w; } }
            else { const u32x4* k4 = (const u32x4*)kp;
#pragma unroll
                for (int i = 0; i < 8; ++i) { const u32x4 w = k4[i];
                    d += q[8 * i + 0] * __uint_as_float(w.x << 16) + q[8 * i + 1] * __uint_as_float(w.x & 0xffff0000u) + q[8 * i + 2] * __uint_as_float(w.y << 16) + q[8 * i + 3] * __uint_as_float(w.y & 0xffff0000u)
                       + q[8 * i + 4] * __uint_as_float(w.z << 16) + q[8 * i + 5] * __uint_as_float(w.z & 0xffff0000u) + q[8 * i + 6] * __uint_as_float(w.w << 16) + q[8 * i + 7] * __uint_as_float(w.w & 0xffff0000u); } }
            sc = d * 0.125f + prm[PR_RELB + t5_bucket(off) * NH + h]; }
        sl[e] = sc; mx = fmaxf(mx, sc);
    }
    mx = wave_max(mx);
    float sum = 0.f;
#pragma unroll 1
    for (int e = lane; e < 387; e += 64) { const float sc = sl[e]; const float pe = (sc == -INFINITY) ? 0.f : __expf(sc - mx); sl[e] = pe; sum += pe; }
    sum = wave_sum(sum);
    LDS_WAIT(); asm volatile("" ::: "memory");
    float o = 0.f;
#pragma unroll 4
    for (int e = 0; e < 387; ++e) {
        const int g = e / 129, j = e - g * 129, off = j << (2 * g); bool valid, isf32;
        const void* vp = kv_ptr<SAMP>(a, proj, C_V, a.cache_v, seq, tpos, off, h, valid, isf32);
        const float pe = sl[e];
        if (valid) { const float vv = isf32 ? ((const float*)vp)[lane] : bf2f(((const bf16*)vp)[lane]); o += pe * vv; }
    }
    LDS_WAIT(); asm volatile("" ::: "memory");
    const float gv = bf2f(proj[(size_t)row * NPROJ + C_G + h * HD + lane]);
    ya[(size_t)row * DA + h * HD + lane] = (bf16)f2bf(o / sum * siluf_(gv));
}

__device__ __forceinline__ void ssd_slow_item(const Args& a, LAS unsigned char* lds, int item) {
    const bf16* proj = (const bf16*)(a.ws + WS_PROJ); const float* dtb = (const float*)(a.ws + WS_DT); bf16* ys = (bf16*)(a.ws + WS_YS); float* ssq = (float*)(a.ws + WS_SSQ);
    const int tid = threadIdx.x, lane = tid & 63, wid = tid >> 6;
    const bool samp = item >= NBATCH * NSH; const int it2 = samp ? item - NBATCH * NSH : item; const int sq = it2 / NSH, hd = it2 % NSH, grp = hd / 4;
    const int L = samp ? DECS : SEQ, row0 = samp ? MP + sq * DECS : sq * SEQ;
    const int p = tid >> 3, n0 = (tid & 7) * 16;
    float h[16];
    if (samp) { const f32x4* s4 = (const f32x4*)(a.state_ssm + ((size_t)(sq * NSH + hd) * SHD + p) * DST + n0);
#pragma unroll
        for (int j = 0; j < 4; ++j) { const f32x4 v = s4[j]; h[4 * j] = v.x; h[4 * j + 1] = v.y; h[4 * j + 2] = v.z; h[4 * j + 3] = v.w; } }
    else {
#pragma unroll
        for (int j = 0; j < 16; ++j) h[j] = 0.f; }
    const float* prm = (const float*)(a.ws + WS_PRM);
    const float Aneg = -__expf(prm[PR_ALOG + hd]), Dk = prm[PR_DSKIP + hd];
    LAS float* xs = (LAS float*)lds;
    LAS float* Bs = xs + 64 * 64;
    LAS float* Cs = Bs + 64 * 128;
    LAS float* dts = Cs + 64 * 128;
    LAS float* dAs = dts + 64;
    LAS float* yb = dAs + 64;
    for (int c0 = 0; c0 < L; c0 += 64) {
        const int tc = (L - c0) < 64 ? (L - c0) : 64;
        for (int idx = tid; idx < tc * 320; idx += NTHR) {
            const int t = idx / 320, c = idx - t * 320;
            const int xc = c < 64 ? hd * 64 + c : (c < 192 ? DSSM + grp * DST + (c - 64) : DSSM + NGRP * DST + grp * DST + (c - 192));
            float acc = prm[PR_CONVB + xc];
#pragma unroll
            for (int tap = 0; tap < 4; ++tap) { const int tt = c0 + t - 3 + tap; float v;
                if (tt >= 0) v = bf2f(proj[(size_t)(row0 + tt) * NPROJ + C_XBC + xc]);
                else v = samp ? a.state_conv[(size_t)(sq * 3 + 3 + tt) * DCONV + xc] : 0.f;
                acc += prm[PR_CONVW + tap * DCONV + xc] * v; }
            const float val = siluf_(acc);
            if (c < 64) xs[t * 64 + c] = val; else if (c < 192) Bs[t * 128 + (c - 64)] = val; else Cs[t * 128 + (c - 192)] = val;
        }
        if (tid < tc) { const float dtv = dtb[(size_t)(row0 + c0 + tid) * 32 + hd]; dts[tid] = dtv; dAs[tid] = __expf(dtv * Aneg); }
        __syncthreads();
        for (int t = 0; t < tc; ++t) {
            const float dA = dAs[t], xv = xs[t * 64 + p], dtx = dts[t] * xv; float acc = 0.f;
            const LAS f32x4* b4 = (const LAS f32x4*)(Bs + t * 128 + n0); const LAS f32x4* c4 = (const LAS f32x4*)(Cs + t * 128 + n0);
#pragma unroll
            for (int j = 0; j < 4; ++j) { const f32x4 bb = b4[j], cc = c4[j];
                h[4 * j] = dA * h[4 * j] + dtx * bb.x; h[4 * j + 1] = dA * h[4 * j + 1] + dtx * bb.y; h[4 * j + 2] = dA * h[4 * j + 2] + dtx * bb.z; h[4 * j + 3] = dA * h[4 * j + 3] + dtx * bb.w;
                acc += h[4 * j] * cc.x + h[4 * j + 1] * cc.y + h[4 * j + 2] * cc.z + h[4 * j + 3] * cc.w; }
            acc += __shfl_xor(acc, 1); acc += __shfl_xor(acc, 2); acc += __shfl_xor(acc, 4);
            if ((tid & 7) == 0) yb[t * 64 + p] = acc + Dk * xv;
        }
        __syncthreads();
        for (int t = wid; t < tc; t += NWAVES) {
            const int row = row0 + c0 + t; const float z = bf2f(proj[(size_t)row * NPROJ + C_Z + hd * 64 + lane]);
            const float val = yb[t * 64 + lane] * siluf_(z);
            ys[(size_t)row * DSSM + hd * 64 + lane] = (bf16)f2bf(val);
            const float ss = wave_sum(val * val); if (lane == 0) ssq[(size_t)row * NSH + hd] = ss;
        }
        __syncthreads();
    }
    float* dst = a.out + (samp ? O_SS : O_SP) + ((size_t)(sq * NSH + hd) * SHD + p) * DST + n0;
#pragma unroll
    for (int j = 0; j < 4; ++j) ((f32x4*)dst)[j] = (f32x4){h[4 * j], h[4 * j + 1], h[4 * j + 2], h[4 * j + 3]};
}

__device__ __forceinline__ void p2_slow(const Args& a, LAS unsigned char* lds, int G, int wave, int lane) {
    const bf16* proj = (const bf16*)(a.ws + WS_PROJ); bf16* ya = (bf16*)(a.ws + WS_YA);
    for (int item = blockIdx.x; item < NBATCH * NSH + DECB * NSH; item += G) ssd_slow_item(a, lds, item);
    const int gw = blockIdx.x * NWAVES + wave, NGW = G * NWAVES; LAS float* sl = (LAS float*)(lds + 100 * 1024 + wave * 2048);
    for (int it = gw; it < MT * NH; it += NGW) { const int row = it / NH, h = it - row * NH; if (row < MP) attn_slow_item<false>(a, proj, ya, sl, row, h, lane); else attn_slow_item<true>(a, proj, ya, sl, row, h, lane); }
    const int gt = blockIdx.x * NTHR + threadIdx.x, NGT = G * NTHR;
    for (int i = gt; i < (NBATCH + DECB) * 3 * DCONV; i += NGT) { const int c = i % DCONV, r = (i / DCONV) % 3, sq = i / (3 * DCONV);
        if (sq < NBATCH) a.out[O_CP + (size_t)(sq * 3 + r) * DCONV + c] = bf2f(proj[(size_t)(sq * SEQ + SEQ - 3 + r) * NPROJ + C_XBC + c]);
        else { const int s2 = sq - NBATCH; a.out[O_CS + (size_t)(s2 * 3 + r) * DCONV + c] = bf2f(proj[(size_t)(MP + s2 * DECS + DECS - 3 + r) * NPROJ + C_XBC + c]); } }
}
__device__ __forceinline__ void p25_norm(const Args& a, int gw, int NGW, int lane) {
    bf16* ys = (bf16*)(a.ws + WS_YS); const float* ssq = (const float*)(a.ws + WS_SSQ);
    for (int m = gw; m < MT; m += NGW) {
        const float sv = (lane < 32) ? ssq[(size_t)m * NSH + lane] : 0.f;
        float gs = sv + __shfl_xor(sv, 1); gs += __shfl_xor(gs, 2);
        const float rstd = rsqrtf(gs * (1.f / 256.f) + 1e-5f);
        u32x4* r4 = (u32x4*)(ys + (size_t)m * DSSM);
#pragma unroll
        for (int j = 0; j < 4; ++j) { const int ci = j * 64 + lane, g = ci >> 5; const float sc = __shfl(rstd, 4 * g); u32x4 w = r4[ci];
            w.x = pk2(__uint_as_float(w.x << 16) * sc, __uint_as_float(w.x & 0xffff0000u) * sc); w.y = pk2(__uint_as_float(w.y << 16) * sc, __uint_as_float(w.y & 0xffff0000u) * sc);
            w.z = pk2(__uint_as_float(w.z << 16) * sc, __uint_as_float(w.z & 0xffff0000u) * sc); w.w = pk2(__uint_as_float(w.w << 16) * sc, __uint_as_float(w.w & 0xffff0000u) * sc); r4[ci] = w; }
    }
}
__device__ __forceinline__ void p5_final_norm(const Args& a, int gw, int NGW, int lane) {
    for (int m = gw; m < MT; m += NGW) {
        f32x4* xr = (f32x4*)(a.out + (size_t)m * DM) + lane; const f32x4* gr = (const f32x4*)((const float*)(a.ws + WS_PRM) + PR_FNORM) + lane;
        f32x4 v[4]; float s = 0.f;
#pragma unroll
        for (int j = 0; j < 4; ++j) { v[j] = xr[64 * j]; s += (v[j].x * v[j].x + v[j].y * v[j].y) + (v[j].z * v[j].z + v[j].w * v[j].w); }
        const float rstd = rsqrtf(wave_sum(s) * (1.f / DM) + 1e-6f);
#pragma unroll
        for (int j = 0; j < 4; ++j) { const f32x4 g = gr[64 * j]; xr[64 * j] = v[j] * rstd * g; }
    }
}
#define GEMM_PHASE(EpiT, Aptr, Bptr, Mrows, Ncols, Kdim, Eobj) do { pg8::Gemm g_{(const pg8::bf16_t*)(Aptr), (const pg8::bf16_t*)(Bptr), (Mrows), (Ncols), (Kdim)}; pg8::StaticOrder S_; S_.init((Mrows), (Ncols), G, (int)blockIdx.x); \
    pg8::gemm_phase<EpiT, pg8::StaticOrder, true, true>(lds, g_, S_, (Eobj)); } while (0)

__global__ void __launch_bounds__(NTHR, 2) fwd_megakernel(Args a) {
    extern __shared__ __attribute__((aligned(16))) unsigned char lds_raw[];
    LAS unsigned char* lds = (LAS unsigned char*)lds_raw;
    cg::grid_group grid = cg::this_grid();
    const int tid = threadIdx.x, lane = tid & 63, wave = __builtin_amdgcn_readfirstlane(tid >> 6);
    const int G = gridDim.x, gw = blockIdx.x * NWAVES + wave, NGW = G * NWAVES;
    unsigned char* ws = a.ws;

    p0_prologue(a, lds, gw, NGW, wave, lane);
    if (blockIdx.x == 0 && tid == 0) { const float** pp = (const float**)(ws + WS_ARGS); pp[0] = a.x_prompt; pp[1] = a.x_sample; pp[2] = a.cache_k; pp[3] = a.cache_v; pp[4] = a.state_conv; pp[5] = a.state_ssm; }
    grid.sync();
    { pg8::EpiInProj E{(pg8::bf16_t*)(ws + WS_PROJ), (float*)(ws + WS_DT), (const float*)(ws + WS_PRM) + PR_DTB, a.out + O_KP, a.out + O_VP, a.out + O_KS, a.out + O_VS};
      GEMM_PHASE(pg8::EpiInProj, ws + WS_HB, ws + WS_WIN, MT, NPAD, DM, E); }
    grid.sync();
    { Args b{}; b.ws = ws; b.out = a.out; b.cache_k = ld_ptr(ws, 2); b.cache_v = ld_ptr(ws, 3); b.state_conv = ld_ptr(ws, 4); b.state_ssm = ld_ptr(ws, 5); p2_slow(b, lds, G, wave, lane); }
    grid.sync();
    p25_norm(a, gw, NGW, lane);
    grid.sync();
    { pg8::EpiGateA E{(const pg8::bf16_t*)(ws + WS_PROJ), (float*)(ws + WS_TMP)}; GEMM_PHASE(pg8::EpiGateA, ws + WS_YA, ws + WS_WA, MT, DM, DA, E); }
    { pg8::EpiGateB E{(const pg8::bf16_t*)(ws + WS_PROJ), (const float*)(ws + WS_TMP), (pg8::bf16_t*)(ws + WS_MRG)}; GEMM_PHASE(pg8::EpiGateB, ws + WS_YS, ws + WS_WB, MT, DM, DSSM, E); }
    grid.sync();
    { pg8::EpiOut E{ld_ptr(ws, 0), ld_ptr(ws, 1), a.out + O_YP}; GEMM_PHASE(pg8::EpiOut, ws + WS_MRG, ws + WS_WO, MT, DM, DM, E); }
    grid.sync();
    p5_final_norm(a, gw, NGW, lane);
}

extern "C" void kernel_launch(void* const* d_in, const int* in_sizes, int n_in, void* d_out, int out_size, void* d_ws, size_t ws_size, hipStream_t stream) {
    static int grid_blocks = 0;
    if (grid_blocks == 0) {
        if (n_in != 19 || (size_t)out_size != O_END || ws_size < WS_END) { fprintf(stderr, "kernel_launch: unexpected shapes: n_in %d out %d (want %zu) ws %zu (want >= %zu)\n", n_in, out_size, (size_t)O_END, ws_size, (size_t)WS_END); grid_blocks = -1; return; }
        int dev = 0, cus = 0, per_cu = 0;
        hipGetDevice(&dev); hipDeviceGetAttribute(&cus, hipDeviceAttributeMultiprocessorCount, dev);
        if (hipFuncSetAttribute((const void*)fwd_megakernel, hipFuncAttributeMaxDynamicSharedMemorySize, LDS_BYTES) != hipSuccess) { fprintf(stderr, "kernel_launch: hipFuncSetAttribute failed\n"); grid_blocks = -1; return; }
        if (hipOccupancyMaxActiveBlocksPerMultiprocessor(&per_cu, (const void*)fwd_megakernel, NTHR, LDS_BYTES) != hipSuccess || per_cu < 1) { fprintf(stderr, "kernel_launch: occupancy query failed (%d)\n", per_cu); (void)hipGetLastError(); per_cu = 1; }
        if (per_cu > 1) per_cu = 1;
        grid_blocks = cus * per_cu;
        fprintf(stderr, "kernel_launch: grid %d (cus %d)\n", grid_blocks, cus);
    }
    if (grid_blocks < 0) return;
    Args a{};
    a.x_prompt = (const float*)d_in[0]; a.x_sample = (const float*)d_in[1]; a.cache_k = (const float*)d_in[2]; a.cache_v = (const float*)d_in[3]; a.state_conv = (const float*)d_in[4]; a.state_ssm = (const float*)d_in[5];
    a.norm_g = (const float*)d_in[6]; a.w_in = (const float*)d_in[7]; a.conv_w = (const float*)d_in[8]; a.conv_b = (const float*)d_in[9]; a.dt_bias = (const float*)d_in[10]; a.a_log = (const float*)d_in[11];
    a.d_skip = (const float*)d_in[12]; a.ssm_norm = (const float*)d_in[13]; a.w_a = (const float*)d_in[14]; a.w_b = (const float*)d_in[15]; a.w_out = (const float*)d_in[16]; a.rel_bias = (const float*)d_in[17]; a.final_norm = (const float*)d_in[18];
    a.out = (float*)d_out; a.ws = (unsigned char*)d_ws;
    void* args[] = {&a};
    hipError_t e = hipLaunchCooperativeKernel((const void*)fwd_megakernel, dim3(grid_blocks), dim3(NTHR), args, LDS_BYTES, stream);
    if (e != hipSuccess) fprintf(stderr, "kernel_launch: cooperative launch failed: %s (grid %d)\n", hipGetErrorString(e), grid_blocks);
}
```

```cpp
#include <hip/hip_runtime.h>
#include <hip/hip_cooperative_groups.h>
#include <cstdio>
#include <cstdint>
namespace cg = cooperative_groups;
namespace pg8 {
#define PG8_LAS __attribute__((address_space(3)))
typedef unsigned short bf16_t;
typedef short bf16x8 __attribute__((ext_vector_type(8)));
typedef float f32x4 __attribute__((ext_vector_type(4)));
typedef unsigned u32x4 __attribute__((ext_vector_type(4)));
constexpr int BM = 256, BK = 64, HALF = 128, HTB = HALF * BK * 2  , STAGE_BYTES = 8 * HTB, NXCD = 8, WGM = 8;

__host__ __device__ __forceinline__ int lds_byte(int r, int c) { const int st = (r >> 4) * 2 + (c >> 5), rr = r & 15, cc = c & 31, ob = rr * 64 + cc * 2; return st * 1024 + (ob ^ (((ob >> 9) & 1) << 5)); }
__host__ __device__ __forceinline__ void stage_rc(int b, int& R, int& C) { const int st = b / 1024, sb = b % 1024, swz = sb ^ (((sb >> 9) & 1) << 5); R = (st >> 1) * 16 + swz / 64; C = (st & 1) * 32 + (swz % 64) / 2; }
__host__ __device__ __forceinline__ int perm32(int rho) { const int n = rho >> 4, i = rho & 15; return 8 * (i >> 2) + 4 * n + (i & 3); }

struct Unit { int pm, pn; };
struct Gemm { const bf16_t* A; const bf16_t* Bt; int M, N, K; };

struct StaticOrder {
    int nM, nN, nwg, G, c;
    __host__ __device__ void init(int M, int N, int G_, int c_) { nM = M / BM; nN = N / BM; nwg = nM * nN; G = G_; c = c_; }
    __host__ __device__ bool next(int i, Unit& u) const {
        const long L = (long)i * G + c; if (L >= nwg) return false;
        int wgid = (int)L; { const int q = nwg / NXCD, r = nwg % NXCD, xcd = wgid % NXCD, off = wgid / NXCD; wgid = (xcd < r ? xcd * (q + 1) : r * (q + 1) + (xcd - r) * q) + off; }
        const int nig = WGM * nN, gid = wgid / nig, fm = gid * WGM, gsz = (nM - fm) < WGM ? (nM - fm) : WGM;
        u.pm = fm + ((wgid % nig) % gsz); u.pn = (wgid % nig) / gsz; return true;
    }
    __device__ __forceinline__ void a_ready(const Unit&) const {}
    __device__ __forceinline__ void done(const Unit&) const {}
};

__device__ __forceinline__ unsigned cvt_pk_bf16(float lo, float hi) { unsigned r; asm volatile("v_cvt_pk_bf16_f32 %0, %1, %2" : "=v"(r) : "v"(lo), "v"(hi)); return r; }
__device__ __forceinline__ float e_bf2f(unsigned short b) { return __uint_as_float(((unsigned)b) << 16); }
__device__ __forceinline__ float e_sigmoid(float x) { return 1.f / (1.f + __expf(-x)); }
__device__ __forceinline__ float e_softplus(float x) { return fmaxf(x, 0.f) + log1pf(__expf(-fabsf(x))); }

struct EpiInProj {
    static constexpr bool PERM = true, AFTER_DRAIN = false;
    bf16_t* proj; float* dt; const float* dt_bias; float* kp; float* vp; float* ks; float* vs;
    __device__ __forceinline__ void operator()(const f32x4 (&acc)[2][2][4][2], const Unit& u, int wr, int wc, int fr, int fq) const {
        const int row0 = u.pm * BM + wr * 64 + fr;
        if (u.pn < 44) {
            const int col0 = u.pn * BM + wc * 32 + 8 * fq;
            const bool isk = (u.pn >= 3 && u.pn < 6), isv = (u.pn >= 6 && u.pn < 9);
#pragma unroll
            for (int ai = 0; ai < 2; ++ai)
#pragma unroll
                for (int m = 0; m < 4; ++m) { const int row = row0 + ai * HALF + m * 16; bf16_t* rowp = proj + (size_t)row * 11264 + col0;
#pragma unroll
                    for (int bj = 0; bj < 2; ++bj) { const f32x4 v0 = acc[ai][bj][m][0], v1 = acc[ai][bj][m][1];
                        u32x4 w; w.x = cvt_pk_bf16(v0[0], v0[1]); w.y = cvt_pk_bf16(v0[2], v0[3]); w.z = cvt_pk_bf16(v1[0], v1[1]); w.w = cvt_pk_bf16(v1[2], v1[3]);
                        *(u32x4*)(rowp + bj * HALF) = w;
                        if (isk || isv) { const int c = col0 + bj * HALF - (isk ? 768 : 1536);
                            float* dst = (u.pm < 64) ? ((isk ? kp : vp) + (size_t)row * 768 + c) : ((isk ? ks : vs) + (size_t)(row - 16384) * 768 + c);
                            *(f32x4*)dst = v0; *(f32x4*)(dst + 4) = v1; } } }
        } else if (wc == 0) {
            const f32x4 b0 = *(const f32x4*)(dt_bias + 8 * fq), b1 = *(const f32x4*)(dt_bias + 8 * fq + 4);
#pragma unroll
            for (int ai = 0; ai < 2; ++ai)
#pragma unroll
                for (int m = 0; m < 4; ++m) { const int row = row0 + ai * HALF + m * 16; const f32x4 v0 = acc[ai][0][m][0] + b0, v1 = acc[ai][0][m][1] + b1;
                    f32x4 o0, o1;
#pragma unroll
                    for (int j = 0; j < 4; ++j) { o0[j] = e_softplus(v0[j]); o1[j] = e_softplus(v1[j]); }
                    float* dst = dt + (size_t)row * 32 + 8 * fq; *(f32x4*)dst = o0; *(f32x4*)(dst + 4) = o1; }
        }
    }
};
struct EpiGateA {
    static constexpr bool PERM = true, AFTER_DRAIN = false;
    const bf16_t* proj; float* tmp;
    __device__ __forceinline__ void operator()(const f32x4 (&acc)[2][2][4][2], const Unit& u, int wr, int wc, int fr, int fq) const {
        const int row0 = u.pm * BM + wr * 64 + fr, col0 = u.pn * BM + wc * 32 + 8 * fq;
#pragma unroll
        for (int ai = 0; ai < 2; ++ai)
#pragma unroll
            for (int m = 0; m < 4; ++m) { const int row = row0 + ai * HALF + m * 16;
#pragma unroll
                for (int bj = 0; bj < 2; ++bj) { const int c = col0 + bj * HALF; const u32x4 g = *(const u32x4*)(proj + (size_t)row * 11264 + 9216 + c);
                    const f32x4 v0 = acc[ai][bj][m][0], v1 = acc[ai][bj][m][1]; f32x4 o0, o1;
                    o0[0] = e_sigmoid(__uint_as_float(g.x << 16)) * v0[0]; o0[1] = e_sigmoid(__uint_as_float(g.x & 0xffff0000u)) * v0[1];
                    o0[2] = e_sigmoid(__uint_as_float(g.y << 16)) * v0[2]; o0[3] = e_sigmoid(__uint_as_float(g.y & 0xffff0000u)) * v0[3];
                    o1[0] = e_sigmoid(__uint_as_float(g.z << 16)) * v1[0]; o1[1] = e_sigmoid(__uint_as_float(g.z & 0xffff0000u)) * v1[1];
                    o1[2] = e_sigmoid(__uint_as_float(g.w << 16)) * v1[2]; o1[3] = e_sigmoid(__uint_as_float(g.w & 0xffff0000u)) * v1[3];
                    float* dst = tmp + (size_t)row * 1024 + c; *(f32x4*)dst = o0; *(f32x4*)(dst + 4) = o1; } }
    }
};
struct EpiGateB {
    static constexpr bool PERM = true, AFTER_DRAIN = false;
    const bf16_t* proj; const float* tmp; bf16_t* mrg;
    __device__ __forceinline__ void operator()(const f32x4 (&acc)[2][2][4][2], const Unit& u, int wr, int wc, int fr, int fq) const {
        const int row0 = u.pm * BM + wr * 64 + fr, col0 = u.pn * BM + wc * 32 + 8 * fq;
#pragma unroll
        for (int ai = 0; ai < 2; ++ai)
#pragma unroll
            for (int m = 0; m < 4; ++m) { const int row = row0 + ai * HALF + m * 16;
#pragma unroll
                for (int bj = 0; bj < 2; ++bj) { const int c = col0 + bj * HALF; const u32x4 g = *(const u32x4*)(proj + (size_t)row * 11264 + 10240 + c);
                    const float* src = tmp + (size_t)row * 1024 + c; const f32x4 t0 = *(const f32x4*)src, t1 = *(const f32x4*)(src + 4);
                    const f32x4 v0 = acc[ai][bj][m][0], v1 = acc[ai][bj][m][1]; f32x4 o0, o1;
                    o0[0] = t0[0] + e_sigmoid(__uint_as_float(g.x << 16)) * v0[0]; o0[1] = t0[1] + e_sigmoid(__uint_as_float(g.x & 0xffff0000u)) * v0[1];
                    o0[2] = t0[2] + e_sigmoid(__uint_as_float(g.y << 16)) * v0[2]; o0[3] = t0[3] + e_sigmoid(__uint_as_float(g.y & 0xffff0000u)) * v0[3];
                    o1[0] = t1[0] + e_sigmoid(__uint_as_float(g.z << 16)) * v1[0]; o1[1] = t1[1] + e_sigmoid(__uint_as_float(g.z & 0xffff0000u)) * v1[1];
                    o1[2] = t1[2] + e_sigmoid(__uint_as_float(g.w << 16)) * v1[2]; o1[3] = t1[3] + e_sigmoid(__uint_as_float(g.w & 0xffff0000u)) * v1[3];
                    u32x4 w; w.x = cvt_pk_bf16(o0[0], o0[1]); w.y = cvt_pk_bf16(o0[2], o0[3]); w.z = cvt_pk_bf16(o1[0], o1[1]); w.w = cvt_pk_bf16(o1[2], o1[3]);
                    *(u32x4*)(mrg + (size_t)row * 1024 + c) = w; } }
    }
};
struct EpiOut {
    static constexpr bool PERM = false, AFTER_DRAIN = false;
    const float* xp; const float* xs; float* out;
    __device__ __forceinline__ void operator()(const f32x4 (&acc)[2][2][4][2], const Unit& u, int wr, int wc, int fr, int fq) const {
        const int row0 = u.pm * BM + wr * 64 + fr, col0 = u.pn * BM + wc * 32 + 4 * fq;
#pragma unroll
        for (int ai = 0; ai < 2; ++ai)
#pragma unroll
            for (int m = 0; m < 4; ++m) { const int row = row0 + ai * HALF + m * 16;
                const float* xr = (u.pm < 64) ? xp + (size_t)row * 1024 : xs + (size_t)(row - 16384) * 1024; float* orow = out + (size_t)row * 1024;
#pragma unroll
                for (int bj = 0; bj < 2; ++bj)
#pragma unroll
                    for (int n = 0; n < 2; ++n) { const int c = col0 + bj * HALF + n * 16; *(f32x4*)(orow + c) = *(const f32x4*)(xr + c) + acc[ai][bj][m][n]; } }
    }
};

template <class Epi, class Sched, bool ALIGN_EPI = false, bool SP2 = false>
__device__ __forceinline__ void gemm_phase(PG8_LAS unsigned char* lds, const Gemm g, const Sched& S, const Epi& E) {
    const int tid = threadIdx.x, wid = __builtin_amdgcn_readfirstlane(tid >> 6), lane = tid & 63, wr = wid >> 2, wc = wid & 3, fr = lane & 15, fq = lane >> 4;
    const int K = g.K, nt = K / BK;
    unsigned voffA[2], voffB[2];
#pragma unroll
    for (int i = 0; i < 2; ++i) { int R, C; stage_rc(tid * 16 + i * 8192, R, C); const int Rb = Epi::PERM ? ((R & ~31) + perm32(R & 31)) : R;
        voffA[i] = (unsigned)(R * K + C) * 2u; voffB[i] = (unsigned)(Rb * K + C) * 2u; }
    const size_t kstep = (size_t)(BK * 2);
    const size_t hstep = (size_t)HALF * K * 2;
    const size_t tstep = 2 * hstep;
    const unsigned ldsw = (unsigned)wid * 1024u;
    const int aoff = lds_byte(wr * 64 + fr, fq * 8), boff = lds_byte(wc * 32 + fr, fq * 8);
#define PG8_SA(b, h) (((b) * 2 + (h)) * HTB)
#define PG8_SB(b, h) ((4 + (b) * 2 + (h)) * HTB)
#define PG8_STAGE(bufoff, gbase, voff) do { _Pragma("unroll") for (int _i = 0; _i < 2; ++_i) \
        __builtin_amdgcn_global_load_lds((const unsigned*)((const char*)(gbase) + (voff)[_i]), (PG8_LAS unsigned*)(lds + (bufoff) + ldsw + _i * 8192), 16, 0, 0); } while (0)
#define PG8_LDA(dst, b, h) do { _Pragma("unroll") for (int m = 0; m < 4; ++m) _Pragma("unroll") for (int k = 0; k < 2; ++k) dst[m][k] = *(const PG8_LAS bf16x8*)(lds + PG8_SA(b, h) + aoff + m * 2048 + k * 1024); } while (0)
#define PG8_LDB(dst, b, h) do { _Pragma("unroll") for (int n = 0; n < 2; ++n) _Pragma("unroll") for (int k = 0; k < 2; ++k) dst[n][k] = *(const PG8_LAS bf16x8*)(lds + PG8_SB(b, h) + boff + n * 2048 + k * 1024); } while (0)
#define PG8_MMA(ai, bj, At, Bt) do { __builtin_amdgcn_s_setprio(1); _Pragma("unroll") for (int m = 0; m < 4; ++m) _Pragma("unroll") for (int n = 0; n < 2; ++n) _Pragma("unroll") for (int k = 0; k < 2; ++k) \
        acc[ai][bj][m][n] = __builtin_amdgcn_mfma_f32_16x16x32_bf16(Bt[n][k], At[m][k], acc[ai][bj][m][n], 0, 0, 0); __builtin_amdgcn_s_setprio(0); } while (0)
#define PG8_WAIT_V(n) asm volatile("s_waitcnt vmcnt(" #n ")" ::: "memory")
#define PG8_WAIT_L(n) asm volatile("s_waitcnt lgkmcnt(" #n ")" ::: "memory")
#define PG8_BAR __builtin_amdgcn_s_barrier()
#define PG8_SCHED __builtin_amdgcn_sched_barrier(0)
    Unit cur, nxt; int ui = 0;
    if (!S.next(0, cur)) return;
    f32x4 acc[2][2][4][2];
#pragma unroll
    for (int a = 0; a < 2; ++a)
#pragma unroll
        for (int b = 0; b < 2; ++b)
#pragma unroll
            for (int m = 0; m < 4; ++m)
#pragma unroll
                for (int n = 0; n < 2; ++n) acc[a][b][m][n] = (f32x4){0.f, 0.f, 0.f, 0.f};
    bf16x8 At[4][2], B0[2][2], B1[2][2];
    const char* cA = (const char*)g.A + (size_t)cur.pm * tstep; const char* cB = (const char*)g.Bt + (size_t)cur.pn * tstep;
    S.a_ready(cur);
    if constexpr (SP2) {
        PG8_STAGE(PG8_SB(0, 0), cB, voffB); PG8_STAGE(PG8_SB(0, 1), cB + hstep, voffB); PG8_STAGE(PG8_SA(0, 0), cA, voffA); PG8_STAGE(PG8_SA(0, 1), cA + hstep, voffA);
        if (wr == 1) PG8_BAR;
        PG8_WAIT_V(2); PG8_BAR;
        PG8_STAGE(PG8_SB(1, 0), cB + kstep, voffB); PG8_STAGE(PG8_SA(1, 0), cA + kstep, voffA); PG8_STAGE(PG8_SB(1, 1), cB + hstep + kstep, voffB);
        PG8_WAIT_V(6); PG8_BAR;
    } else {
        PG8_STAGE(PG8_SB(0, 0), cB, voffB); PG8_STAGE(PG8_SA(0, 0), cA, voffA); PG8_STAGE(PG8_SB(0, 1), cB + hstep, voffB); PG8_STAGE(PG8_SA(0, 1), cA + hstep, voffA);
        if (wr == 1) PG8_BAR;
        PG8_WAIT_V(4); PG8_BAR;
        PG8_STAGE(PG8_SB(1, 0), cB + kstep, voffB); PG8_STAGE(PG8_SA(1, 0), cA + kstep, voffA); PG8_STAGE(PG8_SB(1, 1), cB + hstep + kstep, voffB);
        PG8_WAIT_V(6); PG8_BAR;
    }
    for (;;) {
        const bool has_next = S.next(ui + 1, nxt);
        const char* nA = has_next ? (const char*)g.A + (size_t)nxt.pm * tstep : cA; const char* nB = has_next ? (const char*)g.Bt + (size_t)nxt.pn * tstep : cB;
        for (int t = 0; t < nt; t += 2) {
            const bool last = (t == nt - 2);
            const char* a1 = cA + (size_t)(t + 1) * kstep;
            const char* a2 = last ? nA : cA + (size_t)(t + 2) * kstep; const char* b2 = last ? nB : cB + (size_t)(t + 2) * kstep;
            const char* a3 = a2 + kstep; const char* b3 = b2 + kstep;
            if (last && has_next) S.a_ready(nxt);
            if constexpr (SP2) {
            PG8_LDB(B0, 0, 0); PG8_LDB(B1, 0, 1); PG8_SCHED; PG8_LDA(At, 0, 0); PG8_STAGE(PG8_SA(1, 1), a1 + hstep, voffA);
            PG8_WAIT_V(8); PG8_WAIT_L(0); PG8_BAR; PG8_MMA(0, 0, At, B0); PG8_MMA(0, 1, At, B1); PG8_BAR; PG8_SCHED;
            PG8_LDA(At, 0, 1); PG8_STAGE(PG8_SB(0, 0), b2, voffB); PG8_STAGE(PG8_SB(0, 1), b2 + hstep, voffB); PG8_STAGE(PG8_SA(0, 0), a2, voffA);
            PG8_WAIT_V(8); PG8_WAIT_L(0); PG8_BAR; PG8_MMA(1, 0, At, B0); PG8_MMA(1, 1, At, B1); PG8_BAR; PG8_SCHED;
            PG8_LDB(B0, 1, 0); PG8_LDB(B1, 1, 1); PG8_SCHED; PG8_LDA(At, 1, 0); PG8_STAGE(PG8_SA(0, 1), a2 + hstep, voffA);
            PG8_WAIT_V(8); PG8_WAIT_L(0); PG8_BAR; PG8_MMA(0, 0, At, B0); PG8_MMA(0, 1, At, B1); PG8_BAR; PG8_SCHED;
            PG8_LDA(At, 1, 1); PG8_STAGE(PG8_SB(1, 0), b3, voffB); PG8_STAGE(PG8_SB(1, 1), b3 + hstep, voffB); PG8_STAGE(PG8_SA(1, 0), a3, voffA);
            PG8_WAIT_V(8); PG8_WAIT_L(0); PG8_BAR; PG8_MMA(1, 0, At, B0); PG8_MMA(1, 1, At, B1); PG8_BAR; PG8_SCHED;
            } else {
            PG8_LDB(B0, 0, 0); PG8_SCHED; PG8_LDA(At, 0, 0); PG8_STAGE(PG8_SA(1, 1), a1 + hstep, voffA);
            PG8_WAIT_L(8); PG8_BAR; PG8_WAIT_L(0); PG8_MMA(0, 0, At, B0); PG8_BAR; PG8_SCHED;
            PG8_LDB(B1, 0, 1); PG8_STAGE(PG8_SB(0, 0), b2, voffB);
            PG8_BAR; PG8_WAIT_L(0); PG8_MMA(0, 1, At, B1); PG8_BAR;
            PG8_LDA(At, 0, 1); PG8_STAGE(PG8_SA(0, 0), a2, voffA);
            PG8_BAR; PG8_WAIT_L(0); PG8_MMA(1, 0, At, B0); PG8_BAR; PG8_SCHED;
            PG8_STAGE(PG8_SB(0, 1), b2 + hstep, voffB);
            PG8_WAIT_V(6); PG8_BAR; PG8_MMA(1, 1, At, B1); PG8_BAR;
            PG8_LDB(B0, 1, 0); PG8_SCHED; PG8_LDA(At, 1, 0); PG8_STAGE(PG8_SA(0, 1), a2 + hstep, voffA);
            PG8_WAIT_L(8); PG8_BAR; PG8_WAIT_L(0); PG8_MMA(0, 0, At, B0); PG8_BAR; PG8_SCHED;
            PG8_LDB(B1, 1, 1); PG8_STAGE(PG8_SB(1, 0), b3, voffB);
            PG8_BAR; PG8_WAIT_L(0); PG8_MMA(0, 1, At, B1); PG8_BAR;
            PG8_LDA(At, 1, 1); PG8_STAGE(PG8_SA(1, 0), a3, voffA);
            PG8_BAR; PG8_WAIT_L(0); PG8_MMA(1, 0, At, B0); PG8_BAR; PG8_SCHED;
            PG8_STAGE(PG8_SB(1, 1), b3 + hstep, voffB);
            PG8_WAIT_V(6); PG8_BAR; PG8_MMA(1, 1, At, B1); PG8_BAR;
            }
        }
        if constexpr (ALIGN_EPI) { if (wr == 0) PG8_BAR; }
        if constexpr (!Epi::AFTER_DRAIN) { E(acc, cur, wr, wc, fr, fq); S.done(cur); }
        if (!has_next) break;
#pragma unroll
        for (int a = 0; a < 2; ++a)
#pragma unroll
            for (int b = 0; b < 2; ++b)
#pragma unroll
                for (int m = 0; m < 4; ++m)
#pragma unroll
                    for (int n = 0; n < 2; ++n) acc[a][b][m][n] = (f32x4){0.f, 0.f, 0.f, 0.f};
        cur = nxt; cA = nA; cB = nB; ++ui;
        if constexpr (ALIGN_EPI) { if (wr == 1) PG8_BAR; }
    }
    PG8_WAIT_V(0);
    if constexpr (!ALIGN_EPI) { if (wr == 0) PG8_BAR; }
    PG8_BAR;
    if constexpr (Epi::AFTER_DRAIN) { E.fused(acc, cur, wr, wc, fr, fq, lds, wid, lane); S.done(cur); }
#undef PG8_SA
#undef PG8_SB
#undef PG8_STAGE
#undef PG8_LDA
#undef PG8_LDB
#undef PG8_MMA
#undef PG8_WAIT_V
#undef PG8_WAIT_L
#undef PG8_BAR
#undef PG8_SCHED
}
}

#define LAS __attribute__((address_space(3)))
typedef unsigned short bf16;
typedef float f32x4 __attribute__((ext_vector_type(4)));
typedef unsigned u32x4 __attribute__((ext_vector_type(4)));
typedef unsigned u32x2 __attribute__((ext_vector_type(2)));
constexpr int NWAVES = 8, NTHR = 512;
constexpr int DM = 1024, NBATCH = 8, SEQ = 2048, MP = NBATCH * SEQ, DECB = 32, DECS = 8, MS = DECB * DECS, MT = MP + MS;
constexpr int NH = 12, HD = 64, DA = NH * HD;
constexpr int DSSM = 2048, NSH = 32, SHD = 64, NGRP = 8, DST = 128, DCONV = 4096;
constexpr int PAST = 16384, KVB = 2048;
constexpr int NIN = 11296, NPROJ = 11264, NPAD = 11520;
constexpr int C_Q = 0, C_K = 768, C_V = 1536, C_G = 2304, C_Z = 3072, C_XBC = 5120, C_GA = 9216, C_GB = 10240;
constexpr size_t MiB = 1u << 20;
constexpr size_t WS_ARGS = 1 * MiB - 4096, WS_PRM = 1 * MiB, WS_WIN = 2 * MiB, WS_WA = 26 * MiB, WS_WB = 28 * MiB, WS_WO = 32 * MiB, WS_HB = 36 * MiB, WS_DT = 70 * MiB, WS_PROJ = 74 * MiB,
                 WS_YA = 432 * MiB, WS_YS = 458 * MiB, WS_SSQ = 524 * MiB, WS_TMP = 528 * MiB, WS_MRG = 594 * MiB, WS_END = 628 * MiB;
constexpr size_t O_YP = 0, O_YS = O_YP + (size_t)MP * DM, O_KP = O_YS + (size_t)MS * DM, O_VP = O_KP + (size_t)MP * DA, O_CP = O_VP + (size_t)MP * DA,
                 O_SP = O_CP + (size_t)NBATCH * 3 * DCONV, O_KS = O_SP + (size_t)NBATCH * NSH * SHD * DST, O_VS = O_KS + (size_t)MS * DA, O_CS = O_VS + (size_t)MS * DA,
                 O_SS = O_CS + (size_t)DECB * 3 * DCONV, O_END = O_SS + (size_t)DECB * NSH * SHD * DST;
constexpr int LDS_BYTES = 147456;
constexpr int PR_CONVW = 0, PR_CONVB = 16384, PR_DTB = 20480, PR_ALOG = 20512, PR_DSKIP = 20544, PR_RELB = 20576, PR_FNORM = 20992, PR_END = 22016;

struct Args {
    const float *x_prompt, *x_sample, *cache_k, *cache_v, *state_conv, *state_ssm, *norm_g, *w_in, *conv_w, *conv_b, *dt_bias, *a_log, *d_skip, *ssm_norm, *w_a, *w_b, *w_out, *rel_bias, *final_norm;
    float* out; unsigned char* ws;
};

__device__ __forceinline__ float bf2f(bf16 b) { return __uint_as_float(((unsigned)b) << 16); }
__device__ __forceinline__ unsigned f2bf(float f) { unsigned u = __float_as_uint(f); return (u + 0x7fffu + ((u >> 16) & 1u)) >> 16; }
__device__ __forceinline__ unsigned pk2(float lo, float hi) { return f2bf(lo) | (f2bf(hi) << 16); }
__device__ __forceinline__ float sigmoidf_(float x) { return 1.f / (1.f + __expf(-x)); }
__device__ __forceinline__ float siluf_(float x) { return x / (1.f + __expf(-x)); }
__device__ __forceinline__ float softplusf_(float x) { return fmaxf(x, 0.f) + log1pf(__expf(-fabsf(x))); }
__device__ __forceinline__ float wave_sum(float v) {
#pragma unroll
    for (int o = 1; o < 64; o <<= 1) v += __shfl_xor(v, o);
    return v;
}
__device__ __forceinline__ float wave_max(float v) {
#pragma unroll
    for (int o = 1; o < 64; o <<= 1) v = fmaxf(v, __shfl_xor(v, o));
    return v;
}
__device__ __forceinline__ int t5_bucket(int off) {
    if (off < 16) return off;
    return 16 + (off >= 22) + (off >= 30) + (off >= 40) + (off >= 54) + (off >= 73) + (off >= 99) + (off >= 134) + (off >= 182) + (off >= 246) + (off >= 332) + (off >= 450) + (off >= 609) + (off >= 825) + (off >= 1117) + (off >= 1513);
}
__device__ __forceinline__ const float* ld_ptr(const unsigned char* ws, int idx) { const unsigned long long v = ((const unsigned long long*)(ws + WS_ARGS))[idx];
    const unsigned lo = __builtin_amdgcn_readfirstlane((unsigned)v), hi = __builtin_amdgcn_readfirstlane((unsigned)(v >> 32)); return (const float*)(((unsigned long long)hi << 32) | lo); }
#define LDS_WAIT() asm volatile("s_waitcnt lgkmcnt(0)" ::: "memory")
typedef short bf16x8 __attribute__((ext_vector_type(8)));
typedef short s16x4 __attribute__((ext_vector_type(4)));
constexpr int AT_ST = 0, AT_STROW = 272, AT_ML = 69632, AT_BIAS = 71680, AT_V = 73728, AT_VROW = 144, AT_VBYTES = 32 * AT_VROW;
constexpr float LOG2E = 1.4426950408889634f;
__device__ __forceinline__ s16x4 lds_tr16(LAS const unsigned char* p) { return __builtin_bit_cast(s16x4, __builtin_amdgcn_ds_read_tr16_b64_v4i16((LAS s16x4*)p)); }

__device__ __forceinline__ void attn_item(const bf16* base  , int P0, int stride, const LAS float* bias2, LAS unsigned char* vst, int lane, float& m_out, float& l_out, f32x4 (&o)[4]) {
    const int c = lane & 15, rq = lane >> 4;
    bf16x8 qf[2];
    { const bf16* qp = base + (size_t)(P0 + stride * c) * NPROJ + C_Q + rq * 8; qf[0] = *(const bf16x8*)qp; qf[1] = *(const bf16x8*)(qp + 32); }
    f32x4 sc[9];
#pragma unroll
    for (int kt = 0; kt < 9; ++kt) {
        const bool tile_valid = (P0 + stride * (16 * kt + 15 - 128)) >= 0;
        if (tile_valid) {
            int kpos = P0 + stride * (16 * kt + c - 128); kpos = kpos < 0 ? 0 : kpos;
            const bf16* kp = base + (size_t)kpos * NPROJ + C_K + rq * 8;
            const bf16x8 k0 = *(const bf16x8*)kp, k1 = *(const bf16x8*)(kp + 32);
            f32x4 acc = {0.f, 0.f, 0.f, 0.f};
            acc = __builtin_amdgcn_mfma_f32_16x16x32_bf16(k0, qf[0], acc, 0, 0, 0);
            acc = __builtin_amdgcn_mfma_f32_16x16x32_bf16(k1, qf[1], acc, 0, 0, 0);
#pragma unroll
            for (int j = 0; j < 4; ++j) { const int kidx = 16 * kt + 4 * rq + j, jj = c + 128 - kidx, kp2 = P0 + stride * (kidx - 128);
                const bool valid = (jj >= 0) && (jj <= 128) && (kp2 >= 0); const int jc = jj < 0 ? 0 : (jj > 128 ? 128 : jj);
                sc[kt][j] = valid ? acc[j] * (0.125f * LOG2E) + bias2[jc] : -INFINITY; }
        } else sc[kt] = (f32x4){-INFINITY, -INFINITY, -INFINITY, -INFINITY};
    }
    float m = -INFINITY;
#pragma unroll
    for (int kt = 0; kt < 9; ++kt) m = fmaxf(fmaxf(fmaxf(m, sc[kt][0]), fmaxf(sc[kt][1], sc[kt][2])), sc[kt][3]);
    m = fmaxf(m, __shfl_xor(m, 16)); m = fmaxf(m, __shfl_xor(m, 32));
    float l = 0.f;
#pragma unroll
    for (int kt = 0; kt < 9; ++kt)
#pragma unroll
        for (int j = 0; j < 4; ++j) { const float p = __builtin_amdgcn_exp2f(sc[kt][j] - m); sc[kt][j] = p; l += p; }
    l += __shfl_xor(l, 16); l += __shfl_xor(l, 32);
#pragma unroll
    for (int dt = 0; dt < 4; ++dt) o[dt] = (f32x4){0.f, 0.f, 0.f, 0.f};
#pragma unroll
    for (int ks = 0; ks < 5; ++ks) {
        const int ktl = (2 * ks + 1 < 9) ? 2 * ks + 1 : 8;
        const bool step_valid = (P0 + stride * (16 * ktl + 15 - 128)) >= 0;
        if (step_valid) {
#pragma unroll
            for (int i = 0; i < 4; ++i) { const int kl = 8 * i + (lane >> 3); int kpos = P0 + stride * (32 * ks + kl - 128); kpos = kpos < 0 ? 0 : (kpos > SEQ - 1 ? SEQ - 1 : kpos);
                const u32x4 v = *(const u32x4*)(base + (size_t)kpos * NPROJ + C_V + (lane & 7) * 8);
                *(LAS u32x4*)(vst + kl * AT_VROW + (lane & 7) * 16) = v; }
            bf16x8 pb;
            { const f32x4 pa = sc[2 * ks]; const f32x4 pz = (2 * ks + 1 < 9) ? sc[(2 * ks + 1 < 9) ? 2 * ks + 1 : 8] : (f32x4){0.f, 0.f, 0.f, 0.f};
              u32x4 w; w.x = pk2(pa[0], pa[1]); w.y = pk2(pa[2], pa[3]); w.z = pk2(pz[0], pz[1]); w.w = pk2(pz[2], pz[3]); pb = __builtin_bit_cast(bf16x8, w); }
            LDS_WAIT(); asm volatile("" ::: "memory");
            LAS const unsigned char* vr = vst + (4 * rq + ((lane & 15) >> 2)) * AT_VROW + (lane & 3) * 8;
#pragma unroll
            for (int dt = 0; dt < 4; ++dt) { const s16x4 lo = lds_tr16(vr + dt * 32), hi = lds_tr16(vr + dt * 32 + 16 * AT_VROW);
                const bf16x8 vf = (bf16x8){lo[0], lo[1], lo[2], lo[3], hi[0], hi[1], hi[2], hi[3]};
                o[dt] = __builtin_amdgcn_mfma_f32_16x16x32_bf16(vf, pb, o[dt], 0, 0, 0); }
            LDS_WAIT(); asm volatile("" ::: "memory");
        }
    }
    m_out = m; l_out = l;
}
__device__ __forceinline__ void attn_merge(int mode, LAS unsigned char* lds, int ql, int lane, float m, float l, f32x4 (&o)[4], const bf16* gp  , bf16* yp  ) {
    const int rq = lane >> 4;
    LAS float* ml = (LAS float*)(lds + AT_ML) + ql * 2; LAS unsigned char* st = lds + AT_ST + ql * AT_STROW + rq * 16;
    if (mode == 0) {
#pragma unroll
        for (int dt = 0; dt < 4; ++dt) *(LAS f32x4*)(st + dt * 64) = o[dt];
        if (rq == 0) { ml[0] = m; ml[1] = l; }
    } else {
        const float M = ml[0], L = ml[1]; const float Mn = fmaxf(M, m), ca = __builtin_amdgcn_exp2f(M - Mn), cb = __builtin_amdgcn_exp2f(m - Mn); const float Ln = L * ca + l * cb;
        f32x4 on[4];
#pragma unroll
        for (int dt = 0; dt < 4; ++dt) on[dt] = *(LAS const f32x4*)(st + dt * 64) * ca + o[dt] * cb;
        if (mode == 1) {
            LDS_WAIT(); asm volatile("" ::: "memory");
#pragma unroll
            for (int dt = 0; dt < 4; ++dt) *(LAS f32x4*)(st + dt * 64) = on[dt];
            if (rq == 0) { ml[0] = Mn; ml[1] = Ln; }
        } else {
            const float inv = 1.f / Ln;
#pragma unroll
            for (int dt = 0; dt < 4; ++dt) { const u32x2 g = *(const u32x2*)(gp + 16 * dt + 4 * rq);
                const float g0 = __uint_as_float(g.x << 16), g1 = __uint_as_float(g.x & 0xffff0000u), g2 = __uint_as_float(g.y << 16), g3 = __uint_as_float(g.y & 0xffff0000u);
                u32x2 w; w.x = pk2(on[dt][0] * inv * siluf_(g0), on[dt][1] * inv * siluf_(g1)); w.y = pk2(on[dt][2] * inv * siluf_(g2), on[dt][3] * inv * siluf_(g3));
                *(u32x2*)(yp + 16 * dt + 4 * rq) = w; }
        }
    }
}
__device__ __forceinline__ void attn_unit(const unsigned char* ws, LAS unsigned char* lds, int b, int h, int s, int wave, int lane) {
    const bf16* proj = (const bf16*)(ws + WS_PROJ); bf16* ya = (bf16*)(ws + WS_YA); const float* prm = (const float*)(ws + WS_PRM);
    const bf16* base = proj + (size_t)b * SEQ * NPROJ + h * HD;
    LAS float* bias2 = (LAS float*)(lds + AT_BIAS); LAS unsigned char* vst = lds + AT_V + wave * AT_VBYTES;
    for (int idx = threadIdx.x; idx < 3 * 129; idx += NTHR) { const int g = idx / 129, j = idx - g * 129; bias2[g * 132 + j] = prm[PR_RELB + t5_bucket(j << (2 * g)) * NH + h] * LOG2E; }
    const int c = lane & 15;
#pragma unroll 1
    for (int it = 0; it < 6; ++it) {
        if ((it & 1) == 0) __syncthreads();
        const int id = 2 * wave + (it & 1), mode = it >> 1;
        int q0, stride;
        if (mode == 0) { q0 = id; stride = 16; } else if (mode == 1) { q0 = (id >> 2) + 64 * (id & 3); stride = 4; } else { q0 = 16 * id; stride = 1; }
        float m, l; f32x4 o[4];
        attn_item(base, s + q0, stride, bias2 + (2 - mode) * 132, vst, lane, m, l, o);
        const int ql = q0 + stride * c; const size_t row = (size_t)b * SEQ + s + ql;
        attn_merge(mode, lds, ql, lane, m, l, o, proj + row * NPROJ + C_G + h * HD, ya + row * DA + h * HD);
    }
    __syncthreads();
}
__device__ __forceinline__ void p0_transpose_item(const float* W, int K, int N, bf16* WT, int k0, int n0, int dst_row0, const float* kscale, LAS float* scr, int lane) {
#pragma unroll 8
    for (int i = 0; i < 32; ++i) { const int kk = 2 * i + (lane >> 5); float v = W[(size_t)(k0 + kk) * N + n0 + (lane & 31)]; if (kscale) v *= kscale[k0 + kk]; scr[kk * 33 + (lane & 31)] = v; }
    LDS_WAIT(); asm volatile("" ::: "memory");
    const int c = lane & 7;
#pragma unroll
    for (int j = 0; j < 4; ++j) { const int n = (lane >> 3) + 8 * j; const LAS float* s = scr + (8 * c) * 33 + n;
        u32x4 o; o.x = pk2(s[0 * 33], s[1 * 33]); o.y = pk2(s[2 * 33], s[3 * 33]); o.z = pk2(s[4 * 33], s[5 * 33]); o.w = pk2(s[6 * 33], s[7 * 33]);
        *(u32x4*)(WT + (size_t)(dst_row0 + n) * K + k0 + 8 * c) = o; }
    LDS_WAIT(); asm volatile("" ::: "memory");
}
__device__ __forceinline__ void p0_prologue(const Args& a, LAS unsigned char* lds, int gw, int NGW, int wave, int lane) {
    bf16* win_t = (bf16*)(a.ws + WS_WIN); bf16* wa_t = (bf16*)(a.ws + WS_WA); bf16* wb_t = (bf16*)(a.ws + WS_WB); bf16* wo_t = (bf16*)(a.ws + WS_WO); bf16* hb = (bf16*)(a.ws + WS_HB);
    LAS float* scr = (LAS float*)(lds + wave * 16384);
    constexpr int I_IN = (DM / 64) * (NIN / 32), I_A = (DA / 64) * (DM / 32), I_B = (DSSM / 64) * (DM / 32), I_O = (DM / 64) * (DM / 32);
    for (int it = gw; it < I_IN + I_A + I_B + I_O; it += NGW) {
        int r = it;
        if (r < I_IN) { const int nblk = NIN / 32, kb = r / nblk, nb = r % nblk, n0 = nb * 32; const int dst = (n0 < 9216) ? n0 : (n0 == 9216 ? 11264 : n0 - 32);
            p0_transpose_item(a.w_in, DM, NIN, win_t, kb * 64, n0, dst, nullptr, scr, lane); continue; } r -= I_IN;
        if (r < I_A) { const int nblk = DM / 32, kb = r / nblk, nb = r % nblk; p0_transpose_item(a.w_a, DA, DM, wa_t, kb * 64, nb * 32, nb * 32, nullptr, scr, lane); continue; } r -= I_A;
        if (r < I_B) { const int nblk = DM / 32, kb = r / nblk, nb = r % nblk; p0_transpose_item(a.w_b, DSSM, DM, wb_t, kb * 64, nb * 32, nb * 32, a.ssm_norm, scr, lane); continue; } r -= I_B;
        { const int nblk = DM / 32, kb = r / nblk, nb = r % nblk; p0_transpose_item(a.w_out, DM, DM, wo_t, kb * 64, nb * 32, nb * 32, nullptr, scr, lane); }
    }
    { float* prm = (float*)(a.ws + WS_PRM); const int gt = gw * 64 + lane, NGT = NGW * 64;
      for (int i = gt; i < PR_END; i += NGT) { float v = 0.f;
          if (i < PR_CONVB) v = a.conv_w[i]; else if (i < PR_DTB) v = a.conv_b[i - PR_CONVB]; else if (i < PR_ALOG) v = a.dt_bias[i - PR_DTB]; else if (i < PR_DSKIP) v = a.a_log[i - PR_ALOG];
          else if (i < PR_RELB) v = a.d_skip[i - PR_DSKIP]; else if (i < PR_RELB + 384) v = a.rel_bias[i - PR_RELB]; else if (i >= PR_FNORM) v = a.final_norm[i - PR_FNORM];
          prm[i] = v; } }
    { u32x4* z = (u32x4*)(win_t + (size_t)11296 * DM); const int n16 = 224 * DM * 2 / 16; for (int i = gw * 64 + lane; i < n16; i += NGW * 64) z[i] = (u32x4){0u, 0u, 0u, 0u}; }
    for (int m = gw; m < MT; m += NGW) {
        const float* xrow = (m < MP) ? a.x_prompt + (size_t)m * DM : a.x_sample + (size_t)(m - MP) * DM;
        const f32x4* xr = (const f32x4*)xrow + lane; const f32x4* gr = (const f32x4*)a.norm_g + lane;
        f32x4 v[4]; float s = 0.f;
#pragma unroll
        for (int j = 0; j < 4; ++j) { v[j] = xr[64 * j]; s += (v[j].x * v[j].x + v[j].y * v[j].y) + (v[j].z * v[j].z + v[j].w * v[j].w); }
        const float rstd = rsqrtf(wave_sum(s) * (1.f / DM) + 1e-6f);
        unsigned long long* o8 = (unsigned long long*)(hb + (size_t)m * DM) + lane;
#pragma unroll
        for (int j = 0; j < 4; ++j) { const f32x4 g = gr[64 * j]; o8[64 * j] = (unsigned long long)pk2(v[j].x * rstd * g.x, v[j].y * rstd * g.y) | ((unsigned long long)pk2(v[j].z * rstd * g.z, v[j].w * rstd * g.w) << 32); }
    }
}

template <bool SAMP> __device__ __forceinline__ const void* kv_ptr(const Args& a, const bf16* proj, int colkv, const float* cache, int seq, int tpos, int off, int h, bool& valid, bool& isf32) {
    if (!SAMP) { const int kt = tpos - off; valid = kt >= 0; isf32 = false; return proj + (size_t)(seq * SEQ + (valid ? kt : 0)) * NPROJ + colkv + h * HD; }
    const int idx = KVB + tpos - off; valid = true;
    if (idx >= KVB) { isf32 = false; return proj + (size_t)(MP + seq * DECS + (idx - KVB)) * NPROJ + colkv + h * HD; }
    isf32 = true; return cache + ((size_t)(seq * KVB + idx) * NH + h) * HD;
}
template <bool SAMP> __device__ __forceinline__ void attn_slow_item(const Args& a, const bf16* proj, bf16* ya, LAS float* sl, int row, int h, int lane) {
    const float* prm = (const float*)(a.ws + WS_PRM);
    const int seq = SAMP ? (row - MP) / DECS : row / SEQ, tpos = SAMP ? (row - MP) % DECS : row % SEQ;
    float q[64];
    { const u32x4* qp = (const u32x4*)(proj + (size_t)row * NPROJ + C_Q + h * HD);
#pragma unroll
      for (int i = 0; i < 8; ++i) { const u32x4 w = qp[i]; q[8 * i + 0] = __uint_as_float(w.x << 16); q[8 * i + 1] = __uint_as_float(w.x & 0xffff0000u); q[8 * i + 2] = __uint_as_float(w.y << 16); q[8 * i + 3] = __uint_as_float(w.y & 0xffff0000u);
          q[8 * i + 4] = __uint_as_float(w.z << 16); q[8 * i + 5] = __uint_as_float(w.z & 0xffff0000u); q[8 * i + 6] = __uint_as_float(w.w << 16); q[8 * i + 7] = __uint_as_float(w.w & 0xffff0000u); } }
    float mx = -INFINITY;
#pragma unroll 1
    for (int e = lane; e < 387; e += 64) {
        float sc = -INFINITY;
        const int g = e / 129, j = e - g * 129, off = j << (2 * g); bool valid, isf32;
        const void* kp = kv_ptr<SAMP>(a, proj, C_K, a.cache_k, seq, tpos, off, h, valid, isf32);
        if (valid) { float d = 0.f;
            if (isf32) { const f32x4* k4 = (const f32x4*)kp;
#pragma unroll
                for (int i = 0; i < 16; ++i) { const f32x4 kk = k4[i]; d += q[4 * i] * kk.x + q[4 * i + 1] * kk.y + q[4 * i + 2] * kk.z + q[4 * i + 3] * kk.w; } }
            else { const u32x4* k4 = (const u32x4*)kp;
#pragma unroll
                for (int i = 0; i < 8; ++i) { const u32x4 w = k4[i];
                    d += q[8 * i + 0] * __uint_as_float(w.x << 16) + q[8 * i + 1] * __uint_as_float(w.x & 0xffff0000u) + q[8 * i + 2] * __uint_as_float(w.y << 16) + q[8 * i + 3] * __uint_as_float(w.y & 0xffff0000u)
                       + q[8 * i + 4] * __uint_as_float(w.z << 16) + q[8 * i + 5] * __uint_as_float(w.z & 0xffff0000u) + q[8 * i + 6] * __uint_as_float(w.w << 16) + q[8 * i + 7] * __uint_as_float(w.w & 0xffff0000u); } }
            sc = d * 0.125f + prm[PR_RELB + t5_bucket(off) * NH + h]; }
        sl[e] = sc; mx = fmaxf(mx, sc);
    }
    mx = wave_max(mx);
    float sum = 0.f;
#pragma unroll 1
    for (int e = lane; e < 387; e += 64) { const float sc = sl[e]; const float pe = (sc == -INFINITY) ? 0.f : __expf(sc - mx); sl[e] = pe; sum += pe; }
    sum = wave_sum(sum);
    LDS_WAIT(); asm volatile("" ::: "memory");
    float o = 0.f;
#pragma unroll 4
    for (int e = 0; e < 387; ++e) {
        const int g = e / 129, j = e - g * 129, off = j << (2 * g); bool valid, isf32;
        const void* vp = kv_ptr<SAMP>(a, proj, C_V, a.cache_v, seq, tpos, off, h, valid, isf32);
        const float pe = sl[e];
        if (valid) { const float vv = isf32 ? ((const float*)vp)[lane] : bf2f(((const bf16*)vp)[lane]); o += pe * vv; }
    }
    LDS_WAIT(); asm volatile("" ::: "memory");
    const float gv = bf2f(proj[(size_t)row * NPROJ + C_G + h * HD + lane]);
    ya[(size_t)row * DA + h * HD + lane] = (bf16)f2bf(o / sum * siluf_(gv));
}

__device__ __forceinline__ void ssd_slow_item(const Args& a, LAS unsigned char* lds, int item) {
    const bf16* proj = (const bf16*)(a.ws + WS_PROJ); const float* dtb = (const float*)(a.ws + WS_DT); bf16* ys = (bf16*)(a.ws + WS_YS); float* ssq = (float*)(a.ws + WS_SSQ);
    const int tid = threadIdx.x, lane = tid & 63, wid = tid >> 6;
    const bool samp = item >= NBATCH * NSH; const int it2 = samp ? item - NBATCH * NSH : item; const int sq = it2 / NSH, hd = it2 % NSH, grp = hd / 4;
    const int L = samp ? DECS : SEQ, row0 = samp ? MP + sq * DECS : sq * SEQ;
    const int p = tid >> 3, n0 = (tid & 7) * 16;
    float h[16];
    if (samp) { const f32x4* s4 = (const f32x4*)(a.state_ssm + ((size_t)(sq * NSH + hd) * SHD + p) * DST + n0);
#pragma unroll
        for (int j = 0; j < 4; ++j) { const f32x4 v = s4[j]; h[4 * j] = v.x; h[4 * j + 1] = v.y; h[4 * j + 2] = v.z; h[4 * j + 3] = v.w; } }
    else {
#pragma unroll
        for (int j = 0; j < 16; ++j) h[j] = 0.f; }
    const float* prm = (const float*)(a.ws + WS_PRM);
    const float Aneg = -__expf(prm[PR_ALOG + hd]), Dk = prm[PR_DSKIP + hd];
    LAS float* xs = (LAS float*)lds;
    LAS float* Bs = xs + 64 * 64;
    LAS float* Cs = Bs + 64 * 128;
    LAS float* dts = Cs + 64 * 128;
    LAS float* dAs = dts + 64;
    LAS float* yb = dAs + 64;
    for (int c0 = 0; c0 < L; c0 += 64) {
        const int tc = (L - c0) < 64 ? (L - c0) : 64;
        for (int idx = tid; idx < tc * 320; idx += NTHR) {
            const int t = idx / 320, c = idx - t * 320;
            const int xc = c < 64 ? hd * 64 + c : (c < 192 ? DSSM + grp * DST + (c - 64) : DSSM + NGRP * DST + grp * DST + (c - 192));
            float acc = prm[PR_CONVB + xc];
#pragma unroll
            for (int tap = 0; tap < 4; ++tap) { const int tt = c0 + t - 3 + tap; float v;
                if (tt >= 0) v = bf2f(proj[(size_t)(row0 + tt) * NPROJ + C_XBC + xc]);
                else v = samp ? a.state_conv[(size_t)(sq * 3 + 3 + tt) * DCONV + xc] : 0.f;
                acc += prm[PR_CONVW + tap * DCONV + xc] * v; }
            const float val = siluf_(acc);
            if (c < 64) xs[t * 64 + c] = val; else if (c < 192) Bs[t * 128 + (c - 64)] = val; else Cs[t * 128 + (c - 192)] = val;
        }
        if (tid < tc) { const float dtv = dtb[(size_t)(row0 + c0 + tid) * 32 + hd]; dts[tid] = dtv; dAs[tid] = __expf(dtv * Aneg); }
        __syncthreads();
        for (int t = 0; t < tc; ++t) {
            const float dA = dAs[t], xv = xs[t * 64 + p], dtx = dts[t] * xv; float acc = 0.f;
            const LAS f32x4* b4 = (const LAS f32x4*)(Bs + t * 128 + n0); const LAS f32x4* c4 = (const LAS f32x4*)(Cs + t * 128 + n0);
#pragma unroll
            for (int j = 0; j < 4; ++j) { const f32x4 bb = b4[j], cc = c4[j];
                h[4 * j] = dA * h[4 * j] + dtx * bb.x; h[4 * j + 1] = dA * h[4 * j + 1] + dtx * bb.y; h[4 * j + 2] = dA * h[4 * j + 2] + dtx * bb.z; h[4 * j + 3] = dA * h[4 * j + 3] + dtx * bb.w;
                acc += h[4 * j] * cc.x + h[4 * j + 1] * cc.y + h[4 * j + 2] * cc.z + h[4 * j + 3] * cc.w; }
            acc += __shfl_xor(acc, 1); acc += __shfl_xor(acc, 2); acc += __shfl_xor(acc, 4);
            if ((tid & 7) == 0) yb[t * 64 + p] = acc + Dk * xv;
        }
        __syncthreads();
        for (int t = wid; t < tc; t += NWAVES) {
            const int row = row0 + c0 + t; const float z = bf2f(proj[(size_t)row * NPROJ + C_Z + hd * 64 + lane]);
            const float val = yb[t * 64 + lane] * siluf_(z);
            ys[(size_t)row * DSSM + hd * 64 + lane] = (bf16)f2bf(val);
            const float ss = wave_sum(val * val); if (lane == 0) ssq[(size_t)row * NSH + hd] = ss;
        }
        __syncthreads();
    }
    float* dst = a.out + (samp ? O_SS : O_SP) + ((size_t)(sq * NSH + hd) * SHD + p) * DST + n0;
#pragma unroll
    for (int j = 0; j < 4; ++j) ((f32x4*)dst)[j] = (f32x4){h[4 * j], h[4 * j + 1], h[4 * j + 2], h[4 * j + 3]};
}

__device__ __forceinline__ void p2_slow(const Args& a, LAS unsigned char* lds, int G, int wave, int lane) {
    const bf16* proj = (const bf16*)(a.ws + WS_PROJ); bf16* ya = (bf16*)(a.ws + WS_YA);
    for (int item = blockIdx.x; item < NBATCH * NSH + DECB * NSH; item += G) ssd_slow_item(a, lds, item);
    const int gw = blockIdx.x * NWAVES + wave, NGW = G * NWAVES; LAS float* sl = (LAS float*)(lds + 100 * 1024 + wave * 2048);
    for (int k = 0; ; ++k) { const int v = (G == 256) ? (k < 3 ? (int)((blockIdx.x % 8) * 96 + (blockIdx.x / 8) + 32 * k) : 768) : (int)(blockIdx.x + k * G); if (v >= 768) break;
        const int bh = v >> 3, sb = v & 7; attn_unit(a.ws, lds, bh / NH, bh % NH, sb * 256, wave, lane); }
    for (int it = gw; it < MS * NH; it += NGW) { const int row = MP + it / NH, h = it % NH; attn_slow_item<true>(a, proj, ya, sl, row, h, lane); }
    const int gt = blockIdx.x * NTHR + threadIdx.x, NGT = G * NTHR;
    for (int i = gt; i < (NBATCH + DECB) * 3 * DCONV; i += NGT) { const int c = i % DCONV, r = (i / DCONV) % 3, sq = i / (3 * DCONV);
        if (sq < NBATCH) a.out[O_CP + (size_t)(sq * 3 + r) * DCONV + c] = bf2f(proj[(size_t)(sq * SEQ + SEQ - 3 + r) * NPROJ + C_XBC + c]);
        else { const int s2 = sq - NBATCH; a.out[O_CS + (size_t)(s2 * 3 + r) * DCONV + c] = bf2f(proj[(size_t)(MP + s2 * DECS + DECS - 3 + r) * NPROJ + C_XBC + c]); } }
}
__device__ __forceinline__ void p25_norm(const Args& a, int gw, int NGW, int lane) {
    bf16* ys = (bf16*)(a.ws + WS_YS); const float* ssq = (const float*)(a.ws + WS_SSQ);
    for (int m = gw; m < MT; m += NGW) {
        const float sv = (lane < 32) ? ssq[(size_t)m * NSH + lane] : 0.f;
        float gs = sv + __shfl_xor(sv, 1); gs += __shfl_xor(gs, 2);
        const float rstd = rsqrtf(gs * (1.f / 256.f) + 1e-5f);
        u32x4* r4 = (u32x4*)(ys + (size_t)m * DSSM);
#pragma unroll
        for (int j = 0; j < 4; ++j) { const int ci = j * 64 + lane, g = ci >> 5; const float sc = __shfl(rstd, 4 * g); u32x4 w = r4[ci];
            w.x = pk2(__uint_as_float(w.x << 16) * sc, __uint_as_float(w.x & 0xffff0000u) * sc); w.y = pk2(__uint_as_float(w.y << 16) * sc, __uint_as_float(w.y & 0xffff0000u) * sc);
            w.z = pk2(__uint_as_float(w.z << 16) * sc, __uint_as_float(w.z & 0xffff0000u) * sc); w.w = pk2(__uint_as_float(w.w << 16) * sc, __uint_as_float(w.w & 0xffff0000u) * sc); r4[ci] = w; }
    }
}
__device__ __forceinline__ void p5_final_norm(const Args& a, int gw, int NGW, int lane) {
    for (int m = gw; m < MT; m += NGW) {
        f32x4* xr = (f32x4*)(a.out + (size_t)m * DM) + lane; const f32x4* gr = (const f32x4*)((const float*)(a.ws + WS_PRM) + PR_FNORM) + lane;
        f32x4 v[4]; float s = 0.f;
#pragma unroll
        for (int j = 0; j < 4; ++j) { v[j] = xr[64 * j]; s += (v[j].x * v[j].x + v[j].y * v[j].y) + (v[j].z * v[j].z + v[j].w * v[j].w); }
        const float rstd = rsqrtf(wave_sum(s) * (1.f / DM) + 1e-6f);
#pragma unroll
        for (int j = 0; j < 4; ++j) { const f32x4 g = gr[64 * j]; xr[64 * j] = v[j] * rstd * g; }
    }
}
#define GEMM_PHASE(EpiT, Aptr, Bptr, Mrows, Ncols, Kdim, Eobj) do { pg8::Gemm g_{(const pg8::bf16_t*)(Aptr), (const pg8::bf16_t*)(Bptr), (Mrows), (Ncols), (Kdim)}; pg8::StaticOrder S_; S_.init((Mrows), (Ncols), G, (int)blockIdx.x); \
    pg8::gemm_phase<EpiT, pg8::StaticOrder, true, true>(lds, g_, S_, (Eobj)); } while (0)

__global__ void __launch_bounds__(NTHR, 2) fwd_megakernel(Args a) {
    extern __shared__ __attribute__((aligned(16))) unsigned char lds_raw[];
    LAS unsigned char* lds = (LAS unsigned char*)lds_raw;
    cg::grid_group grid = cg::this_grid();
    const int tid = threadIdx.x, lane = tid & 63, wave = __builtin_amdgcn_readfirstlane(tid >> 6);
    const int G = gridDim.x, gw = blockIdx.x * NWAVES + wave, NGW = G * NWAVES;
    unsigned char* ws = a.ws;

    p0_prologue(a, lds, gw, NGW, wave, lane);
    if (blockIdx.x == 0 && tid == 0) { const float** pp = (const float**)(ws + WS_ARGS); pp[0] = a.x_prompt; pp[1] = a.x_sample; pp[2] = a.cache_k; pp[3] = a.cache_v; pp[4] = a.state_conv; pp[5] = a.state_ssm; }
    grid.sync();
    { pg8::EpiInProj E{(pg8::bf16_t*)(ws + WS_PROJ), (float*)(ws + WS_DT), (const float*)(ws + WS_PRM) + PR_DTB, a.out + O_KP, a.out + O_VP, a.out + O_KS, a.out + O_VS};
      GEMM_PHASE(pg8::EpiInProj, ws + WS_HB, ws + WS_WIN, MT, NPAD, DM, E); }
    grid.sync();
    { Args b{}; b.ws = ws; b.out = a.out; b.cache_k = ld_ptr(ws, 2); b.cache_v = ld_ptr(ws, 3); b.state_conv = ld_ptr(ws, 4); b.state_ssm = ld_ptr(ws, 5); p2_slow(b, lds, G, wave, lane); }
    grid.sync();
    p25_norm(a, gw, NGW, lane);
    grid.sync();
    { pg8::EpiGateA E{(const pg8::bf16_t*)(ws + WS_PROJ), (float*)(ws + WS_TMP)}; GEMM_PHASE(pg8::EpiGateA, ws + WS_YA, ws + WS_WA, MT, DM, DA, E); }
    { pg8::EpiGateB E{(const pg8::bf16_t*)(ws + WS_PROJ), (const float*)(ws + WS_TMP), (pg8::bf16_t*)(ws + WS_MRG)}; GEMM_PHASE(pg8::EpiGateB, ws + WS_YS, ws + WS_WB, MT, DM, DSSM, E); }
    grid.sync();
    { pg8::EpiOut E{ld_ptr(ws, 0), ld_ptr(ws, 1), a.out + O_YP}; GEMM_PHASE(pg8::EpiOut, ws + WS_MRG, ws + WS_WO, MT, DM, DM, E); }
    grid.sync();
    p5_final_norm(a, gw, NGW, lane);
}

extern "C" void kernel_launch(void* const* d_in, const int* in_sizes, int n_in, void* d_out, int out_size, void* d_ws, size_t ws_size, hipStream_t stream) {
    static int grid_blocks = 0;
    if (grid_blocks == 0) {
        if (n_in != 19 || (size_t)out_size != O_END || ws_size < WS_END) { fprintf(stderr, "kernel_launch: unexpected shapes: n_in %d out %d (want %zu) ws %zu (want >= %zu)\n", n_in, out_size, (size_t)O_END, ws_size, (size_t)WS_END); grid_blocks = -1; return; }
        int dev = 0, cus = 0, per_cu = 0;
        hipGetDevice(&dev); hipDeviceGetAttribute(&cus, hipDeviceAttributeMultiprocessorCount, dev);
        if (hipFuncSetAttribute((const void*)fwd_megakernel, hipFuncAttributeMaxDynamicSharedMemorySize, LDS_BYTES) != hipSuccess) { fprintf(stderr, "kernel_launch: hipFuncSetAttribute failed\n"); grid_blocks = -1; return; }
        if (hipOccupancyMaxActiveBlocksPerMultiprocessor(&per_cu, (const void*)fwd_megakernel, NTHR, LDS_BYTES) != hipSuccess || per_cu < 1) { fprintf(stderr, "kernel_launch: occupancy query failed (%d)\n", per_cu); (void)hipGetLastError(); per_cu = 1; }
        if (per_cu > 1) per_cu = 1;
        grid_blocks = cus * per_cu;
        fprintf(stderr, "kernel_launch: grid %d (cus %d)\n", grid_blocks, cus);
    }
    if (grid_blocks < 0) return;
    Args a{};
    a.x_prompt = (const float*)d_in[0]; a.x_sample = (const float*)d_in[1]; a.cache_k = (const float*)d_in[2]; a.cache_v = (const float*)d_in[3]; a.state_conv = (const float*)d_in[4]; a.state_ssm = (const float*)d_in[5];
    a.norm_g = (const float*)d_in[6]; a.w_in = (const float*)d_in[7]; a.conv_w = (const float*)d_in[8]; a.conv_b = (const float*)d_in[9]; a.dt_bias = (const float*)d_in[10]; a.a_log = (const float*)d_in[11];
    a.d_skip = (const float*)d_in[12]; a.ssm_norm = (const float*)d_in[13]; a.w_a = (const float*)d_in[14]; a.w_b = (const float*)d_in[15]; a.w_out = (const float*)d_in[16]; a.rel_bias = (const float*)d_in[17]; a.final_norm = (const float*)d_in[18];
    a.out = (float*)d_out; a.ws = (unsigned char*)d_ws;
    void* args[] = {&a};
    hipError_t e = hipLaunchCooperativeKernel((const void*)fwd_megakernel, dim3(grid_blocks), dim3(NTHR), args, LDS_BYTES, stream);
    if (e != hipSuccess) fprintf(stderr, "kernel_launch: cooperative launch failed: %s (grid %d)\n", hipGetErrorString(e), grid_blocks);
}
```

```cpp
#include <hip/hip_runtime.h>
#include <hip/hip_cooperative_groups.h>
#include <cstdio>
#include <cstdint>
namespace cg = cooperative_groups;
namespace pg8 {
#define PG8_LAS __attribute__((address_space(3)))
typedef unsigned short bf16_t;
typedef short bf16x8 __attribute__((ext_vector_type(8)));
typedef float f32x4 __attribute__((ext_vector_type(4)));
typedef unsigned u32x4 __attribute__((ext_vector_type(4)));
constexpr int BM = 256, BK = 64, HALF = 128, HTB = HALF * BK * 2  , STAGE_BYTES = 8 * HTB, NXCD = 8, WGM = 8;

__host__ __device__ __forceinline__ int lds_byte(int r, int c) { const int st = (r >> 4) * 2 + (c >> 5), rr = r & 15, cc = c & 31, ob = rr * 64 + cc * 2; return st * 1024 + (ob ^ (((ob >> 9) & 1) << 5)); }
__host__ __device__ __forceinline__ void stage_rc(int b, int& R, int& C) { const int st = b / 1024, sb = b % 1024, swz = sb ^ (((sb >> 9) & 1) << 5); R = (st >> 1) * 16 + swz / 64; C = (st & 1) * 32 + (swz % 64) / 2; }
__host__ __device__ __forceinline__ int perm32(int rho) { const int n = rho >> 4, i = rho & 15; return 8 * (i >> 2) + 4 * n + (i & 3); }

struct Unit { int pm, pn; };
struct Gemm { const bf16_t* A; const bf16_t* Bt; int M, N, K; };

struct StaticOrder {
    int nM, nN, nwg, G, c;
    __host__ __device__ void init(int M, int N, int G_, int c_) { nM = M / BM; nN = N / BM; nwg = nM * nN; G = G_; c = c_; }
    __host__ __device__ bool next(int i, Unit& u) const {
        const long L = (long)i * G + c; if (L >= nwg) return false;
        int wgid = (int)L; { const int q = nwg / NXCD, r = nwg % NXCD, xcd = wgid % NXCD, off = wgid / NXCD; wgid = (xcd < r ? xcd * (q + 1) : r * (q + 1) + (xcd - r) * q) + off; }
        const int nig = WGM * nN, gid = wgid / nig, fm = gid * WGM, gsz = (nM - fm) < WGM ? (nM - fm) : WGM;
        u.pm = fm + ((wgid % nig) % gsz); u.pn = (wgid % nig) / gsz; return true;
    }
    __device__ __forceinline__ void a_ready(const Unit&) const {}
    __device__ __forceinline__ void done(const Unit&) const {}
};

__device__ __forceinline__ unsigned cvt_pk_bf16(float lo, float hi) { unsigned r; asm volatile("v_cvt_pk_bf16_f32 %0, %1, %2" : "=v"(r) : "v"(lo), "v"(hi)); return r; }
__device__ __forceinline__ float e_bf2f(unsigned short b) { return __uint_as_float(((unsigned)b) << 16); }
__device__ __forceinline__ float e_sigmoid(float x) { return 1.f / (1.f + __expf(-x)); }
__device__ __forceinline__ float e_softplus(float x) { return fmaxf(x, 0.f) + log1pf(__expf(-fabsf(x))); }

struct EpiInProj {
    static constexpr bool PERM = true, AFTER_DRAIN = false;
    bf16_t* proj; float* dt; const float* dt_bias; float* kp; float* vp; float* ks; float* vs;
    __device__ __forceinline__ void operator()(const f32x4 (&acc)[2][2][4][2], const Unit& u, int wr, int wc, int fr, int fq) const {
        const int row0 = u.pm * BM + wr * 64 + fr;
        if (u.pn < 44) {
            const int col0 = u.pn * BM + wc * 32 + 8 * fq;
            const bool isk = (u.pn >= 3 && u.pn < 6), isv = (u.pn >= 6 && u.pn < 9);
#pragma unroll
            for (int ai = 0; ai < 2; ++ai)
#pragma unroll
                for (int m = 0; m < 4; ++m) { const int row = row0 + ai * HALF + m * 16; bf16_t* rowp = proj + (size_t)row * 11264 + col0;
#pragma unroll
                    for (int bj = 0; bj < 2; ++bj) { const f32x4 v0 = acc[ai][bj][m][0], v1 = acc[ai][bj][m][1];
                        u32x4 w; w.x = cvt_pk_bf16(v0[0], v0[1]); w.y = cvt_pk_bf16(v0[2], v0[3]); w.z = cvt_pk_bf16(v1[0], v1[1]); w.w = cvt_pk_bf16(v1[2], v1[3]);
                        *(u32x4*)(rowp + bj * HALF) = w;
                        if (isk || isv) { const int c = col0 + bj * HALF - (isk ? 768 : 1536);
                            float* dst = (u.pm < 64) ? ((isk ? kp : vp) + (size_t)row * 768 + c) : ((isk ? ks : vs) + (size_t)(row - 16384) * 768 + c);
                            *(f32x4*)dst = v0; *(f32x4*)(dst + 4) = v1; } } }
        } else if (wc == 0) {
            const f32x4 b0 = *(const f32x4*)(dt_bias + 8 * fq), b1 = *(const f32x4*)(dt_bias + 8 * fq + 4);
#pragma unroll
            for (int ai = 0; ai < 2; ++ai)
#pragma unroll
                for (int m = 0; m < 4; ++m) { const int row = row0 + ai * HALF + m * 16; const f32x4 v0 = acc[ai][0][m][0] + b0, v1 = acc[ai][0][m][1] + b1;
                    f32x4 o0, o1;
#pragma unroll
                    for (int j = 0; j < 4; ++j) { o0[j] = e_softplus(v0[j]); o1[j] = e_softplus(v1[j]); }
                    float* dst = dt + (size_t)row * 32 + 8 * fq; *(f32x4*)dst = o0; *(f32x4*)(dst + 4) = o1; }
        }
    }
};
struct EpiGateA {
    static constexpr bool PERM = true, AFTER_DRAIN = false;
    const bf16_t* proj; float* tmp;
    __device__ __forceinline__ void operator()(const f32x4 (&acc)[2][2][4][2], const Unit& u, int wr, int wc, int fr, int fq) const {
        const int row0 = u.pm * BM + wr * 64 + fr, col0 = u.pn * BM + wc * 32 + 8 * fq;
#pragma unroll
        for (int ai = 0; ai < 2; ++ai)
#pragma unroll
            for (int m = 0; m < 4; ++m) { const int row = row0 + ai * HALF + m * 16;
#pragma unroll
                for (int bj = 0; bj < 2; ++bj) { const int c = col0 + bj * HALF; const u32x4 g = *(const u32x4*)(proj + (size_t)row * 11264 + 9216 + c);
                    const f32x4 v0 = acc[ai][bj][m][0], v1 = acc[ai][bj][m][1]; f32x4 o0, o1;
                    o0[0] = e_sigmoid(__uint_as_float(g.x << 16)) * v0[0]; o0[1] = e_sigmoid(__uint_as_float(g.x & 0xffff0000u)) * v0[1];
                    o0[2] = e_sigmoid(__uint_as_float(g.y << 16)) * v0[2]; o0[3] = e_sigmoid(__uint_as_float(g.y & 0xffff0000u)) * v0[3];
                    o1[0] = e_sigmoid(__uint_as_float(g.z << 16)) * v1[0]; o1[1] = e_sigmoid(__uint_as_float(g.z & 0xffff0000u)) * v1[1];
                    o1[2] = e_sigmoid(__uint_as_float(g.w << 16)) * v1[2]; o1[3] = e_sigmoid(__uint_as_float(g.w & 0xffff0000u)) * v1[3];
                    float* dst = tmp + (size_t)row * 1024 + c; *(f32x4*)dst = o0; *(f32x4*)(dst + 4) = o1; } }
    }
};
struct EpiGateB {
    static constexpr bool PERM = true, AFTER_DRAIN = false;
    const bf16_t* proj; const float* tmp; bf16_t* mrg;
    __device__ __forceinline__ void operator()(const f32x4 (&acc)[2][2][4][2], const Unit& u, int wr, int wc, int fr, int fq) const {
        const int row0 = u.pm * BM + wr * 64 + fr, col0 = u.pn * BM + wc * 32 + 8 * fq;
#pragma unroll
        for (int ai = 0; ai < 2; ++ai)
#pragma unroll
            for (int m = 0; m < 4; ++m) { const int row = row0 + ai * HALF + m * 16;
#pragma unroll
                for (int bj = 0; bj < 2; ++bj) { const int c = col0 + bj * HALF; const u32x4 g = *(const u32x4*)(proj + (size_t)row * 11264 + 10240 + c);
                    const float* src = tmp + (size_t)row * 1024 + c; const f32x4 t0 = *(const f32x4*)src, t1 = *(const f32x4*)(src + 4);
                    const f32x4 v0 = acc[ai][bj][m][0], v1 = acc[ai][bj][m][1]; f32x4 o0, o1;
                    o0[0] = t0[0] + e_sigmoid(__uint_as_float(g.x << 16)) * v0[0]; o0[1] = t0[1] + e_sigmoid(__uint_as_float(g.x & 0xffff0000u)) * v0[1];
                    o0[2] = t0[2] + e_sigmoid(__uint_as_float(g.y << 16)) * v0[2]; o0[3] = t0[3] + e_sigmoid(__uint_as_float(g.y & 0xffff0000u)) * v0[3];
                    o1[0] = t1[0] + e_sigmoid(__uint_as_float(g.z << 16)) * v1[0]; o1[1] = t1[1] + e_sigmoid(__uint_as_float(g.z & 0xffff0000u)) * v1[1];
                    o1[2] = t1[2] + e_sigmoid(__uint_as_float(g.w << 16)) * v1[2]; o1[3] = t1[3] + e_sigmoid(__uint_as_float(g.w & 0xffff0000u)) * v1[3];
                    u32x4 w; w.x = cvt_pk_bf16(o0[0], o0[1]); w.y = cvt_pk_bf16(o0[2], o0[3]); w.z = cvt_pk_bf16(o1[0], o1[1]); w.w = cvt_pk_bf16(o1[2], o1[3]);
                    *(u32x4*)(mrg + (size_t)row * 1024 + c) = w; } }
    }
};
struct EpiOut {
    static constexpr bool PERM = false, AFTER_DRAIN = false;
    const float* xp; const float* xs; float* out;
    __device__ __forceinline__ void operator()(const f32x4 (&acc)[2][2][4][2], const Unit& u, int wr, int wc, int fr, int fq) const {
        const int row0 = u.pm * BM + wr * 64 + fr, col0 = u.pn * BM + wc * 32 + 4 * fq;
#pragma unroll
        for (int ai = 0; ai < 2; ++ai)
#pragma unroll
            for (int m = 0; m < 4; ++m) { const int row = row0 + ai * HALF + m * 16;
                const float* xr = (u.pm < 64) ? xp + (size_t)row * 1024 : xs + (size_t)(row - 16384) * 1024; float* orow = out + (size_t)row * 1024;
#pragma unroll
                for (int bj = 0; bj < 2; ++bj)
#pragma unroll
                    for (int n = 0; n < 2; ++n) { const int c = col0 + bj * HALF + n * 16; *(f32x4*)(orow + c) = *(const f32x4*)(xr + c) + acc[ai][bj][m][n]; } }
    }
};

template <class Epi, class Sched, bool ALIGN_EPI = false, bool SP2 = false>
__device__ __forceinline__ void gemm_phase(PG8_LAS unsigned char* lds, const Gemm g, const Sched& S, const Epi& E) {
    const int tid = threadIdx.x, wid = __builtin_amdgcn_readfirstlane(tid >> 6), lane = tid & 63, wr = wid >> 2, wc = wid & 3, fr = lane & 15, fq = lane >> 4;
    const int K = g.K, nt = K / BK;
    unsigned voffA[2], voffB[2];
#pragma unroll
    for (int i = 0; i < 2; ++i) { int R, C; stage_rc(tid * 16 + i * 8192, R, C); const int Rb = Epi::PERM ? ((R & ~31) + perm32(R & 31)) : R;
        voffA[i] = (unsigned)(R * K + C) * 2u; voffB[i] = (unsigned)(Rb * K + C) * 2u; }
    const size_t kstep = (size_t)(BK * 2);
    const size_t hstep = (size_t)HALF * K * 2;
    const size_t tstep = 2 * hstep;
    const unsigned ldsw = (unsigned)wid * 1024u;
    const int aoff = lds_byte(wr * 64 + fr, fq * 8), boff = lds_byte(wc * 32 + fr, fq * 8);
#define PG8_SA(b, h) (((b) * 2 + (h)) * HTB)
#define PG8_SB(b, h) ((4 + (b) * 2 + (h)) * HTB)
#define PG8_STAGE(bufoff, gbase, voff) do { _Pragma("unroll") for (int _i = 0; _i < 2; ++_i) \
        __builtin_amdgcn_global_load_lds((const unsigned*)((const char*)(gbase) + (voff)[_i]), (PG8_LAS unsigned*)(lds + (bufoff) + ldsw + _i * 8192), 16, 0, 0); } while (0)
#define PG8_LDA(dst, b, h) do { _Pragma("unroll") for (int m = 0; m < 4; ++m) _Pragma("unroll") for (int k = 0; k < 2; ++k) dst[m][k] = *(const PG8_LAS bf16x8*)(lds + PG8_SA(b, h) + aoff + m * 2048 + k * 1024); } while (0)
#define PG8_LDB(dst, b, h) do { _Pragma("unroll") for (int n = 0; n < 2; ++n) _Pragma("unroll") for (int k = 0; k < 2; ++k) dst[n][k] = *(const PG8_LAS bf16x8*)(lds + PG8_SB(b, h) + boff + n * 2048 + k * 1024); } while (0)
#define PG8_MMA(ai, bj, At, Bt) do { __builtin_amdgcn_s_setprio(1); _Pragma("unroll") for (int m = 0; m < 4; ++m) _Pragma("unroll") for (int n = 0; n < 2; ++n) _Pragma("unroll") for (int k = 0; k < 2; ++k) \
        acc[ai][bj][m][n] = __builtin_amdgcn_mfma_f32_16x16x32_bf16(Bt[n][k], At[m][k], acc[ai][bj][m][n], 0, 0, 0); __builtin_amdgcn_s_setprio(0); } while (0)
#define PG8_WAIT_V(n) asm volatile("s_waitcnt vmcnt(" #n ")" ::: "memory")
#define PG8_WAIT_L(n) asm volatile("s_waitcnt lgkmcnt(" #n ")" ::: "memory")
#define PG8_BAR __builtin_amdgcn_s_barrier()
#define PG8_SCHED __builtin_amdgcn_sched_barrier(0)
    Unit cur, nxt; int ui = 0;
    if (!S.next(0, cur)) return;
    f32x4 acc[2][2][4][2];
#pragma unroll
    for (int a = 0; a < 2; ++a)
#pragma unroll
        for (int b = 0; b < 2; ++b)
#pragma unroll
            for (int m = 0; m < 4; ++m)
#pragma unroll
                for (int n = 0; n < 2; ++n) acc[a][b][m][n] = (f32x4){0.f, 0.f, 0.f, 0.f};
    bf16x8 At[4][2], B0[2][2], B1[2][2];
    const char* cA = (const char*)g.A + (size_t)cur.pm * tstep; const char* cB = (const char*)g.Bt + (size_t)cur.pn * tstep;
    S.a_ready(cur);
    if constexpr (SP2) {
        PG8_STAGE(PG8_SB(0, 0), cB, voffB); PG8_STAGE(PG8_SB(0, 1), cB + hstep, voffB); PG8_STAGE(PG8_SA(0, 0), cA, voffA); PG8_STAGE(PG8_SA(0, 1), cA + hstep, voffA);
        if (wr == 1) PG8_BAR;
        PG8_WAIT_V(2); PG8_BAR;
        PG8_STAGE(PG8_SB(1, 0), cB + kstep, voffB); PG8_STAGE(PG8_SA(1, 0), cA + kstep, voffA); PG8_STAGE(PG8_SB(1, 1), cB + hstep + kstep, voffB);
        PG8_WAIT_V(6); PG8_BAR;
    } else {
        PG8_STAGE(PG8_SB(0, 0), cB, voffB); PG8_STAGE(PG8_SA(0, 0), cA, voffA); PG8_STAGE(PG8_SB(0, 1), cB + hstep, voffB); PG8_STAGE(PG8_SA(0, 1), cA + hstep, voffA);
        if (wr == 1) PG8_BAR;
        PG8_WAIT_V(4); PG8_BAR;
        PG8_STAGE(PG8_SB(1, 0), cB + kstep, voffB); PG8_STAGE(PG8_SA(1, 0), cA + kstep, voffA); PG8_STAGE(PG8_SB(1, 1), cB + hstep + kstep, voffB);
        PG8_WAIT_V(6); PG8_BAR;
    }
    for (;;) {
        const bool has_next = S.next(ui + 1, nxt);
        const char* nA = has_next ? (const char*)g.A + (size_t)nxt.pm * tstep : cA; const char* nB = has_next ? (const char*)g.Bt + (size_t)nxt.pn * tstep : cB;
        for (int t = 0; t < nt; t += 2) {
            const bool last = (t == nt - 2);
            const char* a1 = cA + (size_t)(t + 1) * kstep;
            const char* a2 = last ? nA : cA + (size_t)(t + 2) * kstep; const char* b2 = last ? nB : cB + (size_t)(t + 2) * kstep;
            const char* a3 = a2 + kstep; const char* b3 = b2 + kstep;
            if (last && has_next) S.a_ready(nxt);
            if constexpr (SP2) {
            PG8_LDB(B0, 0, 0); PG8_LDB(B1, 0, 1); PG8_SCHED; PG8_LDA(At, 0, 0); PG8_STAGE(PG8_SA(1, 1), a1 + hstep, voffA);
            PG8_WAIT_V(8); PG8_WAIT_L(0); PG8_BAR; PG8_MMA(0, 0, At, B0); PG8_MMA(0, 1, At, B1); PG8_BAR; PG8_SCHED;
            PG8_LDA(At, 0, 1); PG8_STAGE(PG8_SB(0, 0), b2, voffB); PG8_STAGE(PG8_SB(0, 1), b2 + hstep, voffB); PG8_STAGE(PG8_SA(0, 0), a2, voffA);
            PG8_WAIT_V(8); PG8_WAIT_L(0); PG8_BAR; PG8_MMA(1, 0, At, B0); PG8_MMA(1, 1, At, B1); PG8_BAR; PG8_SCHED;
            PG8_LDB(B0, 1, 0); PG8_LDB(B1, 1, 1); PG8_SCHED; PG8_LDA(At, 1, 0); PG8_STAGE(PG8_SA(0, 1), a2 + hstep, voffA);
            PG8_WAIT_V(8); PG8_WAIT_L(0); PG8_BAR; PG8_MMA(0, 0, At, B0); PG8_MMA(0, 1, At, B1); PG8_BAR; PG8_SCHED;
            PG8_LDA(At, 1, 1); PG8_STAGE(PG8_SB(1, 0), b3, voffB); PG8_STAGE(PG8_SB(1, 1), b3 + hstep, voffB); PG8_STAGE(PG8_SA(1, 0), a3, voffA);
            PG8_WAIT_V(8); PG8_WAIT_L(0); PG8_BAR; PG8_MMA(1, 0, At, B0); PG8_MMA(1, 1, At, B1); PG8_BAR; PG8_SCHED;
            } else {
            PG8_LDB(B0, 0, 0); PG8_SCHED; PG8_LDA(At, 0, 0); PG8_STAGE(PG8_SA(1, 1), a1 + hstep, voffA);
            PG8_WAIT_L(8); PG8_BAR; PG8_WAIT_L(0); PG8_MMA(0, 0, At, B0); PG8_BAR; PG8_SCHED;
            PG8_LDB(B1, 0, 1); PG8_STAGE(PG8_SB(0, 0), b2, voffB);
            PG8_BAR; PG8_WAIT_L(0); PG8_MMA(0, 1, At, B1); PG8_BAR;
            PG8_LDA(At, 0, 1); PG8_STAGE(PG8_SA(0, 0), a2, voffA);
            PG8_BAR; PG8_WAIT_L(0); PG8_MMA(1, 0, At, B0); PG8_BAR; PG8_SCHED;
            PG8_STAGE(PG8_SB(0, 1), b2 + hstep, voffB);
            PG8_WAIT_V(6); PG8_BAR; PG8_MMA(1, 1, At, B1); PG8_BAR;
            PG8_LDB(B0, 1, 0); PG8_SCHED; PG8_LDA(At, 1, 0); PG8_STAGE(PG8_SA(0, 1), a2 + hstep, voffA);
            PG8_WAIT_L(8); PG8_BAR; PG8_WAIT_L(0); PG8_MMA(0, 0, At, B0); PG8_BAR; PG8_SCHED;
            PG8_LDB(B1, 1, 1); PG8_STAGE(PG8_SB(1, 0), b3, voffB);
            PG8_BAR; PG8_WAIT_L(0); PG8_MMA(0, 1, At, B1); PG8_BAR;
            PG8_LDA(At, 1, 1); PG8_STAGE(PG8_SA(1, 0), a3, voffA);
            PG8_BAR; PG8_WAIT_L(0); PG8_MMA(1, 0, At, B0); PG8_BAR; PG8_SCHED;
            PG8_STAGE(PG8_SB(1, 1), b3 + hstep, voffB);
            PG8_WAIT_V(6); PG8_BAR; PG8_MMA(1, 1, At, B1); PG8_BAR;
            }
        }
        if constexpr (ALIGN_EPI) { if (wr == 0) PG8_BAR; }
        if constexpr (!Epi::AFTER_DRAIN) { E(acc, cur, wr, wc, fr, fq); S.done(cur); }
        if (!has_next) break;
#pragma unroll
        for (int a = 0; a < 2; ++a)
#pragma unroll
            for (int b = 0; b < 2; ++b)
#pragma unroll
                for (int m = 0; m < 4; ++m)
#pragma unroll
                    for (int n = 0; n < 2; ++n) acc[a][b][m][n] = (f32x4){0.f, 0.f, 0.f, 0.f};
        cur = nxt; cA = nA; cB = nB; ++ui;
        if constexpr (ALIGN_EPI) { if (wr == 1) PG8_BAR; }
    }
    PG8_WAIT_V(0);
    if constexpr (!ALIGN_EPI) { if (wr == 0) PG8_BAR; }
    PG8_BAR;
    if constexpr (Epi::AFTER_DRAIN) { E.fused(acc, cur, wr, wc, fr, fq, lds, wid, lane); S.done(cur); }
#undef PG8_SA
#undef PG8_SB
#undef PG8_STAGE
#undef PG8_LDA
#undef PG8_LDB
#undef PG8_MMA
#undef PG8_WAIT_V
#undef PG8_WAIT_L
#undef PG8_BAR
#undef PG8_SCHED
}
}

#define LAS __attribute__((address_space(3)))
typedef unsigned short bf16;
typedef float f32x4 __attribute__((ext_vector_type(4)));
typedef unsigned u32x4 __attribute__((ext_vector_type(4)));
typedef unsigned u32x2 __attribute__((ext_vector_type(2)));
constexpr int NWAVES = 8, NTHR = 512;
constexpr int DM = 1024, NBATCH = 8, SEQ = 2048, MP = NBATCH * SEQ, DECB = 32, DECS = 8, MS = DECB * DECS, MT = MP + MS;
constexpr int NH = 12, HD = 64, DA = NH * HD;
constexpr int DSSM = 2048, NSH = 32, SHD = 64, NGRP = 8, DST = 128, DCONV = 4096;
constexpr int PAST = 16384, KVB = 2048;
constexpr int NIN = 11296, NPROJ = 11264, NPAD = 11520;
constexpr int C_Q = 0, C_K = 768, C_V = 1536, C_G = 2304, C_Z = 3072, C_XBC = 5120, C_GA = 9216, C_GB = 10240;
constexpr size_t MiB = 1u << 20;
constexpr size_t WS_ARGS = 1 * MiB - 4096, WS_PRM = 1 * MiB, WS_WIN = 2 * MiB, WS_WA = 26 * MiB, WS_WB = 28 * MiB, WS_WO = 32 * MiB, WS_HB = 36 * MiB, WS_DT = 70 * MiB, WS_PROJ = 74 * MiB,
                 WS_YA = 432 * MiB, WS_YS = 458 * MiB, WS_SSQ = 524 * MiB, WS_TMP = 528 * MiB, WS_MRG = 594 * MiB, WS_END = 628 * MiB;
constexpr size_t O_YP = 0, O_YS = O_YP + (size_t)MP * DM, O_KP = O_YS + (size_t)MS * DM, O_VP = O_KP + (size_t)MP * DA, O_CP = O_VP + (size_t)MP * DA,
                 O_SP = O_CP + (size_t)NBATCH * 3 * DCONV, O_KS = O_SP + (size_t)NBATCH * NSH * SHD * DST, O_VS = O_KS + (size_t)MS * DA, O_CS = O_VS + (size_t)MS * DA,
                 O_SS = O_CS + (size_t)DECB * 3 * DCONV, O_END = O_SS + (size_t)DECB * NSH * SHD * DST;
constexpr int LDS_BYTES = 147456;
constexpr int PR_CONVW = 0, PR_CONVB = 16384, PR_DTB = 20480, PR_ALOG = 20512, PR_DSKIP = 20544, PR_RELB = 20576, PR_FNORM = 20992, PR_END = 22016;

struct Args {
    const float *x_prompt, *x_sample, *cache_k, *cache_v, *state_conv, *state_ssm, *norm_g, *w_in, *conv_w, *conv_b, *dt_bias, *a_log, *d_skip, *ssm_norm, *w_a, *w_b, *w_out, *rel_bias, *final_norm;
    float* out; unsigned char* ws;
};

__device__ __forceinline__ float bf2f(bf16 b) { return __uint_as_float(((unsigned)b) << 16); }
__device__ __forceinline__ unsigned f2bf(float f) { unsigned u = __float_as_uint(f); return (u + 0x7fffu + ((u >> 16) & 1u)) >> 16; }
__device__ __forceinline__ unsigned pk2(float lo, float hi) { return f2bf(lo) | (f2bf(hi) << 16); }
__device__ __forceinline__ float sigmoidf_(float x) { return 1.f / (1.f + __expf(-x)); }
__device__ __forceinline__ float siluf_(float x) { return x / (1.f + __expf(-x)); }
__device__ __forceinline__ float softplusf_(float x) { return fmaxf(x, 0.f) + log1pf(__expf(-fabsf(x))); }
__device__ __forceinline__ float wave_sum(float v) {
#pragma unroll
    for (int o = 1; o < 64; o <<= 1) v += __shfl_xor(v, o);
    return v;
}
__device__ __forceinline__ float wave_max(float v) {
#pragma unroll
    for (int o = 1; o < 64; o <<= 1) v = fmaxf(v, __shfl_xor(v, o));
    return v;
}
__device__ __forceinline__ int t5_bucket(int off) {
    if (off < 16) return off;
    return 16 + (off >= 22) + (off >= 30) + (off >= 40) + (off >= 54) + (off >= 73) + (off >= 99) + (off >= 134) + (off >= 182) + (off >= 246) + (off >= 332) + (off >= 450) + (off >= 609) + (off >= 825) + (off >= 1117) + (off >= 1513);
}
__device__ __forceinline__ const float* ld_ptr(const unsigned char* ws, int idx) { const unsigned long long v = ((const unsigned long long*)(ws + WS_ARGS))[idx];
    const unsigned lo = __builtin_amdgcn_readfirstlane((unsigned)v), hi = __builtin_amdgcn_readfirstlane((unsigned)(v >> 32)); return (const float*)(((unsigned long long)hi << 32) | lo); }
#define LDS_WAIT() asm volatile("s_waitcnt lgkmcnt(0)" ::: "memory")
typedef short bf16x8 __attribute__((ext_vector_type(8)));
typedef short s16x4 __attribute__((ext_vector_type(4)));
constexpr int AT_ST = 0, AT_STROW = 272, AT_ML = 69632, AT_BIAS = 71680, AT_V = 73728, AT_VROW = 144, AT_VBYTES = 32 * AT_VROW;
constexpr float LOG2E = 1.4426950408889634f;
__device__ __forceinline__ s16x4 lds_tr16(LAS const unsigned char* p) { return __builtin_bit_cast(s16x4, __builtin_amdgcn_ds_read_tr16_b64_v4i16((LAS s16x4*)p)); }

__device__ __forceinline__ void attn_item(const bf16* base  , int P0, int stride, const LAS float* bias2, LAS unsigned char* vst, int lane, float& m_out, float& l_out, f32x4 (&o)[4]) {
    const int c = lane & 15, rq = lane >> 4;
    bf16x8 qf[2];
    { const bf16* qp = base + (size_t)(P0 + stride * c) * NPROJ + C_Q + rq * 8; qf[0] = *(const bf16x8*)qp; qf[1] = *(const bf16x8*)(qp + 32); }
    f32x4 sc[9];
#pragma unroll
    for (int kt = 0; kt < 9; ++kt) {
        const bool tile_valid = (P0 + stride * (16 * kt + 15 - 128)) >= 0;
        if (tile_valid) {
            int kpos = P0 + stride * (16 * kt + c - 128); kpos = kpos < 0 ? 0 : kpos;
            const bf16* kp = base + (size_t)kpos * NPROJ + C_K + rq * 8;
            const bf16x8 k0 = *(const bf16x8*)kp, k1 = *(const bf16x8*)(kp + 32);
            f32x4 acc = {0.f, 0.f, 0.f, 0.f};
            acc = __builtin_amdgcn_mfma_f32_16x16x32_bf16(k0, qf[0], acc, 0, 0, 0);
            acc = __builtin_amdgcn_mfma_f32_16x16x32_bf16(k1, qf[1], acc, 0, 0, 0);
#pragma unroll
            for (int j = 0; j < 4; ++j) { const int kidx = 16 * kt + 4 * rq + j, jj = c + 128 - kidx, kp2 = P0 + stride * (kidx - 128);
                const bool valid = (jj >= 0) && (jj <= 128) && (kp2 >= 0); const int jc = jj < 0 ? 0 : (jj > 128 ? 128 : jj);
                sc[kt][j] = valid ? acc[j] * (0.125f * LOG2E) + bias2[jc] : -INFINITY; }
        } else sc[kt] = (f32x4){-INFINITY, -INFINITY, -INFINITY, -INFINITY};
    }
    float m = -INFINITY;
#pragma unroll
    for (int kt = 0; kt < 9; ++kt) m = fmaxf(fmaxf(fmaxf(m, sc[kt][0]), fmaxf(sc[kt][1], sc[kt][2])), sc[kt][3]);
    m = fmaxf(m, __shfl_xor(m, 16)); m = fmaxf(m, __shfl_xor(m, 32));
    float l = 0.f;
#pragma unroll
    for (int kt = 0; kt < 9; ++kt)
#pragma unroll
        for (int j = 0; j < 4; ++j) { const float p = __builtin_amdgcn_exp2f(sc[kt][j] - m); sc[kt][j] = p; l += p; }
    l += __shfl_xor(l, 16); l += __shfl_xor(l, 32);
#pragma unroll
    for (int dt = 0; dt < 4; ++dt) o[dt] = (f32x4){0.f, 0.f, 0.f, 0.f};
#pragma unroll
    for (int ks = 0; ks < 5; ++ks) {
        const int ktl = (2 * ks + 1 < 9) ? 2 * ks + 1 : 8;
        const bool step_valid = (P0 + stride * (16 * ktl + 15 - 128)) >= 0;
        if (step_valid) {
#pragma unroll
            for (int i = 0; i < 4; ++i) { const int kl = 8 * i + (lane >> 3); int kpos = P0 + stride * (32 * ks + kl - 128); kpos = kpos < 0 ? 0 : (kpos > SEQ - 1 ? SEQ - 1 : kpos);
                const u32x4 v = *(const u32x4*)(base + (size_t)kpos * NPROJ + C_V + (lane & 7) * 8);
                *(LAS u32x4*)(vst + kl * AT_VROW + (lane & 7) * 16) = v; }
            bf16x8 pb;
            { const f32x4 pa = sc[2 * ks]; const f32x4 pz = (2 * ks + 1 < 9) ? sc[(2 * ks + 1 < 9) ? 2 * ks + 1 : 8] : (f32x4){0.f, 0.f, 0.f, 0.f};
              u32x4 w; w.x = pk2(pa[0], pa[1]); w.y = pk2(pa[2], pa[3]); w.z = pk2(pz[0], pz[1]); w.w = pk2(pz[2], pz[3]); pb = __builtin_bit_cast(bf16x8, w); }
            LDS_WAIT(); asm volatile("" ::: "memory");
            LAS const unsigned char* vr = vst + (4 * rq + ((lane & 15) >> 2)) * AT_VROW + (lane & 3) * 8;
#pragma unroll
            for (int dt = 0; dt < 4; ++dt) { const s16x4 lo = lds_tr16(vr + dt * 32), hi = lds_tr16(vr + dt * 32 + 16 * AT_VROW);
                const bf16x8 vf = (bf16x8){lo[0], lo[1], lo[2], lo[3], hi[0], hi[1], hi[2], hi[3]};
                o[dt] = __builtin_amdgcn_mfma_f32_16x16x32_bf16(vf, pb, o[dt], 0, 0, 0); }
            LDS_WAIT(); asm volatile("" ::: "memory");
        }
    }
    m_out = m; l_out = l;
}
__device__ __forceinline__ void attn_merge(int mode, LAS unsigned char* lds, int ql, int lane, float m, float l, f32x4 (&o)[4], const bf16* gp  , bf16* yp  ) {
    const int rq = lane >> 4;
    LAS float* ml = (LAS float*)(lds + AT_ML) + ql * 2; LAS unsigned char* st = lds + AT_ST + ql * AT_STROW + rq * 16;
    if (mode == 0) {
#pragma unroll
        for (int dt = 0; dt < 4; ++dt) *(LAS f32x4*)(st + dt * 64) = o[dt];
        if (rq == 0) { ml[0] = m; ml[1] = l; }
    } else {
        const float M = ml[0], L = ml[1]; const float Mn = fmaxf(M, m), ca = __builtin_amdgcn_exp2f(M - Mn), cb = __builtin_amdgcn_exp2f(m - Mn); const float Ln = L * ca + l * cb;
        f32x4 on[4];
#pragma unroll
        for (int dt = 0; dt < 4; ++dt) on[dt] = *(LAS const f32x4*)(st + dt * 64) * ca + o[dt] * cb;
        if (mode == 1) {
            LDS_WAIT(); asm volatile("" ::: "memory");
#pragma unroll
            for (int dt = 0; dt < 4; ++dt) *(LAS f32x4*)(st + dt * 64) = on[dt];
            if (rq == 0) { ml[0] = Mn; ml[1] = Ln; }
        } else {
            const float inv = 1.f / Ln;
#pragma unroll
            for (int dt = 0; dt < 4; ++dt) { const u32x2 g = *(const u32x2*)(gp + 16 * dt + 4 * rq);
                const float g0 = __uint_as_float(g.x << 16), g1 = __uint_as_float(g.x & 0xffff0000u), g2 = __uint_as_float(g.y << 16), g3 = __uint_as_float(g.y & 0xffff0000u);
                u32x2 w; w.x = pk2(on[dt][0] * inv * siluf_(g0), on[dt][1] * inv * siluf_(g1)); w.y = pk2(on[dt][2] * inv * siluf_(g2), on[dt][3] * inv * siluf_(g3));
                *(u32x2*)(yp + 16 * dt + 4 * rq) = w; }
        }
    }
}
__device__ __forceinline__ void attn_unit(const unsigned char* ws, LAS unsigned char* lds, int b, int h, int s, int wave, int lane) {
    const bf16* proj = (const bf16*)(ws + WS_PROJ); bf16* ya = (bf16*)(ws + WS_YA); const float* prm = (const float*)(ws + WS_PRM);
    const bf16* base = proj + (size_t)b * SEQ * NPROJ + h * HD;
    LAS float* bias2 = (LAS float*)(lds + AT_BIAS); LAS unsigned char* vst = lds + AT_V + wave * AT_VBYTES;
    for (int idx = threadIdx.x; idx < 3 * 129; idx += NTHR) { const int g = idx / 129, j = idx - g * 129; bias2[g * 132 + j] = prm[PR_RELB + t5_bucket(j << (2 * g)) * NH + h] * LOG2E; }
    const int c = lane & 15;
#pragma unroll 1
    for (int it = 0; it < 6; ++it) {
        if ((it & 1) == 0) __syncthreads();
        const int id = 2 * wave + (it & 1), mode = it >> 1;
        int q0, stride;
        if (mode == 0) { q0 = id; stride = 16; } else if (mode == 1) { q0 = (id >> 2) + 64 * (id & 3); stride = 4; } else { q0 = 16 * id; stride = 1; }
        float m, l; f32x4 o[4];
        attn_item(base, s + q0, stride, bias2 + (2 - mode) * 132, vst, lane, m, l, o);
        const int ql = q0 + stride * c; const size_t row = (size_t)b * SEQ + s + ql;
        attn_merge(mode, lds, ql, lane, m, l, o, proj + row * NPROJ + C_G + h * HD, ya + row * DA + h * HD);
    }
    __syncthreads();
}
constexpr int SD_BM = 0, SD_CM = 17408, SD_CS = 34816, SD_ROWN = 272, SD_BWT = 52224, SD_XT = 70656, SD_ROWS = 144, SD_YP = 79872, SD_YROW = 272, SD_AR = 114688;
__device__ __forceinline__ void ssd_dtarrays(LAS float* ar, const float* dtb, size_t row, int hd, float Aneg, int lane) {
    asm volatile("" : "+v"(lane));
    const float dtv = dtb[(row + lane) * 32 + hd]; float x = dtv * Aneg * LOG2E;
#pragma unroll
    for (int o = 1; o < 64; o <<= 1) { const float y = __shfl_up(x, o); if (lane >= o) x += y; }
    const float tot = __shfl(x, 63);
    ar[lane] = x; ar[64 + lane] = dtv; ar[128 + lane] = __builtin_amdgcn_exp2f(tot - x) * dtv; ar[192 + lane] = __builtin_amdgcn_exp2f(x);
}
__device__ __forceinline__ float silu_fast(float x) { return x * __builtin_amdgcn_rcpf(1.f + __builtin_amdgcn_exp2f(-x * LOG2E)); }
template <int KIND, int RL> __device__ __forceinline__ void ssd_conv_task(const bf16* proj, const bf16* zrow  , const float* prm, LAS unsigned char* lds, size_t row0, int c0, int t0, int col  , int ch  ) {
    const LAS float* ar = (const LAS float*)(lds + SD_AR);
    float w0[4], w1[4];
#pragma unroll
    for (int tap = 0; tap < 4; ++tap) { w0[tap] = prm[PR_CONVW + tap * DCONV + col]; w1[tap] = prm[PR_CONVW + tap * DCONV + col + 1]; }
    const float b0 = prm[PR_CONVB + col], b1 = prm[PR_CONVB + col + 1];
    unsigned raw[RL + 3];
#pragma unroll
    for (int k = 0; k < RL + 3; ++k) { const int T = c0 + t0 - 3 + k; const bf16* rp = (T >= 0) ? proj + (row0 + (size_t)T) * NPROJ + C_XBC : zrow; raw[k] = *(const unsigned*)(rp + col); }
#pragma unroll
    for (int blk = 0; blk < RL / 8; ++blk) {
        float o0[8], o1[8];
#pragma unroll
        for (int tt = 0; tt < 8; ++tt) { const int t = blk * 8 + tt; float v0 = b0, v1 = b1;
#pragma unroll
            for (int tap = 0; tap < 4; ++tap) { v0 += w0[tap] * __uint_as_float(raw[t + tap] << 16); v1 += w1[tap] * __uint_as_float(raw[t + tap] & 0xffff0000u); }
            o0[tt] = silu_fast(v0); o1[tt] = silu_fast(v1); }
        const int s0 = t0 + blk * 8;
        if (KIND == 0) {
            u32x4 a, b; a.x = pk2(o0[0], o0[1]); a.y = pk2(o0[2], o0[3]); a.z = pk2(o0[4], o0[5]); a.w = pk2(o0[6], o0[7]); b.x = pk2(o1[0], o1[1]); b.y = pk2(o1[2], o1[3]); b.z = pk2(o1[4], o1[5]); b.w = pk2(o1[6], o1[7]);
            *(LAS u32x4*)(lds + SD_XT + ch * SD_ROWS + s0 * 2) = a; *(LAS u32x4*)(lds + SD_XT + (ch + 1) * SD_ROWS + s0 * 2) = b;
        } else if (KIND == 1) {
            float s0v[8], s1v[8];
#pragma unroll
            for (int tt = 0; tt < 8; ++tt) { *(LAS unsigned*)(lds + SD_BM + (s0 + tt) * SD_ROWN + ch * 2) = pk2(o0[tt], o1[tt]); const float w = ar[128 + s0 + tt]; s0v[tt] = o0[tt] * w; s1v[tt] = o1[tt] * w; }
            u32x4 a, b; a.x = pk2(s0v[0], s0v[1]); a.y = pk2(s0v[2], s0v[3]); a.z = pk2(s0v[4], s0v[5]); a.w = pk2(s0v[6], s0v[7]); b.x = pk2(s1v[0], s1v[1]); b.y = pk2(s1v[2], s1v[3]); b.z = pk2(s1v[4], s1v[5]); b.w = pk2(s1v[6], s1v[7]);
            *(LAS u32x4*)(lds + SD_BWT + ch * SD_ROWS + s0 * 2) = a; *(LAS u32x4*)(lds + SD_BWT + (ch + 1) * SD_ROWS + s0 * 2) = b;
        } else {
#pragma unroll
            for (int tt = 0; tt < 8; ++tt) { *(LAS unsigned*)(lds + SD_CM + (s0 + tt) * SD_ROWN + ch * 2) = pk2(o0[tt], o1[tt]); const float e = ar[192 + s0 + tt];
                *(LAS unsigned*)(lds + SD_CS + (s0 + tt) * SD_ROWN + ch * 2) = pk2(o0[tt] * e, o1[tt] * e); }
        }
    }
}
__device__ __forceinline__ bf16x8 cat8(s16x4 a, s16x4 b) { return (bf16x8){a[0], a[1], a[2], a[3], b[0], b[1], b[2], b[3]}; }
template <int HH> __device__ __forceinline__ void ssd_mfma_step(LAS unsigned char* lds, f32x4 (&Hacc)[4], int pt, int c, int rq, float Dk) {
    const LAS float* ar = (const LAS float*)(lds + SD_AR);
    bf16x8 bmf[2][4];
#pragma unroll
    for (int st = 0; st < 2; ++st)
#pragma unroll
        for (int ks = 0; ks < 4; ++ks) bmf[st][ks] = *(LAS const bf16x8*)(lds + SD_BM + (32 * HH + 16 * st + c) * SD_ROWN + (8 * rq + 32 * ks) * 2);
    const f32x4 as0 = *(LAS const f32x4*)(ar + 32 * HH + 4 * rq), as1 = *(LAS const f32x4*)(ar + 32 * HH + 16 + 4 * rq);
    const f32x4 dt0 = *(LAS const f32x4*)(ar + 64 + 32 * HH + 4 * rq), dt1 = *(LAS const f32x4*)(ar + 64 + 32 * HH + 16 + 4 * rq);
    int dd = c - 4 * rq; asm volatile("" : "+v"(dd));
    const int p = 16 * pt + c;
    const bf16x8 xb = cat8(*(LAS const s16x4*)(lds + SD_XT + p * SD_ROWS + (32 * HH + 4 * rq) * 2), *(LAS const s16x4*)(lds + SD_XT + p * SD_ROWS + (32 * HH + 16 + 4 * rq) * 2));
    bf16x8 hb[2];
#pragma unroll
    for (int k2 = 0; k2 < 2; ++k2) { u32x4 w; w.x = pk2(Hacc[2 * k2][0], Hacc[2 * k2][1]); w.y = pk2(Hacc[2 * k2][2], Hacc[2 * k2][3]); w.z = pk2(Hacc[2 * k2 + 1][0], Hacc[2 * k2 + 1][1]); w.w = pk2(Hacc[2 * k2 + 1][2], Hacc[2 * k2 + 1][3]); hb[k2] = __builtin_bit_cast(bf16x8, w); }
#pragma unroll
    for (int lt = 0; lt < 4; ++lt) {
        constexpr int S0 = 2 * HH, S1 = 2 * HH + 1;
        const int rel0 = lt - S0, rel1 = lt - S1;
        f32x4 y = {0.f, 0.f, 0.f, 0.f};
        if (rel0 >= 0) {
            f32x4 g0 = {0.f, 0.f, 0.f, 0.f}, g1 = {0.f, 0.f, 0.f, 0.f};
#pragma unroll
            for (int ks = 0; ks < 4; ++ks) { const bf16x8 cf = *(LAS const bf16x8*)(lds + SD_CM + (16 * lt + c) * SD_ROWN + (8 * rq + 32 * ks) * 2);
                g0 = __builtin_amdgcn_mfma_f32_16x16x32_bf16(bmf[0][ks], cf, g0, 0, 0, 0);
                if (rel1 >= 0) g1 = __builtin_amdgcn_mfma_f32_16x16x32_bf16(bmf[1][ks], cf, g1, 0, 0, 0); }
            const float acl = ar[16 * lt + c];
            float m0[4], m1[4];
#pragma unroll
            for (int j = 0; j < 4; ++j) {
                float v0 = g0[j] * __builtin_amdgcn_exp2f(fminf(acl - as0[j], 0.f)) * dt0[j];
                if (rel0 == 0) { v0 = (j <= dd) ? v0 : 0.f; v0 += (j == dd) ? Dk : 0.f; }
                m0[j] = v0;
                float v1 = 0.f;
                if (rel1 >= 0) { v1 = g1[j] * __builtin_amdgcn_exp2f(fminf(acl - as1[j], 0.f)) * dt1[j]; if (rel1 == 0) { v1 = (j <= dd) ? v1 : 0.f; v1 += (j == dd) ? Dk : 0.f; } }
                m1[j] = v1; }
            u32x4 w; w.x = pk2(m0[0], m0[1]); w.y = pk2(m0[2], m0[3]); w.z = pk2(m1[0], m1[1]); w.w = pk2(m1[2], m1[3]);
            y = __builtin_amdgcn_mfma_f32_16x16x32_bf16(__builtin_bit_cast(bf16x8, w), xb, y, 0, 0, 0);
        }
#pragma unroll
        for (int k2 = 0; k2 < 2; ++k2) { const LAS unsigned char* cp = lds + SD_CS + (16 * lt + c) * SD_ROWN + (64 * HH + 32 * k2 + 4 * rq) * 2;
            y = __builtin_amdgcn_mfma_f32_16x16x32_bf16(cat8(*(LAS const s16x4*)cp, *(LAS const s16x4*)(cp + 32)), hb[k2], y, 0, 0, 0); }
#pragma unroll
        for (int j = 0; j < 4; ++j) *(LAS float*)(lds + SD_YP + HH * (64 * SD_YROW) + (16 * lt + 4 * rq + j) * SD_YROW + p * 4) = y[j];
    }
    const float dec = __builtin_amdgcn_exp2f(ar[63]);
    bf16x8 xn[2];
#pragma unroll
    for (int k2 = 0; k2 < 2; ++k2) xn[k2] = *(LAS const bf16x8*)(lds + SD_XT + p * SD_ROWS + (8 * rq + 32 * k2) * 2);
#pragma unroll
    for (int nt = 0; nt < 4; ++nt) { Hacc[nt] = Hacc[nt] * dec;
#pragma unroll
        for (int k2 = 0; k2 < 2; ++k2) Hacc[nt] = __builtin_amdgcn_mfma_f32_16x16x32_bf16(*(LAS const bf16x8*)(lds + SD_BWT + (64 * HH + 16 * nt + c) * SD_ROWS + (8 * rq + 32 * k2) * 2), xn[k2], Hacc[nt], 0, 0, 0); }
}
__device__ __forceinline__ void ssd_mfma_unit(const unsigned char* ws, float* out, LAS unsigned char* lds, int b, int hd, int wave, int lane) {
    const bf16* proj = (const bf16*)(ws + WS_PROJ); const float* dtb = (const float*)(ws + WS_DT); const float* prm = (const float*)(ws + WS_PRM); bf16* ys = (bf16*)(ws + WS_YS); float* ssq = (float*)(ws + WS_SSQ);
    const int tid = threadIdx.x, c = lane & 15, rq = lane >> 4, pt = wave & 3, hh = wave >> 2, grp = hd >> 2;
    const size_t row0 = (size_t)b * SEQ; const bf16* zrow = (const bf16*)(ws + WS_WIN) + (size_t)NIN * DM;
    const float Aneg = -__expf(prm[PR_ALOG + hd]), Dk = prm[PR_DSKIP + hd];
    LAS float* ar = (LAS float*)(lds + SD_AR);
    f32x4 Hacc[4];
#pragma unroll
    for (int nt = 0; nt < 4; ++nt) Hacc[nt] = (f32x4){0.f, 0.f, 0.f, 0.f};
    __syncthreads();
    if (wave == 7) ssd_dtarrays(ar, dtb, row0, hd, Aneg, lane);
    __syncthreads();
#pragma unroll 1
    for (int c0 = 0; c0 < SEQ; c0 += 64) {
        if (wave < 2) { const int task = wave * 64 + lane, pair = task & 31, run = task >> 5; ssd_conv_task<0, 16>(proj, zrow, prm, lds, row0, c0, 16 * run, hd * 64 + 2 * pair, 2 * pair); }
        else if (wave < 4) { const int task = (wave - 2) * 64 + lane, pair = task & 63, run = task >> 6; ssd_conv_task<1, 32>(proj, zrow, prm, lds, row0, c0, 32 * run, DSSM + grp * DST + 2 * pair, 2 * pair); }
        else if (wave < 6) { const int task = (wave - 4) * 64 + lane, pair = task & 63, run = task >> 6; ssd_conv_task<2, 32>(proj, zrow, prm, lds, row0, c0, 32 * run, DSSM + NGRP * DST + grp * DST + 2 * pair, 2 * pair); }
        __syncthreads();
        if (hh == 0) ssd_mfma_step<0>(lds, Hacc, pt, c, rq, Dk); else ssd_mfma_step<1>(lds, Hacc, pt, c, rq, Dk);
        __syncthreads();
        {
            const int l = tid >> 3, p0 = (tid & 7) * 8; const size_t row = row0 + c0 + l;
            const LAS float* y0 = (const LAS float*)(lds + SD_YP + l * SD_YROW + p0 * 4); const LAS float* y1 = (const LAS float*)(lds + SD_YP + 64 * SD_YROW + l * SD_YROW + p0 * 4);
            const f32x4 a0 = *(const LAS f32x4*)y0 + *(const LAS f32x4*)y1, a1 = *(const LAS f32x4*)(y0 + 4) + *(const LAS f32x4*)(y1 + 4);
            const u32x4 z = *(const u32x4*)(proj + row * NPROJ + C_Z + hd * 64 + p0);
            float v[8];
            v[0] = a0[0] * silu_fast(__uint_as_float(z.x << 16)); v[1] = a0[1] * silu_fast(__uint_as_float(z.x & 0xffff0000u)); v[2] = a0[2] * silu_fast(__uint_as_float(z.y << 16)); v[3] = a0[3] * silu_fast(__uint_as_float(z.y & 0xffff0000u));
            v[4] = a1[0] * silu_fast(__uint_as_float(z.z << 16)); v[5] = a1[1] * silu_fast(__uint_as_float(z.z & 0xffff0000u)); v[6] = a1[2] * silu_fast(__uint_as_float(z.w << 16)); v[7] = a1[3] * silu_fast(__uint_as_float(z.w & 0xffff0000u));
            u32x4 w; w.x = pk2(v[0], v[1]); w.y = pk2(v[2], v[3]); w.z = pk2(v[4], v[5]); w.w = pk2(v[6], v[7]);
            *(u32x4*)(ys + row * DSSM + hd * 64 + p0) = w;
            float ss = (v[0] * v[0] + v[1] * v[1]) + (v[2] * v[2] + v[3] * v[3]) + (v[4] * v[4] + v[5] * v[5]) + (v[6] * v[6] + v[7] * v[7]);
            ss += __shfl_xor(ss, 1); ss += __shfl_xor(ss, 2); ss += __shfl_xor(ss, 4);
            if ((tid & 7) == 0) ssq[row * NSH + hd] = ss;
            if (wave == 7 && c0 + 64 < SEQ) ssd_dtarrays(ar, dtb, row0 + c0 + 64, hd, Aneg, lane);
        }
        __syncthreads();
    }
    float* dst = out + O_SP + ((size_t)(b * NSH + hd) * SHD + 16 * pt + c) * DST + 64 * hh + 4 * rq;
#pragma unroll
    for (int nt = 0; nt < 4; ++nt) *(f32x4*)(dst + 16 * nt) = Hacc[nt];
}
__device__ __forceinline__ void p0_transpose_item(const float* W, int K, int N, bf16* WT, int k0, int n0, int dst_row0, const float* kscale, LAS float* scr, int lane) {
#pragma unroll 8
    for (int i = 0; i < 32; ++i) { const int kk = 2 * i + (lane >> 5); float v = W[(size_t)(k0 + kk) * N + n0 + (lane & 31)]; if (kscale) v *= kscale[k0 + kk]; scr[kk * 33 + (lane & 31)] = v; }
    LDS_WAIT(); asm volatile("" ::: "memory");
    const int c = lane & 7;
#pragma unroll
    for (int j = 0; j < 4; ++j) { const int n = (lane >> 3) + 8 * j; const LAS float* s = scr + (8 * c) * 33 + n;
        u32x4 o; o.x = pk2(s[0 * 33], s[1 * 33]); o.y = pk2(s[2 * 33], s[3 * 33]); o.z = pk2(s[4 * 33], s[5 * 33]); o.w = pk2(s[6 * 33], s[7 * 33]);
        *(u32x4*)(WT + (size_t)(dst_row0 + n) * K + k0 + 8 * c) = o; }
    LDS_WAIT(); asm volatile("" ::: "memory");
}
__device__ __forceinline__ void p0_prologue(const Args& a, LAS unsigned char* lds, int gw, int NGW, int wave, int lane) {
    bf16* win_t = (bf16*)(a.ws + WS_WIN); bf16* wa_t = (bf16*)(a.ws + WS_WA); bf16* wb_t = (bf16*)(a.ws + WS_WB); bf16* wo_t = (bf16*)(a.ws + WS_WO); bf16* hb = (bf16*)(a.ws + WS_HB);
    LAS float* scr = (LAS float*)(lds + wave * 16384);
    constexpr int I_IN = (DM / 64) * (NIN / 32), I_A = (DA / 64) * (DM / 32), I_B = (DSSM / 64) * (DM / 32), I_O = (DM / 64) * (DM / 32);
    for (int it = gw; it < I_IN + I_A + I_B + I_O; it += NGW) {
        int r = it;
        if (r < I_IN) { const int nblk = NIN / 32, kb = r / nblk, nb = r % nblk, n0 = nb * 32; const int dst = (n0 < 9216) ? n0 : (n0 == 9216 ? 11264 : n0 - 32);
            p0_transpose_item(a.w_in, DM, NIN, win_t, kb * 64, n0, dst, nullptr, scr, lane); continue; } r -= I_IN;
        if (r < I_A) { const int nblk = DM / 32, kb = r / nblk, nb = r % nblk; p0_transpose_item(a.w_a, DA, DM, wa_t, kb * 64, nb * 32, nb * 32, nullptr, scr, lane); continue; } r -= I_A;
        if (r < I_B) { const int nblk = DM / 32, kb = r / nblk, nb = r % nblk; p0_transpose_item(a.w_b, DSSM, DM, wb_t, kb * 64, nb * 32, nb * 32, a.ssm_norm, scr, lane); continue; } r -= I_B;
        { const int nblk = DM / 32, kb = r / nblk, nb = r % nblk; p0_transpose_item(a.w_out, DM, DM, wo_t, kb * 64, nb * 32, nb * 32, nullptr, scr, lane); }
    }
    { float* prm = (float*)(a.ws + WS_PRM); const int gt = gw * 64 + lane, NGT = NGW * 64;
      for (int i = gt; i < PR_END; i += NGT) { float v = 0.f;
          if (i < PR_CONVB) v = a.conv_w[i]; else if (i < PR_DTB) v = a.conv_b[i - PR_CONVB]; else if (i < PR_ALOG) v = a.dt_bias[i - PR_DTB]; else if (i < PR_DSKIP) v = a.a_log[i - PR_ALOG];
          else if (i < PR_RELB) v = a.d_skip[i - PR_DSKIP]; else if (i < PR_RELB + 384) v = a.rel_bias[i - PR_RELB]; else if (i >= PR_FNORM) v = a.final_norm[i - PR_FNORM];
          prm[i] = v; } }
    { u32x4* z = (u32x4*)(win_t + (size_t)11296 * DM); const int n16 = 224 * DM * 2 / 16; for (int i = gw * 64 + lane; i < n16; i += NGW * 64) z[i] = (u32x4){0u, 0u, 0u, 0u}; }
    for (int m = gw; m < MT; m += NGW) {
        const float* xrow = (m < MP) ? a.x_prompt + (size_t)m * DM : a.x_sample + (size_t)(m - MP) * DM;
        const f32x4* xr = (const f32x4*)xrow + lane; const f32x4* gr = (const f32x4*)a.norm_g + lane;
        f32x4 v[4]; float s = 0.f;
#pragma unroll
        for (int j = 0; j < 4; ++j) { v[j] = xr[64 * j]; s += (v[j].x * v[j].x + v[j].y * v[j].y) + (v[j].z * v[j].z + v[j].w * v[j].w); }
        const float rstd = rsqrtf(wave_sum(s) * (1.f / DM) + 1e-6f);
        unsigned long long* o8 = (unsigned long long*)(hb + (size_t)m * DM) + lane;
#pragma unroll
        for (int j = 0; j < 4; ++j) { const f32x4 g = gr[64 * j]; o8[64 * j] = (unsigned long long)pk2(v[j].x * rstd * g.x, v[j].y * rstd * g.y) | ((unsigned long long)pk2(v[j].z * rstd * g.z, v[j].w * rstd * g.w) << 32); }
    }
}

template <bool SAMP> __device__ __forceinline__ const void* kv_ptr(const Args& a, const bf16* proj, int colkv, const float* cache, int seq, int tpos, int off, int h, bool& valid, bool& isf32) {
    if (!SAMP) { const int kt = tpos - off; valid = kt >= 0; isf32 = false; return proj + (size_t)(seq * SEQ + (valid ? kt : 0)) * NPROJ + colkv + h * HD; }
    const int idx = KVB + tpos - off; valid = true;
    if (idx >= KVB) { isf32 = false; return proj + (size_t)(MP + seq * DECS + (idx - KVB)) * NPROJ + colkv + h * HD; }
    isf32 = true; return cache + ((size_t)(seq * KVB + idx) * NH + h) * HD;
}
template <bool SAMP> __device__ __forceinline__ void attn_slow_item(const Args& a, const bf16* proj, bf16* ya, LAS float* sl, int row, int h, int lane) {
    const float* prm = (const float*)(a.ws + WS_PRM);
    const int seq = SAMP ? (row - MP) / DECS : row / SEQ, tpos = SAMP ? (row - MP) % DECS : row % SEQ;
    float q[64];
    { const u32x4* qp = (const u32x4*)(proj + (size_t)row * NPROJ + C_Q + h * HD);
#pragma unroll
      for (int i = 0; i < 8; ++i) { const u32x4 w = qp[i]; q[8 * i + 0] = __uint_as_float(w.x << 16); q[8 * i + 1] = __uint_as_float(w.x & 0xffff0000u); q[8 * i + 2] = __uint_as_float(w.y << 16); q[8 * i + 3] = __uint_as_float(w.y & 0xffff0000u);
          q[8 * i + 4] = __uint_as_float(w.z << 16); q[8 * i + 5] = __uint_as_float(w.z & 0xffff0000u); q[8 * i + 6] = __uint_as_float(w.w << 16); q[8 * i + 7] = __uint_as_float(w.w & 0xffff0000u); } }
    float mx = -INFINITY;
#pragma unroll 1
    for (int e = lane; e < 387; e += 64) {
        float sc = -INFINITY;
        const int g = e / 129, j = e - g * 129, off = j << (2 * g); bool valid, isf32;
        const void* kp = kv_ptr<SAMP>(a, proj, C_K, a.cache_k, seq, tpos, off, h, valid, isf32);
        if (valid) { float d = 0.f;
            if (isf32) { const f32x4* k4 = (const f32x4*)kp;
#pragma unroll
                for (int i = 0; i < 16; ++i) { const f32x4 kk = k4[i]; d += q[4 * i] * kk.x + q[4 * i + 1] * kk.y + q[4 * i + 2] * kk.z + q[4 * i + 3] * kk.w; } }
            else { const u32x4* k4 = (const u32x4*)kp;
#pragma unroll
                for (int i = 0; i < 8; ++i) { const u32x4 w = k4[i];
                    d += q[8 * i + 0] * __uint_as_float(w.x << 16) + q[8 * i + 1] * __uint_as_float(w.x & 0xffff0000u) + q[8 * i + 2] * __uint_as_float(w.y << 16) + q[8 * i + 3] * __uint_as_float(w.y & 0xffff0000u)
                       + q[8 * i + 4] * __uint_as_float(w.z << 16) + q[8 * i + 5] * __uint_as_float(w.z & 0xffff0000u) + q[8 * i + 6] * __uint_as_float(w.w << 16) + q[8 * i + 7] * __uint_as_float(w.w & 0xffff0000u); } }
            sc = d * 0.125f + prm[PR_RELB + t5_bucket(off) * NH + h]; }
        sl[e] = sc; mx = fmaxf(mx, sc);
    }
    mx = wave_max(mx);
    float sum = 0.f;
#pragma unroll 1
    for (int e = lane; e < 387; e += 64) { const float sc = sl[e]; const float pe = (sc == -INFINITY) ? 0.f : __expf(sc - mx); sl[e] = pe; sum += pe; }
    sum = wave_sum(sum);
    LDS_WAIT(); asm volatile("" ::: "memory");
    float o = 0.f;
#pragma unroll 4
    for (int e = 0; e < 387; ++e) {
        const int g = e / 129, j = e - g * 129, off = j << (2 * g); bool valid, isf32;
        const void* vp = kv_ptr<SAMP>(a, proj, C_V, a.cache_v, seq, tpos, off, h, valid, isf32);
        const float pe = sl[e];
        if (valid) { const float vv = isf32 ? ((const float*)vp)[lane] : bf2f(((const bf16*)vp)[lane]); o += pe * vv; }
    }
    LDS_WAIT(); asm volatile("" ::: "memory");
    const float gv = bf2f(proj[(size_t)row * NPROJ + C_G + h * HD + lane]);
    ya[(size_t)row * DA + h * HD + lane] = (bf16)f2bf(o / sum * siluf_(gv));
}

__device__ __forceinline__ void ssd_slow_item(const Args& a, LAS unsigned char* lds, int item) {
    const bf16* proj = (const bf16*)(a.ws + WS_PROJ); const float* dtb = (const float*)(a.ws + WS_DT); bf16* ys = (bf16*)(a.ws + WS_YS); float* ssq = (float*)(a.ws + WS_SSQ);
    const int tid = threadIdx.x, lane = tid & 63, wid = tid >> 6;
    const bool samp = item >= NBATCH * NSH; const int it2 = samp ? item - NBATCH * NSH : item; const int sq = it2 / NSH, hd = it2 % NSH, grp = hd / 4;
    const int L = samp ? DECS : SEQ, row0 = samp ? MP + sq * DECS : sq * SEQ;
    const int p = tid >> 3, n0 = (tid & 7) * 16;
    float h[16];
    if (samp) { const f32x4* s4 = (const f32x4*)(a.state_ssm + ((size_t)(sq * NSH + hd) * SHD + p) * DST + n0);
#pragma unroll
        for (int j = 0; j < 4; ++j) { const f32x4 v = s4[j]; h[4 * j] = v.x; h[4 * j + 1] = v.y; h[4 * j + 2] = v.z; h[4 * j + 3] = v.w; } }
    else {
#pragma unroll
        for (int j = 0; j < 16; ++j) h[j] = 0.f; }
    const float* prm = (const float*)(a.ws + WS_PRM);
    const float Aneg = -__expf(prm[PR_ALOG + hd]), Dk = prm[PR_DSKIP + hd];
    LAS float* xs = (LAS float*)lds;
    LAS float* Bs = xs + 64 * 64;
    LAS float* Cs = Bs + 64 * 128;
    LAS float* dts = Cs + 64 * 128;
    LAS float* dAs = dts + 64;
    LAS float* yb = dAs + 64;
    for (int c0 = 0; c0 < L; c0 += 64) {
        const int tc = (L - c0) < 64 ? (L - c0) : 64;
        for (int idx = tid; idx < tc * 320; idx += NTHR) {
            const int t = idx / 320, c = idx - t * 320;
            const int xc = c < 64 ? hd * 64 + c : (c < 192 ? DSSM + grp * DST + (c - 64) : DSSM + NGRP * DST + grp * DST + (c - 192));
            float acc = prm[PR_CONVB + xc];
#pragma unroll
            for (int tap = 0; tap < 4; ++tap) { const int tt = c0 + t - 3 + tap; float v;
                if (tt >= 0) v = bf2f(proj[(size_t)(row0 + tt) * NPROJ + C_XBC + xc]);
                else v = samp ? a.state_conv[(size_t)(sq * 3 + 3 + tt) * DCONV + xc] : 0.f;
                acc += prm[PR_CONVW + tap * DCONV + xc] * v; }
            const float val = siluf_(acc);
            if (c < 64) xs[t * 64 + c] = val; else if (c < 192) Bs[t * 128 + (c - 64)] = val; else Cs[t * 128 + (c - 192)] = val;
        }
        if (tid < tc) { const float dtv = dtb[(size_t)(row0 + c0 + tid) * 32 + hd]; dts[tid] = dtv; dAs[tid] = __expf(dtv * Aneg); }
        __syncthreads();
        for (int t = 0; t < tc; ++t) {
            const float dA = dAs[t], xv = xs[t * 64 + p], dtx = dts[t] * xv; float acc = 0.f;
            const LAS f32x4* b4 = (const LAS f32x4*)(Bs + t * 128 + n0); const LAS f32x4* c4 = (const LAS f32x4*)(Cs + t * 128 + n0);
#pragma unroll
            for (int j = 0; j < 4; ++j) { const f32x4 bb = b4[j], cc = c4[j];
                h[4 * j] = dA * h[4 * j] + dtx * bb.x; h[4 * j + 1] = dA * h[4 * j + 1] + dtx * bb.y; h[4 * j + 2] = dA * h[4 * j + 2] + dtx * bb.z; h[4 * j + 3] = dA * h[4 * j + 3] + dtx * bb.w;
                acc += h[4 * j] * cc.x + h[4 * j + 1] * cc.y + h[4 * j + 2] * cc.z + h[4 * j + 3] * cc.w; }
            acc += __shfl_xor(acc, 1); acc += __shfl_xor(acc, 2); acc += __shfl_xor(acc, 4);
            if ((tid & 7) == 0) yb[t * 64 + p] = acc + Dk * xv;
        }
        __syncthreads();
        for (int t = wid; t < tc; t += NWAVES) {
            const int row = row0 + c0 + t; const float z = bf2f(proj[(size_t)row * NPROJ + C_Z + hd * 64 + lane]);
            const float val = yb[t * 64 + lane] * siluf_(z);
            ys[(size_t)row * DSSM + hd * 64 + lane] = (bf16)f2bf(val);
            const float ss = wave_sum(val * val); if (lane == 0) ssq[(size_t)row * NSH + hd] = ss;
        }
        __syncthreads();
    }
    float* dst = a.out + (samp ? O_SS : O_SP) + ((size_t)(sq * NSH + hd) * SHD + p) * DST + n0;
#pragma unroll
    for (int j = 0; j < 4; ++j) ((f32x4*)dst)[j] = (f32x4){h[4 * j], h[4 * j + 1], h[4 * j + 2], h[4 * j + 3]};
}

__device__ __forceinline__ void p2_slow(const Args& a, LAS unsigned char* lds, int G, int wave, int lane) {
    const bf16* proj = (const bf16*)(a.ws + WS_PROJ); bf16* ya = (bf16*)(a.ws + WS_YA);
    for (int item = blockIdx.x; item < NBATCH * NSH; item += G) ssd_mfma_unit(a.ws, a.out, lds, item / NSH, item % NSH, wave, lane);
    for (int item = NBATCH * NSH + blockIdx.x; item < NBATCH * NSH + DECB * NSH; item += G) ssd_slow_item(a, lds, item);
    const int gw = blockIdx.x * NWAVES + wave, NGW = G * NWAVES; LAS float* sl = (LAS float*)(lds + 100 * 1024 + wave * 2048);
    for (int k = 0; ; ++k) { const int v = (G == 256) ? (k < 3 ? (int)((blockIdx.x % 8) * 96 + (blockIdx.x / 8) + 32 * k) : 768) : (int)(blockIdx.x + k * G); if (v >= 768) break;
        const int bh = v >> 3, sb = v & 7; attn_unit(a.ws, lds, bh / NH, bh % NH, sb * 256, wave, lane); }
    for (int it = gw; it < MS * NH; it += NGW) { const int row = MP + it / NH, h = it % NH; attn_slow_item<true>(a, proj, ya, sl, row, h, lane); }
    const int gt = blockIdx.x * NTHR + threadIdx.x, NGT = G * NTHR;
    for (int i = gt; i < (NBATCH + DECB) * 3 * DCONV; i += NGT) { const int c = i % DCONV, r = (i / DCONV) % 3, sq = i / (3 * DCONV);
        if (sq < NBATCH) a.out[O_CP + (size_t)(sq * 3 + r) * DCONV + c] = bf2f(proj[(size_t)(sq * SEQ + SEQ - 3 + r) * NPROJ + C_XBC + c]);
        else { const int s2 = sq - NBATCH; a.out[O_CS + (size_t)(s2 * 3 + r) * DCONV + c] = bf2f(proj[(size_t)(MP + s2 * DECS + DECS - 3 + r) * NPROJ + C_XBC + c]); } }
}
__device__ __forceinline__ void p25_norm(const Args& a, int gw, int NGW, int lane) {
    bf16* ys = (bf16*)(a.ws + WS_YS); const float* ssq = (const float*)(a.ws + WS_SSQ);
    for (int m = gw; m < MT; m += NGW) {
        const float sv = (lane < 32) ? ssq[(size_t)m * NSH + lane] : 0.f;
        float gs = sv + __shfl_xor(sv, 1); gs += __shfl_xor(gs, 2);
        const float rstd = rsqrtf(gs * (1.f / 256.f) + 1e-5f);
        u32x4* r4 = (u32x4*)(ys + (size_t)m * DSSM);
#pragma unroll
        for (int j = 0; j < 4; ++j) { const int ci = j * 64 + lane, g = ci >> 5; const float sc = __shfl(rstd, 4 * g); u32x4 w = r4[ci];
            w.x = pk2(__uint_as_float(w.x << 16) * sc, __uint_as_float(w.x & 0xffff0000u) * sc); w.y = pk2(__uint_as_float(w.y << 16) * sc, __uint_as_float(w.y & 0xffff0000u) * sc);
            w.z = pk2(__uint_as_float(w.z << 16) * sc, __uint_as_float(w.z & 0xffff0000u) * sc); w.w = pk2(__uint_as_float(w.w << 16) * sc, __uint_as_float(w.w & 0xffff0000u) * sc); r4[ci] = w; }
    }
}
__device__ __forceinline__ void p5_final_norm(const Args& a, int gw, int NGW, int lane) {
    for (int m = gw; m < MT; m += NGW) {
        f32x4* xr = (f32x4*)(a.out + (size_t)m * DM) + lane; const f32x4* gr = (const f32x4*)((const float*)(a.ws + WS_PRM) + PR_FNORM) + lane;
        f32x4 v[4]; float s = 0.f;
#pragma unroll
        for (int j = 0; j < 4; ++j) { v[j] = xr[64 * j]; s += (v[j].x * v[j].x + v[j].y * v[j].y) + (v[j].z * v[j].z + v[j].w * v[j].w); }
        const float rstd = rsqrtf(wave_sum(s) * (1.f / DM) + 1e-6f);
#pragma unroll
        for (int j = 0; j < 4; ++j) { const f32x4 g = gr[64 * j]; xr[64 * j] = v[j] * rstd * g; }
    }
}
#define GEMM_PHASE(EpiT, Aptr, Bptr, Mrows, Ncols, Kdim, Eobj) do { pg8::Gemm g_{(const pg8::bf16_t*)(Aptr), (const pg8::bf16_t*)(Bptr), (Mrows), (Ncols), (Kdim)}; pg8::StaticOrder S_; S_.init((Mrows), (Ncols), G, (int)blockIdx.x); \
    pg8::gemm_phase<EpiT, pg8::StaticOrder, true, true>(lds, g_, S_, (Eobj)); } while (0)

__global__ void __launch_bounds__(NTHR, 2) fwd_megakernel(Args a) {
    extern __shared__ __attribute__((aligned(16))) unsigned char lds_raw[];
    LAS unsigned char* lds = (LAS unsigned char*)lds_raw;
    cg::grid_group grid = cg::this_grid();
    const int tid = threadIdx.x, lane = tid & 63, wave = __builtin_amdgcn_readfirstlane(tid >> 6);
    const int G = gridDim.x, gw = blockIdx.x * NWAVES + wave, NGW = G * NWAVES;
    unsigned char* ws = a.ws;

    p0_prologue(a, lds, gw, NGW, wave, lane);
    if (blockIdx.x == 0 && tid == 0) { const float** pp = (const float**)(ws + WS_ARGS); pp[0] = a.x_prompt; pp[1] = a.x_sample; pp[2] = a.cache_k; pp[3] = a.cache_v; pp[4] = a.state_conv; pp[5] = a.state_ssm; }
    grid.sync();
    { pg8::EpiInProj E{(pg8::bf16_t*)(ws + WS_PROJ), (float*)(ws + WS_DT), (const float*)(ws + WS_PRM) + PR_DTB, a.out + O_KP, a.out + O_VP, a.out + O_KS, a.out + O_VS};
      GEMM_PHASE(pg8::EpiInProj, ws + WS_HB, ws + WS_WIN, MT, NPAD, DM, E); }
    grid.sync();
    { Args b{}; b.ws = ws; b.out = a.out; b.cache_k = ld_ptr(ws, 2); b.cache_v = ld_ptr(ws, 3); b.state_conv = ld_ptr(ws, 4); b.state_ssm = ld_ptr(ws, 5); p2_slow(b, lds, G, wave, lane); }
    grid.sync();
    p25_norm(a, gw, NGW, lane);
    grid.sync();
    { pg8::EpiGateA E{(const pg8::bf16_t*)(ws + WS_PROJ), (float*)(ws + WS_TMP)}; GEMM_PHASE(pg8::EpiGateA, ws + WS_YA, ws + WS_WA, MT, DM, DA, E); }
    { pg8::EpiGateB E{(const pg8::bf16_t*)(ws + WS_PROJ), (const float*)(ws + WS_TMP), (pg8::bf16_t*)(ws + WS_MRG)}; GEMM_PHASE(pg8::EpiGateB, ws + WS_YS, ws + WS_WB, MT, DM, DSSM, E); }
    grid.sync();
    { pg8::EpiOut E{ld_ptr(ws, 0), ld_ptr(ws, 1), a.out + O_YP}; GEMM_PHASE(pg8::EpiOut, ws + WS_MRG, ws + WS_WO, MT, DM, DM, E); }
    grid.sync();
    p5_final_norm(a, gw, NGW, lane);
}

extern "C" void kernel_launch(void* const* d_in, const int* in_sizes, int n_in, void* d_out, int out_size, void* d_ws, size_t ws_size, hipStream_t stream) {
    static int grid_blocks = 0;
    if (grid_blocks == 0) {
        if (n_in != 19 || (size_t)out_size != O_END || ws_size < WS_END) { fprintf(stderr, "kernel_launch: unexpected shapes: n_in %d out %d (want %zu) ws %zu (want >= %zu)\n", n_in, out_size, (size_t)O_END, ws_size, (size_t)WS_END); grid_blocks = -1; return; }
        int dev = 0, cus = 0, per_cu = 0;
        hipGetDevice(&dev); hipDeviceGetAttribute(&cus, hipDeviceAttributeMultiprocessorCount, dev);
        if (hipFuncSetAttribute((const void*)fwd_megakernel, hipFuncAttributeMaxDynamicSharedMemorySize, LDS_BYTES) != hipSuccess) { fprintf(stderr, "kernel_launch: hipFuncSetAttribute failed\n"); grid_blocks = -1; return; }
        if (hipOccupancyMaxActiveBlocksPerMultiprocessor(&per_cu, (const void*)fwd_megakernel, NTHR, LDS_BYTES) != hipSuccess || per_cu < 1) { fprintf(stderr, "kernel_launch: occupancy query failed (%d)\n", per_cu); (void)hipGetLastError(); per_cu = 1; }
        if (per_cu > 1) per_cu = 1;
        grid_blocks = cus * per_cu;
        fprintf(stderr, "kernel_launch: grid %d (cus %d)\n", grid_blocks, cus);
    }
    if (grid_blocks < 0) return;
    Args a{};
    a.x_prompt = (const float*)d_in[0]; a.x_sample = (const float*)d_in[1]; a.cache_k = (const float*)d_in[2]; a.cache_v = (const float*)d_in[3]; a.state_conv = (const float*)d_in[4]; a.state_ssm = (const float*)d_in[5];
    a.norm_g = (const float*)d_in[6]; a.w_in = (const float*)d_in[7]; a.conv_w = (const float*)d_in[8]; a.conv_b = (const float*)d_in[9]; a.dt_bias = (const float*)d_in[10]; a.a_log = (const float*)d_in[11];
    a.d_skip = (const float*)d_in[12]; a.ssm_norm = (const float*)d_in[13]; a.w_a = (const float*)d_in[14]; a.w_b = (const float*)d_in[15]; a.w_out = (const float*)d_in[16]; a.rel_bias = (const float*)d_in[17]; a.final_norm = (const float*)d_in[18];
    a.out = (float*)d_out; a.ws = (unsigned char*)d_ws;
    void* args[] = {&a};
    hipError_t e = hipLaunchCooperativeKernel((const void*)fwd_megakernel, dim3(grid_blocks), dim3(NTHR), args, LDS_BYTES, stream);
    if (e != hipSuccess) fprintf(stderr, "kernel_launch: cooperative launch failed: %s (grid %d)\n", hipGetErrorString(e), grid_blocks);
}
```

```cpp
#include <hip/hip_runtime.h>
#include <hip/hip_cooperative_groups.h>
#include <cstdio>
#include <cstdint>
namespace cg = cooperative_groups;
namespace pg8 {
#define PG8_LAS __attribute__((address_space(3)))
typedef unsigned short bf16_t;
typedef short bf16x8 __attribute__((ext_vector_type(8)));
typedef float f32x4 __attribute__((ext_vector_type(4)));
typedef unsigned u32x4 __attribute__((ext_vector_type(4)));
constexpr int BM = 256, BK = 64, HALF = 128, HTB = HALF * BK * 2  , STAGE_BYTES = 8 * HTB, NXCD = 8, WGM = 8;

__host__ __device__ __forceinline__ int lds_byte(int r, int c) { const int st = (r >> 4) * 2 + (c >> 5), rr = r & 15, cc = c & 31, ob = rr * 64 + cc * 2; return st * 1024 + (ob ^ (((ob >> 9) & 1) << 5)); }
__host__ __device__ __forceinline__ void stage_rc(int b, int& R, int& C) { const int st = b / 1024, sb = b % 1024, swz = sb ^ (((sb >> 9) & 1) << 5); R = (st >> 1) * 16 + swz / 64; C = (st & 1) * 32 + (swz % 64) / 2; }
__host__ __device__ __forceinline__ int perm32(int rho) { const int n = rho >> 4, i = rho & 15; return 8 * (i >> 2) + 4 * n + (i & 3); }

struct Unit { int pm, pn; };
struct Gemm { const bf16_t* A; const bf16_t* Bt; int M, N, K; };

struct StaticOrder {
    int nM, nN, nwg, G, c;
    __host__ __device__ void init(int M, int N, int G_, int c_) { nM = M / BM; nN = N / BM; nwg = nM * nN; G = G_; c = c_; }
    __host__ __device__ bool next(int i, Unit& u) const {
        const long L = (long)i * G + c; if (L >= nwg) return false;
        int wgid = (int)L; { const int q = nwg / NXCD, r = nwg % NXCD, xcd = wgid % NXCD, off = wgid / NXCD; wgid = (xcd < r ? xcd * (q + 1) : r * (q + 1) + (xcd - r) * q) + off; }
        const int nig = WGM * nN, gid = wgid / nig, fm = gid * WGM, gsz = (nM - fm) < WGM ? (nM - fm) : WGM;
        u.pm = fm + ((wgid % nig) % gsz); u.pn = (wgid % nig) / gsz; return true;
    }
    __device__ __forceinline__ void a_ready(const Unit&) const {}
    __device__ __forceinline__ void done(const Unit&) const {}
};

__device__ __forceinline__ unsigned cvt_pk_bf16(float lo, float hi) { unsigned r; asm volatile("v_cvt_pk_bf16_f32 %0, %1, %2" : "=v"(r) : "v"(lo), "v"(hi)); return r; }
__device__ __forceinline__ float e_bf2f(unsigned short b) { return __uint_as_float(((unsigned)b) << 16); }
__device__ __forceinline__ float e_sigmoid(float x) { return 1.f / (1.f + __expf(-x)); }
__device__ __forceinline__ float e_softplus(float x) { return fmaxf(x, 0.f) + log1pf(__expf(-fabsf(x))); }

struct EpiInProj {
    static constexpr bool PERM = true, AFTER_DRAIN = false;
    bf16_t* proj; float* dt; const float* dt_bias; float* kp; float* vp; float* ks; float* vs;
    __device__ __forceinline__ void operator()(const f32x4 (&acc)[2][2][4][2], const Unit& u, int wr, int wc, int fr, int fq) const {
        const int row0 = u.pm * BM + wr * 64 + fr;
        if (u.pn < 44) {
            const int col0 = u.pn * BM + wc * 32 + 8 * fq;
            const bool isk = (u.pn >= 3 && u.pn < 6), isv = (u.pn >= 6 && u.pn < 9);
#pragma unroll
            for (int ai = 0; ai < 2; ++ai)
#pragma unroll
                for (int m = 0; m < 4; ++m) { const int row = row0 + ai * HALF + m * 16; bf16_t* rowp = proj + (size_t)row * 11264 + col0;
#pragma unroll
                    for (int bj = 0; bj < 2; ++bj) { const f32x4 v0 = acc[ai][bj][m][0], v1 = acc[ai][bj][m][1];
                        u32x4 w; w.x = cvt_pk_bf16(v0[0], v0[1]); w.y = cvt_pk_bf16(v0[2], v0[3]); w.z = cvt_pk_bf16(v1[0], v1[1]); w.w = cvt_pk_bf16(v1[2], v1[3]);
                        *(u32x4*)(rowp + bj * HALF) = w;
                        if (isk || isv) { const int c = col0 + bj * HALF - (isk ? 768 : 1536);
                            float* dst = (u.pm < 64) ? ((isk ? kp : vp) + (size_t)row * 768 + c) : ((isk ? ks : vs) + (size_t)(row - 16384) * 768 + c);
                            *(f32x4*)dst = v0; *(f32x4*)(dst + 4) = v1; } } }
        } else if (wc == 0) {
            const f32x4 b0 = *(const f32x4*)(dt_bias + 8 * fq), b1 = *(const f32x4*)(dt_bias + 8 * fq + 4);
#pragma unroll
            for (int ai = 0; ai < 2; ++ai)
#pragma unroll
                for (int m = 0; m < 4; ++m) { const int row = row0 + ai * HALF + m * 16; const f32x4 v0 = acc[ai][0][m][0] + b0, v1 = acc[ai][0][m][1] + b1;
                    f32x4 o0, o1;
#pragma unroll
                    for (int j = 0; j < 4; ++j) { o0[j] = e_softplus(v0[j]); o1[j] = e_softplus(v1[j]); }
                    float* dst = dt + (size_t)row * 32 + 8 * fq; *(f32x4*)dst = o0; *(f32x4*)(dst + 4) = o1; }
        }
    }
};
struct EpiGateA {
    static constexpr bool PERM = true, AFTER_DRAIN = false;
    const bf16_t* proj; float* tmp;
    __device__ __forceinline__ void operator()(const f32x4 (&acc)[2][2][4][2], const Unit& u, int wr, int wc, int fr, int fq) const {
        const int row0 = u.pm * BM + wr * 64 + fr, col0 = u.pn * BM + wc * 32 + 8 * fq;
#pragma unroll
        for (int ai = 0; ai < 2; ++ai)
#pragma unroll
            for (int m = 0; m < 4; ++m) { const int row = row0 + ai * HALF + m * 16;
#pragma unroll
                for (int bj = 0; bj < 2; ++bj) { const int c = col0 + bj * HALF; const u32x4 g = *(const u32x4*)(proj + (size_t)row * 11264 + 9216 + c);
                    const f32x4 v0 = acc[ai][bj][m][0], v1 = acc[ai][bj][m][1]; f32x4 o0, o1;
                    o0[0] = e_sigmoid(__uint_as_float(g.x << 16)) * v0[0]; o0[1] = e_sigmoid(__uint_as_float(g.x & 0xffff0000u)) * v0[1];
                    o0[2] = e_sigmoid(__uint_as_float(g.y << 16)) * v0[2]; o0[3] = e_sigmoid(__uint_as_float(g.y & 0xffff0000u)) * v0[3];
                    o1[0] = e_sigmoid(__uint_as_float(g.z << 16)) * v1[0]; o1[1] = e_sigmoid(__uint_as_float(g.z & 0xffff0000u)) * v1[1];
                    o1[2] = e_sigmoid(__uint_as_float(g.w << 16)) * v1[2]; o1[3] = e_sigmoid(__uint_as_float(g.w & 0xffff0000u)) * v1[3];
                    float* dst = tmp + (size_t)row * 1024 + c; *(f32x4*)dst = o0; *(f32x4*)(dst + 4) = o1; } }
    }
};
struct EpiGateB {
    static constexpr bool PERM = true, AFTER_DRAIN = false;
    const bf16_t* proj; const float* tmp; bf16_t* mrg;
    __device__ __forceinline__ void operator()(const f32x4 (&acc)[2][2][4][2], const Unit& u, int wr, int wc, int fr, int fq) const {
        const int row0 = u.pm * BM + wr * 64 + fr, col0 = u.pn * BM + wc * 32 + 8 * fq;
#pragma unroll
        for (int ai = 0; ai < 2; ++ai)
#pragma unroll
            for (int m = 0; m < 4; ++m) { const int row = row0 + ai * HALF + m * 16;
#pragma unroll
                for (int bj = 0; bj < 2; ++bj) { const int c = col0 + bj * HALF; const u32x4 g = *(const u32x4*)(proj + (size_t)row * 11264 + 10240 + c);
                    const float* src = tmp + (size_t)row * 1024 + c; const f32x4 t0 = *(const f32x4*)src, t1 = *(const f32x4*)(src + 4);
                    const f32x4 v0 = acc[ai][bj][m][0], v1 = acc[ai][bj][m][1]; f32x4 o0, o1;
                    o0[0] = t0[0] + e_sigmoid(__uint_as_float(g.x << 16)) * v0[0]; o0[1] = t0[1] + e_sigmoid(__uint_as_float(g.x & 0xffff0000u)) * v0[1];
                    o0[2] = t0[2] + e_sigmoid(__uint_as_float(g.y << 16)) * v0[2]; o0[3] = t0[3] + e_sigmoid(__uint_as_float(g.y & 0xffff0000u)) * v0[3];
                    o1[0] = t1[0] + e_sigmoid(__uint_as_float(g.z << 16)) * v1[0]; o1[1] = t1[1] + e_sigmoid(__uint_as_float(g.z & 0xffff0000u)) * v1[1];
                    o1[2] = t1[2] + e_sigmoid(__uint_as_float(g.w << 16)) * v1[2]; o1[3] = t1[3] + e_sigmoid(__uint_as_float(g.w & 0xffff0000u)) * v1[3];
                    u32x4 w; w.x = cvt_pk_bf16(o0[0], o0[1]); w.y = cvt_pk_bf16(o0[2], o0[3]); w.z = cvt_pk_bf16(o1[0], o1[1]); w.w = cvt_pk_bf16(o1[2], o1[3]);
                    *(u32x4*)(mrg + (size_t)row * 1024 + c) = w; } }
    }
};
struct EpiOut {
    static constexpr bool PERM = false, AFTER_DRAIN = false;
    const float* xp; const float* xs; float* out;
    __device__ __forceinline__ void operator()(const f32x4 (&acc)[2][2][4][2], const Unit& u, int wr, int wc, int fr, int fq) const {
        const int row0 = u.pm * BM + wr * 64 + fr, col0 = u.pn * BM + wc * 32 + 4 * fq;
#pragma unroll
        for (int ai = 0; ai < 2; ++ai)
#pragma unroll
            for (int m = 0; m < 4; ++m) { const int row = row0 + ai * HALF + m * 16;
                const float* xr = (u.pm < 64) ? xp + (size_t)row * 1024 : xs + (size_t)(row - 16384) * 1024; float* orow = out + (size_t)row * 1024;
#pragma unroll
                for (int bj = 0; bj < 2; ++bj)
#pragma unroll
                    for (int n = 0; n < 2; ++n) { const int c = col0 + bj * HALF + n * 16; *(f32x4*)(orow + c) = *(const f32x4*)(xr + c) + acc[ai][bj][m][n]; } }
    }
};

template <class Epi, class Sched, bool ALIGN_EPI = false, bool SP2 = false>
__device__ __forceinline__ void gemm_phase(PG8_LAS unsigned char* lds, const Gemm g, const Sched& S, const Epi& E) {
    int tid_ = threadIdx.x; asm volatile("" : "+v"(tid_));
    const int tid = tid_, wid = __builtin_amdgcn_readfirstlane(tid >> 6), lane = tid & 63, wr = wid >> 2, wc = wid & 3, fr = lane & 15, fq = lane >> 4;
    const int K = g.K, nt = K / BK;
    unsigned voffA[2], voffB[2];
#pragma unroll
    for (int i = 0; i < 2; ++i) { int R, C; stage_rc(tid * 16 + i * 8192, R, C); const int Rb = Epi::PERM ? ((R & ~31) + perm32(R & 31)) : R;
        voffA[i] = (unsigned)(R * K + C) * 2u; voffB[i] = (unsigned)(Rb * K + C) * 2u; }
    const size_t kstep = (size_t)(BK * 2);
    const size_t hstep = (size_t)HALF * K * 2;
    const size_t tstep = 2 * hstep;
    const unsigned ldsw = (unsigned)wid * 1024u;
    const int aoff = lds_byte(wr * 64 + fr, fq * 8), boff = lds_byte(wc * 32 + fr, fq * 8);
#define PG8_SA(b, h) (((b) * 2 + (h)) * HTB)
#define PG8_SB(b, h) ((4 + (b) * 2 + (h)) * HTB)
#define PG8_STAGE(bufoff, gbase, voff) do { _Pragma("unroll") for (int _i = 0; _i < 2; ++_i) \
        __builtin_amdgcn_global_load_lds((const unsigned*)((const char*)(gbase) + (voff)[_i]), (PG8_LAS unsigned*)(lds + (bufoff) + ldsw + _i * 8192), 16, 0, 0); } while (0)
#define PG8_LDA(dst, b, h) do { _Pragma("unroll") for (int m = 0; m < 4; ++m) _Pragma("unroll") for (int k = 0; k < 2; ++k) dst[m][k] = *(const PG8_LAS bf16x8*)(lds + PG8_SA(b, h) + aoff + m * 2048 + k * 1024); } while (0)
#define PG8_LDB(dst, b, h) do { _Pragma("unroll") for (int n = 0; n < 2; ++n) _Pragma("unroll") for (int k = 0; k < 2; ++k) dst[n][k] = *(const PG8_LAS bf16x8*)(lds + PG8_SB(b, h) + boff + n * 2048 + k * 1024); } while (0)
#define PG8_MMA(ai, bj, At, Bt) do { __builtin_amdgcn_s_setprio(1); _Pragma("unroll") for (int m = 0; m < 4; ++m) _Pragma("unroll") for (int n = 0; n < 2; ++n) _Pragma("unroll") for (int k = 0; k < 2; ++k) \
        acc[ai][bj][m][n] = __builtin_amdgcn_mfma_f32_16x16x32_bf16(Bt[n][k], At[m][k], acc[ai][bj][m][n], 0, 0, 0); __builtin_amdgcn_s_setprio(0); } while (0)
#define PG8_WAIT_V(n) asm volatile("s_waitcnt vmcnt(" #n ")" ::: "memory")
#define PG8_WAIT_L(n) asm volatile("s_waitcnt lgkmcnt(" #n ")" ::: "memory")
#define PG8_BAR __builtin_amdgcn_s_barrier()
#define PG8_SCHED __builtin_amdgcn_sched_barrier(0)
    Unit cur, nxt; int ui = 0;
    if (!S.next(0, cur)) return;
    f32x4 acc[2][2][4][2];
#pragma unroll
    for (int a = 0; a < 2; ++a)
#pragma unroll
        for (int b = 0; b < 2; ++b)
#pragma unroll
            for (int m = 0; m < 4; ++m)
#pragma unroll
                for (int n = 0; n < 2; ++n) acc[a][b][m][n] = (f32x4){0.f, 0.f, 0.f, 0.f};
    bf16x8 At[4][2], B0[2][2], B1[2][2];
    const char* cA = (const char*)g.A + (size_t)cur.pm * tstep; const char* cB = (const char*)g.Bt + (size_t)cur.pn * tstep;
    S.a_ready(cur);
    if constexpr (SP2) {
        PG8_STAGE(PG8_SB(0, 0), cB, voffB); PG8_STAGE(PG8_SB(0, 1), cB + hstep, voffB); PG8_STAGE(PG8_SA(0, 0), cA, voffA); PG8_STAGE(PG8_SA(0, 1), cA + hstep, voffA);
        if (wr == 1) PG8_BAR;
        PG8_WAIT_V(2); PG8_BAR;
        PG8_STAGE(PG8_SB(1, 0), cB + kstep, voffB); PG8_STAGE(PG8_SA(1, 0), cA + kstep, voffA); PG8_STAGE(PG8_SB(1, 1), cB + hstep + kstep, voffB);
        PG8_WAIT_V(6); PG8_BAR;
    } else {
        PG8_STAGE(PG8_SB(0, 0), cB, voffB); PG8_STAGE(PG8_SA(0, 0), cA, voffA); PG8_STAGE(PG8_SB(0, 1), cB + hstep, voffB); PG8_STAGE(PG8_SA(0, 1), cA + hstep, voffA);
        if (wr == 1) PG8_BAR;
        PG8_WAIT_V(4); PG8_BAR;
        PG8_STAGE(PG8_SB(1, 0), cB + kstep, voffB); PG8_STAGE(PG8_SA(1, 0), cA + kstep, voffA); PG8_STAGE(PG8_SB(1, 1), cB + hstep + kstep, voffB);
        PG8_WAIT_V(6); PG8_BAR;
    }
    for (;;) {
        const bool has_next = S.next(ui + 1, nxt);
        const char* nA = has_next ? (const char*)g.A + (size_t)nxt.pm * tstep : cA; const char* nB = has_next ? (const char*)g.Bt + (size_t)nxt.pn * tstep : cB;
        for (int t = 0; t < nt; t += 2) {
            const bool last = (t == nt - 2);
            const char* a1 = cA + (size_t)(t + 1) * kstep;
            const char* a2 = last ? nA : cA + (size_t)(t + 2) * kstep; const char* b2 = last ? nB : cB + (size_t)(t + 2) * kstep;
            const char* a3 = a2 + kstep; const char* b3 = b2 + kstep;
            if (last && has_next) S.a_ready(nxt);
            if constexpr (SP2) {
            PG8_LDB(B0, 0, 0); PG8_LDB(B1, 0, 1); PG8_SCHED; PG8_LDA(At, 0, 0); PG8_STAGE(PG8_SA(1, 1), a1 + hstep, voffA);
            PG8_WAIT_V(8); PG8_WAIT_L(0); PG8_BAR; PG8_MMA(0, 0, At, B0); PG8_MMA(0, 1, At, B1); PG8_BAR; PG8_SCHED;
            PG8_LDA(At, 0, 1); PG8_STAGE(PG8_SB(0, 0), b2, voffB); PG8_STAGE(PG8_SB(0, 1), b2 + hstep, voffB); PG8_STAGE(PG8_SA(0, 0), a2, voffA);
            PG8_WAIT_V(8); PG8_WAIT_L(0); PG8_BAR; PG8_MMA(1, 0, At, B0); PG8_MMA(1, 1, At, B1); PG8_BAR; PG8_SCHED;
            PG8_LDB(B0, 1, 0); PG8_LDB(B1, 1, 1); PG8_SCHED; PG8_LDA(At, 1, 0); PG8_STAGE(PG8_SA(0, 1), a2 + hstep, voffA);
            PG8_WAIT_V(8); PG8_WAIT_L(0); PG8_BAR; PG8_MMA(0, 0, At, B0); PG8_MMA(0, 1, At, B1); PG8_BAR; PG8_SCHED;
            PG8_LDA(At, 1, 1); PG8_STAGE(PG8_SB(1, 0), b3, voffB); PG8_STAGE(PG8_SB(1, 1), b3 + hstep, voffB); PG8_STAGE(PG8_SA(1, 0), a3, voffA);
            PG8_WAIT_V(8); PG8_WAIT_L(0); PG8_BAR; PG8_MMA(1, 0, At, B0); PG8_MMA(1, 1, At, B1); PG8_BAR; PG8_SCHED;
            } else {
            PG8_LDB(B0, 0, 0); PG8_SCHED; PG8_LDA(At, 0, 0); PG8_STAGE(PG8_SA(1, 1), a1 + hstep, voffA);
            PG8_WAIT_L(8); PG8_BAR; PG8_WAIT_L(0); PG8_MMA(0, 0, At, B0); PG8_BAR; PG8_SCHED;
            PG8_LDB(B1, 0, 1); PG8_STAGE(PG8_SB(0, 0), b2, voffB);
            PG8_BAR; PG8_WAIT_L(0); PG8_MMA(0, 1, At, B1); PG8_BAR;
            PG8_LDA(At, 0, 1); PG8_STAGE(PG8_SA(0, 0), a2, voffA);
            PG8_BAR; PG8_WAIT_L(0); PG8_MMA(1, 0, At, B0); PG8_BAR; PG8_SCHED;
            PG8_STAGE(PG8_SB(0, 1), b2 + hstep, voffB);
            PG8_WAIT_V(6); PG8_BAR; PG8_MMA(1, 1, At, B1); PG8_BAR;
            PG8_LDB(B0, 1, 0); PG8_SCHED; PG8_LDA(At, 1, 0); PG8_STAGE(PG8_SA(0, 1), a2 + hstep, voffA);
            PG8_WAIT_L(8); PG8_BAR; PG8_WAIT_L(0); PG8_MMA(0, 0, At, B0); PG8_BAR; PG8_SCHED;
            PG8_LDB(B1, 1, 1); PG8_STAGE(PG8_SB(1, 0), b3, voffB);
            PG8_BAR; PG8_WAIT_L(0); PG8_MMA(0, 1, At, B1); PG8_BAR;
            PG8_LDA(At, 1, 1); PG8_STAGE(PG8_SA(1, 0), a3, voffA);
            PG8_BAR; PG8_WAIT_L(0); PG8_MMA(1, 0, At, B0); PG8_BAR; PG8_SCHED;
            PG8_STAGE(PG8_SB(1, 1), b3 + hstep, voffB);
            PG8_WAIT_V(6); PG8_BAR; PG8_MMA(1, 1, At, B1); PG8_BAR;
            }
        }
        if constexpr (ALIGN_EPI) { if (wr == 0) PG8_BAR; }
        if constexpr (!Epi::AFTER_DRAIN) { E(acc, cur, wr, wc, fr, fq); S.done(cur); }
        if (!has_next) break;
#pragma unroll
        for (int a = 0; a < 2; ++a)
#pragma unroll
            for (int b = 0; b < 2; ++b)
#pragma unroll
                for (int m = 0; m < 4; ++m)
#pragma unroll
                    for (int n = 0; n < 2; ++n) acc[a][b][m][n] = (f32x4){0.f, 0.f, 0.f, 0.f};
        cur = nxt; cA = nA; cB = nB; ++ui;
        if constexpr (ALIGN_EPI) { if (wr == 1) PG8_BAR; }
    }
    PG8_WAIT_V(0);
    if constexpr (!ALIGN_EPI) { if (wr == 0) PG8_BAR; }
    PG8_BAR;
    if constexpr (Epi::AFTER_DRAIN) { E.fused(acc, cur, wr, wc, fr, fq, lds, wid, lane); S.done(cur); }
#undef PG8_SA
#undef PG8_SB
#undef PG8_STAGE
#undef PG8_LDA
#undef PG8_LDB
#undef PG8_MMA
#undef PG8_WAIT_V
#undef PG8_WAIT_L
#undef PG8_BAR
#undef PG8_SCHED
}
}

#define LAS __attribute__((address_space(3)))
typedef unsigned short bf16;
typedef float f32x4 __attribute__((ext_vector_type(4)));
typedef unsigned u32x4 __attribute__((ext_vector_type(4)));
typedef unsigned u32x2 __attribute__((ext_vector_type(2)));
constexpr int NWAVES = 8, NTHR = 512;
constexpr int DM = 1024, NBATCH = 8, SEQ = 2048, MP = NBATCH * SEQ, DECB = 32, DECS = 8, MS = DECB * DECS, MT = MP + MS;
constexpr int NH = 12, HD = 64, DA = NH * HD;
constexpr int DSSM = 2048, NSH = 32, SHD = 64, NGRP = 8, DST = 128, DCONV = 4096;
constexpr int PAST = 16384, KVB = 2048;
constexpr int NIN = 11296, NPROJ = 11264, NPAD = 11520;
constexpr int C_Q = 0, C_K = 768, C_V = 1536, C_G = 2304, C_Z = 3072, C_XBC = 5120, C_GA = 9216, C_GB = 10240;
constexpr size_t MiB = 1u << 20;
constexpr size_t WS_ARGS = 1 * MiB - 4096, WS_PRM = 1 * MiB, WS_WIN = 2 * MiB, WS_WA = 26 * MiB, WS_WB = 28 * MiB, WS_WO = 32 * MiB, WS_HB = 36 * MiB, WS_DT = 70 * MiB, WS_PROJ = 74 * MiB,
                 WS_YA = 432 * MiB, WS_YS = 458 * MiB, WS_SSQ = 524 * MiB, WS_TMP = 528 * MiB, WS_MRG = 594 * MiB, WS_END = 628 * MiB;
constexpr size_t O_YP = 0, O_YS = O_YP + (size_t)MP * DM, O_KP = O_YS + (size_t)MS * DM, O_VP = O_KP + (size_t)MP * DA, O_CP = O_VP + (size_t)MP * DA,
                 O_SP = O_CP + (size_t)NBATCH * 3 * DCONV, O_KS = O_SP + (size_t)NBATCH * NSH * SHD * DST, O_VS = O_KS + (size_t)MS * DA, O_CS = O_VS + (size_t)MS * DA,
                 O_SS = O_CS + (size_t)DECB * 3 * DCONV, O_END = O_SS + (size_t)DECB * NSH * SHD * DST;
constexpr int LDS_BYTES = 147456;
constexpr int PR_CONVW = 0, PR_CONVB = 16384, PR_DTB = 20480, PR_ALOG = 20512, PR_DSKIP = 20544, PR_RELB = 20576, PR_FNORM = 20992, PR_END = 22016;

struct Args {
    const float *x_prompt, *x_sample, *cache_k, *cache_v, *state_conv, *state_ssm, *norm_g, *w_in, *conv_w, *conv_b, *dt_bias, *a_log, *d_skip, *ssm_norm, *w_a, *w_b, *w_out, *rel_bias, *final_norm;
    float* out; unsigned char* ws;
};

__device__ __forceinline__ float bf2f(bf16 b) { return __uint_as_float(((unsigned)b) << 16); }
__device__ __forceinline__ unsigned f2bf(float f) { unsigned u = __float_as_uint(f); return (u + 0x7fffu + ((u >> 16) & 1u)) >> 16; }
__device__ __forceinline__ unsigned pk2(float lo, float hi) { return f2bf(lo) | (f2bf(hi) << 16); }
__device__ __forceinline__ float sigmoidf_(float x) { return 1.f / (1.f + __expf(-x)); }
__device__ __forceinline__ float siluf_(float x) { return x / (1.f + __expf(-x)); }
__device__ __forceinline__ float softplusf_(float x) { return fmaxf(x, 0.f) + log1pf(__expf(-fabsf(x))); }
__device__ __forceinline__ float wave_sum(float v) {
#pragma unroll
    for (int o = 1; o < 64; o <<= 1) v += __shfl_xor(v, o);
    return v;
}
__device__ __forceinline__ float wave_max(float v) {
#pragma unroll
    for (int o = 1; o < 64; o <<= 1) v = fmaxf(v, __shfl_xor(v, o));
    return v;
}
__device__ __forceinline__ int t5_bucket(int off) {
    if (off < 16) return off;
    return 16 + (off >= 22) + (off >= 30) + (off >= 40) + (off >= 54) + (off >= 73) + (off >= 99) + (off >= 134) + (off >= 182) + (off >= 246) + (off >= 332) + (off >= 450) + (off >= 609) + (off >= 825) + (off >= 1117) + (off >= 1513);
}
__device__ __forceinline__ const float* ld_ptr(const unsigned char* ws, int idx) { const unsigned long long v = ((const unsigned long long*)(ws + WS_ARGS))[idx];
    const unsigned lo = __builtin_amdgcn_readfirstlane((unsigned)v), hi = __builtin_amdgcn_readfirstlane((unsigned)(v >> 32)); return (const float*)(((unsigned long long)hi << 32) | lo); }
#define LDS_WAIT() asm volatile("s_waitcnt lgkmcnt(0)" ::: "memory")
typedef short bf16x8 __attribute__((ext_vector_type(8)));
typedef short s16x4 __attribute__((ext_vector_type(4)));
constexpr int AT_ST = 0, AT_STROW = 272, AT_ML = 69632, AT_BIAS = 71680, AT_V = 73728, AT_VROW = 144, AT_VBYTES = 32 * AT_VROW;
constexpr float LOG2E = 1.4426950408889634f;
__device__ __forceinline__ s16x4 lds_tr16(LAS const unsigned char* p) { return __builtin_bit_cast(s16x4, __builtin_amdgcn_ds_read_tr16_b64_v4i16((LAS s16x4*)p)); }

template <bool SAMP> __device__ __forceinline__ void attn_item(const bf16* base, const float* ck, const float* cv, int P0, int stride, const LAS float* bias2, LAS unsigned char* vst, int lane, float& m_out, float& l_out, f32x4 (&o)[4]) {
    const int c = lane & 15, rq = lane >> 4;
    bf16x8 qf[2];
    { int qrow = P0 + stride * c; if (SAMP) { qrow -= KVB; qrow = qrow > DECS - 1 ? DECS - 1 : qrow; }
      const bf16* qp = base + (size_t)qrow * NPROJ + C_Q + rq * 8; qf[0] = *(const bf16x8*)qp; qf[1] = *(const bf16x8*)(qp + 32); }
    f32x4 sc[9];
#pragma unroll
    for (int kt = 0; kt < 9; ++kt) {
        const bool tile_valid = (P0 + stride * (16 * kt + 15 - 128)) >= 0;
        if (tile_valid) {
            int kpos = P0 + stride * (16 * kt + c - 128); kpos = kpos < 0 ? 0 : kpos;
            bf16x8 k0, k1;
            if (SAMP && kt < 8) { const float* kp = ck + (size_t)kpos * (NH * HD) + rq * 8;
                const f32x4 a0 = *(const f32x4*)kp, a1 = *(const f32x4*)(kp + 4), b0 = *(const f32x4*)(kp + 32), b1 = *(const f32x4*)(kp + 36);
                u32x4 w0, w1; w0.x = pk2(a0[0], a0[1]); w0.y = pk2(a0[2], a0[3]); w0.z = pk2(a1[0], a1[1]); w0.w = pk2(a1[2], a1[3]); w1.x = pk2(b0[0], b0[1]); w1.y = pk2(b0[2], b0[3]); w1.z = pk2(b1[0], b1[1]); w1.w = pk2(b1[2], b1[3]);
                k0 = __builtin_bit_cast(bf16x8, w0); k1 = __builtin_bit_cast(bf16x8, w1);
            } else { if (SAMP) { kpos -= KVB; kpos = kpos > DECS - 1 ? DECS - 1 : kpos; }
                const bf16* kp = base + (size_t)kpos * NPROJ + C_K + rq * 8; k0 = *(const bf16x8*)kp; k1 = *(const bf16x8*)(kp + 32); }
            f32x4 acc = {0.f, 0.f, 0.f, 0.f};
            acc = __builtin_amdgcn_mfma_f32_16x16x32_bf16(k0, qf[0], acc, 0, 0, 0);
            acc = __builtin_amdgcn_mfma_f32_16x16x32_bf16(k1, qf[1], acc, 0, 0, 0);
#pragma unroll
            for (int j = 0; j < 4; ++j) { const int kidx = 16 * kt + 4 * rq + j, jj = c + 128 - kidx, kp2 = P0 + stride * (kidx - 128);
                const bool valid = (jj >= 0) && (jj <= 128) && (kp2 >= 0); const int jc = jj < 0 ? 0 : (jj > 128 ? 128 : jj);
                sc[kt][j] = valid ? acc[j] * (0.125f * LOG2E) + bias2[jc] : -INFINITY; }
        } else sc[kt] = (f32x4){-INFINITY, -INFINITY, -INFINITY, -INFINITY};
    }
    float m = -INFINITY;
#pragma unroll
    for (int kt = 0; kt < 9; ++kt) m = fmaxf(fmaxf(fmaxf(m, sc[kt][0]), fmaxf(sc[kt][1], sc[kt][2])), sc[kt][3]);
    m = fmaxf(m, __shfl_xor(m, 16)); m = fmaxf(m, __shfl_xor(m, 32));
    float l = 0.f;
#pragma unroll
    for (int kt = 0; kt < 9; ++kt)
#pragma unroll
        for (int j = 0; j < 4; ++j) { const float p = __builtin_amdgcn_exp2f(sc[kt][j] - m); sc[kt][j] = p; l += p; }
    l += __shfl_xor(l, 16); l += __shfl_xor(l, 32);
#pragma unroll
    for (int dt = 0; dt < 4; ++dt) o[dt] = (f32x4){0.f, 0.f, 0.f, 0.f};
#pragma unroll
    for (int ks = 0; ks < 5; ++ks) {
        const int ktl = (2 * ks + 1 < 9) ? 2 * ks + 1 : 8;
        const bool step_valid = (P0 + stride * (16 * ktl + 15 - 128)) >= 0;
        if (step_valid) {
            if (SAMP && ks < 4) {
#pragma unroll
                for (int i = 0; i < 8; ++i) { const int kl = 4 * i + (lane >> 4); int kpos = P0 + stride * (32 * ks + kl - 128); kpos = kpos < 0 ? 0 : kpos;
                    const f32x4 v = *(const f32x4*)(cv + (size_t)kpos * (NH * HD) + (lane & 15) * 4);
                    u32x2 w; w.x = pk2(v[0], v[1]); w.y = pk2(v[2], v[3]); *(LAS u32x2*)(vst + kl * AT_VROW + (lane & 15) * 8) = w; }
            } else {
#pragma unroll
                for (int i = 0; i < 4; ++i) { const int kl = 8 * i + (lane >> 3); int kpos = P0 + stride * (32 * ks + kl - 128);
                    if (SAMP) { kpos -= KVB; kpos = kpos < 0 ? 0 : (kpos > DECS - 1 ? DECS - 1 : kpos); } else kpos = kpos < 0 ? 0 : (kpos > SEQ - 1 ? SEQ - 1 : kpos);
                    const u32x4 v = *(const u32x4*)(base + (size_t)kpos * NPROJ + C_V + (lane & 7) * 8);
                    *(LAS u32x4*)(vst + kl * AT_VROW + (lane & 7) * 16) = v; }
            }
            bf16x8 pb;
            { const f32x4 pa = sc[2 * ks]; const f32x4 pz = (2 * ks + 1 < 9) ? sc[(2 * ks + 1 < 9) ? 2 * ks + 1 : 8] : (f32x4){0.f, 0.f, 0.f, 0.f};
              u32x4 w; w.x = pk2(pa[0], pa[1]); w.y = pk2(pa[2], pa[3]); w.z = pk2(pz[0], pz[1]); w.w = pk2(pz[2], pz[3]); pb = __builtin_bit_cast(bf16x8, w); }
            LDS_WAIT(); asm volatile("" ::: "memory");
            LAS const unsigned char* vr = vst + (4 * rq + ((lane & 15) >> 2)) * AT_VROW + (lane & 3) * 8;
#pragma unroll
            for (int dt = 0; dt < 4; ++dt) { const s16x4 lo = lds_tr16(vr + dt * 32), hi = lds_tr16(vr + dt * 32 + 16 * AT_VROW);
                const bf16x8 vf = (bf16x8){lo[0], lo[1], lo[2], lo[3], hi[0], hi[1], hi[2], hi[3]};
                o[dt] = __builtin_amdgcn_mfma_f32_16x16x32_bf16(vf, pb, o[dt], 0, 0, 0); }
            LDS_WAIT(); asm volatile("" ::: "memory");
        }
    }
    m_out = m; l_out = l;
}
__device__ __forceinline__ void attn_merge(int mode, LAS unsigned char* lds, int ql, int lane, float m, float l, f32x4 (&o)[4], const bf16* gp  , bf16* yp  ) {
    const int rq = lane >> 4;
    LAS float* ml = (LAS float*)(lds + AT_ML) + ql * 2; LAS unsigned char* st = lds + AT_ST + ql * AT_STROW + rq * 16;
    if (mode == 0) {
#pragma unroll
        for (int dt = 0; dt < 4; ++dt) *(LAS f32x4*)(st + dt * 64) = o[dt];
        if (rq == 0) { ml[0] = m; ml[1] = l; }
    } else {
        const float M = ml[0], L = ml[1]; const float Mn = fmaxf(M, m), ca = __builtin_amdgcn_exp2f(M - Mn), cb = __builtin_amdgcn_exp2f(m - Mn); const float Ln = L * ca + l * cb;
        f32x4 on[4];
#pragma unroll
        for (int dt = 0; dt < 4; ++dt) on[dt] = *(LAS const f32x4*)(st + dt * 64) * ca + o[dt] * cb;
        if (mode == 1) {
            LDS_WAIT(); asm volatile("" ::: "memory");
#pragma unroll
            for (int dt = 0; dt < 4; ++dt) *(LAS f32x4*)(st + dt * 64) = on[dt];
            if (rq == 0) { ml[0] = Mn; ml[1] = Ln; }
        } else {
            const float inv = 1.f / Ln;
#pragma unroll
            for (int dt = 0; dt < 4; ++dt) { const u32x2 g = *(const u32x2*)(gp + 16 * dt + 4 * rq);
                const float g0 = __uint_as_float(g.x << 16), g1 = __uint_as_float(g.x & 0xffff0000u), g2 = __uint_as_float(g.y << 16), g3 = __uint_as_float(g.y & 0xffff0000u);
                u32x2 w; w.x = pk2(on[dt][0] * inv * siluf_(g0), on[dt][1] * inv * siluf_(g1)); w.y = pk2(on[dt][2] * inv * siluf_(g2), on[dt][3] * inv * siluf_(g3));
                *(u32x2*)(yp + 16 * dt + 4 * rq) = w; }
        }
    }
}
__device__ __forceinline__ void attn_unit(const unsigned char* ws, LAS unsigned char* lds, int b, int h, int s, int wave, int lane) {
    const bf16* proj = (const bf16*)(ws + WS_PROJ); bf16* ya = (bf16*)(ws + WS_YA); const float* prm = (const float*)(ws + WS_PRM);
    const bf16* base = proj + (size_t)b * SEQ * NPROJ + h * HD;
    LAS float* bias2 = (LAS float*)(lds + AT_BIAS); LAS unsigned char* vst = lds + AT_V + wave * AT_VBYTES;
    for (int idx = threadIdx.x; idx < 3 * 129; idx += NTHR) { const int g = idx / 129, j = idx - g * 129; bias2[g * 132 + j] = prm[PR_RELB + t5_bucket(j << (2 * g)) * NH + h] * LOG2E; }
    const int c = lane & 15;
#pragma unroll 1
    for (int it = 0; it < 6; ++it) {
        if ((it & 1) == 0) __syncthreads();
        const int id = 2 * wave + (it & 1), mode = it >> 1;
        int q0, stride;
        if (mode == 0) { q0 = id; stride = 16; } else if (mode == 1) { q0 = (id >> 2) + 64 * (id & 3); stride = 4; } else { q0 = 16 * id; stride = 1; }
        float m, l; f32x4 o[4];
        attn_item<false>(base, nullptr, nullptr, s + q0, stride, bias2 + (2 - mode) * 132, vst, lane, m, l, o);
        const int ql = q0 + stride * c; const size_t row = (size_t)b * SEQ + s + ql;
        attn_merge(mode, lds, ql, lane, m, l, o, proj + row * NPROJ + C_G + h * HD, ya + row * DA + h * HD);
    }
    __syncthreads();
}

constexpr int AS_SLOT = 0, AS_SLOTF = 68;
__device__ __forceinline__ void attn_sample_unit(const unsigned char* ws, const float* cache_k, const float* cache_v, LAS unsigned char* lds, int sq, int h, int wave, int lane) {
    const bf16* proj = (const bf16*)(ws + WS_PROJ); bf16* ya = (bf16*)(ws + WS_YA); const float* prm = (const float*)(ws + WS_PRM);
    const bf16* base = proj + (size_t)(MP + sq * DECS) * NPROJ + h * HD; const float* ck = cache_k + ((size_t)sq * KVB * NH + h) * HD; const float* cv = cache_v + ((size_t)sq * KVB * NH + h) * HD;
    LAS float* bias2 = (LAS float*)(lds + AT_BIAS); LAS unsigned char* vst = lds + AT_V + wave * AT_VBYTES; LAS float* slots = (LAS float*)(lds + AS_SLOT);
    for (int idx = threadIdx.x; idx < 3 * 129; idx += NTHR) { const int g = idx / 129, j = idx - g * 129; bias2[g * 132 + j] = prm[PR_RELB + t5_bucket(j << (2 * g)) * NH + h] * LOG2E; }
    __syncthreads();
    const int c = lane & 15, rq = lane >> 4;
#pragma unroll 1
    for (int id = wave; id < 13; id += NWAVES) {
        const int g = id == 0 ? 0 : (id < 5 ? 1 : 2), r = id == 0 ? 0 : (id < 5 ? id - 1 : id - 5), stride = 1 << (2 * g), nq = (DECS - r + stride - 1) / stride;
        float m, l; f32x4 o[4];
        attn_item<true>(base, ck, cv, KVB + r, stride, bias2 + g * 132, vst, lane, m, l, o);
        if (c < nq) { LAS float* sl = slots + ((r + stride * c) * 3 + g) * AS_SLOTF;
#pragma unroll
            for (int dt = 0; dt < 4; ++dt) *(LAS f32x4*)(sl + 16 * dt + 4 * rq) = o[dt];
            if (rq == 0) { sl[64] = m; sl[65] = l; } }
    }
    __syncthreads();
    { const int i = threadIdx.x >> 6, d = lane; const LAS float* s0 = slots + (i * 3) * AS_SLOTF; const LAS float* s1 = s0 + AS_SLOTF; const LAS float* s2 = s1 + AS_SLOTF;
      const float m0 = s0[64], m1 = s1[64], m2 = s2[64], M = fmaxf(m0, fmaxf(m1, m2));
      const float c0 = __builtin_amdgcn_exp2f(m0 - M), c1 = __builtin_amdgcn_exp2f(m1 - M), c2 = __builtin_amdgcn_exp2f(m2 - M);
      const float L = s0[65] * c0 + s1[65] * c1 + s2[65] * c2, O = s0[d] * c0 + s1[d] * c1 + s2[d] * c2;
      const size_t row = (size_t)MP + sq * DECS + i; const float gv = bf2f(proj[row * NPROJ + C_G + h * HD + d]);
      ya[row * DA + h * HD + d] = (bf16)f2bf(O / L * siluf_(gv)); }
    __syncthreads();
}
constexpr int SD_BM = 0, SD_CM = 17408, SD_CS = 34816, SD_ROWN = 272, SD_BWT = 52224, SD_XT = 70656, SD_ROWS = 144, SD_YP = 79872, SD_YROW = 272, SD_AR = 114688;
__device__ __forceinline__ void ssd_dtarrays(LAS float* ar, const float* dtb, size_t row, int hd, float Aneg, int lane) {
    asm volatile("" : "+v"(lane));
    const float dtv = dtb[(row + lane) * 32 + hd]; float x = dtv * Aneg * LOG2E;
#pragma unroll
    for (int o = 1; o < 64; o <<= 1) { const float y = __shfl_up(x, o); if (lane >= o) x += y; }
    const float tot = __shfl(x, 63);
    ar[lane] = x; ar[64 + lane] = dtv; ar[128 + lane] = __builtin_amdgcn_exp2f(tot - x) * dtv; ar[192 + lane] = __builtin_amdgcn_exp2f(x);
}
__device__ __forceinline__ float silu_fast(float x) { return x * __builtin_amdgcn_rcpf(1.f + __builtin_amdgcn_exp2f(-x * LOG2E)); }
template <int KIND, int RL> __device__ __forceinline__ void ssd_conv_task(const bf16* proj, const bf16* zrow  , const float* prm, LAS unsigned char* lds, size_t row0, int c0, int t0, int col  , int ch  ) {
    const LAS float* ar = (const LAS float*)(lds + SD_AR);
    float w0[4], w1[4];
#pragma unroll
    for (int tap = 0; tap < 4; ++tap) { w0[tap] = prm[PR_CONVW + tap * DCONV + col]; w1[tap] = prm[PR_CONVW + tap * DCONV + col + 1]; }
    const float b0 = prm[PR_CONVB + col], b1 = prm[PR_CONVB + col + 1];
    unsigned raw[RL + 3];
#pragma unroll
    for (int k = 0; k < RL + 3; ++k) { const int T = c0 + t0 - 3 + k; const bf16* rp = (T >= 0) ? proj + (row0 + (size_t)T) * NPROJ + C_XBC : zrow; raw[k] = *(const unsigned*)(rp + col); }
#pragma unroll
    for (int blk = 0; blk < RL / 8; ++blk) {
        float o0[8], o1[8];
#pragma unroll
        for (int tt = 0; tt < 8; ++tt) { const int t = blk * 8 + tt; float v0 = b0, v1 = b1;
#pragma unroll
            for (int tap = 0; tap < 4; ++tap) { v0 += w0[tap] * __uint_as_float(raw[t + tap] << 16); v1 += w1[tap] * __uint_as_float(raw[t + tap] & 0xffff0000u); }
            o0[tt] = silu_fast(v0); o1[tt] = silu_fast(v1); }
        const int s0 = t0 + blk * 8;
        if (KIND == 0) {
            u32x4 a, b; a.x = pk2(o0[0], o0[1]); a.y = pk2(o0[2], o0[3]); a.z = pk2(o0[4], o0[5]); a.w = pk2(o0[6], o0[7]); b.x = pk2(o1[0], o1[1]); b.y = pk2(o1[2], o1[3]); b.z = pk2(o1[4], o1[5]); b.w = pk2(o1[6], o1[7]);
            *(LAS u32x4*)(lds + SD_XT + ch * SD_ROWS + s0 * 2) = a; *(LAS u32x4*)(lds + SD_XT + (ch + 1) * SD_ROWS + s0 * 2) = b;
        } else if (KIND == 1) {
            float s0v[8], s1v[8];
#pragma unroll
            for (int tt = 0; tt < 8; ++tt) { *(LAS unsigned*)(lds + SD_BM + (s0 + tt) * SD_ROWN + ch * 2) = pk2(o0[tt], o1[tt]); const float w = ar[128 + s0 + tt]; s0v[tt] = o0[tt] * w; s1v[tt] = o1[tt] * w; }
            u32x4 a, b; a.x = pk2(s0v[0], s0v[1]); a.y = pk2(s0v[2], s0v[3]); a.z = pk2(s0v[4], s0v[5]); a.w = pk2(s0v[6], s0v[7]); b.x = pk2(s1v[0], s1v[1]); b.y = pk2(s1v[2], s1v[3]); b.z = pk2(s1v[4], s1v[5]); b.w = pk2(s1v[6], s1v[7]);
            *(LAS u32x4*)(lds + SD_BWT + ch * SD_ROWS + s0 * 2) = a; *(LAS u32x4*)(lds + SD_BWT + (ch + 1) * SD_ROWS + s0 * 2) = b;
        } else {
#pragma unroll
            for (int tt = 0; tt < 8; ++tt) { *(LAS unsigned*)(lds + SD_CM + (s0 + tt) * SD_ROWN + ch * 2) = pk2(o0[tt], o1[tt]); const float e = ar[192 + s0 + tt];
                *(LAS unsigned*)(lds + SD_CS + (s0 + tt) * SD_ROWN + ch * 2) = pk2(o0[tt] * e, o1[tt] * e); }
        }
    }
}
__device__ __forceinline__ bf16x8 cat8(s16x4 a, s16x4 b) { return (bf16x8){a[0], a[1], a[2], a[3], b[0], b[1], b[2], b[3]}; }
template <int HH> __device__ __forceinline__ void ssd_mfma_step(LAS unsigned char* lds, f32x4 (&Hacc)[4], int pt, int c, int rq, float Dk) {
    const LAS float* ar = (const LAS float*)(lds + SD_AR);
    bf16x8 bmf[2][4];
#pragma unroll
    for (int st = 0; st < 2; ++st)
#pragma unroll
        for (int ks = 0; ks < 4; ++ks) bmf[st][ks] = *(LAS const bf16x8*)(lds + SD_BM + (32 * HH + 16 * st + c) * SD_ROWN + (8 * rq + 32 * ks) * 2);
    const f32x4 as0 = *(LAS const f32x4*)(ar + 32 * HH + 4 * rq), as1 = *(LAS const f32x4*)(ar + 32 * HH + 16 + 4 * rq);
    const f32x4 dt0 = *(LAS const f32x4*)(ar + 64 + 32 * HH + 4 * rq), dt1 = *(LAS const f32x4*)(ar + 64 + 32 * HH + 16 + 4 * rq);
    int dd = c - 4 * rq; asm volatile("" : "+v"(dd));
    const int p = 16 * pt + c;
    const bf16x8 xb = cat8(*(LAS const s16x4*)(lds + SD_XT + p * SD_ROWS + (32 * HH + 4 * rq) * 2), *(LAS const s16x4*)(lds + SD_XT + p * SD_ROWS + (32 * HH + 16 + 4 * rq) * 2));
    bf16x8 hb[2];
#pragma unroll
    for (int k2 = 0; k2 < 2; ++k2) { u32x4 w; w.x = pk2(Hacc[2 * k2][0], Hacc[2 * k2][1]); w.y = pk2(Hacc[2 * k2][2], Hacc[2 * k2][3]); w.z = pk2(Hacc[2 * k2 + 1][0], Hacc[2 * k2 + 1][1]); w.w = pk2(Hacc[2 * k2 + 1][2], Hacc[2 * k2 + 1][3]); hb[k2] = __builtin_bit_cast(bf16x8, w); }
#pragma unroll
    for (int lt = 0; lt < 4; ++lt) {
        constexpr int S0 = 2 * HH, S1 = 2 * HH + 1;
        const int rel0 = lt - S0, rel1 = lt - S1;
        f32x4 y = {0.f, 0.f, 0.f, 0.f};
        if (rel0 >= 0) {
            f32x4 g0 = {0.f, 0.f, 0.f, 0.f}, g1 = {0.f, 0.f, 0.f, 0.f};
#pragma unroll
            for (int ks = 0; ks < 4; ++ks) { const bf16x8 cf = *(LAS const bf16x8*)(lds + SD_CM + (16 * lt + c) * SD_ROWN + (8 * rq + 32 * ks) * 2);
                g0 = __builtin_amdgcn_mfma_f32_16x16x32_bf16(bmf[0][ks], cf, g0, 0, 0, 0);
                if (rel1 >= 0) g1 = __builtin_amdgcn_mfma_f32_16x16x32_bf16(bmf[1][ks], cf, g1, 0, 0, 0); }
            const float acl = ar[16 * lt + c];
            float m0[4], m1[4];
#pragma unroll
            for (int j = 0; j < 4; ++j) {
                float v0 = g0[j] * __builtin_amdgcn_exp2f(fminf(acl - as0[j], 0.f)) * dt0[j];
                if (rel0 == 0) { v0 = (j <= dd) ? v0 : 0.f; v0 += (j == dd) ? Dk : 0.f; }
                m0[j] = v0;
                float v1 = 0.f;
                if (rel1 >= 0) { v1 = g1[j] * __builtin_amdgcn_exp2f(fminf(acl - as1[j], 0.f)) * dt1[j]; if (rel1 == 0) { v1 = (j <= dd) ? v1 : 0.f; v1 += (j == dd) ? Dk : 0.f; } }
                m1[j] = v1; }
            u32x4 w; w.x = pk2(m0[0], m0[1]); w.y = pk2(m0[2], m0[3]); w.z = pk2(m1[0], m1[1]); w.w = pk2(m1[2], m1[3]);
            y = __builtin_amdgcn_mfma_f32_16x16x32_bf16(__builtin_bit_cast(bf16x8, w), xb, y, 0, 0, 0);
        }
#pragma unroll
        for (int k2 = 0; k2 < 2; ++k2) { const LAS unsigned char* cp = lds + SD_CS + (16 * lt + c) * SD_ROWN + (64 * HH + 32 * k2 + 4 * rq) * 2;
            y = __builtin_amdgcn_mfma_f32_16x16x32_bf16(cat8(*(LAS const s16x4*)cp, *(LAS const s16x4*)(cp + 32)), hb[k2], y, 0, 0, 0); }
#pragma unroll
        for (int j = 0; j < 4; ++j) *(LAS float*)(lds + SD_YP + HH * (64 * SD_YROW) + (16 * lt + 4 * rq + j) * SD_YROW + p * 4) = y[j];
    }
    const float dec = __builtin_amdgcn_exp2f(ar[63]);
    bf16x8 xn[2];
#pragma unroll
    for (int k2 = 0; k2 < 2; ++k2) xn[k2] = *(LAS const bf16x8*)(lds + SD_XT + p * SD_ROWS + (8 * rq + 32 * k2) * 2);
#pragma unroll
    for (int nt = 0; nt < 4; ++nt) { Hacc[nt] = Hacc[nt] * dec;
#pragma unroll
        for (int k2 = 0; k2 < 2; ++k2) Hacc[nt] = __builtin_amdgcn_mfma_f32_16x16x32_bf16(*(LAS const bf16x8*)(lds + SD_BWT + (64 * HH + 16 * nt + c) * SD_ROWS + (8 * rq + 32 * k2) * 2), xn[k2], Hacc[nt], 0, 0, 0); }
}
__device__ __forceinline__ void ssd_mfma_unit(const unsigned char* ws, float* out, LAS unsigned char* lds, int b, int hd, int wave, int lane) {
    const bf16* proj = (const bf16*)(ws + WS_PROJ); const float* dtb = (const float*)(ws + WS_DT); const float* prm = (const float*)(ws + WS_PRM); bf16* ys = (bf16*)(ws + WS_YS); float* ssq = (float*)(ws + WS_SSQ);
    const int tid = threadIdx.x, c = lane & 15, rq = lane >> 4, pt = wave & 3, hh = wave >> 2, grp = hd >> 2;
    const size_t row0 = (size_t)b * SEQ; const bf16* zrow = (const bf16*)(ws + WS_WIN) + (size_t)NIN * DM;
    const float Aneg = -__expf(prm[PR_ALOG + hd]), Dk = prm[PR_DSKIP + hd];
    LAS float* ar = (LAS float*)(lds + SD_AR);
    f32x4 Hacc[4];
#pragma unroll
    for (int nt = 0; nt < 4; ++nt) Hacc[nt] = (f32x4){0.f, 0.f, 0.f, 0.f};
    __syncthreads();
    if (wave == 7) ssd_dtarrays(ar, dtb, row0, hd, Aneg, lane);
    __syncthreads();
#pragma unroll 1
    for (int c0 = 0; c0 < SEQ; c0 += 64) {
        if (wave < 2) { const int task = wave * 64 + lane, pair = task & 31, run = task >> 5; ssd_conv_task<0, 16>(proj, zrow, prm, lds, row0, c0, 16 * run, hd * 64 + 2 * pair, 2 * pair); }
        else if (wave < 4) { const int task = (wave - 2) * 64 + lane, pair = task & 63, run = task >> 6; ssd_conv_task<1, 32>(proj, zrow, prm, lds, row0, c0, 32 * run, DSSM + grp * DST + 2 * pair, 2 * pair); }
        else if (wave < 6) { const int task = (wave - 4) * 64 + lane, pair = task & 63, run = task >> 6; ssd_conv_task<2, 32>(proj, zrow, prm, lds, row0, c0, 32 * run, DSSM + NGRP * DST + grp * DST + 2 * pair, 2 * pair); }
        __syncthreads();
        if (hh == 0) ssd_mfma_step<0>(lds, Hacc, pt, c, rq, Dk); else ssd_mfma_step<1>(lds, Hacc, pt, c, rq, Dk);
        __syncthreads();
        {
            const int l = tid >> 3, p0 = (tid & 7) * 8; const size_t row = row0 + c0 + l;
            const LAS float* y0 = (const LAS float*)(lds + SD_YP + l * SD_YROW + p0 * 4); const LAS float* y1 = (const LAS float*)(lds + SD_YP + 64 * SD_YROW + l * SD_YROW + p0 * 4);
            const f32x4 a0 = *(const LAS f32x4*)y0 + *(const LAS f32x4*)y1, a1 = *(const LAS f32x4*)(y0 + 4) + *(const LAS f32x4*)(y1 + 4);
            const u32x4 z = *(const u32x4*)(proj + row * NPROJ + C_Z + hd * 64 + p0);
            float v[8];
            v[0] = a0[0] * silu_fast(__uint_as_float(z.x << 16)); v[1] = a0[1] * silu_fast(__uint_as_float(z.x & 0xffff0000u)); v[2] = a0[2] * silu_fast(__uint_as_float(z.y << 16)); v[3] = a0[3] * silu_fast(__uint_as_float(z.y & 0xffff0000u));
            v[4] = a1[0] * silu_fast(__uint_as_float(z.z << 16)); v[5] = a1[1] * silu_fast(__uint_as_float(z.z & 0xffff0000u)); v[6] = a1[2] * silu_fast(__uint_as_float(z.w << 16)); v[7] = a1[3] * silu_fast(__uint_as_float(z.w & 0xffff0000u));
            u32x4 w; w.x = pk2(v[0], v[1]); w.y = pk2(v[2], v[3]); w.z = pk2(v[4], v[5]); w.w = pk2(v[6], v[7]);
            *(u32x4*)(ys + row * DSSM + hd * 64 + p0) = w;
            float ss = (v[0] * v[0] + v[1] * v[1]) + (v[2] * v[2] + v[3] * v[3]) + (v[4] * v[4] + v[5] * v[5]) + (v[6] * v[6] + v[7] * v[7]);
            ss += __shfl_xor(ss, 1); ss += __shfl_xor(ss, 2); ss += __shfl_xor(ss, 4);
            if ((tid & 7) == 0) ssq[row * NSH + hd] = ss;
            if (wave == 7 && c0 + 64 < SEQ) ssd_dtarrays(ar, dtb, row0 + c0 + 64, hd, Aneg, lane);
        }
        __syncthreads();
    }
    float* dst = out + O_SP + ((size_t)(b * NSH + hd) * SHD + 16 * pt + c) * DST + 64 * hh + 4 * rq;
#pragma unroll
    for (int nt = 0; nt < 4; ++nt) *(f32x4*)(dst + 16 * nt) = Hacc[nt];
}
__device__ __forceinline__ void p0_transpose_item(const float* W, int K, int N, bf16* WT, int k0, int n0, int dst_row0, const float* kscale, LAS float* scr, int lane) {
#pragma unroll 8
    for (int i = 0; i < 32; ++i) { const int kk = 2 * i + (lane >> 5); float v = W[(size_t)(k0 + kk) * N + n0 + (lane & 31)]; if (kscale) v *= kscale[k0 + kk]; scr[kk * 33 + (lane & 31)] = v; }
    LDS_WAIT(); asm volatile("" ::: "memory");
    const int c = lane & 7;
#pragma unroll
    for (int j = 0; j < 4; ++j) { const int n = (lane >> 3) + 8 * j; const LAS float* s = scr + (8 * c) * 33 + n;
        u32x4 o; o.x = pk2(s[0 * 33], s[1 * 33]); o.y = pk2(s[2 * 33], s[3 * 33]); o.z = pk2(s[4 * 33], s[5 * 33]); o.w = pk2(s[6 * 33], s[7 * 33]);
        *(u32x4*)(WT + (size_t)(dst_row0 + n) * K + k0 + 8 * c) = o; }
    LDS_WAIT(); asm volatile("" ::: "memory");
}
__device__ __forceinline__ void p0_prologue(const Args& a, LAS unsigned char* lds, int gw, int NGW, int wave, int lane) {
    bf16* win_t = (bf16*)(a.ws + WS_WIN); bf16* wa_t = (bf16*)(a.ws + WS_WA); bf16* wb_t = (bf16*)(a.ws + WS_WB); bf16* wo_t = (bf16*)(a.ws + WS_WO); bf16* hb = (bf16*)(a.ws + WS_HB);
    LAS float* scr = (LAS float*)(lds + wave * 16384);
    constexpr int I_IN = (DM / 64) * (NIN / 32), I_A = (DA / 64) * (DM / 32), I_B = (DSSM / 64) * (DM / 32), I_O = (DM / 64) * (DM / 32);
    for (int it = gw; it < I_IN + I_A + I_B + I_O; it += NGW) {
        int r = it;
        if (r < I_IN) { const int nblk = NIN / 32, kb = r / nblk, nb = r % nblk, n0 = nb * 32; const int dst = (n0 < 9216) ? n0 : (n0 == 9216 ? 11264 : n0 - 32);
            p0_transpose_item(a.w_in, DM, NIN, win_t, kb * 64, n0, dst, nullptr, scr, lane); continue; } r -= I_IN;
        if (r < I_A) { const int nblk = DM / 32, kb = r / nblk, nb = r % nblk; p0_transpose_item(a.w_a, DA, DM, wa_t, kb * 64, nb * 32, nb * 32, nullptr, scr, lane); continue; } r -= I_A;
        if (r < I_B) { const int nblk = DM / 32, kb = r / nblk, nb = r % nblk; p0_transpose_item(a.w_b, DSSM, DM, wb_t, kb * 64, nb * 32, nb * 32, a.ssm_norm, scr, lane); continue; } r -= I_B;
        { const int nblk = DM / 32, kb = r / nblk, nb = r % nblk; p0_transpose_item(a.w_out, DM, DM, wo_t, kb * 64, nb * 32, nb * 32, nullptr, scr, lane); }
    }
    { float* prm = (float*)(a.ws + WS_PRM); const int gt = gw * 64 + lane, NGT = NGW * 64;
      for (int i = gt; i < PR_END; i += NGT) { float v = 0.f;
          if (i < PR_CONVB) v = a.conv_w[i]; else if (i < PR_DTB) v = a.conv_b[i - PR_CONVB]; else if (i < PR_ALOG) v = a.dt_bias[i - PR_DTB]; else if (i < PR_DSKIP) v = a.a_log[i - PR_ALOG];
          else if (i < PR_RELB) v = a.d_skip[i - PR_DSKIP]; else if (i < PR_RELB + 384) v = a.rel_bias[i - PR_RELB]; else if (i >= PR_FNORM) v = a.final_norm[i - PR_FNORM];
          prm[i] = v; } }
    { u32x4* z = (u32x4*)(win_t + (size_t)11296 * DM); const int n16 = 224 * DM * 2 / 16; for (int i = gw * 64 + lane; i < n16; i += NGW * 64) z[i] = (u32x4){0u, 0u, 0u, 0u}; }
    for (int m = gw; m < MT; m += NGW) {
        const float* xrow = (m < MP) ? a.x_prompt + (size_t)m * DM : a.x_sample + (size_t)(m - MP) * DM;
        const f32x4* xr = (const f32x4*)xrow + lane; const f32x4* gr = (const f32x4*)a.norm_g + lane;
        f32x4 v[4]; float s = 0.f;
#pragma unroll
        for (int j = 0; j < 4; ++j) { v[j] = xr[64 * j]; s += (v[j].x * v[j].x + v[j].y * v[j].y) + (v[j].z * v[j].z + v[j].w * v[j].w); }
        const float rstd = rsqrtf(wave_sum(s) * (1.f / DM) + 1e-6f);
        unsigned long long* o8 = (unsigned long long*)(hb + (size_t)m * DM) + lane;
#pragma unroll
        for (int j = 0; j < 4; ++j) { const f32x4 g = gr[64 * j]; o8[64 * j] = (unsigned long long)pk2(v[j].x * rstd * g.x, v[j].y * rstd * g.y) | ((unsigned long long)pk2(v[j].z * rstd * g.z, v[j].w * rstd * g.w) << 32); }
    }
}

template <bool SAMP> __device__ __forceinline__ const void* kv_ptr(const Args& a, const bf16* proj, int colkv, const float* cache, int seq, int tpos, int off, int h, bool& valid, bool& isf32) {
    if (!SAMP) { const int kt = tpos - off; valid = kt >= 0; isf32 = false; return proj + (size_t)(seq * SEQ + (valid ? kt : 0)) * NPROJ + colkv + h * HD; }
    const int idx = KVB + tpos - off; valid = true;
    if (idx >= KVB) { isf32 = false; return proj + (size_t)(MP + seq * DECS + (idx - KVB)) * NPROJ + colkv + h * HD; }
    isf32 = true; return cache + ((size_t)(seq * KVB + idx) * NH + h) * HD;
}
template <bool SAMP> __device__ __forceinline__ void attn_slow_item(const Args& a, const bf16* proj, bf16* ya, LAS float* sl, int row, int h, int lane) {
    const float* prm = (const float*)(a.ws + WS_PRM);
    const int seq = SAMP ? (row - MP) / DECS : row / SEQ, tpos = SAMP ? (row - MP) % DECS : row % SEQ;
    float q[64];
    { const u32x4* qp = (const u32x4*)(proj + (size_t)row * NPROJ + C_Q + h * HD);
#pragma unroll
      for (int i = 0; i < 8; ++i) { const u32x4 w = qp[i]; q[8 * i + 0] = __uint_as_float(w.x << 16); q[8 * i + 1] = __uint_as_float(w.x & 0xffff0000u); q[8 * i + 2] = __uint_as_float(w.y << 16); q[8 * i + 3] = __uint_as_float(w.y & 0xffff0000u);
          q[8 * i + 4] = __uint_as_float(w.z << 16); q[8 * i + 5] = __uint_as_float(w.z & 0xffff0000u); q[8 * i + 6] = __uint_as_float(w.w << 16); q[8 * i + 7] = __uint_as_float(w.w & 0xffff0000u); } }
    float mx = -INFINITY;
#pragma unroll 1
    for (int e = lane; e < 387; e += 64) {
        float sc = -INFINITY;
        const int g = e / 129, j = e - g * 129, off = j << (2 * g); bool valid, isf32;
        const void* kp = kv_ptr<SAMP>(a, proj, C_K, a.cache_k, seq, tpos, off, h, valid, isf32);
        if (valid) { float d = 0.f;
            if (isf32) { const f32x4* k4 = (const f32x4*)kp;
#pragma unroll
                for (int i = 0; i < 16; ++i) { const f32x4 kk = k4[i]; d += q[4 * i] * kk.x + q[4 * i + 1] * kk.y + q[4 * i + 2] * kk.z + q[4 * i + 3] * kk.w; } }
            else { const u32x4* k4 = (const u32x4*)kp;
#pragma unroll
                for (int i = 0; i < 8; ++i) { const u32x4 w = k4[i];
                    d += q[8 * i + 0] * __uint_as_float(w.x << 16) + q[8 * i + 1] * __uint_as_float(w.x & 0xffff0000u) + q[8 * i + 2] * __uint_as_float(w.y << 16) + q[8 * i + 3] * __uint_as_float(w.y & 0xffff0000u)
                       + q[8 * i + 4] * __uint_as_float(w.z << 16) + q[8 * i + 5] * __uint_as_float(w.z & 0xffff0000u) + q[8 * i + 6] * __uint_as_float(w.w << 16) + q[8 * i + 7] * __uint_as_float(w.w & 0xffff0000u); } }
            sc = d * 0.125f + prm[PR_RELB + t5_bucket(off) * NH + h]; }
        sl[e] = sc; mx = fmaxf(mx, sc);
    }
    mx = wave_max(mx);
    float sum = 0.f;
#pragma unroll 1
    for (int e = lane; e < 387; e += 64) { const float sc = sl[e]; const float pe = (sc == -INFINITY) ? 0.f : __expf(sc - mx); sl[e] = pe; sum += pe; }
    sum = wave_sum(sum);
    LDS_WAIT(); asm volatile("" ::: "memory");
    float o = 0.f;
#pragma unroll 4
    for (int e = 0; e < 387; ++e) {
        const int g = e / 129, j = e - g * 129, off = j << (2 * g); bool valid, isf32;
        const void* vp = kv_ptr<SAMP>(a, proj, C_V, a.cache_v, seq, tpos, off, h, valid, isf32);
        const float pe = sl[e];
        if (valid) { const float vv = isf32 ? ((const float*)vp)[lane] : bf2f(((const bf16*)vp)[lane]); o += pe * vv; }
    }
    LDS_WAIT(); asm volatile("" ::: "memory");
    const float gv = bf2f(proj[(size_t)row * NPROJ + C_G + h * HD + lane]);
    ya[(size_t)row * DA + h * HD + lane] = (bf16)f2bf(o / sum * siluf_(gv));
}

__device__ __forceinline__ void ssd_slow_item(const Args& a, LAS unsigned char* lds, int item) {
    const bf16* proj = (const bf16*)(a.ws + WS_PROJ); const float* dtb = (const float*)(a.ws + WS_DT); bf16* ys = (bf16*)(a.ws + WS_YS); float* ssq = (float*)(a.ws + WS_SSQ);
    const int tid = threadIdx.x, lane = tid & 63, wid = tid >> 6;
    const bool samp = item >= NBATCH * NSH; const int it2 = samp ? item - NBATCH * NSH : item; const int sq = it2 / NSH, hd = it2 % NSH, grp = hd / 4;
    const int L = samp ? DECS : SEQ, row0 = samp ? MP + sq * DECS : sq * SEQ;
    const int p = tid >> 3, n0 = (tid & 7) * 16;
    float h[16];
    if (samp) { const f32x4* s4 = (const f32x4*)(a.state_ssm + ((size_t)(sq * NSH + hd) * SHD + p) * DST + n0);
#pragma unroll
        for (int j = 0; j < 4; ++j) { const f32x4 v = s4[j]; h[4 * j] = v.x; h[4 * j + 1] = v.y; h[4 * j + 2] = v.z; h[4 * j + 3] = v.w; } }
    else {
#pragma unroll
        for (int j = 0; j < 16; ++j) h[j] = 0.f; }
    const float* prm = (const float*)(a.ws + WS_PRM);
    const float Aneg = -__expf(prm[PR_ALOG + hd]), Dk = prm[PR_DSKIP + hd];
    LAS float* xs = (LAS float*)lds;
    LAS float* Bs = xs + 64 * 64;
    LAS float* Cs = Bs + 64 * 128;
    LAS float* dts = Cs + 64 * 128;
    LAS float* dAs = dts + 64;
    LAS float* yb = dAs + 64;
    for (int c0 = 0; c0 < L; c0 += 64) {
        const int tc = (L - c0) < 64 ? (L - c0) : 64;
        for (int idx = tid; idx < tc * 320; idx += NTHR) {
            const int t = idx / 320, c = idx - t * 320;
            const int xc = c < 64 ? hd * 64 + c : (c < 192 ? DSSM + grp * DST + (c - 64) : DSSM + NGRP * DST + grp * DST + (c - 192));
            float acc = prm[PR_CONVB + xc];
#pragma unroll
            for (int tap = 0; tap < 4; ++tap) { const int tt = c0 + t - 3 + tap; float v;
                if (tt >= 0) v = bf2f(proj[(size_t)(row0 + tt) * NPROJ + C_XBC + xc]);
                else v = samp ? a.state_conv[(size_t)(sq * 3 + 3 + tt) * DCONV + xc] : 0.f;
                acc += prm[PR_CONVW + tap * DCONV + xc] * v; }
            const float val = siluf_(acc);
            if (c < 64) xs[t * 64 + c] = val; else if (c < 192) Bs[t * 128 + (c - 64)] = val; else Cs[t * 128 + (c - 192)] = val;
        }
        if (tid < tc) { const float dtv = dtb[(size_t)(row0 + c0 + tid) * 32 + hd]; dts[tid] = dtv; dAs[tid] = __expf(dtv * Aneg); }
        __syncthreads();
        for (int t = 0; t < tc; ++t) {
            const float dA = dAs[t], xv = xs[t * 64 + p], dtx = dts[t] * xv; float acc = 0.f;
            const LAS f32x4* b4 = (const LAS f32x4*)(Bs + t * 128 + n0); const LAS f32x4* c4 = (const LAS f32x4*)(Cs + t * 128 + n0);
#pragma unroll
            for (int j = 0; j < 4; ++j) { const f32x4 bb = b4[j], cc = c4[j];
                h[4 * j] = dA * h[4 * j] + dtx * bb.x; h[4 * j + 1] = dA * h[4 * j + 1] + dtx * bb.y; h[4 * j + 2] = dA * h[4 * j + 2] + dtx * bb.z; h[4 * j + 3] = dA * h[4 * j + 3] + dtx * bb.w;
                acc += h[4 * j] * cc.x + h[4 * j + 1] * cc.y + h[4 * j + 2] * cc.z + h[4 * j + 3] * cc.w; }
            acc += __shfl_xor(acc, 1); acc += __shfl_xor(acc, 2); acc += __shfl_xor(acc, 4);
            if ((tid & 7) == 0) yb[t * 64 + p] = acc + Dk * xv;
        }
        __syncthreads();
        for (int t = wid; t < tc; t += NWAVES) {
            const int row = row0 + c0 + t; const float z = bf2f(proj[(size_t)row * NPROJ + C_Z + hd * 64 + lane]);
            const float val = yb[t * 64 + lane] * siluf_(z);
            ys[(size_t)row * DSSM + hd * 64 + lane] = (bf16)f2bf(val);
            const float ss = wave_sum(val * val); if (lane == 0) ssq[(size_t)row * NSH + hd] = ss;
        }
        __syncthreads();
    }
    float* dst = a.out + (samp ? O_SS : O_SP) + ((size_t)(sq * NSH + hd) * SHD + p) * DST + n0;
#pragma unroll
    for (int j = 0; j < 4; ++j) ((f32x4*)dst)[j] = (f32x4){h[4 * j], h[4 * j + 1], h[4 * j + 2], h[4 * j + 3]};
}

__device__ __forceinline__ void p2_slow(const Args& a, LAS unsigned char* lds, int G, int wave, int lane) {
    const bf16* proj = (const bf16*)(a.ws + WS_PROJ); bf16* ya = (bf16*)(a.ws + WS_YA);
    for (int item = blockIdx.x; item < NBATCH * NSH; item += G) ssd_mfma_unit(a.ws, a.out, lds, item / NSH, item % NSH, wave, lane);
    for (int item = NBATCH * NSH + blockIdx.x; item < NBATCH * NSH + DECB * NSH; item += G) ssd_slow_item(a, lds, item);
    const int gw = blockIdx.x * NWAVES + wave, NGW = G * NWAVES; LAS float* sl = (LAS float*)(lds + 100 * 1024 + wave * 2048);
    for (int k = 0; ; ++k) { const int v = (G == 256) ? (k < 3 ? (int)((blockIdx.x % 8) * 96 + (blockIdx.x / 8) + 32 * k) : 768) : (int)(blockIdx.x + k * G); if (v >= 768) break;
        const int bh = v >> 3, sb = v & 7; attn_unit(a.ws, lds, bh / NH, bh % NH, sb * 256, wave, lane); }
    for (int u = blockIdx.x; u < DECB * NH; u += G) attn_sample_unit(a.ws, a.cache_k, a.cache_v, lds, u / NH, u % NH, wave, lane);
    const int gt = blockIdx.x * NTHR + threadIdx.x, NGT = G * NTHR;
    for (int i = gt; i < (NBATCH + DECB) * 3 * DCONV; i += NGT) { const int c = i % DCONV, r = (i / DCONV) % 3, sq = i / (3 * DCONV);
        if (sq < NBATCH) a.out[O_CP + (size_t)(sq * 3 + r) * DCONV + c] = bf2f(proj[(size_t)(sq * SEQ + SEQ - 3 + r) * NPROJ + C_XBC + c]);
        else { const int s2 = sq - NBATCH; a.out[O_CS + (size_t)(s2 * 3 + r) * DCONV + c] = bf2f(proj[(size_t)(MP + s2 * DECS + DECS - 3 + r) * NPROJ + C_XBC + c]); } }
}
__device__ __forceinline__ void p25_norm(const Args& a, int gw, int NGW, int lane) {
    bf16* ys = (bf16*)(a.ws + WS_YS); const float* ssq = (const float*)(a.ws + WS_SSQ);
    for (int m = gw; m < MT; m += NGW) {
        const float sv = (lane < 32) ? ssq[(size_t)m * NSH + lane] : 0.f;
        float gs = sv + __shfl_xor(sv, 1); gs += __shfl_xor(gs, 2);
        const float rstd = rsqrtf(gs * (1.f / 256.f) + 1e-5f);
        u32x4* r4 = (u32x4*)(ys + (size_t)m * DSSM);
#pragma unroll
        for (int j = 0; j < 4; ++j) { const int ci = j * 64 + lane, g = ci >> 5; const float sc = __shfl(rstd, 4 * g); u32x4 w = r4[ci];
            w.x = pk2(__uint_as_float(w.x << 16) * sc, __uint_as_float(w.x & 0xffff0000u) * sc); w.y = pk2(__uint_as_float(w.y << 16) * sc, __uint_as_float(w.y & 0xffff0000u) * sc);
            w.z = pk2(__uint_as_float(w.z << 16) * sc, __uint_as_float(w.z & 0xffff0000u) * sc); w.w = pk2(__uint_as_float(w.w << 16) * sc, __uint_as_float(w.w & 0xffff0000u) * sc); r4[ci] = w; }
    }
}
__device__ __forceinline__ void p5_final_norm(const Args& a, int gw, int NGW, int lane) {
    for (int m = gw; m < MT; m += NGW) {
        f32x4* xr = (f32x4*)(a.out + (size_t)m * DM) + lane; const f32x4* gr = (const f32x4*)((const float*)(a.ws + WS_PRM) + PR_FNORM) + lane;
        f32x4 v[4]; float s = 0.f;
#pragma unroll
        for (int j = 0; j < 4; ++j) { v[j] = xr[64 * j]; s += (v[j].x * v[j].x + v[j].y * v[j].y) + (v[j].z * v[j].z + v[j].w * v[j].w); }
        const float rstd = rsqrtf(wave_sum(s) * (1.f / DM) + 1e-6f);
#pragma unroll
        for (int j = 0; j < 4; ++j) { const f32x4 g = gr[64 * j]; xr[64 * j] = v[j] * rstd * g; }
    }
}
#define GEMM_PHASE(EpiT, Aptr, Bptr, Mrows, Ncols, Kdim, Eobj) do { pg8::Gemm g_{(const pg8::bf16_t*)(Aptr), (const pg8::bf16_t*)(Bptr), (Mrows), (Ncols), (Kdim)}; pg8::StaticOrder S_; S_.init((Mrows), (Ncols), G, (int)blockIdx.x); \
    pg8::gemm_phase<EpiT, pg8::StaticOrder, true, true>(lds, g_, S_, (Eobj)); } while (0)

__global__ void __launch_bounds__(NTHR, 2) fwd_megakernel(Args a) {
    extern __shared__ __attribute__((aligned(16))) unsigned char lds_raw[];
    LAS unsigned char* lds = (LAS unsigned char*)lds_raw;
    cg::grid_group grid = cg::this_grid();
    const int tid = threadIdx.x, lane = tid & 63, wave = __builtin_amdgcn_readfirstlane(tid >> 6);
    const int G = gridDim.x, gw = blockIdx.x * NWAVES + wave, NGW = G * NWAVES;
    unsigned char* ws = a.ws;

    p0_prologue(a, lds, gw, NGW, wave, lane);
    if (blockIdx.x == 0 && tid == 0) { const float** pp = (const float**)(ws + WS_ARGS); pp[0] = a.x_prompt; pp[1] = a.x_sample; pp[2] = a.cache_k; pp[3] = a.cache_v; pp[4] = a.state_conv; pp[5] = a.state_ssm; }
    grid.sync();
    { pg8::EpiInProj E{(pg8::bf16_t*)(ws + WS_PROJ), (float*)(ws + WS_DT), (const float*)(ws + WS_PRM) + PR_DTB, a.out + O_KP, a.out + O_VP, a.out + O_KS, a.out + O_VS};
      GEMM_PHASE(pg8::EpiInProj, ws + WS_HB, ws + WS_WIN, MT, NPAD, DM, E); }
    grid.sync();
    { Args b{}; b.ws = ws; b.out = a.out; b.cache_k = ld_ptr(ws, 2); b.cache_v = ld_ptr(ws, 3); b.state_conv = ld_ptr(ws, 4); b.state_ssm = ld_ptr(ws, 5); p2_slow(b, lds, G, wave, lane); }
    grid.sync();
    p25_norm(a, gw, NGW, lane);
    grid.sync();
    { pg8::EpiGateA E{(const pg8::bf16_t*)(ws + WS_PROJ), (float*)(ws + WS_TMP)}; GEMM_PHASE(pg8::EpiGateA, ws + WS_YA, ws + WS_WA, MT, DM, DA, E); }
    { pg8::EpiGateB E{(const pg8::bf16_t*)(ws + WS_PROJ), (const float*)(ws + WS_TMP), (pg8::bf16_t*)(ws + WS_MRG)}; GEMM_PHASE(pg8::EpiGateB, ws + WS_YS, ws + WS_WB, MT, DM, DSSM, E); }
    grid.sync();
    { pg8::EpiOut E{ld_ptr(ws, 0), ld_ptr(ws, 1), a.out + O_YP}; GEMM_PHASE(pg8::EpiOut, ws + WS_MRG, ws + WS_WO, MT, DM, DM, E); }
    grid.sync();
    p5_final_norm(a, gw, NGW, lane);
}

extern "C" void kernel_launch(void* const* d_in, const int* in_sizes, int n_in, void* d_out, int out_size, void* d_ws, size_t ws_size, hipStream_t stream) {
    static int grid_blocks = 0;
    if (grid_blocks == 0) {
        if (n_in != 19 || (size_t)out_size != O_END || ws_size < WS_END) { fprintf(stderr, "kernel_launch: unexpected shapes: n_in %d out %d (want %zu) ws %zu (want >= %zu)\n", n_in, out_size, (size_t)O_END, ws_size, (size_t)WS_END); grid_blocks = -1; return; }
        int dev = 0, cus = 0, per_cu = 0;
        hipGetDevice(&dev); hipDeviceGetAttribute(&cus, hipDeviceAttributeMultiprocessorCount, dev);
        if (hipFuncSetAttribute((const void*)fwd_megakernel, hipFuncAttributeMaxDynamicSharedMemorySize, LDS_BYTES) != hipSuccess) { fprintf(stderr, "kernel_launch: hipFuncSetAttribute failed\n"); grid_blocks = -1; return; }
        if (hipOccupancyMaxActiveBlocksPerMultiprocessor(&per_cu, (const void*)fwd_megakernel, NTHR, LDS_BYTES) != hipSuccess || per_cu < 1) { fprintf(stderr, "kernel_launch: occupancy query failed (%d)\n", per_cu); (void)hipGetLastError(); per_cu = 1; }
        if (per_cu > 1) per_cu = 1;
        grid_blocks = cus * per_cu;
        fprintf(stderr, "kernel_launch: grid %d (cus %d)\n", grid_blocks, cus);
    }
    if (grid_blocks < 0) return;
    Args a{};
    a.x_prompt = (const float*)d_in[0]; a.x_sample = (const float*)d_in[1]; a.cache_k = (const float*)d_in[2]; a.cache_v = (const float*)d_in[3]; a.state_conv = (const float*)d_in[4]; a.state_ssm = (const float*)d_in[5];
    a.norm_g = (const float*)d_in[6]; a.w_in = (const float*)d_in[7]; a.conv_w = (const float*)d_in[8]; a.conv_b = (const float*)d_in[9]; a.dt_bias = (const float*)d_in[10]; a.a_log = (const float*)d_in[11];
    a.d_skip = (const float*)d_in[12]; a.ssm_norm = (const float*)d_in[13]; a.w_a = (const float*)d_in[14]; a.w_b = (const float*)d_in[15]; a.w_out = (const float*)d_in[16]; a.rel_bias = (const float*)d_in[17]; a.final_norm = (const float*)d_in[18];
    a.out = (float*)d_out; a.ws = (unsigned char*)d_ws;
    void* args[] = {&a};
    hipError_t e = hipLaunchCooperativeKernel((const void*)fwd_megakernel, dim3(grid_blocks), dim3(NTHR), args, LDS_BYTES, stream);
    if (e != hipSuccess) fprintf(stderr, "kernel_launch: cooperative launch failed: %s (grid %d)\n", hipGetErrorString(e), grid_blocks);
}
```

```cpp
#include <hip/hip_runtime.h>
#include <hip/hip_cooperative_groups.h>
#include <cstdio>
#include <cstdint>
namespace cg = cooperative_groups;
namespace pg8 {
#define PG8_LAS __attribute__((address_space(3)))
typedef unsigned short bf16_t;
typedef short bf16x8 __attribute__((ext_vector_type(8)));
typedef float f32x4 __attribute__((ext_vector_type(4)));
typedef unsigned u32x4 __attribute__((ext_vector_type(4)));
constexpr int BM = 256, BK = 64, HALF = 128, HTB = HALF * BK * 2  , STAGE_BYTES = 8 * HTB, NXCD = 8, WGM = 8;

__host__ __device__ __forceinline__ int lds_byte(int r, int c) { const int st = (r >> 4) * 2 + (c >> 5), rr = r & 15, cc = c & 31, ob = rr * 64 + cc * 2; return st * 1024 + (ob ^ (((ob >> 9) & 1) << 5)); }
__host__ __device__ __forceinline__ void stage_rc(int b, int& R, int& C) { const int st = b / 1024, sb = b % 1024, swz = sb ^ (((sb >> 9) & 1) << 5); R = (st >> 1) * 16 + swz / 64; C = (st & 1) * 32 + (swz % 64) / 2; }
__host__ __device__ __forceinline__ int perm32(int rho) { const int n = rho >> 4, i = rho & 15; return 8 * (i >> 2) + 4 * n + (i & 3); }

struct Unit { int pm, pn; };
struct Gemm { const bf16_t* A; const bf16_t* Bt; int M, N, K; };

struct StaticOrder {
    int nM, nN, nwg, G, c;
    __host__ __device__ void init(int M, int N, int G_, int c_) { nM = M / BM; nN = N / BM; nwg = nM * nN; G = G_; c = c_; }
    __host__ __device__ bool next(int i, Unit& u) const {
        const long L = (long)i * G + c; if (L >= nwg) return false;
        int wgid = (int)L; { const int q = nwg / NXCD, r = nwg % NXCD, xcd = wgid % NXCD, off = wgid / NXCD; wgid = (xcd < r ? xcd * (q + 1) : r * (q + 1) + (xcd - r) * q) + off; }
        const int nig = WGM * nN, gid = wgid / nig, fm = gid * WGM, gsz = (nM - fm) < WGM ? (nM - fm) : WGM;
        u.pm = fm + ((wgid % nig) % gsz); u.pn = (wgid % nig) / gsz; return true;
    }
    __device__ __forceinline__ void a_ready(const Unit&) const {}
    __device__ __forceinline__ void done(const Unit&) const {}
};

__device__ __forceinline__ unsigned cvt_pk_bf16(float lo, float hi) { unsigned r; asm volatile("v_cvt_pk_bf16_f32 %0, %1, %2" : "=v"(r) : "v"(lo), "v"(hi)); return r; }
__device__ __forceinline__ float e_bf2f(unsigned short b) { return __uint_as_float(((unsigned)b) << 16); }
__device__ __forceinline__ float e_sigmoid(float x) { return 1.f / (1.f + __expf(-x)); }
__device__ __forceinline__ float e_softplus(float x) { return fmaxf(x, 0.f) + log1pf(__expf(-fabsf(x))); }

struct EpiInProj {
    static constexpr bool PERM = true, AFTER_DRAIN = false;
    bf16_t* proj; float* dt; const float* dt_bias; float* kp; float* vp; float* ks; float* vs;
    __device__ __forceinline__ void operator()(const f32x4 (&acc)[2][2][4][2], const Unit& u, int wr, int wc, int fr, int fq) const {
        const int row0 = u.pm * BM + wr * 64 + fr;
        if (u.pn < 44) {
            const int col0 = u.pn * BM + wc * 32 + 8 * fq;
            const bool isk = (u.pn >= 3 && u.pn < 6), isv = (u.pn >= 6 && u.pn < 9);
#pragma unroll
            for (int ai = 0; ai < 2; ++ai)
#pragma unroll
                for (int m = 0; m < 4; ++m) { const int row = row0 + ai * HALF + m * 16; bf16_t* rowp = proj + (size_t)row * 11264 + col0;
#pragma unroll
                    for (int bj = 0; bj < 2; ++bj) { const f32x4 v0 = acc[ai][bj][m][0], v1 = acc[ai][bj][m][1];
                        u32x4 w; w.x = cvt_pk_bf16(v0[0], v0[1]); w.y = cvt_pk_bf16(v0[2], v0[3]); w.z = cvt_pk_bf16(v1[0], v1[1]); w.w = cvt_pk_bf16(v1[2], v1[3]);
                        *(u32x4*)(rowp + bj * HALF) = w;
                        if (isk || isv) { const int c = col0 + bj * HALF - (isk ? 768 : 1536);
                            float* dst = (u.pm < 64) ? ((isk ? kp : vp) + (size_t)row * 768 + c) : ((isk ? ks : vs) + (size_t)(row - 16384) * 768 + c);
                            *(f32x4*)dst = v0; *(f32x4*)(dst + 4) = v1; } } }
        } else if (wc == 0) {
            const f32x4 b0 = *(const f32x4*)(dt_bias + 8 * fq), b1 = *(const f32x4*)(dt_bias + 8 * fq + 4);
#pragma unroll
            for (int ai = 0; ai < 2; ++ai)
#pragma unroll
                for (int m = 0; m < 4; ++m) { const int row = row0 + ai * HALF + m * 16; const f32x4 v0 = acc[ai][0][m][0] + b0, v1 = acc[ai][0][m][1] + b1;
                    f32x4 o0, o1;
#pragma unroll
                    for (int j = 0; j < 4; ++j) { o0[j] = e_softplus(v0[j]); o1[j] = e_softplus(v1[j]); }
                    float* dst = dt + (size_t)row * 32 + 8 * fq; *(f32x4*)dst = o0; *(f32x4*)(dst + 4) = o1; }
        }
    }
};
struct EpiGateA {
    static constexpr bool PERM = true, AFTER_DRAIN = false;
    const bf16_t* proj; float* tmp;
    __device__ __forceinline__ void operator()(const f32x4 (&acc)[2][2][4][2], const Unit& u, int wr, int wc, int fr, int fq) const {
        const int row0 = u.pm * BM + wr * 64 + fr, col0 = u.pn * BM + wc * 32 + 8 * fq;
#pragma unroll
        for (int ai = 0; ai < 2; ++ai)
#pragma unroll
            for (int m = 0; m < 4; ++m) { const int row = row0 + ai * HALF + m * 16;
#pragma unroll
                for (int bj = 0; bj < 2; ++bj) { const int c = col0 + bj * HALF; const u32x4 g = *(const u32x4*)(proj + (size_t)row * 11264 + 9216 + c);
                    const f32x4 v0 = acc[ai][bj][m][0], v1 = acc[ai][bj][m][1]; f32x4 o0, o1;
                    o0[0] = e_sigmoid(__uint_as_float(g.x << 16)) * v0[0]; o0[1] = e_sigmoid(__uint_as_float(g.x & 0xffff0000u)) * v0[1];
                    o0[2] = e_sigmoid(__uint_as_float(g.y << 16)) * v0[2]; o0[3] = e_sigmoid(__uint_as_float(g.y & 0xffff0000u)) * v0[3];
                    o1[0] = e_sigmoid(__uint_as_float(g.z << 16)) * v1[0]; o1[1] = e_sigmoid(__uint_as_float(g.z & 0xffff0000u)) * v1[1];
                    o1[2] = e_sigmoid(__uint_as_float(g.w << 16)) * v1[2]; o1[3] = e_sigmoid(__uint_as_float(g.w & 0xffff0000u)) * v1[3];
                    float* dst = tmp + (size_t)row * 1024 + c; *(f32x4*)dst = o0; *(f32x4*)(dst + 4) = o1; } }
    }
};
struct EpiGateB {
    static constexpr bool PERM = true, AFTER_DRAIN = false;
    const bf16_t* proj; const float* tmp; bf16_t* mrg;
    __device__ __forceinline__ void operator()(const f32x4 (&acc)[2][2][4][2], const Unit& u, int wr, int wc, int fr, int fq) const {
        const int row0 = u.pm * BM + wr * 64 + fr, col0 = u.pn * BM + wc * 32 + 8 * fq;
#pragma unroll
        for (int ai = 0; ai < 2; ++ai)
#pragma unroll
            for (int m = 0; m < 4; ++m) { const int row = row0 + ai * HALF + m * 16;
#pragma unroll
                for (int bj = 0; bj < 2; ++bj) { const int c = col0 + bj * HALF; const u32x4 g = *(const u32x4*)(proj + (size_t)row * 11264 + 10240 + c);
                    const float* src = tmp + (size_t)row * 1024 + c; const f32x4 t0 = *(const f32x4*)src, t1 = *(const f32x4*)(src + 4);
                    const f32x4 v0 = acc[ai][bj][m][0], v1 = acc[ai][bj][m][1]; f32x4 o0, o1;
                    o0[0] = t0[0] + e_sigmoid(__uint_as_float(g.x << 16)) * v0[0]; o0[1] = t0[1] + e_sigmoid(__uint_as_float(g.x & 0xffff0000u)) * v0[1];
                    o0[2] = t0[2] + e_sigmoid(__uint_as_float(g.y << 16)) * v0[2]; o0[3] = t0[3] + e_sigmoid(__uint_as_float(g.y & 0xffff0000u)) * v0[3];
                    o1[0] = t1[0] + e_sigmoid(__uint_as_float(g.z << 16)) * v1[0]; o1[1] = t1[1] + e_sigmoid(__uint_as_float(g.z & 0xffff0000u)) * v1[1];
                    o1[2] = t1[2] + e_sigmoid(__uint_as_float(g.w << 16)) * v1[2]; o1[3] = t1[3] + e_sigmoid(__uint_as_float(g.w & 0xffff0000u)) * v1[3];
                    u32x4 w; w.x = cvt_pk_bf16(o0[0], o0[1]); w.y = cvt_pk_bf16(o0[2], o0[3]); w.z = cvt_pk_bf16(o1[0], o1[1]); w.w = cvt_pk_bf16(o1[2], o1[3]);
                    *(u32x4*)(mrg + (size_t)row * 1024 + c) = w; } }
    }
};
struct EpiOut {
    static constexpr bool PERM = false, AFTER_DRAIN = false;
    const float* xp; const float* xs; float* out;
    __device__ __forceinline__ void operator()(const f32x4 (&acc)[2][2][4][2], const Unit& u, int wr, int wc, int fr, int fq) const {
        const int row0 = u.pm * BM + wr * 64 + fr, col0 = u.pn * BM + wc * 32 + 4 * fq;
#pragma unroll
        for (int ai = 0; ai < 2; ++ai)
#pragma unroll
            for (int m = 0; m < 4; ++m) { const int row = row0 + ai * HALF + m * 16;
                const float* xr = (u.pm < 64) ? xp + (size_t)row * 1024 : xs + (size_t)(row - 16384) * 1024; float* orow = out + (size_t)row * 1024;
#pragma unroll
                for (int bj = 0; bj < 2; ++bj)
#pragma unroll
                    for (int n = 0; n < 2; ++n) { const int c = col0 + bj * HALF + n * 16; *(f32x4*)(orow + c) = *(const f32x4*)(xr + c) + acc[ai][bj][m][n]; } }
    }
};

template <class Epi, class Sched, bool ALIGN_EPI = false, bool SP2 = false>
__device__ __forceinline__ void gemm_phase(PG8_LAS unsigned char* lds, const Gemm g, const Sched& S, const Epi& E) {
    int tid_ = threadIdx.x; asm volatile("" : "+v"(tid_));
    const int tid = tid_, wid = __builtin_amdgcn_readfirstlane(tid >> 6), lane = tid & 63, wr = wid >> 2, wc = wid & 3, fr = lane & 15, fq = lane >> 4;
    const int K = g.K, nt = K / BK;
    unsigned voffA[2], voffB[2];
#pragma unroll
    for (int i = 0; i < 2; ++i) { int R, C; stage_rc(tid * 16 + i * 8192, R, C); const int Rb = Epi::PERM ? ((R & ~31) + perm32(R & 31)) : R;
        voffA[i] = (unsigned)(R * K + C) * 2u; voffB[i] = (unsigned)(Rb * K + C) * 2u; }
    const size_t kstep = (size_t)(BK * 2);
    const size_t hstep = (size_t)HALF * K * 2;
    const size_t tstep = 2 * hstep;
    const unsigned ldsw = (unsigned)wid * 1024u;
    const int aoff = lds_byte(wr * 64 + fr, fq * 8), boff = lds_byte(wc * 32 + fr, fq * 8);
#define PG8_SA(b, h) (((b) * 2 + (h)) * HTB)
#define PG8_SB(b, h) ((4 + (b) * 2 + (h)) * HTB)
#define PG8_STAGE(bufoff, gbase, voff) do { _Pragma("unroll") for (int _i = 0; _i < 2; ++_i) \
        __builtin_amdgcn_global_load_lds((const unsigned*)((const char*)(gbase) + (voff)[_i]), (PG8_LAS unsigned*)(lds + (bufoff) + ldsw + _i * 8192), 16, 0, 0); } while (0)
#define PG8_LDA(dst, b, h) do { _Pragma("unroll") for (int m = 0; m < 4; ++m) _Pragma("unroll") for (int k = 0; k < 2; ++k) dst[m][k] = *(const PG8_LAS bf16x8*)(lds + PG8_SA(b, h) + aoff + m * 2048 + k * 1024); } while (0)
#define PG8_LDB(dst, b, h) do { _Pragma("unroll") for (int n = 0; n < 2; ++n) _Pragma("unroll") for (int k = 0; k < 2; ++k) dst[n][k] = *(const PG8_LAS bf16x8*)(lds + PG8_SB(b, h) + boff + n * 2048 + k * 1024); } while (0)
#define PG8_MMA(ai, bj, At, Bt) do { __builtin_amdgcn_s_setprio(1); _Pragma("unroll") for (int m = 0; m < 4; ++m) _Pragma("unroll") for (int n = 0; n < 2; ++n) _Pragma("unroll") for (int k = 0; k < 2; ++k) \
        acc[ai][bj][m][n] = __builtin_amdgcn_mfma_f32_16x16x32_bf16(Bt[n][k], At[m][k], acc[ai][bj][m][n], 0, 0, 0); __builtin_amdgcn_s_setprio(0); } while (0)
#define PG8_WAIT_V(n) asm volatile("s_waitcnt vmcnt(" #n ")" ::: "memory")
#define PG8_WAIT_L(n) asm volatile("s_waitcnt lgkmcnt(" #n ")" ::: "memory")
#define PG8_BAR __builtin_amdgcn_s_barrier()
#define PG8_SCHED __builtin_amdgcn_sched_barrier(0)
    Unit cur, nxt; int ui = 0;
    if (!S.next(0, cur)) return;
    f32x4 acc[2][2][4][2];
#pragma unroll
    for (int a = 0; a < 2; ++a)
#pragma unroll
        for (int b = 0; b < 2; ++b)
#pragma unroll
            for (int m = 0; m < 4; ++m)
#pragma unroll
                for (int n = 0; n < 2; ++n) acc[a][b][m][n] = (f32x4){0.f, 0.f, 0.f, 0.f};
    bf16x8 At[4][2], B0[2][2], B1[2][2];
    const char* cA = (const char*)g.A + (size_t)cur.pm * tstep; const char* cB = (const char*)g.Bt + (size_t)cur.pn * tstep;
    S.a_ready(cur);
    if constexpr (SP2) {
        PG8_STAGE(PG8_SB(0, 0), cB, voffB); PG8_STAGE(PG8_SB(0, 1), cB + hstep, voffB); PG8_STAGE(PG8_SA(0, 0), cA, voffA); PG8_STAGE(PG8_SA(0, 1), cA + hstep, voffA);
        if (wr == 1) PG8_BAR;
        PG8_WAIT_V(2); PG8_BAR;
        PG8_STAGE(PG8_SB(1, 0), cB + kstep, voffB); PG8_STAGE(PG8_SA(1, 0), cA + kstep, voffA); PG8_STAGE(PG8_SB(1, 1), cB + hstep + kstep, voffB);
        PG8_WAIT_V(6); PG8_BAR;
    } else {
        PG8_STAGE(PG8_SB(0, 0), cB, voffB); PG8_STAGE(PG8_SA(0, 0), cA, voffA); PG8_STAGE(PG8_SB(0, 1), cB + hstep, voffB); PG8_STAGE(PG8_SA(0, 1), cA + hstep, voffA);
        if (wr == 1) PG8_BAR;
        PG8_WAIT_V(4); PG8_BAR;
        PG8_STAGE(PG8_SB(1, 0), cB + kstep, voffB); PG8_STAGE(PG8_SA(1, 0), cA + kstep, voffA); PG8_STAGE(PG8_SB(1, 1), cB + hstep + kstep, voffB);
        PG8_WAIT_V(6); PG8_BAR;
    }
    for (;;) {
        const bool has_next = S.next(ui + 1, nxt);
        const char* nA = has_next ? (const char*)g.A + (size_t)nxt.pm * tstep : cA; const char* nB = has_next ? (const char*)g.Bt + (size_t)nxt.pn * tstep : cB;
        for (int t = 0; t < nt; t += 2) {
            const bool last = (t == nt - 2);
            const char* a1 = cA + (size_t)(t + 1) * kstep;
            const char* a2 = last ? nA : cA + (size_t)(t + 2) * kstep; const char* b2 = last ? nB : cB + (size_t)(t + 2) * kstep;
            const char* a3 = a2 + kstep; const char* b3 = b2 + kstep;
            if (last && has_next) S.a_ready(nxt);
            if constexpr (SP2) {
            PG8_LDB(B0, 0, 0); PG8_LDB(B1, 0, 1); PG8_SCHED; PG8_LDA(At, 0, 0); PG8_STAGE(PG8_SA(1, 1), a1 + hstep, voffA);
            PG8_WAIT_V(8); PG8_WAIT_L(0); PG8_BAR; PG8_MMA(0, 0, At, B0); PG8_MMA(0, 1, At, B1); PG8_BAR; PG8_SCHED;
            PG8_LDA(At, 0, 1); PG8_STAGE(PG8_SB(0, 0), b2, voffB); PG8_STAGE(PG8_SB(0, 1), b2 + hstep, voffB); PG8_STAGE(PG8_SA(0, 0), a2, voffA);
            PG8_WAIT_V(8); PG8_WAIT_L(0); PG8_BAR; PG8_MMA(1, 0, At, B0); PG8_MMA(1, 1, At, B1); PG8_BAR; PG8_SCHED;
            PG8_LDB(B0, 1, 0); PG8_LDB(B1, 1, 1); PG8_SCHED; PG8_LDA(At, 1, 0); PG8_STAGE(PG8_SA(0, 1), a2 + hstep, voffA);
            PG8_WAIT_V(8); PG8_WAIT_L(0); PG8_BAR; PG8_MMA(0, 0, At, B0); PG8_MMA(0, 1, At, B1); PG8_BAR; PG8_SCHED;
            PG8_LDA(At, 1, 1); PG8_STAGE(PG8_SB(1, 0), b3, voffB); PG8_STAGE(PG8_SB(1, 1), b3 + hstep, voffB); PG8_STAGE(PG8_SA(1, 0), a3, voffA);
            PG8_WAIT_V(8); PG8_WAIT_L(0); PG8_BAR; PG8_MMA(1, 0, At, B0); PG8_MMA(1, 1, At, B1); PG8_BAR; PG8_SCHED;
            } else {
            PG8_LDB(B0, 0, 0); PG8_SCHED; PG8_LDA(At, 0, 0); PG8_STAGE(PG8_SA(1, 1), a1 + hstep, voffA);
            PG8_WAIT_L(8); PG8_BAR; PG8_WAIT_L(0); PG8_MMA(0, 0, At, B0); PG8_BAR; PG8_SCHED;
            PG8_LDB(B1, 0, 1); PG8_STAGE(PG8_SB(0, 0), b2, voffB);
            PG8_BAR; PG8_WAIT_L(0); PG8_MMA(0, 1, At, B1); PG8_BAR;
            PG8_LDA(At, 0, 1); PG8_STAGE(PG8_SA(0, 0), a2, voffA);
            PG8_BAR; PG8_WAIT_L(0); PG8_MMA(1, 0, At, B0); PG8_BAR; PG8_SCHED;
            PG8_STAGE(PG8_SB(0, 1), b2 + hstep, voffB);
            PG8_WAIT_V(6); PG8_BAR; PG8_MMA(1, 1, At, B1); PG8_BAR;
            PG8_LDB(B0, 1, 0); PG8_SCHED; PG8_LDA(At, 1, 0); PG8_STAGE(PG8_SA(0, 1), a2 + hstep, voffA);
            PG8_WAIT_L(8); PG8_BAR; PG8_WAIT_L(0); PG8_MMA(0, 0, At, B0); PG8_BAR; PG8_SCHED;
            PG8_LDB(B1, 1, 1); PG8_STAGE(PG8_SB(1, 0), b3, voffB);
            PG8_BAR; PG8_WAIT_L(0); PG8_MMA(0, 1, At, B1); PG8_BAR;
            PG8_LDA(At, 1, 1); PG8_STAGE(PG8_SA(1, 0), a3, voffA);
            PG8_BAR; PG8_WAIT_L(0); PG8_MMA(1, 0, At, B0); PG8_BAR; PG8_SCHED;
            PG8_STAGE(PG8_SB(1, 1), b3 + hstep, voffB);
            PG8_WAIT_V(6); PG8_BAR; PG8_MMA(1, 1, At, B1); PG8_BAR;
            }
        }
        if constexpr (ALIGN_EPI) { if (wr == 0) PG8_BAR; }
        if constexpr (!Epi::AFTER_DRAIN) { E(acc, cur, wr, wc, fr, fq); S.done(cur); }
        if (!has_next) break;
#pragma unroll
        for (int a = 0; a < 2; ++a)
#pragma unroll
            for (int b = 0; b < 2; ++b)
#pragma unroll
                for (int m = 0; m < 4; ++m)
#pragma unroll
                    for (int n = 0; n < 2; ++n) acc[a][b][m][n] = (f32x4){0.f, 0.f, 0.f, 0.f};
        cur = nxt; cA = nA; cB = nB; ++ui;
        if constexpr (ALIGN_EPI) { if (wr == 1) PG8_BAR; }
    }
    PG8_WAIT_V(0);
    if constexpr (!ALIGN_EPI) { if (wr == 0) PG8_BAR; }
    PG8_BAR;
    if constexpr (Epi::AFTER_DRAIN) { E.fused(acc, cur, wr, wc, fr, fq, lds, wid, lane); S.done(cur); }
#undef PG8_SA
#undef PG8_SB
#undef PG8_STAGE
#undef PG8_LDA
#undef PG8_LDB
#undef PG8_MMA
#undef PG8_WAIT_V
#undef PG8_WAIT_L
#undef PG8_BAR
#undef PG8_SCHED
}
}

#define LAS __attribute__((address_space(3)))
typedef unsigned short bf16;
typedef float f32x4 __attribute__((ext_vector_type(4)));
typedef unsigned u32x4 __attribute__((ext_vector_type(4)));
typedef unsigned u32x2 __attribute__((ext_vector_type(2)));
constexpr int NWAVES = 8, NTHR = 512;
constexpr int DM = 1024, NBATCH = 8, SEQ = 2048, MP = NBATCH * SEQ, DECB = 32, DECS = 8, MS = DECB * DECS, MT = MP + MS;
constexpr int NH = 12, HD = 64, DA = NH * HD;
constexpr int DSSM = 2048, NSH = 32, SHD = 64, NGRP = 8, DST = 128, DCONV = 4096;
constexpr int PAST = 16384, KVB = 2048;
constexpr int NIN = 11296, NPROJ = 11264, NPAD = 11520;
constexpr int C_Q = 0, C_K = 768, C_V = 1536, C_G = 2304, C_Z = 3072, C_XBC = 5120, C_GA = 9216, C_GB = 10240;
constexpr size_t MiB = 1u << 20;
constexpr size_t WS_ARGS = 1 * MiB - 4096, WS_PRM = 1 * MiB, WS_WIN = 2 * MiB, WS_WA = 26 * MiB, WS_WB = 28 * MiB, WS_WO = 32 * MiB, WS_HB = 36 * MiB, WS_DT = 70 * MiB, WS_PROJ = 74 * MiB,
                 WS_YA = 432 * MiB, WS_YS = 458 * MiB, WS_SSQ = 524 * MiB, WS_TMP = 528 * MiB, WS_MRG = 594 * MiB, WS_END = 628 * MiB;
constexpr size_t O_YP = 0, O_YS = O_YP + (size_t)MP * DM, O_KP = O_YS + (size_t)MS * DM, O_VP = O_KP + (size_t)MP * DA, O_CP = O_VP + (size_t)MP * DA,
                 O_SP = O_CP + (size_t)NBATCH * 3 * DCONV, O_KS = O_SP + (size_t)NBATCH * NSH * SHD * DST, O_VS = O_KS + (size_t)MS * DA, O_CS = O_VS + (size_t)MS * DA,
                 O_SS = O_CS + (size_t)DECB * 3 * DCONV, O_END = O_SS + (size_t)DECB * NSH * SHD * DST;
constexpr int LDS_BYTES = 147456;
constexpr int PR_CONVW = 0, PR_CONVB = 16384, PR_DTB = 20480, PR_ALOG = 20512, PR_DSKIP = 20544, PR_RELB = 20576, PR_FNORM = 20992, PR_END = 22016;

struct Args {
    const float *x_prompt, *x_sample, *cache_k, *cache_v, *state_conv, *state_ssm, *norm_g, *w_in, *conv_w, *conv_b, *dt_bias, *a_log, *d_skip, *ssm_norm, *w_a, *w_b, *w_out, *rel_bias, *final_norm;
    float* out; unsigned char* ws;
    int ph_lo, ph_hi;
};

__device__ __forceinline__ float bf2f(bf16 b) { return __uint_as_float(((unsigned)b) << 16); }
__device__ __forceinline__ unsigned f2bf(float f) { unsigned u = __float_as_uint(f); return (u + 0x7fffu + ((u >> 16) & 1u)) >> 16; }
__device__ __forceinline__ unsigned pk2(float lo, float hi) { return f2bf(lo) | (f2bf(hi) << 16); }
__device__ __forceinline__ float sigmoidf_(float x) { return 1.f / (1.f + __expf(-x)); }
__device__ __forceinline__ float siluf_(float x) { return x / (1.f + __expf(-x)); }
__device__ __forceinline__ float softplusf_(float x) { return fmaxf(x, 0.f) + log1pf(__expf(-fabsf(x))); }
__device__ __forceinline__ float wave_sum(float v) {
#pragma unroll
    for (int o = 1; o < 64; o <<= 1) v += __shfl_xor(v, o);
    return v;
}
__device__ __forceinline__ float wave_max(float v) {
#pragma unroll
    for (int o = 1; o < 64; o <<= 1) v = fmaxf(v, __shfl_xor(v, o));
    return v;
}
__device__ __forceinline__ int t5_bucket(int off) {
    if (off < 16) return off;
    return 16 + (off >= 22) + (off >= 30) + (off >= 40) + (off >= 54) + (off >= 73) + (off >= 99) + (off >= 134) + (off >= 182) + (off >= 246) + (off >= 332) + (off >= 450) + (off >= 609) + (off >= 825) + (off >= 1117) + (off >= 1513);
}
__device__ __forceinline__ const float* ld_ptr(const unsigned char* ws, int idx) { const unsigned long long v = ((const unsigned long long*)(ws + WS_ARGS))[idx];
    const unsigned lo = __builtin_amdgcn_readfirstlane((unsigned)v), hi = __builtin_amdgcn_readfirstlane((unsigned)(v >> 32)); return (const float*)(((unsigned long long)hi << 32) | lo); }
#define LDS_WAIT() asm volatile("s_waitcnt lgkmcnt(0)" ::: "memory")
typedef short bf16x8 __attribute__((ext_vector_type(8)));
typedef short s16x4 __attribute__((ext_vector_type(4)));
constexpr int AT_ST = 0, AT_STROW = 272, AT_ML = 69632, AT_BIAS = 71680, AT_V = 73728, AT_VROW = 144, AT_VBYTES = 32 * AT_VROW;
constexpr float LOG2E = 1.4426950408889634f;
__device__ __forceinline__ s16x4 lds_tr16(LAS const unsigned char* p) { return __builtin_bit_cast(s16x4, __builtin_amdgcn_ds_read_tr16_b64_v4i16((LAS s16x4*)p)); }

template <bool SAMP> __device__ __forceinline__ void attn_item(const bf16* base, const float* ck, const float* cv, int P0, int stride, const LAS float* bias2, LAS unsigned char* vst, int lane, float& m_out, float& l_out, f32x4 (&o)[4]) {
    const int c = lane & 15, rq = lane >> 4;
    bf16x8 qf[2];
    { int qrow = P0 + stride * c; if (SAMP) { qrow -= KVB; qrow = qrow > DECS - 1 ? DECS - 1 : qrow; }
      const bf16* qp = base + (size_t)qrow * NPROJ + C_Q + rq * 8; qf[0] = *(const bf16x8*)qp; qf[1] = *(const bf16x8*)(qp + 32); }
    f32x4 sc[9];
#pragma unroll
    for (int kt = 0; kt < 9; ++kt) {
        const bool tile_valid = (P0 + stride * (16 * kt + 15 - 128)) >= 0;
        if (tile_valid) {
            int kpos = P0 + stride * (16 * kt + c - 128); kpos = kpos < 0 ? 0 : kpos;
            bf16x8 k0, k1;
            if (SAMP && kt < 8) { const float* kp = ck + (size_t)kpos * (NH * HD) + rq * 8;
                const f32x4 a0 = *(const f32x4*)kp, a1 = *(const f32x4*)(kp + 4), b0 = *(const f32x4*)(kp + 32), b1 = *(const f32x4*)(kp + 36);
                u32x4 w0, w1; w0.x = pk2(a0[0], a0[1]); w0.y = pk2(a0[2], a0[3]); w0.z = pk2(a1[0], a1[1]); w0.w = pk2(a1[2], a1[3]); w1.x = pk2(b0[0], b0[1]); w1.y = pk2(b0[2], b0[3]); w1.z = pk2(b1[0], b1[1]); w1.w = pk2(b1[2], b1[3]);
                k0 = __builtin_bit_cast(bf16x8, w0); k1 = __builtin_bit_cast(bf16x8, w1);
            } else { if (SAMP) { kpos -= KVB; kpos = kpos > DECS - 1 ? DECS - 1 : kpos; }
                const bf16* kp = base + (size_t)kpos * NPROJ + C_K + rq * 8; k0 = *(const bf16x8*)kp; k1 = *(const bf16x8*)(kp + 32); }
            f32x4 acc = {0.f, 0.f, 0.f, 0.f};
            acc = __builtin_amdgcn_mfma_f32_16x16x32_bf16(k0, qf[0], acc, 0, 0, 0);
            acc = __builtin_amdgcn_mfma_f32_16x16x32_bf16(k1, qf[1], acc, 0, 0, 0);
#pragma unroll
            for (int j = 0; j < 4; ++j) { const int kidx = 16 * kt + 4 * rq + j, jj = c + 128 - kidx, kp2 = P0 + stride * (kidx - 128);
                const bool valid = (jj >= 0) && (jj <= 128) && (kp2 >= 0); const int jc = jj < 0 ? 0 : (jj > 128 ? 128 : jj);
                sc[kt][j] = valid ? acc[j] * (0.125f * LOG2E) + bias2[jc] : -INFINITY; }
        } else sc[kt] = (f32x4){-INFINITY, -INFINITY, -INFINITY, -INFINITY};
    }
    float m = -INFINITY;
#pragma unroll
    for (int kt = 0; kt < 9; ++kt) m = fmaxf(fmaxf(fmaxf(m, sc[kt][0]), fmaxf(sc[kt][1], sc[kt][2])), sc[kt][3]);
    m = fmaxf(m, __shfl_xor(m, 16)); m = fmaxf(m, __shfl_xor(m, 32));
    float l = 0.f;
#pragma unroll
    for (int kt = 0; kt < 9; ++kt)
#pragma unroll
        for (int j = 0; j < 4; ++j) { const float p = __builtin_amdgcn_exp2f(sc[kt][j] - m); sc[kt][j] = p; l += p; }
    l += __shfl_xor(l, 16); l += __shfl_xor(l, 32);
#pragma unroll
    for (int dt = 0; dt < 4; ++dt) o[dt] = (f32x4){0.f, 0.f, 0.f, 0.f};
#pragma unroll
    for (int ks = 0; ks < 5; ++ks) {
        const int ktl = (2 * ks + 1 < 9) ? 2 * ks + 1 : 8;
        const bool step_valid = (P0 + stride * (16 * ktl + 15 - 128)) >= 0;
        if (step_valid) {
            if (SAMP && ks < 4) {
#pragma unroll
                for (int i = 0; i < 8; ++i) { const int kl = 4 * i + (lane >> 4); int kpos = P0 + stride * (32 * ks + kl - 128); kpos = kpos < 0 ? 0 : kpos;
                    const f32x4 v = *(const f32x4*)(cv + (size_t)kpos * (NH * HD) + (lane & 15) * 4);
                    u32x2 w; w.x = pk2(v[0], v[1]); w.y = pk2(v[2], v[3]); *(LAS u32x2*)(vst + kl * AT_VROW + (lane & 15) * 8) = w; }
            } else {
#pragma unroll
                for (int i = 0; i < 4; ++i) { const int kl = 8 * i + (lane >> 3); int kpos = P0 + stride * (32 * ks + kl - 128);
                    if (SAMP) { kpos -= KVB; kpos = kpos < 0 ? 0 : (kpos > DECS - 1 ? DECS - 1 : kpos); } else kpos = kpos < 0 ? 0 : (kpos > SEQ - 1 ? SEQ - 1 : kpos);
                    const u32x4 v = *(const u32x4*)(base + (size_t)kpos * NPROJ + C_V + (lane & 7) * 8);
                    *(LAS u32x4*)(vst + kl * AT_VROW + (lane & 7) * 16) = v; }
            }
            bf16x8 pb;
            { const f32x4 pa = sc[2 * ks]; const f32x4 pz = (2 * ks + 1 < 9) ? sc[(2 * ks + 1 < 9) ? 2 * ks + 1 : 8] : (f32x4){0.f, 0.f, 0.f, 0.f};
              u32x4 w; w.x = pk2(pa[0], pa[1]); w.y = pk2(pa[2], pa[3]); w.z = pk2(pz[0], pz[1]); w.w = pk2(pz[2], pz[3]); pb = __builtin_bit_cast(bf16x8, w); }
            LDS_WAIT(); asm volatile("" ::: "memory");
            LAS const unsigned char* vr = vst + (4 * rq + ((lane & 15) >> 2)) * AT_VROW + (lane & 3) * 8;
#pragma unroll
            for (int dt = 0; dt < 4; ++dt) { const s16x4 lo = lds_tr16(vr + dt * 32), hi = lds_tr16(vr + dt * 32 + 16 * AT_VROW);
                const bf16x8 vf = (bf16x8){lo[0], lo[1], lo[2], lo[3], hi[0], hi[1], hi[2], hi[3]};
                o[dt] = __builtin_amdgcn_mfma_f32_16x16x32_bf16(vf, pb, o[dt], 0, 0, 0); }
            LDS_WAIT(); asm volatile("" ::: "memory");
        }
    }
    m_out = m; l_out = l;
}
__device__ __forceinline__ void attn_merge(int mode, LAS unsigned char* lds, int ql, int lane, float m, float l, f32x4 (&o)[4], const bf16* gp  , bf16* yp  ) {
    const int rq = lane >> 4;
    LAS float* ml = (LAS float*)(lds + AT_ML) + ql * 2; LAS unsigned char* st = lds + AT_ST + ql * AT_STROW + rq * 16;
    if (mode == 0) {
#pragma unroll
        for (int dt = 0; dt < 4; ++dt) *(LAS f32x4*)(st + dt * 64) = o[dt];
        if (rq == 0) { ml[0] = m; ml[1] = l; }
    } else {
        const float M = ml[0], L = ml[1]; const float Mn = fmaxf(M, m), ca = __builtin_amdgcn_exp2f(M - Mn), cb = __builtin_amdgcn_exp2f(m - Mn); const float Ln = L * ca + l * cb;
        f32x4 on[4];
#pragma unroll
        for (int dt = 0; dt < 4; ++dt) on[dt] = *(LAS const f32x4*)(st + dt * 64) * ca + o[dt] * cb;
        if (mode == 1) {
            LDS_WAIT(); asm volatile("" ::: "memory");
#pragma unroll
            for (int dt = 0; dt < 4; ++dt) *(LAS f32x4*)(st + dt * 64) = on[dt];
            if (rq == 0) { ml[0] = Mn; ml[1] = Ln; }
        } else {
            const float inv = 1.f / Ln;
#pragma unroll
            for (int dt = 0; dt < 4; ++dt) { const u32x2 g = *(const u32x2*)(gp + 16 * dt + 4 * rq);
                const float g0 = __uint_as_float(g.x << 16), g1 = __uint_as_float(g.x & 0xffff0000u), g2 = __uint_as_float(g.y << 16), g3 = __uint_as_float(g.y & 0xffff0000u);
                u32x2 w; w.x = pk2(on[dt][0] * inv * siluf_(g0), on[dt][1] * inv * siluf_(g1)); w.y = pk2(on[dt][2] * inv * siluf_(g2), on[dt][3] * inv * siluf_(g3));
                *(u32x2*)(yp + 16 * dt + 4 * rq) = w; }
        }
    }
}
__device__ __forceinline__ void attn_unit(const unsigned char* ws, LAS unsigned char* lds, int b, int h, int s, int wave, int lane) {
    const bf16* proj = (const bf16*)(ws + WS_PROJ); bf16* ya = (bf16*)(ws + WS_YA); const float* prm = (const float*)(ws + WS_PRM);
    const bf16* base = proj + (size_t)b * SEQ * NPROJ + h * HD;
    LAS float* bias2 = (LAS float*)(lds + AT_BIAS); LAS unsigned char* vst = lds + AT_V + wave * AT_VBYTES;
    for (int idx = threadIdx.x; idx < 3 * 129; idx += NTHR) { const int g = idx / 129, j = idx - g * 129; bias2[g * 132 + j] = prm[PR_RELB + t5_bucket(j << (2 * g)) * NH + h] * LOG2E; }
    const int c = lane & 15;
#pragma unroll 1
    for (int it = 0; it < 6; ++it) {
        if ((it & 1) == 0) __syncthreads();
        const int id = 2 * wave + (it & 1), mode = it >> 1;
        int q0, stride;
        if (mode == 0) { q0 = id; stride = 16; } else if (mode == 1) { q0 = (id >> 2) + 64 * (id & 3); stride = 4; } else { q0 = 16 * id; stride = 1; }
        float m, l; f32x4 o[4];
        attn_item<false>(base, nullptr, nullptr, s + q0, stride, bias2 + (2 - mode) * 132, vst, lane, m, l, o);
        const int ql = q0 + stride * c; const size_t row = (size_t)b * SEQ + s + ql;
        attn_merge(mode, lds, ql, lane, m, l, o, proj + row * NPROJ + C_G + h * HD, ya + row * DA + h * HD);
    }
    __syncthreads();
}

constexpr int AS_SLOT = 0, AS_SLOTF = 68;
__device__ __forceinline__ void attn_sample_unit(const unsigned char* ws, const float* cache_k, const float* cache_v, LAS unsigned char* lds, int sq, int h, int wave, int lane) {
    const bf16* proj = (const bf16*)(ws + WS_PROJ); bf16* ya = (bf16*)(ws + WS_YA); const float* prm = (const float*)(ws + WS_PRM);
    const bf16* base = proj + (size_t)(MP + sq * DECS) * NPROJ + h * HD; const float* ck = cache_k + ((size_t)sq * KVB * NH + h) * HD; const float* cv = cache_v + ((size_t)sq * KVB * NH + h) * HD;
    LAS float* bias2 = (LAS float*)(lds + AT_BIAS); LAS unsigned char* vst = lds + AT_V + wave * AT_VBYTES; LAS float* slots = (LAS float*)(lds + AS_SLOT);
    for (int idx = threadIdx.x; idx < 3 * 129; idx += NTHR) { const int g = idx / 129, j = idx - g * 129; bias2[g * 132 + j] = prm[PR_RELB + t5_bucket(j << (2 * g)) * NH + h] * LOG2E; }
    __syncthreads();
    const int c = lane & 15, rq = lane >> 4;
#pragma unroll 1
    for (int id = wave; id < 13; id += NWAVES) {
        const int g = id == 0 ? 0 : (id < 5 ? 1 : 2), r = id == 0 ? 0 : (id < 5 ? id - 1 : id - 5), stride = 1 << (2 * g), nq = (DECS - r + stride - 1) / stride;
        float m, l; f32x4 o[4];
        attn_item<true>(base, ck, cv, KVB + r, stride, bias2 + g * 132, vst, lane, m, l, o);
        if (c < nq) { LAS float* sl = slots + ((r + stride * c) * 3 + g) * AS_SLOTF;
#pragma unroll
            for (int dt = 0; dt < 4; ++dt) *(LAS f32x4*)(sl + 16 * dt + 4 * rq) = o[dt];
            if (rq == 0) { sl[64] = m; sl[65] = l; } }
    }
    __syncthreads();
    { const int i = threadIdx.x >> 6, d = lane; const LAS float* s0 = slots + (i * 3) * AS_SLOTF; const LAS float* s1 = s0 + AS_SLOTF; const LAS float* s2 = s1 + AS_SLOTF;
      const float m0 = s0[64], m1 = s1[64], m2 = s2[64], M = fmaxf(m0, fmaxf(m1, m2));
      const float c0 = __builtin_amdgcn_exp2f(m0 - M), c1 = __builtin_amdgcn_exp2f(m1 - M), c2 = __builtin_amdgcn_exp2f(m2 - M);
      const float L = s0[65] * c0 + s1[65] * c1 + s2[65] * c2, O = s0[d] * c0 + s1[d] * c1 + s2[d] * c2;
      const size_t row = (size_t)MP + sq * DECS + i; const float gv = bf2f(proj[row * NPROJ + C_G + h * HD + d]);
      ya[row * DA + h * HD + d] = (bf16)f2bf(O / L * siluf_(gv)); }
    __syncthreads();
}
constexpr int SD_BM = 0, SD_CM = 17408, SD_CS = 34816, SD_ROWN = 272, SD_BWT = 52224, SD_XT = 70656, SD_ROWS = 144, SD_YP = 79872, SD_YROW = 272, SD_AR = 114688;
__device__ __forceinline__ void ssd_dtarrays(LAS float* ar, const float* dtb, size_t row, int hd, float Aneg, int lane) {
    asm volatile("" : "+v"(lane));
    const float dtv = dtb[(row + lane) * 32 + hd]; float x = dtv * Aneg * LOG2E;
#pragma unroll
    for (int o = 1; o < 64; o <<= 1) { const float y = __shfl_up(x, o); if (lane >= o) x += y; }
    const float tot = __shfl(x, 63);
    ar[lane] = x; ar[64 + lane] = dtv; ar[128 + lane] = __builtin_amdgcn_exp2f(tot - x) * dtv; ar[192 + lane] = __builtin_amdgcn_exp2f(x);
}
__device__ __forceinline__ float silu_fast(float x) { return x * __builtin_amdgcn_rcpf(1.f + __builtin_amdgcn_exp2f(-x * LOG2E)); }
template <int KIND, int RL> __device__ __forceinline__ void ssd_conv_task(const bf16* proj, const bf16* zrow  , const float* prm, LAS unsigned char* lds, size_t row0, int c0, int t0, int col  , int ch  ) {
    const LAS float* ar = (const LAS float*)(lds + SD_AR);
    float w0[4], w1[4];
#pragma unroll
    for (int tap = 0; tap < 4; ++tap) { w0[tap] = prm[PR_CONVW + tap * DCONV + col]; w1[tap] = prm[PR_CONVW + tap * DCONV + col + 1]; }
    const float b0 = prm[PR_CONVB + col], b1 = prm[PR_CONVB + col + 1];
    unsigned raw[RL + 3];
#pragma unroll
    for (int k = 0; k < RL + 3; ++k) { const int T = c0 + t0 - 3 + k; const bf16* rp = (T >= 0) ? proj + (row0 + (size_t)T) * NPROJ + C_XBC : zrow; raw[k] = *(const unsigned*)(rp + col); }
#pragma unroll
    for (int blk = 0; blk < RL / 8; ++blk) {
        float o0[8], o1[8];
#pragma unroll
        for (int tt = 0; tt < 8; ++tt) { const int t = blk * 8 + tt; float v0 = b0, v1 = b1;
#pragma unroll
            for (int tap = 0; tap < 4; ++tap) { v0 += w0[tap] * __uint_as_float(raw[t + tap] << 16); v1 += w1[tap] * __uint_as_float(raw[t + tap] & 0xffff0000u); }
            o0[tt] = silu_fast(v0); o1[tt] = silu_fast(v1); }
        const int s0 = t0 + blk * 8;
        if (KIND == 0) {
            u32x4 a, b; a.x = pk2(o0[0], o0[1]); a.y = pk2(o0[2], o0[3]); a.z = pk2(o0[4], o0[5]); a.w = pk2(o0[6], o0[7]); b.x = pk2(o1[0], o1[1]); b.y = pk2(o1[2], o1[3]); b.z = pk2(o1[4], o1[5]); b.w = pk2(o1[6], o1[7]);
            *(LAS u32x4*)(lds + SD_XT + ch * SD_ROWS + s0 * 2) = a; *(LAS u32x4*)(lds + SD_XT + (ch + 1) * SD_ROWS + s0 * 2) = b;
        } else if (KIND == 1) {
            float s0v[8], s1v[8];
#pragma unroll
            for (int tt = 0; tt < 8; ++tt) { *(LAS unsigned*)(lds + SD_BM + (s0 + tt) * SD_ROWN + ch * 2) = pk2(o0[tt], o1[tt]); const float w = ar[128 + s0 + tt]; s0v[tt] = o0[tt] * w; s1v[tt] = o1[tt] * w; }
            u32x4 a, b; a.x = pk2(s0v[0], s0v[1]); a.y = pk2(s0v[2], s0v[3]); a.z = pk2(s0v[4], s0v[5]); a.w = pk2(s0v[6], s0v[7]); b.x = pk2(s1v[0], s1v[1]); b.y = pk2(s1v[2], s1v[3]); b.z = pk2(s1v[4], s1v[5]); b.w = pk2(s1v[6], s1v[7]);
            *(LAS u32x4*)(lds + SD_BWT + ch * SD_ROWS + s0 * 2) = a; *(LAS u32x4*)(lds + SD_BWT + (ch + 1) * SD_ROWS + s0 * 2) = b;
        } else {
#pragma unroll
            for (int tt = 0; tt < 8; ++tt) { *(LAS unsigned*)(lds + SD_CM + (s0 + tt) * SD_ROWN + ch * 2) = pk2(o0[tt], o1[tt]); const float e = ar[192 + s0 + tt];
                *(LAS unsigned*)(lds + SD_CS + (s0 + tt) * SD_ROWN + ch * 2) = pk2(o0[tt] * e, o1[tt] * e); }
        }
    }
}
__device__ __forceinline__ bf16x8 cat8(s16x4 a, s16x4 b) { return (bf16x8){a[0], a[1], a[2], a[3], b[0], b[1], b[2], b[3]}; }
template <int HH> __device__ __forceinline__ void ssd_mfma_step(LAS unsigned char* lds, f32x4 (&Hacc)[4], int pt, int c, int rq, float Dk) {
    const LAS float* ar = (const LAS float*)(lds + SD_AR);
    const f32x4 as0 = *(LAS const f32x4*)(ar + 32 * HH + 4 * rq), as1 = *(LAS const f32x4*)(ar + 32 * HH + 16 + 4 * rq);
    const f32x4 dt0 = *(LAS const f32x4*)(ar + 64 + 32 * HH + 4 * rq), dt1 = *(LAS const f32x4*)(ar + 64 + 32 * HH + 16 + 4 * rq);
    int dd = c - 4 * rq; asm volatile("" : "+v"(dd));
    const int p = 16 * pt + c;
    const bf16x8 xb = cat8(*(LAS const s16x4*)(lds + SD_XT + p * SD_ROWS + (32 * HH + 4 * rq) * 2), *(LAS const s16x4*)(lds + SD_XT + p * SD_ROWS + (32 * HH + 16 + 4 * rq) * 2));
    bf16x8 hb[2];
#pragma unroll
    for (int k2 = 0; k2 < 2; ++k2) { u32x4 w; w.x = pk2(Hacc[2 * k2][0], Hacc[2 * k2][1]); w.y = pk2(Hacc[2 * k2][2], Hacc[2 * k2][3]); w.z = pk2(Hacc[2 * k2 + 1][0], Hacc[2 * k2 + 1][1]); w.w = pk2(Hacc[2 * k2 + 1][2], Hacc[2 * k2 + 1][3]); hb[k2] = __builtin_bit_cast(bf16x8, w); }
#pragma unroll
    for (int lt = 0; lt < 4; ++lt) {
        constexpr int S0 = 2 * HH, S1 = 2 * HH + 1;
        const int rel0 = lt - S0, rel1 = lt - S1;
        f32x4 y = {0.f, 0.f, 0.f, 0.f};
        if (rel0 >= 0) {
            f32x4 g0 = {0.f, 0.f, 0.f, 0.f}, g1 = {0.f, 0.f, 0.f, 0.f};
#pragma unroll
            for (int ks = 0; ks < 4; ++ks) { const bf16x8 cf = *(LAS const bf16x8*)(lds + SD_CM + (16 * lt + c) * SD_ROWN + (8 * rq + 32 * ks) * 2);
                g0 = __builtin_amdgcn_mfma_f32_16x16x32_bf16(*(LAS const bf16x8*)(lds + SD_BM + (32 * HH + c) * SD_ROWN + (8 * rq + 32 * ks) * 2), cf, g0, 0, 0, 0);
                if (rel1 >= 0) g1 = __builtin_amdgcn_mfma_f32_16x16x32_bf16(*(LAS const bf16x8*)(lds + SD_BM + (32 * HH + 16 + c) * SD_ROWN + (8 * rq + 32 * ks) * 2), cf, g1, 0, 0, 0); }
            const float acl = ar[16 * lt + c];
            float m0[4], m1[4];
#pragma unroll
            for (int j = 0; j < 4; ++j) {
                float v0 = g0[j] * __builtin_amdgcn_exp2f(fminf(acl - as0[j], 0.f)) * dt0[j];
                if (rel0 == 0) { v0 = (j <= dd) ? v0 : 0.f; v0 += (j == dd) ? Dk : 0.f; }
                m0[j] = v0;
                float v1 = 0.f;
                if (rel1 >= 0) { v1 = g1[j] * __builtin_amdgcn_exp2f(fminf(acl - as1[j], 0.f)) * dt1[j]; if (rel1 == 0) { v1 = (j <= dd) ? v1 : 0.f; v1 += (j == dd) ? Dk : 0.f; } }
                m1[j] = v1; }
            u32x4 w; w.x = pk2(m0[0], m0[1]); w.y = pk2(m0[2], m0[3]); w.z = pk2(m1[0], m1[1]); w.w = pk2(m1[2], m1[3]);
            y = __builtin_amdgcn_mfma_f32_16x16x32_bf16(__builtin_bit_cast(bf16x8, w), xb, y, 0, 0, 0);
        }
#pragma unroll
        for (int k2 = 0; k2 < 2; ++k2) { const LAS unsigned char* cp = lds + SD_CS + (16 * lt + c) * SD_ROWN + (64 * HH + 32 * k2 + 4 * rq) * 2;
            y = __builtin_amdgcn_mfma_f32_16x16x32_bf16(cat8(*(LAS const s16x4*)cp, *(LAS const s16x4*)(cp + 32)), hb[k2], y, 0, 0, 0); }
#pragma unroll
        for (int j = 0; j < 4; ++j) *(LAS float*)(lds + SD_YP + HH * (64 * SD_YROW) + (16 * lt + 4 * rq + j) * SD_YROW + p * 4) = y[j];
    }
    const float dec = __builtin_amdgcn_exp2f(ar[63]);
    bf16x8 xn[2];
#pragma unroll
    for (int k2 = 0; k2 < 2; ++k2) xn[k2] = *(LAS const bf16x8*)(lds + SD_XT + p * SD_ROWS + (8 * rq + 32 * k2) * 2);
#pragma unroll
    for (int nt = 0; nt < 4; ++nt) { Hacc[nt] = Hacc[nt] * dec;
#pragma unroll
        for (int k2 = 0; k2 < 2; ++k2) Hacc[nt] = __builtin_amdgcn_mfma_f32_16x16x32_bf16(*(LAS const bf16x8*)(lds + SD_BWT + (64 * HH + 16 * nt + c) * SD_ROWS + (8 * rq + 32 * k2) * 2), xn[k2], Hacc[nt], 0, 0, 0); }
}
__device__ __forceinline__ void ssd_mfma_unit(const unsigned char* ws, float* out, LAS unsigned char* lds, int b, int hd, int wave, int lane) {
    const bf16* proj = (const bf16*)(ws + WS_PROJ); const float* dtb = (const float*)(ws + WS_DT); const float* prm = (const float*)(ws + WS_PRM); bf16* ys = (bf16*)(ws + WS_YS); float* ssq = (float*)(ws + WS_SSQ);
    const int tid = threadIdx.x, c = lane & 15, rq = lane >> 4, pt = wave & 3, hh = wave >> 2, grp = hd >> 2;
    const size_t row0 = (size_t)b * SEQ; const bf16* zrow = (const bf16*)(ws + WS_WIN) + (size_t)NIN * DM;
    const float Aneg = -__expf(prm[PR_ALOG + hd]), Dk = prm[PR_DSKIP + hd];
    LAS float* ar = (LAS float*)(lds + SD_AR);
    f32x4 Hacc[4];
#pragma unroll
    for (int nt = 0; nt < 4; ++nt) Hacc[nt] = (f32x4){0.f, 0.f, 0.f, 0.f};
    __syncthreads();
    if (wave == 7) ssd_dtarrays(ar, dtb, row0, hd, Aneg, lane);
    __syncthreads();
#pragma unroll 1
    for (int c0 = 0; c0 < SEQ; c0 += 64) {
#pragma unroll 1
        for (int task = tid; task < 640; task += NTHR) {
            const int tk = __builtin_amdgcn_readfirstlane(task >> 6);
            if (tk < 2) { const int pair = task & 31, run = task >> 5; ssd_conv_task<0, 16>(proj, zrow, prm, lds, row0, c0, 16 * run, hd * 64 + 2 * pair, 2 * pair); }
            else if (tk < 6) { const int t2 = task - 128, pair = t2 & 63, run = t2 >> 6; ssd_conv_task<1, 16>(proj, zrow, prm, lds, row0, c0, 16 * run, DSSM + grp * DST + 2 * pair, 2 * pair); }
            else { const int t2 = task - 384, pair = t2 & 63, run = t2 >> 6; ssd_conv_task<2, 16>(proj, zrow, prm, lds, row0, c0, 16 * run, DSSM + NGRP * DST + grp * DST + 2 * pair, 2 * pair); }
        }
        __syncthreads();
        if (hh == 0) ssd_mfma_step<0>(lds, Hacc, pt, c, rq, Dk); else ssd_mfma_step<1>(lds, Hacc, pt, c, rq, Dk);
        __syncthreads();
        {
            const int l = tid >> 3, p0 = (tid & 7) * 8; const size_t row = row0 + c0 + l;
            const LAS float* y0 = (const LAS float*)(lds + SD_YP + l * SD_YROW + p0 * 4); const LAS float* y1 = (const LAS float*)(lds + SD_YP + 64 * SD_YROW + l * SD_YROW + p0 * 4);
            const f32x4 a0 = *(const LAS f32x4*)y0 + *(const LAS f32x4*)y1, a1 = *(const LAS f32x4*)(y0 + 4) + *(const LAS f32x4*)(y1 + 4);
            const u32x4 z = *(const u32x4*)(proj + row * NPROJ + C_Z + hd * 64 + p0);
            float v[8];
            v[0] = a0[0] * silu_fast(__uint_as_float(z.x << 16)); v[1] = a0[1] * silu_fast(__uint_as_float(z.x & 0xffff0000u)); v[2] = a0[2] * silu_fast(__uint_as_float(z.y << 16)); v[3] = a0[3] * silu_fast(__uint_as_float(z.y & 0xffff0000u));
            v[4] = a1[0] * silu_fast(__uint_as_float(z.z << 16)); v[5] = a1[1] * silu_fast(__uint_as_float(z.z & 0xffff0000u)); v[6] = a1[2] * silu_fast(__uint_as_float(z.w << 16)); v[7] = a1[3] * silu_fast(__uint_as_float(z.w & 0xffff0000u));
            u32x4 w; w.x = pk2(v[0], v[1]); w.y = pk2(v[2], v[3]); w.z = pk2(v[4], v[5]); w.w = pk2(v[6], v[7]);
            *(u32x4*)(ys + row * DSSM + hd * 64 + p0) = w;
            float ss = (v[0] * v[0] + v[1] * v[1]) + (v[2] * v[2] + v[3] * v[3]) + (v[4] * v[4] + v[5] * v[5]) + (v[6] * v[6] + v[7] * v[7]);
            ss += __shfl_xor(ss, 1); ss += __shfl_xor(ss, 2); ss += __shfl_xor(ss, 4);
            if ((tid & 7) == 0) ssq[row * NSH + hd] = ss;
            if (wave == 7 && c0 + 64 < SEQ) ssd_dtarrays(ar, dtb, row0 + c0 + 64, hd, Aneg, lane);
        }
        __syncthreads();
    }
    float* dst = out + O_SP + ((size_t)(b * NSH + hd) * SHD + 16 * pt + c) * DST + 64 * hh + 4 * rq;
#pragma unroll
    for (int nt = 0; nt < 4; ++nt) *(f32x4*)(dst + 16 * nt) = Hacc[nt];
}
__device__ __forceinline__ void p0_transpose_item(const float* W, int K, int N, bf16* WT, int k0, int n0, int dst_row0, const float* kscale, LAS float* scr, int lane) {
#pragma unroll 8
    for (int i = 0; i < 32; ++i) { const int kk = 2 * i + (lane >> 5); float v = W[(size_t)(k0 + kk) * N + n0 + (lane & 31)]; if (kscale) v *= kscale[k0 + kk]; scr[kk * 33 + (lane & 31)] = v; }
    LDS_WAIT(); asm volatile("" ::: "memory");
    const int c = lane & 7;
#pragma unroll
    for (int j = 0; j < 4; ++j) { const int n = (lane >> 3) + 8 * j; const LAS float* s = scr + (8 * c) * 33 + n;
        u32x4 o; o.x = pk2(s[0 * 33], s[1 * 33]); o.y = pk2(s[2 * 33], s[3 * 33]); o.z = pk2(s[4 * 33], s[5 * 33]); o.w = pk2(s[6 * 33], s[7 * 33]);
        *(u32x4*)(WT + (size_t)(dst_row0 + n) * K + k0 + 8 * c) = o; }
    LDS_WAIT(); asm volatile("" ::: "memory");
}
__device__ __forceinline__ void p0_prologue(const Args& a, LAS unsigned char* lds, int gw, int NGW, int wave, int lane) {
    bf16* win_t = (bf16*)(a.ws + WS_WIN); bf16* wa_t = (bf16*)(a.ws + WS_WA); bf16* wb_t = (bf16*)(a.ws + WS_WB); bf16* wo_t = (bf16*)(a.ws + WS_WO); bf16* hb = (bf16*)(a.ws + WS_HB);
    LAS float* scr = (LAS float*)(lds + wave * 16384);
    constexpr int I_IN = (DM / 64) * (NIN / 32), I_A = (DA / 64) * (DM / 32), I_B = (DSSM / 64) * (DM / 32), I_O = (DM / 64) * (DM / 32);
    for (int it = gw; it < I_IN + I_A + I_B + I_O; it += NGW) {
        int r = it;
        if (r < I_IN) { const int nblk = NIN / 32, kb = r / nblk, nb = r % nblk, n0 = nb * 32; const int dst = (n0 < 9216) ? n0 : (n0 == 9216 ? 11264 : n0 - 32);
            p0_transpose_item(a.w_in, DM, NIN, win_t, kb * 64, n0, dst, nullptr, scr, lane); continue; } r -= I_IN;
        if (r < I_A) { const int nblk = DM / 32, kb = r / nblk, nb = r % nblk; p0_transpose_item(a.w_a, DA, DM, wa_t, kb * 64, nb * 32, nb * 32, nullptr, scr, lane); continue; } r -= I_A;
        if (r < I_B) { const int nblk = DM / 32, kb = r / nblk, nb = r % nblk; p0_transpose_item(a.w_b, DSSM, DM, wb_t, kb * 64, nb * 32, nb * 32, a.ssm_norm, scr, lane); continue; } r -= I_B;
        { const int nblk = DM / 32, kb = r / nblk, nb = r % nblk; p0_transpose_item(a.w_out, DM, DM, wo_t, kb * 64, nb * 32, nb * 32, nullptr, scr, lane); }
    }
    { float* prm = (float*)(a.ws + WS_PRM); const int gt = gw * 64 + lane, NGT = NGW * 64;
      for (int i = gt; i < PR_END; i += NGT) { float v = 0.f;
          if (i < PR_CONVB) v = a.conv_w[i]; else if (i < PR_DTB) v = a.conv_b[i - PR_CONVB]; else if (i < PR_ALOG) v = a.dt_bias[i - PR_DTB]; else if (i < PR_DSKIP) v = a.a_log[i - PR_ALOG];
          else if (i < PR_RELB) v = a.d_skip[i - PR_DSKIP]; else if (i < PR_RELB + 384) v = a.rel_bias[i - PR_RELB]; else if (i >= PR_FNORM) v = a.final_norm[i - PR_FNORM];
          prm[i] = v; } }
    { u32x4* z = (u32x4*)(win_t + (size_t)11296 * DM); const int n16 = 224 * DM * 2 / 16; for (int i = gw * 64 + lane; i < n16; i += NGW * 64) z[i] = (u32x4){0u, 0u, 0u, 0u}; }
    for (int m = gw; m < MT; m += NGW) {
        const float* xrow = (m < MP) ? a.x_prompt + (size_t)m * DM : a.x_sample + (size_t)(m - MP) * DM;
        const f32x4* xr = (const f32x4*)xrow + lane; const f32x4* gr = (const f32x4*)a.norm_g + lane;
        f32x4 v[4]; float s = 0.f;
#pragma unroll
        for (int j = 0; j < 4; ++j) { v[j] = xr[64 * j]; s += (v[j].x * v[j].x + v[j].y * v[j].y) + (v[j].z * v[j].z + v[j].w * v[j].w); }
        const float rstd = rsqrtf(wave_sum(s) * (1.f / DM) + 1e-6f);
        unsigned long long* o8 = (unsigned long long*)(hb + (size_t)m * DM) + lane;
#pragma unroll
        for (int j = 0; j < 4; ++j) { const f32x4 g = gr[64 * j]; o8[64 * j] = (unsigned long long)pk2(v[j].x * rstd * g.x, v[j].y * rstd * g.y) | ((unsigned long long)pk2(v[j].z * rstd * g.z, v[j].w * rstd * g.w) << 32); }
    }
}

template <bool SAMP> __device__ __forceinline__ const void* kv_ptr(const Args& a, const bf16* proj, int colkv, const float* cache, int seq, int tpos, int off, int h, bool& valid, bool& isf32) {
    if (!SAMP) { const int kt = tpos - off; valid = kt >= 0; isf32 = false; return proj + (size_t)(seq * SEQ + (valid ? kt : 0)) * NPROJ + colkv + h * HD; }
    const int idx = KVB + tpos - off; valid = true;
    if (idx >= KVB) { isf32 = false; return proj + (size_t)(MP + seq * DECS + (idx - KVB)) * NPROJ + colkv + h * HD; }
    isf32 = true; return cache + ((size_t)(seq * KVB + idx) * NH + h) * HD;
}
template <bool SAMP> __device__ __forceinline__ void attn_slow_item(const Args& a, const bf16* proj, bf16* ya, LAS float* sl, int row, int h, int lane) {
    const float* prm = (const float*)(a.ws + WS_PRM);
    const int seq = SAMP ? (row - MP) / DECS : row / SEQ, tpos = SAMP ? (row - MP) % DECS : row % SEQ;
    float q[64];
    { const u32x4* qp = (const u32x4*)(proj + (size_t)row * NPROJ + C_Q + h * HD);
#pragma unroll
      for (int i = 0; i < 8; ++i) { const u32x4 w = qp[i]; q[8 * i + 0] = __uint_as_float(w.x << 16); q[8 * i + 1] = __uint_as_float(w.x & 0xffff0000u); q[8 * i + 2] = __uint_as_float(w.y << 16); q[8 * i + 3] = __uint_as_float(w.y & 0xffff0000u);
          q[8 * i + 4] = __uint_as_float(w.z << 16); q[8 * i + 5] = __uint_as_float(w.z & 0xffff0000u); q[8 * i + 6] = __uint_as_float(w.w << 16); q[8 * i + 7] = __uint_as_float(w.w & 0xffff0000u); } }
    float mx = -INFINITY;
#pragma unroll 1
    for (int e = lane; e < 387; e += 64) {
        float sc = -INFINITY;
        const int g = e / 129, j = e - g * 129, off = j << (2 * g); bool valid, isf32;
        const void* kp = kv_ptr<SAMP>(a, proj, C_K, a.cache_k, seq, tpos, off, h, valid, isf32);
        if (valid) { float d = 0.f;
            if (isf32) { const f32x4* k4 = (const f32x4*)kp;
#pragma unroll
                for (int i = 0; i < 16; ++i) { const f32x4 kk = k4[i]; d += q[4 * i] * kk.x + q[4 * i + 1] * kk.y + q[4 * i + 2] * kk.z + q[4 * i + 3] * kk.w; } }
            else { const u32x4* k4 = (const u32x4*)kp;
#pragma unroll
                for (int i = 0; i < 8; ++i) { const u32x4 w = k4[i];
                    d += q[8 * i + 0] * __uint_as_float(w.x << 16) + q[8 * i + 1] * __uint_as_float(w.x & 0xffff0000u) + q[8 * i + 2] * __uint_as_float(w.y << 16) + q[8 * i + 3] * __uint_as_float(w.y & 0xffff0000u)
                       + q[8 * i + 4] * __uint_as_float(w.z << 16) + q[8 * i + 5] * __uint_as_float(w.z & 0xffff0000u) + q[8 * i + 6] * __uint_as_float(w.w << 16) + q[8 * i + 7] * __uint_as_float(w.w & 0xffff0000u); } }
            sc = d * 0.125f + prm[PR_RELB + t5_bucket(off) * NH + h]; }
        sl[e] = sc; mx = fmaxf(mx, sc);
    }
    mx = wave_max(mx);
    float sum = 0.f;
#pragma unroll 1
    for (int e = lane; e < 387; e += 64) { const float sc = sl[e]; const float pe = (sc == -INFINITY) ? 0.f : __expf(sc - mx); sl[e] = pe; sum += pe; }
    sum = wave_sum(sum);
    LDS_WAIT(); asm volatile("" ::: "memory");
    float o = 0.f;
#pragma unroll 4
    for (int e = 0; e < 387; ++e) {
        const int g = e / 129, j = e - g * 129, off = j << (2 * g); bool valid, isf32;
        const void* vp = kv_ptr<SAMP>(a, proj, C_V, a.cache_v, seq, tpos, off, h, valid, isf32);
        const float pe = sl[e];
        if (valid) { const float vv = isf32 ? ((const float*)vp)[lane] : bf2f(((const bf16*)vp)[lane]); o += pe * vv; }
    }
    LDS_WAIT(); asm volatile("" ::: "memory");
    const float gv = bf2f(proj[(size_t)row * NPROJ + C_G + h * HD + lane]);
    ya[(size_t)row * DA + h * HD + lane] = (bf16)f2bf(o / sum * siluf_(gv));
}

__device__ __forceinline__ void ssd_slow_item(const Args& a, LAS unsigned char* lds, int item) {
    const bf16* proj = (const bf16*)(a.ws + WS_PROJ); const float* dtb = (const float*)(a.ws + WS_DT); bf16* ys = (bf16*)(a.ws + WS_YS); float* ssq = (float*)(a.ws + WS_SSQ);
    const int tid = threadIdx.x, lane = tid & 63, wid = tid >> 6;
    const bool samp = item >= NBATCH * NSH; const int it2 = samp ? item - NBATCH * NSH : item; const int sq = it2 / NSH, hd = it2 % NSH, grp = hd / 4;
    const int L = samp ? DECS : SEQ, row0 = samp ? MP + sq * DECS : sq * SEQ;
    const int p = tid >> 3, n0 = (tid & 7) * 16;
    float h[16];
    if (samp) { const f32x4* s4 = (const f32x4*)(a.state_ssm + ((size_t)(sq * NSH + hd) * SHD + p) * DST + n0);
#pragma unroll
        for (int j = 0; j < 4; ++j) { const f32x4 v = s4[j]; h[4 * j] = v.x; h[4 * j + 1] = v.y; h[4 * j + 2] = v.z; h[4 * j + 3] = v.w; } }
    else {
#pragma unroll
        for (int j = 0; j < 16; ++j) h[j] = 0.f; }
    const float* prm = (const float*)(a.ws + WS_PRM);
    const float Aneg = -__expf(prm[PR_ALOG + hd]), Dk = prm[PR_DSKIP + hd];
    LAS float* xs = (LAS float*)lds;
    LAS float* Bs = xs + 64 * 64;
    LAS float* Cs = Bs + 64 * 128;
    LAS float* dts = Cs + 64 * 128;
    LAS float* dAs = dts + 64;
    LAS float* yb = dAs + 64;
    for (int c0 = 0; c0 < L; c0 += 64) {
        const int tc = (L - c0) < 64 ? (L - c0) : 64;
        for (int idx = tid; idx < tc * 320; idx += NTHR) {
            const int t = idx / 320, c = idx - t * 320;
            const int xc = c < 64 ? hd * 64 + c : (c < 192 ? DSSM + grp * DST + (c - 64) : DSSM + NGRP * DST + grp * DST + (c - 192));
            float acc = prm[PR_CONVB + xc];
#pragma unroll
            for (int tap = 0; tap < 4; ++tap) { const int tt = c0 + t - 3 + tap; float v;
                if (tt >= 0) v = bf2f(proj[(size_t)(row0 + tt) * NPROJ + C_XBC + xc]);
                else v = samp ? a.state_conv[(size_t)(sq * 3 + 3 + tt) * DCONV + xc] : 0.f;
                acc += prm[PR_CONVW + tap * DCONV + xc] * v; }
            const float val = siluf_(acc);
            if (c < 64) xs[t * 64 + c] = val; else if (c < 192) Bs[t * 128 + (c - 64)] = val; else Cs[t * 128 + (c - 192)] = val;
        }
        if (tid < tc) { const float dtv = dtb[(size_t)(row0 + c0 + tid) * 32 + hd]; dts[tid] = dtv; dAs[tid] = __expf(dtv * Aneg); }
        __syncthreads();
        for (int t = 0; t < tc; ++t) {
            const float dA = dAs[t], xv = xs[t * 64 + p], dtx = dts[t] * xv; float acc = 0.f;
            const LAS f32x4* b4 = (const LAS f32x4*)(Bs + t * 128 + n0); const LAS f32x4* c4 = (const LAS f32x4*)(Cs + t * 128 + n0);
#pragma unroll
            for (int j = 0; j < 4; ++j) { const f32x4 bb = b4[j], cc = c4[j];
                h[4 * j] = dA * h[4 * j] + dtx * bb.x; h[4 * j + 1] = dA * h[4 * j + 1] + dtx * bb.y; h[4 * j + 2] = dA * h[4 * j + 2] + dtx * bb.z; h[4 * j + 3] = dA * h[4 * j + 3] + dtx * bb.w;
                acc += h[4 * j] * cc.x + h[4 * j + 1] * cc.y + h[4 * j + 2] * cc.z + h[4 * j + 3] * cc.w; }
            acc += __shfl_xor(acc, 1); acc += __shfl_xor(acc, 2); acc += __shfl_xor(acc, 4);
            if ((tid & 7) == 0) yb[t * 64 + p] = acc + Dk * xv;
        }
        __syncthreads();
        for (int t = wid; t < tc; t += NWAVES) {
            const int row = row0 + c0 + t; const float z = bf2f(proj[(size_t)row * NPROJ + C_Z + hd * 64 + lane]);
            const float val = yb[t * 64 + lane] * siluf_(z);
            ys[(size_t)row * DSSM + hd * 64 + lane] = (bf16)f2bf(val);
            const float ss = wave_sum(val * val); if (lane == 0) ssq[(size_t)row * NSH + hd] = ss;
        }
        __syncthreads();
    }
    float* dst = a.out + (samp ? O_SS : O_SP) + ((size_t)(sq * NSH + hd) * SHD + p) * DST + n0;
#pragma unroll
    for (int j = 0; j < 4; ++j) ((f32x4*)dst)[j] = (f32x4){h[4 * j], h[4 * j + 1], h[4 * j + 2], h[4 * j + 3]};
}

__device__ __forceinline__ void p2_ssd_prompt(const Args& a, LAS unsigned char* lds, int G, int wave, int lane) {
    for (int item = blockIdx.x; item < NBATCH * NSH; item += G) ssd_mfma_unit(a.ws, a.out, lds, item / NSH, item % NSH, wave, lane);
}
__device__ __forceinline__ void p2_ssd_sample(const Args& a, LAS unsigned char* lds, int G) {
    for (int item = NBATCH * NSH + blockIdx.x; item < NBATCH * NSH + DECB * NSH; item += G) ssd_slow_item(a, lds, item);
}
__device__ __forceinline__ void p2_attn_prompt(const Args& a, LAS unsigned char* lds, int G, int wave, int lane) {
    for (int k = 0; ; ++k) { const int v = (G == 256) ? (k < 3 ? (int)((blockIdx.x % 8) * 96 + (blockIdx.x / 8) + 32 * k) : 768) : (int)(blockIdx.x + k * G); if (v >= 768) break;
        const int bh = v >> 3, sb = v & 7; attn_unit(a.ws, lds, bh / NH, bh % NH, sb * 256, wave, lane); }
}
__device__ __forceinline__ void p2_attn_sample(const Args& a, LAS unsigned char* lds, int G, int wave, int lane) {
    const bf16* proj = (const bf16*)(a.ws + WS_PROJ);
    for (int u = blockIdx.x; u < DECB * NH; u += G) attn_sample_unit(a.ws, a.cache_k, a.cache_v, lds, u / NH, u % NH, wave, lane);
    const int gt = blockIdx.x * NTHR + threadIdx.x, NGT = G * NTHR;
    for (int i = gt; i < (NBATCH + DECB) * 3 * DCONV; i += NGT) { const int c = i % DCONV, r = (i / DCONV) % 3, sq = i / (3 * DCONV);
        if (sq < NBATCH) a.out[O_CP + (size_t)(sq * 3 + r) * DCONV + c] = bf2f(proj[(size_t)(sq * SEQ + SEQ - 3 + r) * NPROJ + C_XBC + c]);
        else { const int s2 = sq - NBATCH; a.out[O_CS + (size_t)(s2 * 3 + r) * DCONV + c] = bf2f(proj[(size_t)(MP + s2 * DECS + DECS - 3 + r) * NPROJ + C_XBC + c]); } }
}
__device__ __forceinline__ void p25_norm(const Args& a, int gw, int NGW, int lane) {
    bf16* ys = (bf16*)(a.ws + WS_YS); const float* ssq = (const float*)(a.ws + WS_SSQ);
    for (int m = gw; m < MT; m += NGW) {
        const float sv = (lane < 32) ? ssq[(size_t)m * NSH + lane] : 0.f;
        float gs = sv + __shfl_xor(sv, 1); gs += __shfl_xor(gs, 2);
        const float rstd = rsqrtf(gs * (1.f / 256.f) + 1e-5f);
        u32x4* r4 = (u32x4*)(ys + (size_t)m * DSSM);
#pragma unroll
        for (int j = 0; j < 4; ++j) { const int ci = j * 64 + lane, g = ci >> 5; const float sc = __shfl(rstd, 4 * g); u32x4 w = r4[ci];
            w.x = pk2(__uint_as_float(w.x << 16) * sc, __uint_as_float(w.x & 0xffff0000u) * sc); w.y = pk2(__uint_as_float(w.y << 16) * sc, __uint_as_float(w.y & 0xffff0000u) * sc);
            w.z = pk2(__uint_as_float(w.z << 16) * sc, __uint_as_float(w.z & 0xffff0000u) * sc); w.w = pk2(__uint_as_float(w.w << 16) * sc, __uint_as_float(w.w & 0xffff0000u) * sc); r4[ci] = w; }
    }
}
__device__ __forceinline__ void p5_final_norm(const Args& a, int gw, int NGW, int lane) {
    for (int m = gw; m < MT; m += NGW) {
        f32x4* xr = (f32x4*)(a.out + (size_t)m * DM) + lane; const f32x4* gr = (const f32x4*)((const float*)(a.ws + WS_PRM) + PR_FNORM) + lane;
        f32x4 v[4]; float s = 0.f;
#pragma unroll
        for (int j = 0; j < 4; ++j) { v[j] = xr[64 * j]; s += (v[j].x * v[j].x + v[j].y * v[j].y) + (v[j].z * v[j].z + v[j].w * v[j].w); }
        const float rstd = rsqrtf(wave_sum(s) * (1.f / DM) + 1e-6f);
#pragma unroll
        for (int j = 0; j < 4; ++j) { const f32x4 g = gr[64 * j]; xr[64 * j] = v[j] * rstd * g; }
    }
}
#define GEMM_PHASE(EpiT, Aptr, Bptr, Mrows, Ncols, Kdim, Eobj) do { pg8::Gemm g_{(const pg8::bf16_t*)(Aptr), (const pg8::bf16_t*)(Bptr), (Mrows), (Ncols), (Kdim)}; pg8::StaticOrder S_; S_.init((Mrows), (Ncols), G, (int)blockIdx.x); \
    pg8::gemm_phase<EpiT, pg8::StaticOrder, true, true>(lds, g_, S_, (Eobj)); } while (0)

constexpr int NPHASE = 10;
__global__ void __launch_bounds__(NTHR, 2) fwd_megakernel(Args a) {
    extern __shared__ __attribute__((aligned(16))) unsigned char lds_raw[];
    LAS unsigned char* lds = (LAS unsigned char*)lds_raw;
    cg::grid_group grid = cg::this_grid();
    const int tid = threadIdx.x, lane = tid & 63, wave = __builtin_amdgcn_readfirstlane(tid >> 6);
    const int G = gridDim.x, gw = blockIdx.x * NWAVES + wave, NGW = G * NWAVES;
    unsigned char* ws = a.ws;

#define IN(k) (a.ph_lo <= (k) && (k) < a.ph_hi)
#define SEAM(k) do { if (IN(k) && IN((k) + 1)) grid.sync(); } while (0)
    if (IN(0)) {
        p0_prologue(a, lds, gw, NGW, wave, lane);
        if (blockIdx.x == 0 && tid == 0) { const float** pp = (const float**)(ws + WS_ARGS); pp[0] = a.x_prompt; pp[1] = a.x_sample; pp[2] = a.cache_k; pp[3] = a.cache_v; pp[4] = a.state_conv; pp[5] = a.state_ssm; }
    }
    SEAM(0);
    if (IN(1)) { pg8::EpiInProj E{(pg8::bf16_t*)(ws + WS_PROJ), (float*)(ws + WS_DT), (const float*)(ws + WS_PRM) + PR_DTB, a.out + O_KP, a.out + O_VP, a.out + O_KS, a.out + O_VS};
      GEMM_PHASE(pg8::EpiInProj, ws + WS_HB, ws + WS_WIN, MT, NPAD, DM, E); }
    SEAM(1);
    if (IN(2)) { Args b{}; b.ws = ws; b.out = a.out; p2_ssd_prompt(b, lds, G, wave, lane); }
    if (IN(3)) { Args b{}; b.ws = ws; b.out = a.out; b.state_conv = ld_ptr(ws, 4); b.state_ssm = ld_ptr(ws, 5); p2_ssd_sample(b, lds, G); }
    if (IN(4)) { Args b{}; b.ws = ws; b.out = a.out; p2_attn_prompt(b, lds, G, wave, lane); }
    if (IN(5)) { Args b{}; b.ws = ws; b.out = a.out; b.cache_k = ld_ptr(ws, 2); b.cache_v = ld_ptr(ws, 3); p2_attn_sample(b, lds, G, wave, lane); }
    SEAM(5);
    if (IN(6)) p25_norm(a, gw, NGW, lane);
    SEAM(6);
    if (IN(7)) {
    { pg8::EpiGateA E{(const pg8::bf16_t*)(ws + WS_PROJ), (float*)(ws + WS_TMP)}; GEMM_PHASE(pg8::EpiGateA, ws + WS_YA, ws + WS_WA, MT, DM, DA, E); }
    { pg8::EpiGateB E{(const pg8::bf16_t*)(ws + WS_PROJ), (const float*)(ws + WS_TMP), (pg8::bf16_t*)(ws + WS_MRG)}; GEMM_PHASE(pg8::EpiGateB, ws + WS_YS, ws + WS_WB, MT, DM, DSSM, E); }
    }
    SEAM(7);
    if (IN(8)) { pg8::EpiOut E{ld_ptr(ws, 0), ld_ptr(ws, 1), a.out + O_YP}; GEMM_PHASE(pg8::EpiOut, ws + WS_MRG, ws + WS_WO, MT, DM, DM, E); }
    SEAM(8);
    if (IN(9)) p5_final_norm(a, gw, NGW, lane);
#undef IN
#undef SEAM
}

extern "C" void kernel_launch(void* const* d_in, const int* in_sizes, int n_in, void* d_out, int out_size, void* d_ws, size_t ws_size, hipStream_t stream) {
    static int grid_blocks = 0;
    if (grid_blocks == 0) {
        if (n_in != 19 || (size_t)out_size != O_END || ws_size < WS_END) { fprintf(stderr, "kernel_launch: unexpected shapes: n_in %d out %d (want %zu) ws %zu (want >= %zu)\n", n_in, out_size, (size_t)O_END, ws_size, (size_t)WS_END); grid_blocks = -1; return; }
        int dev = 0, cus = 0, per_cu = 0;
        hipGetDevice(&dev); hipDeviceGetAttribute(&cus, hipDeviceAttributeMultiprocessorCount, dev);
        if (hipFuncSetAttribute((const void*)fwd_megakernel, hipFuncAttributeMaxDynamicSharedMemorySize, LDS_BYTES) != hipSuccess) { fprintf(stderr, "kernel_launch: hipFuncSetAttribute failed\n"); grid_blocks = -1; return; }
        if (hipOccupancyMaxActiveBlocksPerMultiprocessor(&per_cu, (const void*)fwd_megakernel, NTHR, LDS_BYTES) != hipSuccess || per_cu < 1) { fprintf(stderr, "kernel_launch: occupancy query failed (%d)\n", per_cu); (void)hipGetLastError(); per_cu = 1; }
        if (per_cu > 1) per_cu = 1;
        grid_blocks = cus * per_cu;
        fprintf(stderr, "kernel_launch: grid %d (cus %d)\n", grid_blocks, cus);
    }
    if (grid_blocks < 0) return;
    Args a{};
    a.x_prompt = (const float*)d_in[0]; a.x_sample = (const float*)d_in[1]; a.cache_k = (const float*)d_in[2]; a.cache_v = (const float*)d_in[3]; a.state_conv = (const float*)d_in[4]; a.state_ssm = (const float*)d_in[5];
    a.norm_g = (const float*)d_in[6]; a.w_in = (const float*)d_in[7]; a.conv_w = (const float*)d_in[8]; a.conv_b = (const float*)d_in[9]; a.dt_bias = (const float*)d_in[10]; a.a_log = (const float*)d_in[11];
    a.d_skip = (const float*)d_in[12]; a.ssm_norm = (const float*)d_in[13]; a.w_a = (const float*)d_in[14]; a.w_b = (const float*)d_in[15]; a.w_out = (const float*)d_in[16]; a.rel_bias = (const float*)d_in[17]; a.final_norm = (const float*)d_in[18];
    a.out = (float*)d_out; a.ws = (unsigned char*)d_ws;
#ifndef PROBE_LO
    const int ranges[1][2] = {{0, NPHASE}}; const int nr = 1;
#else
    const int ranges[2][2] = {{0, NPHASE}, {PROBE_LO, PROBE_HI}}; const int nr = 2;
#endif
    for (int r = 0; r < nr; ++r) {
        a.ph_lo = ranges[r][0]; a.ph_hi = ranges[r][1];
        void* args[] = {&a};
        hipError_t e = hipLaunchCooperativeKernel((const void*)fwd_megakernel, dim3(grid_blocks), dim3(NTHR), args, LDS_BYTES, stream);
        if (e != hipSuccess) fprintf(stderr, "kernel_launch: cooperative launch failed: %s (grid %d)\n", hipGetErrorString(e), grid_blocks);
    }
}
```

```cpp
#include <hip/hip_runtime.h>
#include <hip/hip_cooperative_groups.h>
#include <cstdio>
#include <cstdint>
namespace cg = cooperative_groups;
namespace pg8 {
#define PG8_LAS __attribute__((address_space(3)))
typedef unsigned short bf16_t;
typedef short bf16x8 __attribute__((ext_vector_type(8)));
typedef float f32x4 __attribute__((ext_vector_type(4)));
typedef unsigned u32x4 __attribute__((ext_vector_type(4)));
constexpr int BM = 256, BK = 64, HALF = 128, HTB = HALF * BK * 2  , STAGE_BYTES = 8 * HTB, NXCD = 8, WGM = 8;

__host__ __device__ __forceinline__ int lds_byte(int r, int c) { const int st = (r >> 4) * 2 + (c >> 5), rr = r & 15, cc = c & 31, ob = rr * 64 + cc * 2; return st * 1024 + (ob ^ (((ob >> 9) & 1) << 5)); }
__host__ __device__ __forceinline__ void stage_rc(int b, int& R, int& C) { const int st = b / 1024, sb = b % 1024, swz = sb ^ (((sb >> 9) & 1) << 5); R = (st >> 1) * 16 + swz / 64; C = (st & 1) * 32 + (swz % 64) / 2; }
__host__ __device__ __forceinline__ int perm32(int rho) { const int n = rho >> 4, i = rho & 15; return 8 * (i >> 2) + 4 * n + (i & 3); }

struct Unit { int pm, pn; };
struct Gemm { const bf16_t* A; const bf16_t* Bt; int M, N, K; };

struct StaticOrder {
    int nM, nN, nwg, G, c;
    __host__ __device__ void init(int M, int N, int G_, int c_) { nM = M / BM; nN = N / BM; nwg = nM * nN; G = G_; c = c_; }
    __host__ __device__ bool next(int i, Unit& u) const {
        const long L = (long)i * G + c; if (L >= nwg) return false;
        int wgid = (int)L; { const int q = nwg / NXCD, r = nwg % NXCD, xcd = wgid % NXCD, off = wgid / NXCD; wgid = (xcd < r ? xcd * (q + 1) : r * (q + 1) + (xcd - r) * q) + off; }
        const int nig = WGM * nN, gid = wgid / nig, fm = gid * WGM, gsz = (nM - fm) < WGM ? (nM - fm) : WGM;
        u.pm = fm + ((wgid % nig) % gsz); u.pn = (wgid % nig) / gsz; return true;
    }
    __device__ __forceinline__ void a_ready(const Unit&) const {}
    __device__ __forceinline__ void done(const Unit&) const {}
};

__device__ __forceinline__ unsigned cvt_pk_bf16(float lo, float hi) { unsigned r; asm volatile("v_cvt_pk_bf16_f32 %0, %1, %2" : "=v"(r) : "v"(lo), "v"(hi)); return r; }
__device__ __forceinline__ float e_bf2f(unsigned short b) { return __uint_as_float(((unsigned)b) << 16); }
__device__ __forceinline__ float e_sigmoid(float x) { return 1.f / (1.f + __expf(-x)); }
__device__ __forceinline__ float e_softplus(float x) { return fmaxf(x, 0.f) + log1pf(__expf(-fabsf(x))); }

struct EpiInProj {
    static constexpr bool PERM = true, AFTER_DRAIN = false;
    bf16_t* proj; float* dt; const float* dt_bias; float* kp; float* vp; float* ks; float* vs;
    __device__ __forceinline__ void operator()(const f32x4 (&acc)[2][2][4][2], const Unit& u, int wr, int wc, int fr, int fq) const {
        const int row0 = u.pm * BM + wr * 64 + fr;
        if (u.pn < 44) {
            const int col0 = u.pn * BM + wc * 32 + 8 * fq;
            const bool isk = (u.pn >= 3 && u.pn < 6), isv = (u.pn >= 6 && u.pn < 9);
#pragma unroll
            for (int ai = 0; ai < 2; ++ai)
#pragma unroll
                for (int m = 0; m < 4; ++m) { const int row = row0 + ai * HALF + m * 16; bf16_t* rowp = proj + (size_t)row * 11264 + col0;
#pragma unroll
                    for (int bj = 0; bj < 2; ++bj) { const f32x4 v0 = acc[ai][bj][m][0], v1 = acc[ai][bj][m][1];
                        u32x4 w; w.x = cvt_pk_bf16(v0[0], v0[1]); w.y = cvt_pk_bf16(v0[2], v0[3]); w.z = cvt_pk_bf16(v1[0], v1[1]); w.w = cvt_pk_bf16(v1[2], v1[3]);
                        *(u32x4*)(rowp + bj * HALF) = w;
                        if (isk || isv) { const int c = col0 + bj * HALF - (isk ? 768 : 1536);
                            float* dst = (u.pm < 64) ? ((isk ? kp : vp) + (size_t)row * 768 + c) : ((isk ? ks : vs) + (size_t)(row - 16384) * 768 + c);
                            *(f32x4*)dst = v0; *(f32x4*)(dst + 4) = v1; } } }
        } else if (wc == 0) {
            const f32x4 b0 = *(const f32x4*)(dt_bias + 8 * fq), b1 = *(const f32x4*)(dt_bias + 8 * fq + 4);
#pragma unroll
            for (int ai = 0; ai < 2; ++ai)
#pragma unroll
                for (int m = 0; m < 4; ++m) { const int row = row0 + ai * HALF + m * 16; const f32x4 v0 = acc[ai][0][m][0] + b0, v1 = acc[ai][0][m][1] + b1;
                    f32x4 o0, o1;
#pragma unroll
                    for (int j = 0; j < 4; ++j) { o0[j] = e_softplus(v0[j]); o1[j] = e_softplus(v1[j]); }
                    float* dst = dt + (size_t)row * 32 + 8 * fq; *(f32x4*)dst = o0; *(f32x4*)(dst + 4) = o1; }
        }
    }
};
struct EpiGateA {
    static constexpr bool PERM = true, AFTER_DRAIN = false;
    const bf16_t* proj; float* tmp;
    __device__ __forceinline__ void operator()(const f32x4 (&acc)[2][2][4][2], const Unit& u, int wr, int wc, int fr, int fq) const {
        const int row0 = u.pm * BM + wr * 64 + fr, col0 = u.pn * BM + wc * 32 + 8 * fq;
#pragma unroll
        for (int ai = 0; ai < 2; ++ai)
#pragma unroll
            for (int m = 0; m < 4; ++m) { const int row = row0 + ai * HALF + m * 16;
#pragma unroll
                for (int bj = 0; bj < 2; ++bj) { const int c = col0 + bj * HALF; const u32x4 g = *(const u32x4*)(proj + (size_t)row * 11264 + 9216 + c);
                    const f32x4 v0 = acc[ai][bj][m][0], v1 = acc[ai][bj][m][1]; f32x4 o0, o1;
                    o0[0] = e_sigmoid(__uint_as_float(g.x << 16)) * v0[0]; o0[1] = e_sigmoid(__uint_as_float(g.x & 0xffff0000u)) * v0[1];
                    o0[2] = e_sigmoid(__uint_as_float(g.y << 16)) * v0[2]; o0[3] = e_sigmoid(__uint_as_float(g.y & 0xffff0000u)) * v0[3];
                    o1[0] = e_sigmoid(__uint_as_float(g.z << 16)) * v1[0]; o1[1] = e_sigmoid(__uint_as_float(g.z & 0xffff0000u)) * v1[1];
                    o1[2] = e_sigmoid(__uint_as_float(g.w << 16)) * v1[2]; o1[3] = e_sigmoid(__uint_as_float(g.w & 0xffff0000u)) * v1[3];
                    float* dst = tmp + (size_t)row * 1024 + c; *(f32x4*)dst = o0; *(f32x4*)(dst + 4) = o1; } }
    }
};
struct EpiGateB {
    static constexpr bool PERM = true, AFTER_DRAIN = false;
    const bf16_t* proj; const float* tmp; bf16_t* mrg;
    __device__ __forceinline__ void operator()(const f32x4 (&acc)[2][2][4][2], const Unit& u, int wr, int wc, int fr, int fq) const {
        const int row0 = u.pm * BM + wr * 64 + fr, col0 = u.pn * BM + wc * 32 + 8 * fq;
#pragma unroll
        for (int ai = 0; ai < 2; ++ai)
#pragma unroll
            for (int m = 0; m < 4; ++m) { const int row = row0 + ai * HALF + m * 16;
#pragma unroll
                for (int bj = 0; bj < 2; ++bj) { const int c = col0 + bj * HALF; const u32x4 g = *(const u32x4*)(proj + (size_t)row * 11264 + 10240 + c);
                    const float* src = tmp + (size_t)row * 1024 + c; const f32x4 t0 = *(const f32x4*)src, t1 = *(const f32x4*)(src + 4);
                    const f32x4 v0 = acc[ai][bj][m][0], v1 = acc[ai][bj][m][1]; f32x4 o0, o1;
                    o0[0] = t0[0] + e_sigmoid(__uint_as_float(g.x << 16)) * v0[0]; o0[1] = t0[1] + e_sigmoid(__uint_as_float(g.x & 0xffff0000u)) * v0[1];
                    o0[2] = t0[2] + e_sigmoid(__uint_as_float(g.y << 16)) * v0[2]; o0[3] = t0[3] + e_sigmoid(__uint_as_float(g.y & 0xffff0000u)) * v0[3];
                    o1[0] = t1[0] + e_sigmoid(__uint_as_float(g.z << 16)) * v1[0]; o1[1] = t1[1] + e_sigmoid(__uint_as_float(g.z & 0xffff0000u)) * v1[1];
                    o1[2] = t1[2] + e_sigmoid(__uint_as_float(g.w << 16)) * v1[2]; o1[3] = t1[3] + e_sigmoid(__uint_as_float(g.w & 0xffff0000u)) * v1[3];
                    u32x4 w; w.x = cvt_pk_bf16(o0[0], o0[1]); w.y = cvt_pk_bf16(o0[2], o0[3]); w.z = cvt_pk_bf16(o1[0], o1[1]); w.w = cvt_pk_bf16(o1[2], o1[3]);
                    *(u32x4*)(mrg + (size_t)row * 1024 + c) = w; } }
    }
};
struct EpiOut {
    static constexpr bool PERM = false, AFTER_DRAIN = false;
    const float* xp; const float* xs; float* out;
    __device__ __forceinline__ void operator()(const f32x4 (&acc)[2][2][4][2], const Unit& u, int wr, int wc, int fr, int fq) const {
        const int row0 = u.pm * BM + wr * 64 + fr, col0 = u.pn * BM + wc * 32 + 4 * fq;
#pragma unroll
        for (int ai = 0; ai < 2; ++ai)
#pragma unroll
            for (int m = 0; m < 4; ++m) { const int row = row0 + ai * HALF + m * 16;
                const float* xr = (u.pm < 64) ? xp + (size_t)row * 1024 : xs + (size_t)(row - 16384) * 1024; float* orow = out + (size_t)row * 1024;
#pragma unroll
                for (int bj = 0; bj < 2; ++bj)
#pragma unroll
                    for (int n = 0; n < 2; ++n) { const int c = col0 + bj * HALF + n * 16; *(f32x4*)(orow + c) = *(const f32x4*)(xr + c) + acc[ai][bj][m][n]; } }
    }
};

template <class Epi, class Sched, bool ALIGN_EPI = false, bool SP2 = false>
__device__ __forceinline__ void gemm_phase(PG8_LAS unsigned char* lds, const Gemm g, const Sched& S, const Epi& E) {
    int tid_ = threadIdx.x; asm volatile("" : "+v"(tid_));
    const int tid = tid_, wid = __builtin_amdgcn_readfirstlane(tid >> 6), lane = tid & 63, wr = wid >> 2, wc = wid & 3, fr = lane & 15, fq = lane >> 4;
    const int K = g.K, nt = K / BK;
    unsigned voffA[2], voffB[2];
#pragma unroll
    for (int i = 0; i < 2; ++i) { int R, C; stage_rc(tid * 16 + i * 8192, R, C); const int Rb = Epi::PERM ? ((R & ~31) + perm32(R & 31)) : R;
        voffA[i] = (unsigned)(R * K + C) * 2u; voffB[i] = (unsigned)(Rb * K + C) * 2u; }
    const size_t kstep = (size_t)(BK * 2);
    const size_t hstep = (size_t)HALF * K * 2;
    const size_t tstep = 2 * hstep;
    const unsigned ldsw = (unsigned)wid * 1024u;
    const int aoff = lds_byte(wr * 64 + fr, fq * 8), boff = lds_byte(wc * 32 + fr, fq * 8);
#define PG8_SA(b, h) (((b) * 2 + (h)) * HTB)
#define PG8_SB(b, h) ((4 + (b) * 2 + (h)) * HTB)
#define PG8_STAGE(bufoff, gbase, voff) do { _Pragma("unroll") for (int _i = 0; _i < 2; ++_i) \
        __builtin_amdgcn_global_load_lds((const unsigned*)((const char*)(gbase) + (voff)[_i]), (PG8_LAS unsigned*)(lds + (bufoff) + ldsw + _i * 8192), 16, 0, 0); } while (0)
#define PG8_LDA(dst, b, h) do { _Pragma("unroll") for (int m = 0; m < 4; ++m) _Pragma("unroll") for (int k = 0; k < 2; ++k) dst[m][k] = *(const PG8_LAS bf16x8*)(lds + PG8_SA(b, h) + aoff + m * 2048 + k * 1024); } while (0)
#define PG8_LDB(dst, b, h) do { _Pragma("unroll") for (int n = 0; n < 2; ++n) _Pragma("unroll") for (int k = 0; k < 2; ++k) dst[n][k] = *(const PG8_LAS bf16x8*)(lds + PG8_SB(b, h) + boff + n * 2048 + k * 1024); } while (0)
#define PG8_MMA(ai, bj, At, Bt) do { __builtin_amdgcn_s_setprio(1); _Pragma("unroll") for (int m = 0; m < 4; ++m) _Pragma("unroll") for (int n = 0; n < 2; ++n) _Pragma("unroll") for (int k = 0; k < 2; ++k) \
        acc[ai][bj][m][n] = __builtin_amdgcn_mfma_f32_16x16x32_bf16(Bt[n][k], At[m][k], acc[ai][bj][m][n], 0, 0, 0); __builtin_amdgcn_s_setprio(0); } while (0)
#define PG8_WAIT_V(n) asm volatile("s_waitcnt vmcnt(" #n ")" ::: "memory")
#define PG8_WAIT_L(n) asm volatile("s_waitcnt lgkmcnt(" #n ")" ::: "memory")
#define PG8_BAR __builtin_amdgcn_s_barrier()
#define PG8_SCHED __builtin_amdgcn_sched_barrier(0)
    Unit cur, nxt; int ui = 0;
    if (!S.next(0, cur)) return;
    f32x4 acc[2][2][4][2];
#pragma unroll
    for (int a = 0; a < 2; ++a)
#pragma unroll
        for (int b = 0; b < 2; ++b)
#pragma unroll
            for (int m = 0; m < 4; ++m)
#pragma unroll
                for (int n = 0; n < 2; ++n) acc[a][b][m][n] = (f32x4){0.f, 0.f, 0.f, 0.f};
    bf16x8 At[4][2], B0[2][2], B1[2][2];
    const char* cA = (const char*)g.A + (size_t)cur.pm * tstep; const char* cB = (const char*)g.Bt + (size_t)cur.pn * tstep;
    S.a_ready(cur);
    if constexpr (SP2) {
        PG8_STAGE(PG8_SB(0, 0), cB, voffB); PG8_STAGE(PG8_SB(0, 1), cB + hstep, voffB); PG8_STAGE(PG8_SA(0, 0), cA, voffA); PG8_STAGE(PG8_SA(0, 1), cA + hstep, voffA);
        if (wr == 1) PG8_BAR;
        PG8_WAIT_V(2); PG8_BAR;
        PG8_STAGE(PG8_SB(1, 0), cB + kstep, voffB); PG8_STAGE(PG8_SA(1, 0), cA + kstep, voffA); PG8_STAGE(PG8_SB(1, 1), cB + hstep + kstep, voffB);
        PG8_WAIT_V(6); PG8_BAR;
    } else {
        PG8_STAGE(PG8_SB(0, 0), cB, voffB); PG8_STAGE(PG8_SA(0, 0), cA, voffA); PG8_STAGE(PG8_SB(0, 1), cB + hstep, voffB); PG8_STAGE(PG8_SA(0, 1), cA + hstep, voffA);
        if (wr == 1) PG8_BAR;
        PG8_WAIT_V(4); PG8_BAR;
        PG8_STAGE(PG8_SB(1, 0), cB + kstep, voffB); PG8_STAGE(PG8_SA(1, 0), cA + kstep, voffA); PG8_STAGE(PG8_SB(1, 1), cB + hstep + kstep, voffB);
        PG8_WAIT_V(6); PG8_BAR;
    }
    for (;;) {
        const bool has_next = S.next(ui + 1, nxt);
        const char* nA = has_next ? (const char*)g.A + (size_t)nxt.pm * tstep : cA; const char* nB = has_next ? (const char*)g.Bt + (size_t)nxt.pn * tstep : cB;
        for (int t = 0; t < nt; t += 2) {
            const bool last = (t == nt - 2);
            const char* a1 = cA + (size_t)(t + 1) * kstep;
            const char* a2 = last ? nA : cA + (size_t)(t + 2) * kstep; const char* b2 = last ? nB : cB + (size_t)(t + 2) * kstep;
            const char* a3 = a2 + kstep; const char* b3 = b2 + kstep;
            if (last && has_next) S.a_ready(nxt);
            if constexpr (SP2) {
            PG8_LDB(B0, 0, 0); PG8_LDB(B1, 0, 1); PG8_SCHED; PG8_LDA(At, 0, 0); PG8_STAGE(PG8_SA(1, 1), a1 + hstep, voffA);
            PG8_WAIT_V(8); PG8_WAIT_L(0); PG8_BAR; PG8_MMA(0, 0, At, B0); PG8_MMA(0, 1, At, B1); PG8_BAR; PG8_SCHED;
            PG8_LDA(At, 0, 1); PG8_STAGE(PG8_SB(0, 0), b2, voffB); PG8_STAGE(PG8_SB(0, 1), b2 + hstep, voffB); PG8_STAGE(PG8_SA(0, 0), a2, voffA);
            PG8_WAIT_V(8); PG8_WAIT_L(0); PG8_BAR; PG8_MMA(1, 0, At, B0); PG8_MMA(1, 1, At, B1); PG8_BAR; PG8_SCHED;
            PG8_LDB(B0, 1, 0); PG8_LDB(B1, 1, 1); PG8_SCHED; PG8_LDA(At, 1, 0); PG8_STAGE(PG8_SA(0, 1), a2 + hstep, voffA);
            PG8_WAIT_V(8); PG8_WAIT_L(0); PG8_BAR; PG8_MMA(0, 0, At, B0); PG8_MMA(0, 1, At, B1); PG8_BAR; PG8_SCHED;
            PG8_LDA(At, 1, 1); PG8_STAGE(PG8_SB(1, 0), b3, voffB); PG8_STAGE(PG8_SB(1, 1), b3 + hstep, voffB); PG8_STAGE(PG8_SA(1, 0), a3, voffA);
            PG8_WAIT_V(8); PG8_WAIT_L(0); PG8_BAR; PG8_MMA(1, 0, At, B0); PG8_MMA(1, 1, At, B1); PG8_BAR; PG8_SCHED;
            } else {
            PG8_LDB(B0, 0, 0); PG8_SCHED; PG8_LDA(At, 0, 0); PG8_STAGE(PG8_SA(1, 1), a1 + hstep, voffA);
            PG8_WAIT_L(8); PG8_BAR; PG8_WAIT_L(0); PG8_MMA(0, 0, At, B0); PG8_BAR; PG8_SCHED;
            PG8_LDB(B1, 0, 1); PG8_STAGE(PG8_SB(0, 0), b2, voffB);
            PG8_BAR; PG8_WAIT_L(0); PG8_MMA(0, 1, At, B1); PG8_BAR;
            PG8_LDA(At, 0, 1); PG8_STAGE(PG8_SA(0, 0), a2, voffA);
            PG8_BAR; PG8_WAIT_L(0); PG8_MMA(1, 0, At, B0); PG8_BAR; PG8_SCHED;
            PG8_STAGE(PG8_SB(0, 1), b2 + hstep, voffB);
            PG8_WAIT_V(6); PG8_BAR; PG8_MMA(1, 1, At, B1); PG8_BAR;
            PG8_LDB(B0, 1, 0); PG8_SCHED; PG8_LDA(At, 1, 0); PG8_STAGE(PG8_SA(0, 1), a2 + hstep, voffA);
            PG8_WAIT_L(8); PG8_BAR; PG8_WAIT_L(0); PG8_MMA(0, 0, At, B0); PG8_BAR; PG8_SCHED;
            PG8_LDB(B1, 1, 1); PG8_STAGE(PG8_SB(1, 0), b3, voffB);
            PG8_BAR; PG8_WAIT_L(0); PG8_MMA(0, 1, At, B1); PG8_BAR;
            PG8_LDA(At, 1, 1); PG8_STAGE(PG8_SA(1, 0), a3, voffA);
            PG8_BAR; PG8_WAIT_L(0); PG8_MMA(1, 0, At, B0); PG8_BAR; PG8_SCHED;
            PG8_STAGE(PG8_SB(1, 1), b3 + hstep, voffB);
            PG8_WAIT_V(6); PG8_BAR; PG8_MMA(1, 1, At, B1); PG8_BAR;
            }
        }
        if constexpr (ALIGN_EPI) { if (wr == 0) PG8_BAR; }
        if constexpr (!Epi::AFTER_DRAIN) { E(acc, cur, wr, wc, fr, fq); S.done(cur); }
        if (!has_next) break;
#pragma unroll
        for (int a = 0; a < 2; ++a)
#pragma unroll
            for (int b = 0; b < 2; ++b)
#pragma unroll
                for (int m = 0; m < 4; ++m)
#pragma unroll
                    for (int n = 0; n < 2; ++n) acc[a][b][m][n] = (f32x4){0.f, 0.f, 0.f, 0.f};
        cur = nxt; cA = nA; cB = nB; ++ui;
        if constexpr (ALIGN_EPI) { if (wr == 1) PG8_BAR; }
    }
    PG8_WAIT_V(0);
    if constexpr (!ALIGN_EPI) { if (wr == 0) PG8_BAR; }
    PG8_BAR;
    if constexpr (Epi::AFTER_DRAIN) { E.fused(acc, cur, wr, wc, fr, fq, lds, wid, lane); S.done(cur); }
#undef PG8_SA
#undef PG8_SB
#undef PG8_STAGE
#undef PG8_LDA
#undef PG8_LDB
#undef PG8_MMA
#undef PG8_WAIT_V
#undef PG8_WAIT_L
#undef PG8_BAR
#undef PG8_SCHED
}
}

#define LAS __attribute__((address_space(3)))
typedef unsigned short bf16;
typedef float f32x4 __attribute__((ext_vector_type(4)));
typedef unsigned u32x4 __attribute__((ext_vector_type(4)));
typedef unsigned u32x2 __attribute__((ext_vector_type(2)));
constexpr int NWAVES = 8, NTHR = 512;
constexpr int DM = 1024, NBATCH = 8, SEQ = 2048, MP = NBATCH * SEQ, DECB = 32, DECS = 8, MS = DECB * DECS, MT = MP + MS;
constexpr int NH = 12, HD = 64, DA = NH * HD;
constexpr int DSSM = 2048, NSH = 32, SHD = 64, NGRP = 8, DST = 128, DCONV = 4096;
constexpr int PAST = 16384, KVB = 2048;
constexpr int NIN = 11296, NPROJ = 11264, NPAD = 11520;
constexpr int C_Q = 0, C_K = 768, C_V = 1536, C_G = 2304, C_Z = 3072, C_XBC = 5120, C_GA = 9216, C_GB = 10240;
constexpr size_t MiB = 1u << 20;
constexpr size_t WS_ARGS = 1 * MiB - 4096, WS_PRM = 1 * MiB, WS_WIN = 2 * MiB, WS_WA = 26 * MiB, WS_WB = 28 * MiB, WS_WO = 32 * MiB, WS_HB = 36 * MiB, WS_DT = 70 * MiB, WS_PROJ = 74 * MiB,
                 WS_YA = 432 * MiB, WS_YS = 458 * MiB, WS_SSQ = 524 * MiB, WS_TMP = 528 * MiB, WS_MRG = 594 * MiB, WS_END = 628 * MiB;
constexpr size_t O_YP = 0, O_YS = O_YP + (size_t)MP * DM, O_KP = O_YS + (size_t)MS * DM, O_VP = O_KP + (size_t)MP * DA, O_CP = O_VP + (size_t)MP * DA,
                 O_SP = O_CP + (size_t)NBATCH * 3 * DCONV, O_KS = O_SP + (size_t)NBATCH * NSH * SHD * DST, O_VS = O_KS + (size_t)MS * DA, O_CS = O_VS + (size_t)MS * DA,
                 O_SS = O_CS + (size_t)DECB * 3 * DCONV, O_END = O_SS + (size_t)DECB * NSH * SHD * DST;
constexpr int LDS_BYTES = 147456;
constexpr int PR_CONVW = 0, PR_CONVB = 16384, PR_DTB = 20480, PR_ALOG = 20512, PR_DSKIP = 20544, PR_RELB = 20576, PR_FNORM = 20992, PR_END = 22016;

struct Args {
    const float *x_prompt, *x_sample, *cache_k, *cache_v, *state_conv, *state_ssm, *norm_g, *w_in, *conv_w, *conv_b, *dt_bias, *a_log, *d_skip, *ssm_norm, *w_a, *w_b, *w_out, *rel_bias, *final_norm;
    float* out; unsigned char* ws;
    int ph_lo, ph_hi, probe, pad_;
};

__device__ __forceinline__ float bf2f(bf16 b) { return __uint_as_float(((unsigned)b) << 16); }
__device__ __forceinline__ unsigned f2bf(float f) { unsigned u = __float_as_uint(f); return (u + 0x7fffu + ((u >> 16) & 1u)) >> 16; }
typedef float f32x2_t __attribute__((ext_vector_type(2))); typedef __bf16 bf16x2_t __attribute__((ext_vector_type(2)));
__device__ __forceinline__ unsigned pk2(float lo, float hi) { const f32x2_t v = {lo, hi}; return __builtin_bit_cast(unsigned, __builtin_convertvector(v, bf16x2_t)); }
__device__ __forceinline__ float sigmoidf_(float x) { return 1.f / (1.f + __expf(-x)); }
__device__ __forceinline__ float siluf_(float x) { return x / (1.f + __expf(-x)); }
__device__ __forceinline__ float softplusf_(float x) { return fmaxf(x, 0.f) + log1pf(__expf(-fabsf(x))); }
__device__ __forceinline__ float wave_sum(float v) {
#pragma unroll
    for (int o = 1; o < 64; o <<= 1) v += __shfl_xor(v, o);
    return v;
}
__device__ __forceinline__ float wave_max(float v) {
#pragma unroll
    for (int o = 1; o < 64; o <<= 1) v = fmaxf(v, __shfl_xor(v, o));
    return v;
}
__device__ __forceinline__ int t5_bucket(int off) {
    if (off < 16) return off;
    return 16 + (off >= 22) + (off >= 30) + (off >= 40) + (off >= 54) + (off >= 73) + (off >= 99) + (off >= 134) + (off >= 182) + (off >= 246) + (off >= 332) + (off >= 450) + (off >= 609) + (off >= 825) + (off >= 1117) + (off >= 1513);
}
__device__ __forceinline__ const float* ld_ptr(const unsigned char* ws, int idx) { const unsigned long long v = ((const unsigned long long*)(ws + WS_ARGS))[idx];
    const unsigned lo = __builtin_amdgcn_readfirstlane((unsigned)v), hi = __builtin_amdgcn_readfirstlane((unsigned)(v >> 32)); return (const float*)(((unsigned long long)hi << 32) | lo); }
#define LDS_WAIT() asm volatile("s_waitcnt lgkmcnt(0)" ::: "memory")
typedef short bf16x8 __attribute__((ext_vector_type(8)));
typedef short s16x4 __attribute__((ext_vector_type(4)));
constexpr int AT_ST = 0, AT_STROW = 272, AT_ML = 69632, AT_BIAS = 71680, AT_V = 73728, AT_VROW = 144, AT_VBYTES = 32 * AT_VROW;
constexpr float LOG2E = 1.4426950408889634f;
__device__ __forceinline__ s16x4 lds_tr16(LAS const unsigned char* p) { return __builtin_bit_cast(s16x4, __builtin_amdgcn_ds_read_tr16_b64_v4i16((LAS s16x4*)p)); }

template <bool SAMP> __device__ __forceinline__ void attn_item(const bf16* base, const float* ck, const float* cv, int P0, int stride, const LAS float* bias2, LAS unsigned char* vst, int lane, float& m_out, float& l_out, f32x4 (&o)[4]) {
    const int c = lane & 15, rq = lane >> 4;
    bf16x8 qf[2];
    { int qrow = P0 + stride * c; if (SAMP) { qrow -= KVB; qrow = qrow > DECS - 1 ? DECS - 1 : qrow; }
      const bf16* qp = base + (size_t)qrow * NPROJ + C_Q + rq * 8; qf[0] = *(const bf16x8*)qp; qf[1] = *(const bf16x8*)(qp + 32); }
    f32x4 sc[9];
#pragma unroll
    for (int kt = 0; kt < 9; ++kt) {
        const bool tile_valid = (P0 + stride * (16 * kt + 15 - 128)) >= 0;
        if (tile_valid) {
            int kpos = P0 + stride * (16 * kt + c - 128); kpos = kpos < 0 ? 0 : kpos;
            bf16x8 k0, k1;
            if (SAMP && kt < 8) { const float* kp = ck + (size_t)kpos * (NH * HD) + rq * 8;
                const f32x4 a0 = *(const f32x4*)kp, a1 = *(const f32x4*)(kp + 4), b0 = *(const f32x4*)(kp + 32), b1 = *(const f32x4*)(kp + 36);
                u32x4 w0, w1; w0.x = pk2(a0[0], a0[1]); w0.y = pk2(a0[2], a0[3]); w0.z = pk2(a1[0], a1[1]); w0.w = pk2(a1[2], a1[3]); w1.x = pk2(b0[0], b0[1]); w1.y = pk2(b0[2], b0[3]); w1.z = pk2(b1[0], b1[1]); w1.w = pk2(b1[2], b1[3]);
                k0 = __builtin_bit_cast(bf16x8, w0); k1 = __builtin_bit_cast(bf16x8, w1);
            } else { if (SAMP) { kpos -= KVB; kpos = kpos > DECS - 1 ? DECS - 1 : kpos; }
                const bf16* kp = base + (size_t)kpos * NPROJ + C_K + rq * 8; k0 = *(const bf16x8*)kp; k1 = *(const bf16x8*)(kp + 32); }
            f32x4 acc = {0.f, 0.f, 0.f, 0.f};
            acc = __builtin_amdgcn_mfma_f32_16x16x32_bf16(k0, qf[0], acc, 0, 0, 0);
            acc = __builtin_amdgcn_mfma_f32_16x16x32_bf16(k1, qf[1], acc, 0, 0, 0);
#pragma unroll
            for (int j = 0; j < 4; ++j) { const int kidx = 16 * kt + 4 * rq + j, jj = c + 128 - kidx, kp2 = P0 + stride * (kidx - 128);
                const bool valid = (jj >= 0) && (jj <= 128) && (kp2 >= 0); const int jc = jj < 0 ? 0 : (jj > 128 ? 128 : jj);
                sc[kt][j] = valid ? acc[j] * (0.125f * LOG2E) + bias2[jc] : -INFINITY; }
        } else sc[kt] = (f32x4){-INFINITY, -INFINITY, -INFINITY, -INFINITY};
    }
    float m = -INFINITY;
#pragma unroll
    for (int kt = 0; kt < 9; ++kt) m = fmaxf(fmaxf(fmaxf(m, sc[kt][0]), fmaxf(sc[kt][1], sc[kt][2])), sc[kt][3]);
    m = fmaxf(m, __shfl_xor(m, 16)); m = fmaxf(m, __shfl_xor(m, 32));
    float l = 0.f;
#pragma unroll
    for (int kt = 0; kt < 9; ++kt)
#pragma unroll
        for (int j = 0; j < 4; ++j) { const float p = __builtin_amdgcn_exp2f(sc[kt][j] - m); sc[kt][j] = p; l += p; }
    l += __shfl_xor(l, 16); l += __shfl_xor(l, 32);
#pragma unroll
    for (int dt = 0; dt < 4; ++dt) o[dt] = (f32x4){0.f, 0.f, 0.f, 0.f};
#pragma unroll
    for (int ks = 0; ks < 5; ++ks) {
        const int ktl = (2 * ks + 1 < 9) ? 2 * ks + 1 : 8;
        const bool step_valid = (P0 + stride * (16 * ktl + 15 - 128)) >= 0;
        if (step_valid) {
            if (SAMP && ks < 4) {
#pragma unroll
                for (int i = 0; i < 8; ++i) { const int kl = 4 * i + (lane >> 4); int kpos = P0 + stride * (32 * ks + kl - 128); kpos = kpos < 0 ? 0 : kpos;
                    const f32x4 v = *(const f32x4*)(cv + (size_t)kpos * (NH * HD) + (lane & 15) * 4);
                    u32x2 w; w.x = pk2(v[0], v[1]); w.y = pk2(v[2], v[3]); *(LAS u32x2*)(vst + kl * AT_VROW + (lane & 15) * 8) = w; }
            } else {
#pragma unroll
                for (int i = 0; i < 4; ++i) { const int kl = 8 * i + (lane >> 3); int kpos = P0 + stride * (32 * ks + kl - 128);
                    if (SAMP) { kpos -= KVB; kpos = kpos < 0 ? 0 : (kpos > DECS - 1 ? DECS - 1 : kpos); } else kpos = kpos < 0 ? 0 : (kpos > SEQ - 1 ? SEQ - 1 : kpos);
                    const u32x4 v = *(const u32x4*)(base + (size_t)kpos * NPROJ + C_V + (lane & 7) * 8);
                    *(LAS u32x4*)(vst + kl * AT_VROW + (lane & 7) * 16) = v; }
            }
            bf16x8 pb;
            { const f32x4 pa = sc[2 * ks]; const f32x4 pz = (2 * ks + 1 < 9) ? sc[(2 * ks + 1 < 9) ? 2 * ks + 1 : 8] : (f32x4){0.f, 0.f, 0.f, 0.f};
              u32x4 w; w.x = pk2(pa[0], pa[1]); w.y = pk2(pa[2], pa[3]); w.z = pk2(pz[0], pz[1]); w.w = pk2(pz[2], pz[3]); pb = __builtin_bit_cast(bf16x8, w); }
            LDS_WAIT(); asm volatile("" ::: "memory");
            LAS const unsigned char* vr = vst + (4 * rq + ((lane & 15) >> 2)) * AT_VROW + (lane & 3) * 8;
#pragma unroll
            for (int dt = 0; dt < 4; ++dt) { const s16x4 lo = lds_tr16(vr + dt * 32), hi = lds_tr16(vr + dt * 32 + 16 * AT_VROW);
                const bf16x8 vf = (bf16x8){lo[0], lo[1], lo[2], lo[3], hi[0], hi[1], hi[2], hi[3]};
                o[dt] = __builtin_amdgcn_mfma_f32_16x16x32_bf16(vf, pb, o[dt], 0, 0, 0); }
            LDS_WAIT(); asm volatile("" ::: "memory");
        }
    }
    m_out = m; l_out = l;
}
__device__ __forceinline__ void attn_merge(int mode, LAS unsigned char* lds, int ql, int lane, float m, float l, f32x4 (&o)[4], const bf16* gp  , bf16* yp  ) {
    const int rq = lane >> 4;
    LAS float* ml = (LAS float*)(lds + AT_ML) + ql * 2; LAS unsigned char* st = lds + AT_ST + ql * AT_STROW + rq * 16;
    if (mode == 0) {
#pragma unroll
        for (int dt = 0; dt < 4; ++dt) *(LAS f32x4*)(st + dt * 64) = o[dt];
        if (rq == 0) { ml[0] = m; ml[1] = l; }
    } else {
        const float M = ml[0], L = ml[1]; const float Mn = fmaxf(M, m), ca = __builtin_amdgcn_exp2f(M - Mn), cb = __builtin_amdgcn_exp2f(m - Mn); const float Ln = L * ca + l * cb;
        f32x4 on[4];
#pragma unroll
        for (int dt = 0; dt < 4; ++dt) on[dt] = *(LAS const f32x4*)(st + dt * 64) * ca + o[dt] * cb;
        if (mode == 1) {
            LDS_WAIT(); asm volatile("" ::: "memory");
#pragma unroll
            for (int dt = 0; dt < 4; ++dt) *(LAS f32x4*)(st + dt * 64) = on[dt];
            if (rq == 0) { ml[0] = Mn; ml[1] = Ln; }
        } else {
            const float inv = 1.f / Ln;
#pragma unroll
            for (int dt = 0; dt < 4; ++dt) { const u32x2 g = *(const u32x2*)(gp + 16 * dt + 4 * rq);
                const float g0 = __uint_as_float(g.x << 16), g1 = __uint_as_float(g.x & 0xffff0000u), g2 = __uint_as_float(g.y << 16), g3 = __uint_as_float(g.y & 0xffff0000u);
                u32x2 w; w.x = pk2(on[dt][0] * inv * siluf_(g0), on[dt][1] * inv * siluf_(g1)); w.y = pk2(on[dt][2] * inv * siluf_(g2), on[dt][3] * inv * siluf_(g3));
                *(u32x2*)(yp + 16 * dt + 4 * rq) = w; }
        }
    }
}
__device__ __forceinline__ void attn_unit(const unsigned char* ws, LAS unsigned char* lds, int b, int h, int s, int wave, int lane) {
    const bf16* proj = (const bf16*)(ws + WS_PROJ); bf16* ya = (bf16*)(ws + WS_YA); const float* prm = (const float*)(ws + WS_PRM);
    const bf16* base = proj + (size_t)b * SEQ * NPROJ + h * HD;
    LAS float* bias2 = (LAS float*)(lds + AT_BIAS); LAS unsigned char* vst = lds + AT_V + wave * AT_VBYTES;
    for (int idx = threadIdx.x; idx < 3 * 129; idx += NTHR) { const int g = idx / 129, j = idx - g * 129; bias2[g * 132 + j] = prm[PR_RELB + t5_bucket(j << (2 * g)) * NH + h] * LOG2E; }
    const int c = lane & 15;
#pragma unroll 1
    for (int it = 0; it < 6; ++it) {
        if ((it & 1) == 0) __syncthreads();
        const int id = 2 * wave + (it & 1), mode = it >> 1;
        int q0, stride;
        if (mode == 0) { q0 = id; stride = 16; } else if (mode == 1) { q0 = (id >> 2) + 64 * (id & 3); stride = 4; } else { q0 = 16 * id; stride = 1; }
        float m, l; f32x4 o[4];
        attn_item<false>(base, nullptr, nullptr, s + q0, stride, bias2 + (2 - mode) * 132, vst, lane, m, l, o);
        const int ql = q0 + stride * c; const size_t row = (size_t)b * SEQ + s + ql;
        attn_merge(mode, lds, ql, lane, m, l, o, proj + row * NPROJ + C_G + h * HD, ya + row * DA + h * HD);
    }
    __syncthreads();
}

constexpr int AS_SLOT = 0, AS_SLOTF = 68;
__device__ __forceinline__ void attn_sample_unit(const unsigned char* ws, const float* cache_k, const float* cache_v, LAS unsigned char* lds, int sq, int h, int wave, int lane) {
    const bf16* proj = (const bf16*)(ws + WS_PROJ); bf16* ya = (bf16*)(ws + WS_YA); const float* prm = (const float*)(ws + WS_PRM);
    const bf16* base = proj + (size_t)(MP + sq * DECS) * NPROJ + h * HD; const float* ck = cache_k + ((size_t)sq * KVB * NH + h) * HD; const float* cv = cache_v + ((size_t)sq * KVB * NH + h) * HD;
    LAS float* bias2 = (LAS float*)(lds + AT_BIAS); LAS unsigned char* vst = lds + AT_V + wave * AT_VBYTES; LAS float* slots = (LAS float*)(lds + AS_SLOT);
    for (int idx = threadIdx.x; idx < 3 * 129; idx += NTHR) { const int g = idx / 129, j = idx - g * 129; bias2[g * 132 + j] = prm[PR_RELB + t5_bucket(j << (2 * g)) * NH + h] * LOG2E; }
    __syncthreads();
    const int c = lane & 15, rq = lane >> 4;
#pragma unroll 1
    for (int id = wave; id < 13; id += NWAVES) {
        const int g = id == 0 ? 0 : (id < 5 ? 1 : 2), r = id == 0 ? 0 : (id < 5 ? id - 1 : id - 5), stride = 1 << (2 * g), nq = (DECS - r + stride - 1) / stride;
        float m, l; f32x4 o[4];
        attn_item<true>(base, ck, cv, KVB + r, stride, bias2 + g * 132, vst, lane, m, l, o);
        if (c < nq) { LAS float* sl = slots + ((r + stride * c) * 3 + g) * AS_SLOTF;
#pragma unroll
            for (int dt = 0; dt < 4; ++dt) *(LAS f32x4*)(sl + 16 * dt + 4 * rq) = o[dt];
            if (rq == 0) { sl[64] = m; sl[65] = l; } }
    }
    __syncthreads();
    { const int i = threadIdx.x >> 6, d = lane; const LAS float* s0 = slots + (i * 3) * AS_SLOTF; const LAS float* s1 = s0 + AS_SLOTF; const LAS float* s2 = s1 + AS_SLOTF;
      const float m0 = s0[64], m1 = s1[64], m2 = s2[64], M = fmaxf(m0, fmaxf(m1, m2));
      const float c0 = __builtin_amdgcn_exp2f(m0 - M), c1 = __builtin_amdgcn_exp2f(m1 - M), c2 = __builtin_amdgcn_exp2f(m2 - M);
      const float L = s0[65] * c0 + s1[65] * c1 + s2[65] * c2, O = s0[d] * c0 + s1[d] * c1 + s2[d] * c2;
      const size_t row = (size_t)MP + sq * DECS + i; const float gv = bf2f(proj[row * NPROJ + C_G + h * HD + d]);
      ya[row * DA + h * HD + d] = (bf16)f2bf(O / L * siluf_(gv)); }
    __syncthreads();
}
constexpr int SD_BM = 0, SD_CM = 17408, SD_CS = 34816, SD_ROWN = 272, SD_BWT = 52224, SD_XT = 70656, SD_ROWS = 144, SD_YP = 79872, SD_YROW = 272, SD_AR = 114688, SD_CW = 115712;
__device__ __forceinline__ void ssd_dtarrays(LAS float* ar, float dtv, float Aneg, int lane) {
    asm volatile("" : "+v"(lane));
    float x = dtv * Aneg * LOG2E;
#pragma unroll
    for (int o = 1; o < 64; o <<= 1) { const float y = __shfl_up(x, o); if (lane >= o) x += y; }
    const float tot = __shfl(x, 63);
    ar[lane] = x; ar[64 + lane] = dtv; ar[128 + lane] = __builtin_amdgcn_exp2f(tot - x) * dtv; ar[192 + lane] = __builtin_amdgcn_exp2f(x);
}
__device__ __forceinline__ float silu_fast(float x) { return x * __builtin_amdgcn_rcpf(1.f + __builtin_amdgcn_exp2f(-x * LOG2E)); }
typedef float f32x2 __attribute__((ext_vector_type(2)));
__device__ __forceinline__ void ssd_conv_load(unsigned (&raw)[19], const bf16* proj, const bf16* zrow, size_t row0, int c0, int t0, int col) {
    const bf16* basep = proj + (row0 + (size_t)(c0 + t0)) * NPROJ + C_XBC + col;
#pragma unroll
    for (int k = 0; k < 19; ++k) { const int T = c0 + t0 - 3 + k; const bf16* rp = (T >= 0) ? basep + (ptrdiff_t)(k - 3) * NPROJ : zrow + col; raw[k] = *(const unsigned*)rp; }
}
template <int KIND> __device__ __forceinline__ void ssd_conv_compute(const unsigned (&raw)[19], LAS unsigned char* lds, int t0, int chl  , int ch) {
    const LAS float* ar = (const LAS float*)(lds + SD_AR); const LAS float* cw = (const LAS float*)(lds + SD_CW) + chl;
    f32x2 w[4];
#pragma unroll
    for (int tap = 0; tap < 4; ++tap) w[tap] = *(const LAS f32x2*)(cw + tap * 320);
    const f32x2 bb = *(const LAS f32x2*)(cw + 4 * 320);
#pragma unroll
    for (int blk = 0; blk < 2; ++blk) {
        float o0[8], o1[8];
#pragma unroll
        for (int tt = 0; tt < 8; ++tt) { const int t = blk * 8 + tt; f32x2 v = bb;
#pragma unroll
            for (int tap = 0; tap < 4; ++tap) v += w[tap] * (f32x2){__uint_as_float(raw[t + tap] << 16), __uint_as_float(raw[t + tap] & 0xffff0000u)};
            o0[tt] = silu_fast(v.x); o1[tt] = silu_fast(v.y); }
        const int s0 = t0 + blk * 8;
        if (KIND == 0) {
            u32x4 a, b; a.x = pk2(o0[0], o0[1]); a.y = pk2(o0[2], o0[3]); a.z = pk2(o0[4], o0[5]); a.w = pk2(o0[6], o0[7]); b.x = pk2(o1[0], o1[1]); b.y = pk2(o1[2], o1[3]); b.z = pk2(o1[4], o1[5]); b.w = pk2(o1[6], o1[7]);
            *(LAS u32x4*)(lds + SD_XT + ch * SD_ROWS + s0 * 2) = a; *(LAS u32x4*)(lds + SD_XT + (ch + 1) * SD_ROWS + s0 * 2) = b;
        } else if (KIND == 1) {
            float s0v[8], s1v[8];
#pragma unroll
            for (int tt = 0; tt < 8; ++tt) { *(LAS unsigned*)(lds + SD_BM + (s0 + tt) * SD_ROWN + ch * 2) = pk2(o0[tt], o1[tt]); const float ww = ar[128 + s0 + tt]; s0v[tt] = o0[tt] * ww; s1v[tt] = o1[tt] * ww; }
            u32x4 a, b; a.x = pk2(s0v[0], s0v[1]); a.y = pk2(s0v[2], s0v[3]); a.z = pk2(s0v[4], s0v[5]); a.w = pk2(s0v[6], s0v[7]); b.x = pk2(s1v[0], s1v[1]); b.y = pk2(s1v[2], s1v[3]); b.z = pk2(s1v[4], s1v[5]); b.w = pk2(s1v[6], s1v[7]);
            *(LAS u32x4*)(lds + SD_BWT + ch * SD_ROWS + s0 * 2) = a; *(LAS u32x4*)(lds + SD_BWT + (ch + 1) * SD_ROWS + s0 * 2) = b;
        } else {
#pragma unroll
            for (int tt = 0; tt < 8; ++tt) { *(LAS unsigned*)(lds + SD_CM + (s0 + tt) * SD_ROWN + ch * 2) = pk2(o0[tt], o1[tt]); const float e = ar[192 + s0 + tt];
                *(LAS unsigned*)(lds + SD_CS + (s0 + tt) * SD_ROWN + ch * 2) = pk2(o0[tt] * e, o1[tt] * e); }
        }
    }
}
__device__ __forceinline__ bf16x8 cat8(s16x4 a, s16x4 b) { return (bf16x8){a[0], a[1], a[2], a[3], b[0], b[1], b[2], b[3]}; }
template <int HH> __device__ __forceinline__ void ssd_mfma_step(LAS unsigned char* lds, f32x4 (&Hacc)[4], int pt, int c, int rq, float Dk) {
    const LAS float* ar = (const LAS float*)(lds + SD_AR);
    constexpr int S0 = 2 * HH, S1 = 2 * HH + 1;
    const int p = 16 * pt + c;
    f32x4 g0[4], g1[4];
#pragma unroll
    for (int lt = 0; lt < 4; ++lt) { g0[lt] = (f32x4){0.f, 0.f, 0.f, 0.f}; g1[lt] = (f32x4){0.f, 0.f, 0.f, 0.f}; }
#pragma unroll
    for (int ks = 0; ks < 4; ++ks) {
        const bf16x8 b0 = *(LAS const bf16x8*)(lds + SD_BM + (32 * HH + c) * SD_ROWN + (8 * rq + 32 * ks) * 2), b1 = *(LAS const bf16x8*)(lds + SD_BM + (32 * HH + 16 + c) * SD_ROWN + (8 * rq + 32 * ks) * 2);
#pragma unroll
        for (int lt = 0; lt < 4; ++lt) if (lt >= S0) { const bf16x8 cf = *(LAS const bf16x8*)(lds + SD_CM + (16 * lt + c) * SD_ROWN + (8 * rq + 32 * ks) * 2);
            g0[lt] = __builtin_amdgcn_mfma_f32_16x16x32_bf16(b0, cf, g0[lt], 0, 0, 0);
            if (lt >= S1) g1[lt] = __builtin_amdgcn_mfma_f32_16x16x32_bf16(b1, cf, g1[lt], 0, 0, 0); }
    }
    const f32x4 as0 = *(LAS const f32x4*)(ar + 32 * HH + 4 * rq), as1 = *(LAS const f32x4*)(ar + 32 * HH + 16 + 4 * rq);
    const f32x4 dt0 = *(LAS const f32x4*)(ar + 64 + 32 * HH + 4 * rq), dt1 = *(LAS const f32x4*)(ar + 64 + 32 * HH + 16 + 4 * rq);
    int dd = c - 4 * rq; asm volatile("" : "+v"(dd));
    const bf16x8 xb = cat8(*(LAS const s16x4*)(lds + SD_XT + p * SD_ROWS + (32 * HH + 4 * rq) * 2), *(LAS const s16x4*)(lds + SD_XT + p * SD_ROWS + (32 * HH + 16 + 4 * rq) * 2));
    bf16x8 hb[2];
#pragma unroll
    for (int k2 = 0; k2 < 2; ++k2) { u32x4 w; w.x = pk2(Hacc[2 * k2][0], Hacc[2 * k2][1]); w.y = pk2(Hacc[2 * k2][2], Hacc[2 * k2][3]); w.z = pk2(Hacc[2 * k2 + 1][0], Hacc[2 * k2 + 1][1]); w.w = pk2(Hacc[2 * k2 + 1][2], Hacc[2 * k2 + 1][3]); hb[k2] = __builtin_bit_cast(bf16x8, w); }
    f32x4 y[4];
#pragma unroll
    for (int lt = 0; lt < 4; ++lt) {
        y[lt] = (f32x4){0.f, 0.f, 0.f, 0.f};
#pragma unroll
        for (int k2 = 0; k2 < 2; ++k2) { const LAS unsigned char* cp = lds + SD_CS + (16 * lt + c) * SD_ROWN + (64 * HH + 32 * k2 + 4 * rq) * 2;
            y[lt] = __builtin_amdgcn_mfma_f32_16x16x32_bf16(cat8(*(LAS const s16x4*)cp, *(LAS const s16x4*)(cp + 32)), hb[k2], y[lt], 0, 0, 0); }
    }
#pragma unroll
    for (int lt = 0; lt < 4; ++lt) if (lt >= S0) {
        const float acl = ar[16 * lt + c];
        float m0[4], m1[4];
#pragma unroll
        for (int j = 0; j < 4; ++j) {
            float v0 = g0[lt][j] * __builtin_amdgcn_exp2f(fminf(acl - as0[j], 0.f)) * dt0[j];
            if (lt == S0) { v0 = (j <= dd) ? v0 : 0.f; v0 += (j == dd) ? Dk : 0.f; }
            m0[j] = v0;
            float v1 = 0.f;
            if (lt >= S1) { v1 = g1[lt][j] * __builtin_amdgcn_exp2f(fminf(acl - as1[j], 0.f)) * dt1[j]; if (lt == S1) { v1 = (j <= dd) ? v1 : 0.f; v1 += (j == dd) ? Dk : 0.f; } }
            m1[j] = v1; }
        u32x4 w; w.x = pk2(m0[0], m0[1]); w.y = pk2(m0[2], m0[3]); w.z = pk2(m1[0], m1[1]); w.w = pk2(m1[2], m1[3]);
        y[lt] = __builtin_amdgcn_mfma_f32_16x16x32_bf16(__builtin_bit_cast(bf16x8, w), xb, y[lt], 0, 0, 0);
    }
    const float dec = __builtin_amdgcn_exp2f(ar[63]);
    bf16x8 xn[2];
#pragma unroll
    for (int k2 = 0; k2 < 2; ++k2) xn[k2] = *(LAS const bf16x8*)(lds + SD_XT + p * SD_ROWS + (8 * rq + 32 * k2) * 2);
#pragma unroll
    for (int nt = 0; nt < 4; ++nt) Hacc[nt] = Hacc[nt] * dec;
#pragma unroll
    for (int k2 = 0; k2 < 2; ++k2)
#pragma unroll
        for (int nt = 0; nt < 4; ++nt) Hacc[nt] = __builtin_amdgcn_mfma_f32_16x16x32_bf16(*(LAS const bf16x8*)(lds + SD_BWT + (64 * HH + 16 * nt + c) * SD_ROWS + (8 * rq + 32 * k2) * 2), xn[k2], Hacc[nt], 0, 0, 0);
#pragma unroll
    for (int lt = 0; lt < 4; ++lt)
#pragma unroll
        for (int j = 0; j < 4; ++j) *(LAS float*)(lds + SD_YP + HH * (64 * SD_YROW) + (16 * lt + 4 * rq + j) * SD_YROW + p * 4) = y[lt][j];
}
__device__ __forceinline__ void ssd_mfma_unit(const unsigned char* ws, float* out, bf16* ys, float* ssq, int probe, LAS unsigned char* lds, int b, int hd, int wave, int lane) {
    const bf16* proj = (const bf16*)(ws + WS_PROJ); const float* dtb = (const float*)(ws + WS_DT); const float* prm = (const float*)(ws + WS_PRM);
    const int tid = threadIdx.x, c = lane & 15, rq = lane >> 4, pt = wave & 3, hh = wave >> 2, grp = hd >> 2;
    const size_t row0 = (size_t)b * SEQ; const bf16* zrow = (const bf16*)(ws + WS_WIN) + (size_t)NIN * DM;
    const float Aneg = -__expf(prm[PR_ALOG + hd]), Dk = prm[PR_DSKIP + hd];
    LAS float* ar = (LAS float*)(lds + SD_AR);
    f32x4 Hacc[4];
#pragma unroll
    for (int nt = 0; nt < 4; ++nt) Hacc[nt] = (f32x4){0.f, 0.f, 0.f, 0.f};
    const int kindA = wave < 2 ? 0 : (wave < 6 ? 1 : 2);
    const int tA = kindA == 0 ? tid : (kindA == 1 ? tid - 128 : tid - 384), pairA = kindA == 0 ? (tA & 31) : (tA & 63), runA = kindA == 0 ? (tA >> 5) : (tA >> 6);
    const int colA = kindA == 0 ? hd * 64 + 2 * pairA : (kindA == 1 ? DSSM + grp * DST + 2 * pairA : DSSM + NGRP * DST + grp * DST + 2 * pairA);
    const int tB = tid + 128, pairB = tB & 63, runB = tB >> 6, colB = DSSM + NGRP * DST + grp * DST + 2 * pairB;
    unsigned rawA[19], rawB[19];
    ssd_conv_load(rawA, proj, zrow, row0, 0, 16 * runA, colA);
    if (wave < 2) ssd_conv_load(rawB, proj, zrow, row0, 0, 16 * runB, colB);
    float dtn = (wave == 7) ? dtb[(row0 + lane) * 32 + hd] : 0.f;
    __syncthreads();
    for (int idx = tid; idx < 5 * 320; idx += NTHR) { const int t5 = idx / 320, chl = idx - t5 * 320; const int col = chl < 64 ? hd * 64 + chl : (chl < 192 ? DSSM + grp * DST + (chl - 64) : DSSM + NGRP * DST + grp * DST + (chl - 192));
        ((LAS float*)(lds + SD_CW))[idx] = t5 < 4 ? prm[PR_CONVW + t5 * DCONV + col] : prm[PR_CONVB + col]; }
    if (wave == 7) { ssd_dtarrays(ar, dtn, Aneg, lane); dtn = dtb[(row0 + 64 + lane) * 32 + hd]; }
    __syncthreads();
    const int el = tid >> 3, ep0 = (tid & 7) * 8;
#pragma unroll 1
    for (int c0 = 0; c0 < SEQ; c0 += 64) {
        const bool more = c0 + 64 < SEQ;
        const u32x4 zreg = *(const u32x4*)(proj + (row0 + c0 + el) * NPROJ + C_Z + hd * 64 + ep0);
        if (!(probe & 2)) {
        if (kindA == 0) ssd_conv_compute<0>(rawA, lds, 16 * runA, 2 * pairA, 2 * pairA); else if (kindA == 1) ssd_conv_compute<1>(rawA, lds, 16 * runA, 64 + 2 * pairA, 2 * pairA); else ssd_conv_compute<2>(rawA, lds, 16 * runA, 192 + 2 * pairA, 2 * pairA);
        if (more) ssd_conv_load(rawA, proj, zrow, row0, c0 + 64, 16 * runA, colA);
        if (wave < 2) { ssd_conv_compute<2>(rawB, lds, 16 * runB, 192 + 2 * pairB, 2 * pairB); if (more) ssd_conv_load(rawB, proj, zrow, row0, c0 + 64, 16 * runB, colB); }
        }
        __syncthreads();
        if (!(probe & 4)) { if (hh == 0) ssd_mfma_step<0>(lds, Hacc, pt, c, rq, Dk); else ssd_mfma_step<1>(lds, Hacc, pt, c, rq, Dk); }
        __syncthreads();
        if (!(probe & 8)) {
            const size_t row = row0 + c0 + el;
            const LAS float* y0 = (const LAS float*)(lds + SD_YP + el * SD_YROW + ep0 * 4); const LAS float* y1 = (const LAS float*)(lds + SD_YP + 64 * SD_YROW + el * SD_YROW + ep0 * 4);
            const f32x4 a0 = *(const LAS f32x4*)y0 + *(const LAS f32x4*)y1, a1 = *(const LAS f32x4*)(y0 + 4) + *(const LAS f32x4*)(y1 + 4);
            const u32x4 z = zreg;
            float v[8];
            v[0] = a0[0] * silu_fast(__uint_as_float(z.x << 16)); v[1] = a0[1] * silu_fast(__uint_as_float(z.x & 0xffff0000u)); v[2] = a0[2] * silu_fast(__uint_as_float(z.y << 16)); v[3] = a0[3] * silu_fast(__uint_as_float(z.y & 0xffff0000u));
            v[4] = a1[0] * silu_fast(__uint_as_float(z.z << 16)); v[5] = a1[1] * silu_fast(__uint_as_float(z.z & 0xffff0000u)); v[6] = a1[2] * silu_fast(__uint_as_float(z.w << 16)); v[7] = a1[3] * silu_fast(__uint_as_float(z.w & 0xffff0000u));
            u32x4 w; w.x = pk2(v[0], v[1]); w.y = pk2(v[2], v[3]); w.z = pk2(v[4], v[5]); w.w = pk2(v[6], v[7]);
            *(u32x4*)(ys + row * DSSM + hd * 64 + ep0) = w;
            float ss = (v[0] * v[0] + v[1] * v[1]) + (v[2] * v[2] + v[3] * v[3]) + (v[4] * v[4] + v[5] * v[5]) + (v[6] * v[6] + v[7] * v[7]);
            ss += __shfl_xor(ss, 1); ss += __shfl_xor(ss, 2); ss += __shfl_xor(ss, 4);
            if ((tid & 7) == 0) ssq[row * NSH + hd] = ss;
            if (wave == 7 && more) { ssd_dtarrays(ar, dtn, Aneg, lane); const int cn = c0 + 128 < SEQ ? c0 + 128 : c0; dtn = dtb[(row0 + cn + lane) * 32 + hd]; }
        }
        __syncthreads();
    }
    float* dst = out + O_SP + ((size_t)(b * NSH + hd) * SHD + 16 * pt + c) * DST + 64 * hh + 4 * rq;
#pragma unroll
    for (int nt = 0; nt < 4; ++nt) *(f32x4*)(dst + 16 * nt) = Hacc[nt];
}
__device__ __forceinline__ void p0_transpose_item(const float* W, int K, int N, bf16* WT, int k0, int n0, int dst_row0, const float* kscale, LAS float* scr, int lane) {
#pragma unroll 8
    for (int i = 0; i < 32; ++i) { const int kk = 2 * i + (lane >> 5); float v = W[(size_t)(k0 + kk) * N + n0 + (lane & 31)]; if (kscale) v *= kscale[k0 + kk]; scr[kk * 33 + (lane & 31)] = v; }
    LDS_WAIT(); asm volatile("" ::: "memory");
    const int c = lane & 7;
#pragma unroll
    for (int j = 0; j < 4; ++j) { const int n = (lane >> 3) + 8 * j; const LAS float* s = scr + (8 * c) * 33 + n;
        u32x4 o; o.x = pk2(s[0 * 33], s[1 * 33]); o.y = pk2(s[2 * 33], s[3 * 33]); o.z = pk2(s[4 * 33], s[5 * 33]); o.w = pk2(s[6 * 33], s[7 * 33]);
        *(u32x4*)(WT + (size_t)(dst_row0 + n) * K + k0 + 8 * c) = o; }
    LDS_WAIT(); asm volatile("" ::: "memory");
}
__device__ __forceinline__ void p0_prologue(const Args& a, LAS unsigned char* lds, int gw, int NGW, int wave, int lane) {
    bf16* win_t = (bf16*)(a.ws + WS_WIN); bf16* wa_t = (bf16*)(a.ws + WS_WA); bf16* wb_t = (bf16*)(a.ws + WS_WB); bf16* wo_t = (bf16*)(a.ws + WS_WO); bf16* hb = (bf16*)(a.ws + WS_HB);
    LAS float* scr = (LAS float*)(lds + wave * 16384);
    constexpr int I_IN = (DM / 64) * (NIN / 32), I_A = (DA / 64) * (DM / 32), I_B = (DSSM / 64) * (DM / 32), I_O = (DM / 64) * (DM / 32);
    for (int it = gw; it < I_IN + I_A + I_B + I_O; it += NGW) {
        int r = it;
        if (r < I_IN) { const int nblk = NIN / 32, kb = r / nblk, nb = r % nblk, n0 = nb * 32; const int dst = (n0 < 9216) ? n0 : (n0 == 9216 ? 11264 : n0 - 32);
            p0_transpose_item(a.w_in, DM, NIN, win_t, kb * 64, n0, dst, nullptr, scr, lane); continue; } r -= I_IN;
        if (r < I_A) { const int nblk = DM / 32, kb = r / nblk, nb = r % nblk; p0_transpose_item(a.w_a, DA, DM, wa_t, kb * 64, nb * 32, nb * 32, nullptr, scr, lane); continue; } r -= I_A;
        if (r < I_B) { const int nblk = DM / 32, kb = r / nblk, nb = r % nblk; p0_transpose_item(a.w_b, DSSM, DM, wb_t, kb * 64, nb * 32, nb * 32, a.ssm_norm, scr, lane); continue; } r -= I_B;
        { const int nblk = DM / 32, kb = r / nblk, nb = r % nblk; p0_transpose_item(a.w_out, DM, DM, wo_t, kb * 64, nb * 32, nb * 32, nullptr, scr, lane); }
    }
    { float* prm = (float*)(a.ws + WS_PRM); const int gt = gw * 64 + lane, NGT = NGW * 64;
      for (int i = gt; i < PR_END; i += NGT) { float v = 0.f;
          if (i < PR_CONVB) v = a.conv_w[i]; else if (i < PR_DTB) v = a.conv_b[i - PR_CONVB]; else if (i < PR_ALOG) v = a.dt_bias[i - PR_DTB]; else if (i < PR_DSKIP) v = a.a_log[i - PR_ALOG];
          else if (i < PR_RELB) v = a.d_skip[i - PR_DSKIP]; else if (i < PR_RELB + 384) v = a.rel_bias[i - PR_RELB]; else if (i >= PR_FNORM) v = a.final_norm[i - PR_FNORM];
          prm[i] = v; } }
    { u32x4* z = (u32x4*)(win_t + (size_t)11296 * DM); const int n16 = 224 * DM * 2 / 16; for (int i = gw * 64 + lane; i < n16; i += NGW * 64) z[i] = (u32x4){0u, 0u, 0u, 0u}; }
    for (int m = gw; m < MT; m += NGW) {
        const float* xrow = (m < MP) ? a.x_prompt + (size_t)m * DM : a.x_sample + (size_t)(m - MP) * DM;
        const f32x4* xr = (const f32x4*)xrow + lane; const f32x4* gr = (const f32x4*)a.norm_g + lane;
        f32x4 v[4]; float s = 0.f;
#pragma unroll
        for (int j = 0; j < 4; ++j) { v[j] = xr[64 * j]; s += (v[j].x * v[j].x + v[j].y * v[j].y) + (v[j].z * v[j].z + v[j].w * v[j].w); }
        const float rstd = rsqrtf(wave_sum(s) * (1.f / DM) + 1e-6f);
        unsigned long long* o8 = (unsigned long long*)(hb + (size_t)m * DM) + lane;
#pragma unroll
        for (int j = 0; j < 4; ++j) { const f32x4 g = gr[64 * j]; o8[64 * j] = (unsigned long long)pk2(v[j].x * rstd * g.x, v[j].y * rstd * g.y) | ((unsigned long long)pk2(v[j].z * rstd * g.z, v[j].w * rstd * g.w) << 32); }
    }
}

template <bool SAMP> __device__ __forceinline__ const void* kv_ptr(const Args& a, const bf16* proj, int colkv, const float* cache, int seq, int tpos, int off, int h, bool& valid, bool& isf32) {
    if (!SAMP) { const int kt = tpos - off; valid = kt >= 0; isf32 = false; return proj + (size_t)(seq * SEQ + (valid ? kt : 0)) * NPROJ + colkv + h * HD; }
    const int idx = KVB + tpos - off; valid = true;
    if (idx >= KVB) { isf32 = false; return proj + (size_t)(MP + seq * DECS + (idx - KVB)) * NPROJ + colkv + h * HD; }
    isf32 = true; return cache + ((size_t)(seq * KVB + idx) * NH + h) * HD;
}
template <bool SAMP> __device__ __forceinline__ void attn_slow_item(const Args& a, const bf16* proj, bf16* ya, LAS float* sl, int row, int h, int lane) {
    const float* prm = (const float*)(a.ws + WS_PRM);
    const int seq = SAMP ? (row - MP) / DECS : row / SEQ, tpos = SAMP ? (row - MP) % DECS : row % SEQ;
    float q[64];
    { const u32x4* qp = (const u32x4*)(proj + (size_t)row * NPROJ + C_Q + h * HD);
#pragma unroll
      for (int i = 0; i < 8; ++i) { const u32x4 w = qp[i]; q[8 * i + 0] = __uint_as_float(w.x << 16); q[8 * i + 1] = __uint_as_float(w.x & 0xffff0000u); q[8 * i + 2] = __uint_as_float(w.y << 16); q[8 * i + 3] = __uint_as_float(w.y & 0xffff0000u);
          q[8 * i + 4] = __uint_as_float(w.z << 16); q[8 * i + 5] = __uint_as_float(w.z & 0xffff0000u); q[8 * i + 6] = __uint_as_float(w.w << 16); q[8 * i + 7] = __uint_as_float(w.w & 0xffff0000u); } }
    float mx = -INFINITY;
#pragma unroll 1
    for (int e = lane; e < 387; e += 64) {
        float sc = -INFINITY;
        const int g = e / 129, j = e - g * 129, off = j << (2 * g); bool valid, isf32;
        const void* kp = kv_ptr<SAMP>(a, proj, C_K, a.cache_k, seq, tpos, off, h, valid, isf32);
        if (valid) { float d = 0.f;
            if (isf32) { const f32x4* k4 = (const f32x4*)kp;
#pragma unroll
                for (int i = 0; i < 16; ++i) { const f32x4 kk = k4[i]; d += q[4 * i] * kk.x + q[4 * i + 1] * kk.y + q[4 * i + 2] * kk.z + q[4 * i + 3] * kk.w; } }
            else { const u32x4* k4 = (const u32x4*)kp;
#pragma unroll
                for (int i = 0; i < 8; ++i) { const u32x4 w = k4[i];
                    d += q[8 * i + 0] * __uint_as_float(w.x << 16) + q[8 * i + 1] * __uint_as_float(w.x & 0xffff0000u) + q[8 * i + 2] * __uint_as_float(w.y << 16) + q[8 * i + 3] * __uint_as_float(w.y & 0xffff0000u)
                       + q[8 * i + 4] * __uint_as_float(w.z << 16) + q[8 * i + 5] * __uint_as_float(w.z & 0xffff0000u) + q[8 * i + 6] * __uint_as_float(w.w << 16) + q[8 * i + 7] * __uint_as_float(w.w & 0xffff0000u); } }
            sc = d * 0.125f + prm[PR_RELB + t5_bucket(off) * NH + h]; }
        sl[e] = sc; mx = fmaxf(mx, sc);
    }
    mx = wave_max(mx);
    float sum = 0.f;
#pragma unroll 1
    for (int e = lane; e < 387; e += 64) { const float sc = sl[e]; const float pe = (sc == -INFINITY) ? 0.f : __expf(sc - mx); sl[e] = pe; sum += pe; }
    sum = wave_sum(sum);
    LDS_WAIT(); asm volatile("" ::: "memory");
    float o = 0.f;
#pragma unroll 4
    for (int e = 0; e < 387; ++e) {
        const int g = e / 129, j = e - g * 129, off = j << (2 * g); bool valid, isf32;
        const void* vp = kv_ptr<SAMP>(a, proj, C_V, a.cache_v, seq, tpos, off, h, valid, isf32);
        const float pe = sl[e];
        if (valid) { const float vv = isf32 ? ((const float*)vp)[lane] : bf2f(((const bf16*)vp)[lane]); o += pe * vv; }
    }
    LDS_WAIT(); asm volatile("" ::: "memory");
    const float gv = bf2f(proj[(size_t)row * NPROJ + C_G + h * HD + lane]);
    ya[(size_t)row * DA + h * HD + lane] = (bf16)f2bf(o / sum * siluf_(gv));
}

__device__ __forceinline__ void ssd_slow_item(const Args& a, LAS unsigned char* lds, int item) {
    const bf16* proj = (const bf16*)(a.ws + WS_PROJ); const float* dtb = (const float*)(a.ws + WS_DT); bf16* ys = (bf16*)(a.ws + WS_YS); float* ssq = (float*)(a.ws + WS_SSQ);
    const int tid = threadIdx.x, lane = tid & 63, wid = tid >> 6;
    const bool samp = item >= NBATCH * NSH; const int it2 = samp ? item - NBATCH * NSH : item; const int sq = it2 / NSH, hd = it2 % NSH, grp = hd / 4;
    const int L = samp ? DECS : SEQ, row0 = samp ? MP + sq * DECS : sq * SEQ;
    const int p = tid >> 3, n0 = (tid & 7) * 16;
    float h[16];
    if (samp) { const f32x4* s4 = (const f32x4*)(a.state_ssm + ((size_t)(sq * NSH + hd) * SHD + p) * DST + n0);
#pragma unroll
        for (int j = 0; j < 4; ++j) { const f32x4 v = s4[j]; h[4 * j] = v.x; h[4 * j + 1] = v.y; h[4 * j + 2] = v.z; h[4 * j + 3] = v.w; } }
    else {
#pragma unroll
        for (int j = 0; j < 16; ++j) h[j] = 0.f; }
    const float* prm = (const float*)(a.ws + WS_PRM);
    const float Aneg = -__expf(prm[PR_ALOG + hd]), Dk = prm[PR_DSKIP + hd];
    LAS float* xs = (LAS float*)lds;
    LAS float* Bs = xs + 64 * 64;
    LAS float* Cs = Bs + 64 * 128;
    LAS float* dts = Cs + 64 * 128;
    LAS float* dAs = dts + 64;
    LAS float* yb = dAs + 64;
    for (int c0 = 0; c0 < L; c0 += 64) {
        const int tc = (L - c0) < 64 ? (L - c0) : 64;
        for (int idx = tid; idx < tc * 320; idx += NTHR) {
            const int t = idx / 320, c = idx - t * 320;
            const int xc = c < 64 ? hd * 64 + c : (c < 192 ? DSSM + grp * DST + (c - 64) : DSSM + NGRP * DST + grp * DST + (c - 192));
            float acc = prm[PR_CONVB + xc];
#pragma unroll
            for (int tap = 0; tap < 4; ++tap) { const int tt = c0 + t - 3 + tap; float v;
                if (tt >= 0) v = bf2f(proj[(size_t)(row0 + tt) * NPROJ + C_XBC + xc]);
                else v = samp ? a.state_conv[(size_t)(sq * 3 + 3 + tt) * DCONV + xc] : 0.f;
                acc += prm[PR_CONVW + tap * DCONV + xc] * v; }
            const float val = siluf_(acc);
            if (c < 64) xs[t * 64 + c] = val; else if (c < 192) Bs[t * 128 + (c - 64)] = val; else Cs[t * 128 + (c - 192)] = val;
        }
        if (tid < tc) { const float dtv = dtb[(size_t)(row0 + c0 + tid) * 32 + hd]; dts[tid] = dtv; dAs[tid] = __expf(dtv * Aneg); }
        __syncthreads();
        for (int t = 0; t < tc; ++t) {
            const float dA = dAs[t], xv = xs[t * 64 + p], dtx = dts[t] * xv; float acc = 0.f;
            const LAS f32x4* b4 = (const LAS f32x4*)(Bs + t * 128 + n0); const LAS f32x4* c4 = (const LAS f32x4*)(Cs + t * 128 + n0);
#pragma unroll
            for (int j = 0; j < 4; ++j) { const f32x4 bb = b4[j], cc = c4[j];
                h[4 * j] = dA * h[4 * j] + dtx * bb.x; h[4 * j + 1] = dA * h[4 * j + 1] + dtx * bb.y; h[4 * j + 2] = dA * h[4 * j + 2] + dtx * bb.z; h[4 * j + 3] = dA * h[4 * j + 3] + dtx * bb.w;
                acc += h[4 * j] * cc.x + h[4 * j + 1] * cc.y + h[4 * j + 2] * cc.z + h[4 * j + 3] * cc.w; }
            acc += __shfl_xor(acc, 1); acc += __shfl_xor(acc, 2); acc += __shfl_xor(acc, 4);
            if ((tid & 7) == 0) yb[t * 64 + p] = acc + Dk * xv;
        }
        __syncthreads();
        for (int t = wid; t < tc; t += NWAVES) {
            const int row = row0 + c0 + t; const float z = bf2f(proj[(size_t)row * NPROJ + C_Z + hd * 64 + lane]);
            const float val = yb[t * 64 + lane] * siluf_(z);
            ys[(size_t)row * DSSM + hd * 64 + lane] = (bf16)f2bf(val);
            const float ss = wave_sum(val * val); if (lane == 0) ssq[(size_t)row * NSH + hd] = ss;
        }
        __syncthreads();
    }
    float* dst = a.out + (samp ? O_SS : O_SP) + ((size_t)(sq * NSH + hd) * SHD + p) * DST + n0;
#pragma unroll
    for (int j = 0; j < 4; ++j) ((f32x4*)dst)[j] = (f32x4){h[4 * j], h[4 * j + 1], h[4 * j + 2], h[4 * j + 3]};
}

__device__ __forceinline__ void p2_ssd_prompt(const Args& a, LAS unsigned char* lds, int G, int wave, int lane) {
    for (int item = blockIdx.x; item < NBATCH * NSH; item += G) ssd_mfma_unit(a.ws, a.probe ? (float*)(a.ws + WS_TMP) - O_SP : a.out, a.probe ? (bf16*)(a.ws + WS_MRG) - 0 : (bf16*)(a.ws + WS_YS), a.probe ? (float*)(a.ws + WS_SSQ) + (size_t)MT * NSH : (float*)(a.ws + WS_SSQ), a.probe, lds, item / NSH, item % NSH, wave, lane);
}
__device__ __forceinline__ void p2_ssd_sample(const Args& a, LAS unsigned char* lds, int G) {
    for (int item = NBATCH * NSH + blockIdx.x; item < NBATCH * NSH + DECB * NSH; item += G) ssd_slow_item(a, lds, item);
}
__device__ __forceinline__ void p2_attn_prompt(const Args& a, LAS unsigned char* lds, int G, int wave, int lane) {
    for (int k = 0; ; ++k) { const int v = (G == 256) ? (k < 3 ? (int)((blockIdx.x % 8) * 96 + (blockIdx.x / 8) + 32 * k) : 768) : (int)(blockIdx.x + k * G); if (v >= 768) break;
        const int bh = v >> 3, sb = v & 7; attn_unit(a.ws, lds, bh / NH, bh % NH, sb * 256, wave, lane); }
}
__device__ __forceinline__ void p2_attn_sample(const Args& a, LAS unsigned char* lds, int G, int wave, int lane) {
    const bf16* proj = (const bf16*)(a.ws + WS_PROJ);
    for (int u = blockIdx.x; u < DECB * NH; u += G) attn_sample_unit(a.ws, a.cache_k, a.cache_v, lds, u / NH, u % NH, wave, lane);
    const int gt = blockIdx.x * NTHR + threadIdx.x, NGT = G * NTHR;
    for (int i = gt; i < (NBATCH + DECB) * 3 * DCONV; i += NGT) { const int c = i % DCONV, r = (i / DCONV) % 3, sq = i / (3 * DCONV);
        if (sq < NBATCH) a.out[O_CP + (size_t)(sq * 3 + r) * DCONV + c] = bf2f(proj[(size_t)(sq * SEQ + SEQ - 3 + r) * NPROJ + C_XBC + c]);
        else { const int s2 = sq - NBATCH; a.out[O_CS + (size_t)(s2 * 3 + r) * DCONV + c] = bf2f(proj[(size_t)(MP + s2 * DECS + DECS - 3 + r) * NPROJ + C_XBC + c]); } }
}
__device__ __forceinline__ void p25_norm(const Args& a, int gw, int NGW, int lane) {
    bf16* ys = (bf16*)(a.ws + WS_YS); const float* ssq = (const float*)(a.ws + WS_SSQ);
    for (int m = gw; m < MT; m += NGW) {
        const float sv = (lane < 32) ? ssq[(size_t)m * NSH + lane] : 0.f;
        float gs = sv + __shfl_xor(sv, 1); gs += __shfl_xor(gs, 2);
        const float rstd = rsqrtf(gs * (1.f / 256.f) + 1e-5f);
        u32x4* r4 = (u32x4*)(ys + (size_t)m * DSSM);
#pragma unroll
        for (int j = 0; j < 4; ++j) { const int ci = j * 64 + lane, g = ci >> 5; const float sc = __shfl(rstd, 4 * g); u32x4 w = r4[ci];
            w.x = pk2(__uint_as_float(w.x << 16) * sc, __uint_as_float(w.x & 0xffff0000u) * sc); w.y = pk2(__uint_as_float(w.y << 16) * sc, __uint_as_float(w.y & 0xffff0000u) * sc);
            w.z = pk2(__uint_as_float(w.z << 16) * sc, __uint_as_float(w.z & 0xffff0000u) * sc); w.w = pk2(__uint_as_float(w.w << 16) * sc, __uint_as_float(w.w & 0xffff0000u) * sc); r4[ci] = w; }
    }
}
__device__ __forceinline__ void p5_final_norm(const Args& a, int gw, int NGW, int lane) {
    for (int m = gw; m < MT; m += NGW) {
        f32x4* xr = (f32x4*)(a.out + (size_t)m * DM) + lane; const f32x4* gr = (const f32x4*)((const float*)(a.ws + WS_PRM) + PR_FNORM) + lane;
        f32x4 v[4]; float s = 0.f;
#pragma unroll
        for (int j = 0; j < 4; ++j) { v[j] = xr[64 * j]; s += (v[j].x * v[j].x + v[j].y * v[j].y) + (v[j].z * v[j].z + v[j].w * v[j].w); }
        const float rstd = rsqrtf(wave_sum(s) * (1.f / DM) + 1e-6f);
#pragma unroll
        for (int j = 0; j < 4; ++j) { const f32x4 g = gr[64 * j]; xr[64 * j] = v[j] * rstd * g; }
    }
}
#define GEMM_PHASE(EpiT, Aptr, Bptr, Mrows, Ncols, Kdim, Eobj) do { pg8::Gemm g_{(const pg8::bf16_t*)(Aptr), (const pg8::bf16_t*)(Bptr), (Mrows), (Ncols), (Kdim)}; pg8::StaticOrder S_; S_.init((Mrows), (Ncols), G, (int)blockIdx.x); \
    pg8::gemm_phase<EpiT, pg8::StaticOrder, true, true>(lds, g_, S_, (Eobj)); } while (0)

constexpr int NPHASE = 10;
__global__ void __launch_bounds__(NTHR, 2) fwd_megakernel(Args a) {
    extern __shared__ __attribute__((aligned(16))) unsigned char lds_raw[];
    LAS unsigned char* lds = (LAS unsigned char*)lds_raw;
    cg::grid_group grid = cg::this_grid();
    const int tid = threadIdx.x, lane = tid & 63, wave = __builtin_amdgcn_readfirstlane(tid >> 6);
    const int G = gridDim.x, gw = blockIdx.x * NWAVES + wave, NGW = G * NWAVES;
    unsigned char* ws = a.ws;

#define IN(k) (a.ph_lo <= (k) && (k) < a.ph_hi)
#define SEAM(k) do { if (IN(k) && IN((k) + 1)) grid.sync(); } while (0)
    if (IN(0)) {
        p0_prologue(a, lds, gw, NGW, wave, lane);
        if (blockIdx.x == 0 && tid == 0) { const float** pp = (const float**)(ws + WS_ARGS); pp[0] = a.x_prompt; pp[1] = a.x_sample; pp[2] = a.cache_k; pp[3] = a.cache_v; pp[4] = a.state_conv; pp[5] = a.state_ssm; }
    }
    SEAM(0);
    if (IN(1)) { pg8::EpiInProj E{(pg8::bf16_t*)(ws + WS_PROJ), (float*)(ws + WS_DT), (const float*)(ws + WS_PRM) + PR_DTB, a.out + O_KP, a.out + O_VP, a.out + O_KS, a.out + O_VS};
      GEMM_PHASE(pg8::EpiInProj, ws + WS_HB, ws + WS_WIN, MT, NPAD, DM, E); }
    SEAM(1);
    if (IN(2)) { Args b{}; b.ws = ws; b.out = a.out; b.probe = a.probe; p2_ssd_prompt(b, lds, G, wave, lane); }
    if (IN(3)) { Args b{}; b.ws = ws; b.out = a.out; b.state_conv = ld_ptr(ws, 4); b.state_ssm = ld_ptr(ws, 5); p2_ssd_sample(b, lds, G); }
    if (IN(4)) { Args b{}; b.ws = ws; b.out = a.out; p2_attn_prompt(b, lds, G, wave, lane); }
    if (IN(5)) { Args b{}; b.ws = ws; b.out = a.out; b.cache_k = ld_ptr(ws, 2); b.cache_v = ld_ptr(ws, 3); p2_attn_sample(b, lds, G, wave, lane); }
    SEAM(5);
    if (IN(6)) p25_norm(a, gw, NGW, lane);
    SEAM(6);
    if (IN(7)) {
    { pg8::EpiGateA E{(const pg8::bf16_t*)(ws + WS_PROJ), (float*)(ws + WS_TMP)}; GEMM_PHASE(pg8::EpiGateA, ws + WS_YA, ws + WS_WA, MT, DM, DA, E); }
    { pg8::EpiGateB E{(const pg8::bf16_t*)(ws + WS_PROJ), (const float*)(ws + WS_TMP), (pg8::bf16_t*)(ws + WS_MRG)}; GEMM_PHASE(pg8::EpiGateB, ws + WS_YS, ws + WS_WB, MT, DM, DSSM, E); }
    }
    SEAM(7);
    if (IN(8)) { pg8::EpiOut E{ld_ptr(ws, 0), ld_ptr(ws, 1), a.out + O_YP}; GEMM_PHASE(pg8::EpiOut, ws + WS_MRG, ws + WS_WO, MT, DM, DM, E); }
    SEAM(8);
    if (IN(9)) p5_final_norm(a, gw, NGW, lane);
#undef IN
#undef SEAM
}

extern "C" void kernel_launch(void* const* d_in, const int* in_sizes, int n_in, void* d_out, int out_size, void* d_ws, size_t ws_size, hipStream_t stream) {
    static int grid_blocks = 0;
    if (grid_blocks == 0) {
        if (n_in != 19 || (size_t)out_size != O_END || ws_size < WS_END) { fprintf(stderr, "kernel_launch: unexpected shapes: n_in %d out %d (want %zu) ws %zu (want >= %zu)\n", n_in, out_size, (size_t)O_END, ws_size, (size_t)WS_END); grid_blocks = -1; return; }
        int dev = 0, cus = 0, per_cu = 0;
        hipGetDevice(&dev); hipDeviceGetAttribute(&cus, hipDeviceAttributeMultiprocessorCount, dev);
        if (hipFuncSetAttribute((const void*)fwd_megakernel, hipFuncAttributeMaxDynamicSharedMemorySize, LDS_BYTES) != hipSuccess) { fprintf(stderr, "kernel_launch: hipFuncSetAttribute failed\n"); grid_blocks = -1; return; }
        if (hipOccupancyMaxActiveBlocksPerMultiprocessor(&per_cu, (const void*)fwd_megakernel, NTHR, LDS_BYTES) != hipSuccess || per_cu < 1) { fprintf(stderr, "kernel_launch: occupancy query failed (%d)\n", per_cu); (void)hipGetLastError(); per_cu = 1; }
        if (per_cu > 1) per_cu = 1;
        grid_blocks = cus * per_cu;
        fprintf(stderr, "kernel_launch: grid %d (cus %d)\n", grid_blocks, cus);
    }
    if (grid_blocks < 0) return;
    Args a{};
    a.x_prompt = (const float*)d_in[0]; a.x_sample = (const float*)d_in[1]; a.cache_k = (const float*)d_in[2]; a.cache_v = (const float*)d_in[3]; a.state_conv = (const float*)d_in[4]; a.state_ssm = (const float*)d_in[5];
    a.norm_g = (const float*)d_in[6]; a.w_in = (const float*)d_in[7]; a.conv_w = (const float*)d_in[8]; a.conv_b = (const float*)d_in[9]; a.dt_bias = (const float*)d_in[10]; a.a_log = (const float*)d_in[11];
    a.d_skip = (const float*)d_in[12]; a.ssm_norm = (const float*)d_in[13]; a.w_a = (const float*)d_in[14]; a.w_b = (const float*)d_in[15]; a.w_out = (const float*)d_in[16]; a.rel_bias = (const float*)d_in[17]; a.final_norm = (const float*)d_in[18];
    a.out = (float*)d_out; a.ws = (unsigned char*)d_ws;
#ifndef PROBE_LO
    const int ranges[1][2] = {{0, NPHASE}}; const int nr = 1;
#else
    const int ranges[2][2] = {{0, NPHASE}, {PROBE_LO, PROBE_HI}}; const int nr = 2;
#endif
    for (int r = 0; r < nr; ++r) {
        a.ph_lo = ranges[r][0]; a.ph_hi = ranges[r][1];
#ifdef PROBE_FLAGS
        a.probe = r ? PROBE_FLAGS : 0;
#endif
        void* args[] = {&a};
        hipError_t e = hipLaunchCooperativeKernel((const void*)fwd_megakernel, dim3(grid_blocks), dim3(NTHR), args, LDS_BYTES, stream);
        if (e != hipSuccess) fprintf(stderr, "kernel_launch: cooperative launch failed: %s (grid %d)\n", hipGetErrorString(e), grid_blocks);
    }
}
```

```cpp
#include <hip/hip_runtime.h>
#include <hip/hip_cooperative_groups.h>
#include <cstdio>
#include <cstdint>
namespace cg = cooperative_groups;
namespace pg8 {
#define PG8_LAS __attribute__((address_space(3)))
typedef unsigned short bf16_t;
typedef short bf16x8 __attribute__((ext_vector_type(8)));
typedef float f32x4 __attribute__((ext_vector_type(4)));
typedef unsigned u32x4 __attribute__((ext_vector_type(4)));
constexpr int BM = 256, BK = 64, HALF = 128, HTB = HALF * BK * 2  , STAGE_BYTES = 8 * HTB, NXCD = 8, WGM = 8;

__host__ __device__ __forceinline__ int lds_byte(int r, int c) { const int st = (r >> 4) * 2 + (c >> 5), rr = r & 15, cc = c & 31, ob = rr * 64 + cc * 2; return st * 1024 + (ob ^ (((ob >> 9) & 1) << 5)); }
__host__ __device__ __forceinline__ void stage_rc(int b, int& R, int& C) { const int st = b / 1024, sb = b % 1024, swz = sb ^ (((sb >> 9) & 1) << 5); R = (st >> 1) * 16 + swz / 64; C = (st & 1) * 32 + (swz % 64) / 2; }
__host__ __device__ __forceinline__ int perm32(int rho) { const int n = rho >> 4, i = rho & 15; return 8 * (i >> 2) + 4 * n + (i & 3); }

struct Unit { int pm, pn; };
struct Gemm { const bf16_t* A; const bf16_t* Bt; int M, N, K; };

struct StaticOrder {
    int nM, nN, nwg, G, c;
    __host__ __device__ void init(int M, int N, int G_, int c_) { nM = M / BM; nN = N / BM; nwg = nM * nN; G = G_; c = c_; }
    __host__ __device__ bool next(int i, Unit& u) const {
        const long L = (long)i * G + c; if (L >= nwg) return false;
        int wgid = (int)L; { const int q = nwg / NXCD, r = nwg % NXCD, xcd = wgid % NXCD, off = wgid / NXCD; wgid = (xcd < r ? xcd * (q + 1) : r * (q + 1) + (xcd - r) * q) + off; }
        const int nig = WGM * nN, gid = wgid / nig, fm = gid * WGM, gsz = (nM - fm) < WGM ? (nM - fm) : WGM;
        u.pm = fm + ((wgid % nig) % gsz); u.pn = (wgid % nig) / gsz; return true;
    }
    __device__ __forceinline__ void a_ready(const Unit&) const {}
    __device__ __forceinline__ void done(const Unit&) const {}
};

__device__ __forceinline__ unsigned cvt_pk_bf16(float lo, float hi) { unsigned r; asm volatile("v_cvt_pk_bf16_f32 %0, %1, %2" : "=v"(r) : "v"(lo), "v"(hi)); return r; }
__device__ __forceinline__ float e_bf2f(unsigned short b) { return __uint_as_float(((unsigned)b) << 16); }
__device__ __forceinline__ float e_sigmoid(float x) { return 1.f / (1.f + __expf(-x)); }
__device__ __forceinline__ float e_softplus(float x) { return fmaxf(x, 0.f) + log1pf(__expf(-fabsf(x))); }

struct EpiInProj {
    static constexpr bool PERM = true, AFTER_DRAIN = false;
    bf16_t* proj; float* dt; const float* dt_bias; float* kp; float* vp; float* ks; float* vs;
    __device__ __forceinline__ void operator()(const f32x4 (&acc)[2][2][4][2], const Unit& u, int wr, int wc, int fr, int fq) const {
        const int row0 = u.pm * BM + wr * 64 + fr;
        if (u.pn < 44) {
            const int col0 = u.pn * BM + wc * 32 + 8 * fq;
            const bool isk = (u.pn >= 3 && u.pn < 6), isv = (u.pn >= 6 && u.pn < 9);
#pragma unroll
            for (int ai = 0; ai < 2; ++ai)
#pragma unroll
                for (int m = 0; m < 4; ++m) { const int row = row0 + ai * HALF + m * 16; bf16_t* rowp = proj + (size_t)row * 11264 + col0;
#pragma unroll
                    for (int bj = 0; bj < 2; ++bj) { const f32x4 v0 = acc[ai][bj][m][0], v1 = acc[ai][bj][m][1];
                        u32x4 w; w.x = cvt_pk_bf16(v0[0], v0[1]); w.y = cvt_pk_bf16(v0[2], v0[3]); w.z = cvt_pk_bf16(v1[0], v1[1]); w.w = cvt_pk_bf16(v1[2], v1[3]);
                        *(u32x4*)(rowp + bj * HALF) = w;
                        if (isk || isv) { const int c = col0 + bj * HALF - (isk ? 768 : 1536);
                            float* dst = (u.pm < 64) ? ((isk ? kp : vp) + (size_t)row * 768 + c) : ((isk ? ks : vs) + (size_t)(row - 16384) * 768 + c);
                            *(f32x4*)dst = v0; *(f32x4*)(dst + 4) = v1; } } }
        } else if (wc == 0) {
            const f32x4 b0 = *(const f32x4*)(dt_bias + 8 * fq), b1 = *(const f32x4*)(dt_bias + 8 * fq + 4);
#pragma unroll
            for (int ai = 0; ai < 2; ++ai)
#pragma unroll
                for (int m = 0; m < 4; ++m) { const int row = row0 + ai * HALF + m * 16; const f32x4 v0 = acc[ai][0][m][0] + b0, v1 = acc[ai][0][m][1] + b1;
                    f32x4 o0, o1;
#pragma unroll
                    for (int j = 0; j < 4; ++j) { o0[j] = e_softplus(v0[j]); o1[j] = e_softplus(v1[j]); }
                    float* dst = dt + (size_t)row * 32 + 8 * fq; *(f32x4*)dst = o0; *(f32x4*)(dst + 4) = o1; }
        }
    }
};
struct EpiGateA {
    static constexpr bool PERM = true, AFTER_DRAIN = false;
    const bf16_t* proj; float* tmp;
    __device__ __forceinline__ void operator()(const f32x4 (&acc)[2][2][4][2], const Unit& u, int wr, int wc, int fr, int fq) const {
        const int row0 = u.pm * BM + wr * 64 + fr, col0 = u.pn * BM + wc * 32 + 8 * fq;
#pragma unroll
        for (int ai = 0; ai < 2; ++ai)
#pragma unroll
            for (int m = 0; m < 4; ++m) { const int row = row0 + ai * HALF + m * 16;
#pragma unroll
                for (int bj = 0; bj < 2; ++bj) { const int c = col0 + bj * HALF; const u32x4 g = *(const u32x4*)(proj + (size_t)row * 11264 + 9216 + c);
                    const f32x4 v0 = acc[ai][bj][m][0], v1 = acc[ai][bj][m][1]; f32x4 o0, o1;
                    o0[0] = e_sigmoid(__uint_as_float(g.x << 16)) * v0[0]; o0[1] = e_sigmoid(__uint_as_float(g.x & 0xffff0000u)) * v0[1];
                    o0[2] = e_sigmoid(__uint_as_float(g.y << 16)) * v0[2]; o0[3] = e_sigmoid(__uint_as_float(g.y & 0xffff0000u)) * v0[3];
                    o1[0] = e_sigmoid(__uint_as_float(g.z << 16)) * v1[0]; o1[1] = e_sigmoid(__uint_as_float(g.z & 0xffff0000u)) * v1[1];
                    o1[2] = e_sigmoid(__uint_as_float(g.w << 16)) * v1[2]; o1[3] = e_sigmoid(__uint_as_float(g.w & 0xffff0000u)) * v1[3];
                    float* dst = tmp + (size_t)row * 1024 + c; *(f32x4*)dst = o0; *(f32x4*)(dst + 4) = o1; } }
    }
};
struct EpiGateB {
    static constexpr bool PERM = true, AFTER_DRAIN = false;
    const bf16_t* proj; const float* tmp; bf16_t* mrg;
    __device__ __forceinline__ void operator()(const f32x4 (&acc)[2][2][4][2], const Unit& u, int wr, int wc, int fr, int fq) const {
        const int row0 = u.pm * BM + wr * 64 + fr, col0 = u.pn * BM + wc * 32 + 8 * fq;
#pragma unroll
        for (int ai = 0; ai < 2; ++ai)
#pragma unroll
            for (int m = 0; m < 4; ++m) { const int row = row0 + ai * HALF + m * 16;
#pragma unroll
                for (int bj = 0; bj < 2; ++bj) { const int c = col0 + bj * HALF; const u32x4 g = *(const u32x4*)(proj + (size_t)row * 11264 + 10240 + c);
                    const float* src = tmp + (size_t)row * 1024 + c; const f32x4 t0 = *(const f32x4*)src, t1 = *(const f32x4*)(src + 4);
                    const f32x4 v0 = acc[ai][bj][m][0], v1 = acc[ai][bj][m][1]; f32x4 o0, o1;
                    o0[0] = t0[0] + e_sigmoid(__uint_as_float(g.x << 16)) * v0[0]; o0[1] = t0[1] + e_sigmoid(__uint_as_float(g.x & 0xffff0000u)) * v0[1];
                    o0[2] = t0[2] + e_sigmoid(__uint_as_float(g.y << 16)) * v0[2]; o0[3] = t0[3] + e_sigmoid(__uint_as_float(g.y & 0xffff0000u)) * v0[3];
                    o1[0] = t1[0] + e_sigmoid(__uint_as_float(g.z << 16)) * v1[0]; o1[1] = t1[1] + e_sigmoid(__uint_as_float(g.z & 0xffff0000u)) * v1[1];
                    o1[2] = t1[2] + e_sigmoid(__uint_as_float(g.w << 16)) * v1[2]; o1[3] = t1[3] + e_sigmoid(__uint_as_float(g.w & 0xffff0000u)) * v1[3];
                    u32x4 w; w.x = cvt_pk_bf16(o0[0], o0[1]); w.y = cvt_pk_bf16(o0[2], o0[3]); w.z = cvt_pk_bf16(o1[0], o1[1]); w.w = cvt_pk_bf16(o1[2], o1[3]);
                    *(u32x4*)(mrg + (size_t)row * 1024 + c) = w; } }
    }
};
struct EpiOut {
    static constexpr bool PERM = false, AFTER_DRAIN = false;
    const float* xp; const float* xs; float* out;
    __device__ __forceinline__ void operator()(const f32x4 (&acc)[2][2][4][2], const Unit& u, int wr, int wc, int fr, int fq) const {
        const int row0 = u.pm * BM + wr * 64 + fr, col0 = u.pn * BM + wc * 32 + 4 * fq;
#pragma unroll
        for (int ai = 0; ai < 2; ++ai)
#pragma unroll
            for (int m = 0; m < 4; ++m) { const int row = row0 + ai * HALF + m * 16;
                const float* xr = (u.pm < 64) ? xp + (size_t)row * 1024 : xs + (size_t)(row - 16384) * 1024; float* orow = out + (size_t)row * 1024;
#pragma unroll
                for (int bj = 0; bj < 2; ++bj)
#pragma unroll
                    for (int n = 0; n < 2; ++n) { const int c = col0 + bj * HALF + n * 16; *(f32x4*)(orow + c) = *(const f32x4*)(xr + c) + acc[ai][bj][m][n]; } }
    }
};

template <class Epi, class Sched, bool ALIGN_EPI = false, bool SP2 = false>
__device__ __forceinline__ void gemm_phase(PG8_LAS unsigned char* lds, const Gemm g, const Sched& S, const Epi& E) {
    int tid_ = threadIdx.x; asm volatile("" : "+v"(tid_));
    const int tid = tid_, wid = __builtin_amdgcn_readfirstlane(tid >> 6), lane = tid & 63, wr = wid >> 2, wc = wid & 3, fr = lane & 15, fq = lane >> 4;
    const int K = g.K, nt = K / BK;
    unsigned voffA[2], voffB[2];
#pragma unroll
    for (int i = 0; i < 2; ++i) { int R, C; stage_rc(tid * 16 + i * 8192, R, C); const int Rb = Epi::PERM ? ((R & ~31) + perm32(R & 31)) : R;
        voffA[i] = (unsigned)(R * K + C) * 2u; voffB[i] = (unsigned)(Rb * K + C) * 2u; }
    const size_t kstep = (size_t)(BK * 2);
    const size_t hstep = (size_t)HALF * K * 2;
    const size_t tstep = 2 * hstep;
    const unsigned ldsw = (unsigned)wid * 1024u;
    const int aoff = lds_byte(wr * 64 + fr, fq * 8), boff = lds_byte(wc * 32 + fr, fq * 8);
#define PG8_SA(b, h) (((b) * 2 + (h)) * HTB)
#define PG8_SB(b, h) ((4 + (b) * 2 + (h)) * HTB)
#define PG8_STAGE(bufoff, gbase, voff) do { _Pragma("unroll") for (int _i = 0; _i < 2; ++_i) \
        __builtin_amdgcn_global_load_lds((const unsigned*)((const char*)(gbase) + (voff)[_i]), (PG8_LAS unsigned*)(lds + (bufoff) + ldsw + _i * 8192), 16, 0, 0); } while (0)
#define PG8_LDA(dst, b, h) do { _Pragma("unroll") for (int m = 0; m < 4; ++m) _Pragma("unroll") for (int k = 0; k < 2; ++k) dst[m][k] = *(const PG8_LAS bf16x8*)(lds + PG8_SA(b, h) + aoff + m * 2048 + k * 1024); } while (0)
#define PG8_LDB(dst, b, h) do { _Pragma("unroll") for (int n = 0; n < 2; ++n) _Pragma("unroll") for (int k = 0; k < 2; ++k) dst[n][k] = *(const PG8_LAS bf16x8*)(lds + PG8_SB(b, h) + boff + n * 2048 + k * 1024); } while (0)
#define PG8_MMA(ai, bj, At, Bt) do { __builtin_amdgcn_s_setprio(1); _Pragma("unroll") for (int m = 0; m < 4; ++m) _Pragma("unroll") for (int n = 0; n < 2; ++n) _Pragma("unroll") for (int k = 0; k < 2; ++k) \
        acc[ai][bj][m][n] = __builtin_amdgcn_mfma_f32_16x16x32_bf16(Bt[n][k], At[m][k], acc[ai][bj][m][n], 0, 0, 0); __builtin_amdgcn_s_setprio(0); } while (0)
#define PG8_WAIT_V(n) asm volatile("s_waitcnt vmcnt(" #n ")" ::: "memory")
#define PG8_WAIT_L(n) asm volatile("s_waitcnt lgkmcnt(" #n ")" ::: "memory")
#define PG8_BAR __builtin_amdgcn_s_barrier()
#define PG8_SCHED __builtin_amdgcn_sched_barrier(0)
    Unit cur, nxt; int ui = 0;
    if (!S.next(0, cur)) return;
    f32x4 acc[2][2][4][2];
#pragma unroll
    for (int a = 0; a < 2; ++a)
#pragma unroll
        for (int b = 0; b < 2; ++b)
#pragma unroll
            for (int m = 0; m < 4; ++m)
#pragma unroll
                for (int n = 0; n < 2; ++n) acc[a][b][m][n] = (f32x4){0.f, 0.f, 0.f, 0.f};
    bf16x8 At[4][2], B0[2][2], B1[2][2];
    const char* cA = (const char*)g.A + (size_t)cur.pm * tstep; const char* cB = (const char*)g.Bt + (size_t)cur.pn * tstep;
    S.a_ready(cur);
    if constexpr (SP2) {
        PG8_STAGE(PG8_SB(0, 0), cB, voffB); PG8_STAGE(PG8_SB(0, 1), cB + hstep, voffB); PG8_STAGE(PG8_SA(0, 0), cA, voffA); PG8_STAGE(PG8_SA(0, 1), cA + hstep, voffA);
        if (wr == 1) PG8_BAR;
        PG8_WAIT_V(2); PG8_BAR;
        PG8_STAGE(PG8_SB(1, 0), cB + kstep, voffB); PG8_STAGE(PG8_SA(1, 0), cA + kstep, voffA); PG8_STAGE(PG8_SB(1, 1), cB + hstep + kstep, voffB);
        PG8_WAIT_V(6); PG8_BAR;
    } else {
        PG8_STAGE(PG8_SB(0, 0), cB, voffB); PG8_STAGE(PG8_SA(0, 0), cA, voffA); PG8_STAGE(PG8_SB(0, 1), cB + hstep, voffB); PG8_STAGE(PG8_SA(0, 1), cA + hstep, voffA);
        if (wr == 1) PG8_BAR;
        PG8_WAIT_V(4); PG8_BAR;
        PG8_STAGE(PG8_SB(1, 0), cB + kstep, voffB); PG8_STAGE(PG8_SA(1, 0), cA + kstep, voffA); PG8_STAGE(PG8_SB(1, 1), cB + hstep + kstep, voffB);
        PG8_WAIT_V(6); PG8_BAR;
    }
    for (;;) {
        const bool has_next = S.next(ui + 1, nxt);
        const char* nA = has_next ? (const char*)g.A + (size_t)nxt.pm * tstep : cA; const char* nB = has_next ? (const char*)g.Bt + (size_t)nxt.pn * tstep : cB;
        for (int t = 0; t < nt; t += 2) {
            const bool last = (t == nt - 2);
            const char* a1 = cA + (size_t)(t + 1) * kstep;
            const char* a2 = last ? nA : cA + (size_t)(t + 2) * kstep; const char* b2 = last ? nB : cB + (size_t)(t + 2) * kstep;
            const char* a3 = a2 + kstep; const char* b3 = b2 + kstep;
            if (last && has_next) S.a_ready(nxt);
            if constexpr (SP2) {
            PG8_LDB(B0, 0, 0); PG8_LDB(B1, 0, 1); PG8_SCHED; PG8_LDA(At, 0, 0); PG8_STAGE(PG8_SA(1, 1), a1 + hstep, voffA);
            PG8_WAIT_V(8); PG8_WAIT_L(0); PG8_BAR; PG8_MMA(0, 0, At, B0); PG8_MMA(0, 1, At, B1); PG8_BAR; PG8_SCHED;
            PG8_LDA(At, 0, 1); PG8_STAGE(PG8_SB(0, 0), b2, voffB); PG8_STAGE(PG8_SB(0, 1), b2 + hstep, voffB); PG8_STAGE(PG8_SA(0, 0), a2, voffA);
            PG8_WAIT_V(8); PG8_WAIT_L(0); PG8_BAR; PG8_MMA(1, 0, At, B0); PG8_MMA(1, 1, At, B1); PG8_BAR; PG8_SCHED;
            PG8_LDB(B0, 1, 0); PG8_LDB(B1, 1, 1); PG8_SCHED; PG8_LDA(At, 1, 0); PG8_STAGE(PG8_SA(0, 1), a2 + hstep, voffA);
            PG8_WAIT_V(8); PG8_WAIT_L(0); PG8_BAR; PG8_MMA(0, 0, At, B0); PG8_MMA(0, 1, At, B1); PG8_BAR; PG8_SCHED;
            PG8_LDA(At, 1, 1); PG8_STAGE(PG8_SB(1, 0), b3, voffB); PG8_STAGE(PG8_SB(1, 1), b3 + hstep, voffB); PG8_STAGE(PG8_SA(1, 0), a3, voffA);
            PG8_WAIT_V(8); PG8_WAIT_L(0); PG8_BAR; PG8_MMA(1, 0, At, B0); PG8_MMA(1, 1, At, B1); PG8_BAR; PG8_SCHED;
            } else {
            PG8_LDB(B0, 0, 0); PG8_SCHED; PG8_LDA(At, 0, 0); PG8_STAGE(PG8_SA(1, 1), a1 + hstep, voffA);
            PG8_WAIT_L(8); PG8_BAR; PG8_WAIT_L(0); PG8_MMA(0, 0, At, B0); PG8_BAR; PG8_SCHED;
            PG8_LDB(B1, 0, 1); PG8_STAGE(PG8_SB(0, 0), b2, voffB);
            PG8_BAR; PG8_WAIT_L(0); PG8_MMA(0, 1, At, B1); PG8_BAR;
            PG8_LDA(At, 0, 1); PG8_STAGE(PG8_SA(0, 0), a2, voffA);
            PG8_BAR; PG8_WAIT_L(0); PG8_MMA(1, 0, At, B0); PG8_BAR; PG8_SCHED;
            PG8_STAGE(PG8_SB(0, 1), b2 + hstep, voffB);
            PG8_WAIT_V(6); PG8_BAR; PG8_MMA(1, 1, At, B1); PG8_BAR;
            PG8_LDB(B0, 1, 0); PG8_SCHED; PG8_LDA(At, 1, 0); PG8_STAGE(PG8_SA(0, 1), a2 + hstep, voffA);
            PG8_WAIT_L(8); PG8_BAR; PG8_WAIT_L(0); PG8_MMA(0, 0, At, B0); PG8_BAR; PG8_SCHED;
            PG8_LDB(B1, 1, 1); PG8_STAGE(PG8_SB(1, 0), b3, voffB);
            PG8_BAR; PG8_WAIT_L(0); PG8_MMA(0, 1, At, B1); PG8_BAR;
            PG8_LDA(At, 1, 1); PG8_STAGE(PG8_SA(1, 0), a3, voffA);
            PG8_BAR; PG8_WAIT_L(0); PG8_MMA(1, 0, At, B0); PG8_BAR; PG8_SCHED;
            PG8_STAGE(PG8_SB(1, 1), b3 + hstep, voffB);
            PG8_WAIT_V(6); PG8_BAR; PG8_MMA(1, 1, At, B1); PG8_BAR;
            }
        }
        if constexpr (ALIGN_EPI) { if (wr == 0) PG8_BAR; }
        if constexpr (!Epi::AFTER_DRAIN) { E(acc, cur, wr, wc, fr, fq); S.done(cur); }
        if (!has_next) break;
#pragma unroll
        for (int a = 0; a < 2; ++a)
#pragma unroll
            for (int b = 0; b < 2; ++b)
#pragma unroll
                for (int m = 0; m < 4; ++m)
#pragma unroll
                    for (int n = 0; n < 2; ++n) acc[a][b][m][n] = (f32x4){0.f, 0.f, 0.f, 0.f};
        cur = nxt; cA = nA; cB = nB; ++ui;
        if constexpr (ALIGN_EPI) { if (wr == 1) PG8_BAR; }
    }
    PG8_WAIT_V(0);
    if constexpr (!ALIGN_EPI) { if (wr == 0) PG8_BAR; }
    PG8_BAR;
    if constexpr (Epi::AFTER_DRAIN) { E.fused(acc, cur, wr, wc, fr, fq, lds, wid, lane); S.done(cur); }
#undef PG8_SA
#undef PG8_SB
#undef PG8_STAGE
#undef PG8_LDA
#undef PG8_LDB
#undef PG8_MMA
#undef PG8_WAIT_V
#undef PG8_WAIT_L
#undef PG8_BAR
#undef PG8_SCHED
}
}

#define LAS __attribute__((address_space(3)))
typedef unsigned short bf16;
typedef float f32x4 __attribute__((ext_vector_type(4)));
typedef unsigned u32x4 __attribute__((ext_vector_type(4)));
typedef unsigned u32x2 __attribute__((ext_vector_type(2)));
constexpr int NWAVES = 8, NTHR = 512;
constexpr int DM = 1024, NBATCH = 8, SEQ = 2048, MP = NBATCH * SEQ, DECB = 32, DECS = 8, MS = DECB * DECS, MT = MP + MS;
constexpr int NH = 12, HD = 64, DA = NH * HD;
constexpr int DSSM = 2048, NSH = 32, SHD = 64, NGRP = 8, DST = 128, DCONV = 4096;
constexpr int PAST = 16384, KVB = 2048;
constexpr int NIN = 11296, NPROJ = 11264, NPAD = 11520;
constexpr int C_Q = 0, C_K = 768, C_V = 1536, C_G = 2304, C_Z = 3072, C_XBC = 5120, C_GA = 9216, C_GB = 10240;
constexpr size_t MiB = 1u << 20;
constexpr size_t WS_ARGS = 1 * MiB - 4096, WS_PRM = 1 * MiB, WS_WIN = 2 * MiB, WS_WA = 26 * MiB, WS_WB = 28 * MiB, WS_WO = 32 * MiB, WS_HB = 36 * MiB, WS_DT = 70 * MiB, WS_PROJ = 74 * MiB,
                 WS_YA = 432 * MiB, WS_YS = 458 * MiB, WS_SSQ = 524 * MiB, WS_TMP = 528 * MiB, WS_MRG = 594 * MiB, WS_END = 628 * MiB;
constexpr size_t O_YP = 0, O_YS = O_YP + (size_t)MP * DM, O_KP = O_YS + (size_t)MS * DM, O_VP = O_KP + (size_t)MP * DA, O_CP = O_VP + (size_t)MP * DA,
                 O_SP = O_CP + (size_t)NBATCH * 3 * DCONV, O_KS = O_SP + (size_t)NBATCH * NSH * SHD * DST, O_VS = O_KS + (size_t)MS * DA, O_CS = O_VS + (size_t)MS * DA,
                 O_SS = O_CS + (size_t)DECB * 3 * DCONV, O_END = O_SS + (size_t)DECB * NSH * SHD * DST;
constexpr int LDS_BYTES = 147456;
constexpr int PR_CONVW = 0, PR_CONVB = 16384, PR_DTB = 20480, PR_ALOG = 20512, PR_DSKIP = 20544, PR_RELB = 20576, PR_FNORM = 20992, PR_END = 22016;

struct Args {
    const float *x_prompt, *x_sample, *cache_k, *cache_v, *state_conv, *state_ssm, *norm_g, *w_in, *conv_w, *conv_b, *dt_bias, *a_log, *d_skip, *ssm_norm, *w_a, *w_b, *w_out, *rel_bias, *final_norm;
    float* out; unsigned char* ws;
    int ph_lo, ph_hi, probe, pad_;
};

__device__ __forceinline__ float bf2f(bf16 b) { return __uint_as_float(((unsigned)b) << 16); }
__device__ __forceinline__ unsigned f2bf(float f) { unsigned u = __float_as_uint(f); return (u + 0x7fffu + ((u >> 16) & 1u)) >> 16; }
typedef float f32x2_t __attribute__((ext_vector_type(2))); typedef __bf16 bf16x2_t __attribute__((ext_vector_type(2)));
__device__ __forceinline__ unsigned pk2(float lo, float hi) { const f32x2_t v = {lo, hi}; return __builtin_bit_cast(unsigned, __builtin_convertvector(v, bf16x2_t)); }
__device__ __forceinline__ float sigmoidf_(float x) { return 1.f / (1.f + __expf(-x)); }
__device__ __forceinline__ float siluf_(float x) { return x / (1.f + __expf(-x)); }
__device__ __forceinline__ float softplusf_(float x) { return fmaxf(x, 0.f) + log1pf(__expf(-fabsf(x))); }
__device__ __forceinline__ float wave_sum(float v) {
#pragma unroll
    for (int o = 1; o < 64; o <<= 1) v += __shfl_xor(v, o);
    return v;
}
__device__ __forceinline__ float wave_max(float v) {
#pragma unroll
    for (int o = 1; o < 64; o <<= 1) v = fmaxf(v, __shfl_xor(v, o));
    return v;
}
__device__ __forceinline__ int t5_bucket(int off) {
    if (off < 16) return off;
    return 16 + (off >= 22) + (off >= 30) + (off >= 40) + (off >= 54) + (off >= 73) + (off >= 99) + (off >= 134) + (off >= 182) + (off >= 246) + (off >= 332) + (off >= 450) + (off >= 609) + (off >= 825) + (off >= 1117) + (off >= 1513);
}
__device__ __forceinline__ const float* ld_ptr(const unsigned char* ws, int idx) { const unsigned long long v = ((const unsigned long long*)(ws + WS_ARGS))[idx];
    const unsigned lo = __builtin_amdgcn_readfirstlane((unsigned)v), hi = __builtin_amdgcn_readfirstlane((unsigned)(v >> 32)); return (const float*)(((unsigned long long)hi << 32) | lo); }
#define LDS_WAIT() asm volatile("s_waitcnt lgkmcnt(0)" ::: "memory")
typedef short bf16x8 __attribute__((ext_vector_type(8)));
typedef short s16x4 __attribute__((ext_vector_type(4)));
constexpr int AT_ST = 0, AT_STROW = 272, AT_ML = 69632, AT_BIAS = 71680, AT_V = 73728, AT_VROW = 144, AT_VBYTES = 32 * AT_VROW;
constexpr float LOG2E = 1.4426950408889634f;
__device__ __forceinline__ s16x4 lds_tr16(LAS const unsigned char* p) { return __builtin_bit_cast(s16x4, __builtin_amdgcn_ds_read_tr16_b64_v4i16((LAS s16x4*)p)); }

template <bool SAMP> __device__ __forceinline__ void attn_item(const bf16* base, const float* ck, const float* cv, int P0, int stride, const LAS float* bias2, LAS unsigned char* vst, int lane, float& m_out, float& l_out, f32x4 (&o)[4]) {
    const int c = lane & 15, rq = lane >> 4;
    bf16x8 qf[2];
    { int qrow = P0 + stride * c; if (SAMP) { qrow -= KVB; qrow = qrow > DECS - 1 ? DECS - 1 : qrow; }
      const bf16* qp = base + (size_t)qrow * NPROJ + C_Q + rq * 8; qf[0] = *(const bf16x8*)qp; qf[1] = *(const bf16x8*)(qp + 32); }
    f32x4 sc[9];
#pragma unroll
    for (int kt = 0; kt < 9; ++kt) {
        const bool tile_valid = (P0 + stride * (16 * kt + 15 - 128)) >= 0;
        if (tile_valid) {
            int kpos = P0 + stride * (16 * kt + c - 128); kpos = kpos < 0 ? 0 : kpos;
            bf16x8 k0, k1;
            if (SAMP && kt < 8) { const float* kp = ck + (size_t)kpos * (NH * HD) + rq * 8;
                const f32x4 a0 = *(const f32x4*)kp, a1 = *(const f32x4*)(kp + 4), b0 = *(const f32x4*)(kp + 32), b1 = *(const f32x4*)(kp + 36);
                u32x4 w0, w1; w0.x = pk2(a0[0], a0[1]); w0.y = pk2(a0[2], a0[3]); w0.z = pk2(a1[0], a1[1]); w0.w = pk2(a1[2], a1[3]); w1.x = pk2(b0[0], b0[1]); w1.y = pk2(b0[2], b0[3]); w1.z = pk2(b1[0], b1[1]); w1.w = pk2(b1[2], b1[3]);
                k0 = __builtin_bit_cast(bf16x8, w0); k1 = __builtin_bit_cast(bf16x8, w1);
            } else { if (SAMP) { kpos -= KVB; kpos = kpos > DECS - 1 ? DECS - 1 : kpos; }
                const bf16* kp = base + (size_t)kpos * NPROJ + C_K + rq * 8; k0 = *(const bf16x8*)kp; k1 = *(const bf16x8*)(kp + 32); }
            f32x4 acc = {0.f, 0.f, 0.f, 0.f};
            acc = __builtin_amdgcn_mfma_f32_16x16x32_bf16(k0, qf[0], acc, 0, 0, 0);
            acc = __builtin_amdgcn_mfma_f32_16x16x32_bf16(k1, qf[1], acc, 0, 0, 0);
#pragma unroll
            for (int j = 0; j < 4; ++j) { const int kidx = 16 * kt + 4 * rq + j, jj = c + 128 - kidx, kp2 = P0 + stride * (kidx - 128);
                const bool valid = (jj >= 0) && (jj <= 128) && (kp2 >= 0); const int jc = jj < 0 ? 0 : (jj > 128 ? 128 : jj);
                sc[kt][j] = valid ? acc[j] * (0.125f * LOG2E) + bias2[jc] : -INFINITY; }
        } else sc[kt] = (f32x4){-INFINITY, -INFINITY, -INFINITY, -INFINITY};
    }
    float m = -INFINITY;
#pragma unroll
    for (int kt = 0; kt < 9; ++kt) m = fmaxf(fmaxf(fmaxf(m, sc[kt][0]), fmaxf(sc[kt][1], sc[kt][2])), sc[kt][3]);
    m = fmaxf(m, __shfl_xor(m, 16)); m = fmaxf(m, __shfl_xor(m, 32));
    float l = 0.f;
#pragma unroll
    for (int kt = 0; kt < 9; ++kt)
#pragma unroll
        for (int j = 0; j < 4; ++j) { const float p = __builtin_amdgcn_exp2f(sc[kt][j] - m); sc[kt][j] = p; l += p; }
    l += __shfl_xor(l, 16); l += __shfl_xor(l, 32);
#pragma unroll
    for (int dt = 0; dt < 4; ++dt) o[dt] = (f32x4){0.f, 0.f, 0.f, 0.f};
#pragma unroll
    for (int ks = 0; ks < 5; ++ks) {
        const int ktl = (2 * ks + 1 < 9) ? 2 * ks + 1 : 8;
        const bool step_valid = (P0 + stride * (16 * ktl + 15 - 128)) >= 0;
        if (step_valid) {
            if (SAMP && ks < 4) {
#pragma unroll
                for (int i = 0; i < 8; ++i) { const int kl = 4 * i + (lane >> 4); int kpos = P0 + stride * (32 * ks + kl - 128); kpos = kpos < 0 ? 0 : kpos;
                    const f32x4 v = *(const f32x4*)(cv + (size_t)kpos * (NH * HD) + (lane & 15) * 4);
                    u32x2 w; w.x = pk2(v[0], v[1]); w.y = pk2(v[2], v[3]); *(LAS u32x2*)(vst + kl * AT_VROW + (lane & 15) * 8) = w; }
            } else {
#pragma unroll
                for (int i = 0; i < 4; ++i) { const int kl = 8 * i + (lane >> 3); int kpos = P0 + stride * (32 * ks + kl - 128);
                    if (SAMP) { kpos -= KVB; kpos = kpos < 0 ? 0 : (kpos > DECS - 1 ? DECS - 1 : kpos); } else kpos = kpos < 0 ? 0 : (kpos > SEQ - 1 ? SEQ - 1 : kpos);
                    const u32x4 v = *(const u32x4*)(base + (size_t)kpos * NPROJ + C_V + (lane & 7) * 8);
                    *(LAS u32x4*)(vst + kl * AT_VROW + (lane & 7) * 16) = v; }
            }
            bf16x8 pb;
            { const f32x4 pa = sc[2 * ks]; const f32x4 pz = (2 * ks + 1 < 9) ? sc[(2 * ks + 1 < 9) ? 2 * ks + 1 : 8] : (f32x4){0.f, 0.f, 0.f, 0.f};
              u32x4 w; w.x = pk2(pa[0], pa[1]); w.y = pk2(pa[2], pa[3]); w.z = pk2(pz[0], pz[1]); w.w = pk2(pz[2], pz[3]); pb = __builtin_bit_cast(bf16x8, w); }
            LDS_WAIT(); asm volatile("" ::: "memory");
            LAS const unsigned char* vr = vst + (4 * rq + ((lane & 15) >> 2)) * AT_VROW + (lane & 3) * 8;
#pragma unroll
            for (int dt = 0; dt < 4; ++dt) { const s16x4 lo = lds_tr16(vr + dt * 32), hi = lds_tr16(vr + dt * 32 + 16 * AT_VROW);
                const bf16x8 vf = (bf16x8){lo[0], lo[1], lo[2], lo[3], hi[0], hi[1], hi[2], hi[3]};
                o[dt] = __builtin_amdgcn_mfma_f32_16x16x32_bf16(vf, pb, o[dt], 0, 0, 0); }
            LDS_WAIT(); asm volatile("" ::: "memory");
        }
    }
    m_out = m; l_out = l;
}
__device__ __forceinline__ void attn_merge(int mode, LAS unsigned char* lds, int ql, int lane, float m, float l, f32x4 (&o)[4], const bf16* gp  , bf16* yp  ) {
    const int rq = lane >> 4;
    LAS float* ml = (LAS float*)(lds + AT_ML) + ql * 2; LAS unsigned char* st = lds + AT_ST + ql * AT_STROW + rq * 16;
    if (mode == 0) {
#pragma unroll
        for (int dt = 0; dt < 4; ++dt) *(LAS f32x4*)(st + dt * 64) = o[dt];
        if (rq == 0) { ml[0] = m; ml[1] = l; }
    } else {
        const float M = ml[0], L = ml[1]; const float Mn = fmaxf(M, m), ca = __builtin_amdgcn_exp2f(M - Mn), cb = __builtin_amdgcn_exp2f(m - Mn); const float Ln = L * ca + l * cb;
        f32x4 on[4];
#pragma unroll
        for (int dt = 0; dt < 4; ++dt) on[dt] = *(LAS const f32x4*)(st + dt * 64) * ca + o[dt] * cb;
        if (mode == 1) {
            LDS_WAIT(); asm volatile("" ::: "memory");
#pragma unroll
            for (int dt = 0; dt < 4; ++dt) *(LAS f32x4*)(st + dt * 64) = on[dt];
            if (rq == 0) { ml[0] = Mn; ml[1] = Ln; }
        } else {
            const float inv = 1.f / Ln;
#pragma unroll
            for (int dt = 0; dt < 4; ++dt) { const u32x2 g = *(const u32x2*)(gp + 16 * dt + 4 * rq);
                const float g0 = __uint_as_float(g.x << 16), g1 = __uint_as_float(g.x & 0xffff0000u), g2 = __uint_as_float(g.y << 16), g3 = __uint_as_float(g.y & 0xffff0000u);
                u32x2 w; w.x = pk2(on[dt][0] * inv * siluf_(g0), on[dt][1] * inv * siluf_(g1)); w.y = pk2(on[dt][2] * inv * siluf_(g2), on[dt][3] * inv * siluf_(g3));
                *(u32x2*)(yp + 16 * dt + 4 * rq) = w; }
        }
    }
}
__device__ __forceinline__ void attn_unit(const unsigned char* ws, LAS unsigned char* lds, int b, int h, int s, int wave, int lane) {
    const bf16* proj = (const bf16*)(ws + WS_PROJ); bf16* ya = (bf16*)(ws + WS_YA); const float* prm = (const float*)(ws + WS_PRM);
    const bf16* base = proj + (size_t)b * SEQ * NPROJ + h * HD;
    LAS float* bias2 = (LAS float*)(lds + AT_BIAS); LAS unsigned char* vst = lds + AT_V + wave * AT_VBYTES;
    for (int idx = threadIdx.x; idx < 3 * 129; idx += NTHR) { const int g = idx / 129, j = idx - g * 129; bias2[g * 132 + j] = prm[PR_RELB + t5_bucket(j << (2 * g)) * NH + h] * LOG2E; }
    const int c = lane & 15;
#pragma unroll 1
    for (int it = 0; it < 6; ++it) {
        if ((it & 1) == 0) __syncthreads();
        const int id = 2 * wave + (it & 1), mode = it >> 1;
        int q0, stride;
        if (mode == 0) { q0 = id; stride = 16; } else if (mode == 1) { q0 = (id >> 2) + 64 * (id & 3); stride = 4; } else { q0 = 16 * id; stride = 1; }
        float m, l; f32x4 o[4];
        attn_item<false>(base, nullptr, nullptr, s + q0, stride, bias2 + (2 - mode) * 132, vst, lane, m, l, o);
        const int ql = q0 + stride * c; const size_t row = (size_t)b * SEQ + s + ql;
        attn_merge(mode, lds, ql, lane, m, l, o, proj + row * NPROJ + C_G + h * HD, ya + row * DA + h * HD);
    }
    __syncthreads();
}

constexpr int AS_SLOT = 0, AS_SLOTF = 68;
__device__ __forceinline__ void attn_sample_unit(const unsigned char* ws, const float* cache_k, const float* cache_v, LAS unsigned char* lds, int sq, int h, int wave, int lane) {
    const bf16* proj = (const bf16*)(ws + WS_PROJ); bf16* ya = (bf16*)(ws + WS_YA); const float* prm = (const float*)(ws + WS_PRM);
    const bf16* base = proj + (size_t)(MP + sq * DECS) * NPROJ + h * HD; const float* ck = cache_k + ((size_t)sq * KVB * NH + h) * HD; const float* cv = cache_v + ((size_t)sq * KVB * NH + h) * HD;
    LAS float* bias2 = (LAS float*)(lds + AT_BIAS); LAS unsigned char* vst = lds + AT_V + wave * AT_VBYTES; LAS float* slots = (LAS float*)(lds + AS_SLOT);
    for (int idx = threadIdx.x; idx < 3 * 129; idx += NTHR) { const int g = idx / 129, j = idx - g * 129; bias2[g * 132 + j] = prm[PR_RELB + t5_bucket(j << (2 * g)) * NH + h] * LOG2E; }
    __syncthreads();
    const int c = lane & 15, rq = lane >> 4;
#pragma unroll 1
    for (int id = wave; id < 13; id += NWAVES) {
        const int g = id == 0 ? 0 : (id < 5 ? 1 : 2), r = id == 0 ? 0 : (id < 5 ? id - 1 : id - 5), stride = 1 << (2 * g), nq = (DECS - r + stride - 1) / stride;
        float m, l; f32x4 o[4];
        attn_item<true>(base, ck, cv, KVB + r, stride, bias2 + g * 132, vst, lane, m, l, o);
        if (c < nq) { LAS float* sl = slots + ((r + stride * c) * 3 + g) * AS_SLOTF;
#pragma unroll
            for (int dt = 0; dt < 4; ++dt) *(LAS f32x4*)(sl + 16 * dt + 4 * rq) = o[dt];
            if (rq == 0) { sl[64] = m; sl[65] = l; } }
    }
    __syncthreads();
    { const int i = threadIdx.x >> 6, d = lane; const LAS float* s0 = slots + (i * 3) * AS_SLOTF; const LAS float* s1 = s0 + AS_SLOTF; const LAS float* s2 = s1 + AS_SLOTF;
      const float m0 = s0[64], m1 = s1[64], m2 = s2[64], M = fmaxf(m0, fmaxf(m1, m2));
      const float c0 = __builtin_amdgcn_exp2f(m0 - M), c1 = __builtin_amdgcn_exp2f(m1 - M), c2 = __builtin_amdgcn_exp2f(m2 - M);
      const float L = s0[65] * c0 + s1[65] * c1 + s2[65] * c2, O = s0[d] * c0 + s1[d] * c1 + s2[d] * c2;
      const size_t row = (size_t)MP + sq * DECS + i; const float gv = bf2f(proj[row * NPROJ + C_G + h * HD + d]);
      ya[row * DA + h * HD + d] = (bf16)f2bf(O / L * siluf_(gv)); }
    __syncthreads();
}
constexpr int SD_BM = 0, SD_CM = 17408, SD_CS = 34816, SD_ROWN = 272, SD_BWT = 52224, SD_XT = 70656, SD_ROWS = 144, SD_YP = 79872, SD_YROW = 272, SD_AR = 114688, SD_CW = 115712;
__device__ __forceinline__ void ssd_dtarrays(LAS float* ar, float dtv, float Aneg, int lane) {
    asm volatile("" : "+v"(lane));
    float x = dtv * Aneg * LOG2E;
#pragma unroll
    for (int o = 1; o < 64; o <<= 1) { const float y = __shfl_up(x, o); if (lane >= o) x += y; }
    const float tot = __shfl(x, 63);
    ar[lane] = x; ar[64 + lane] = dtv; ar[128 + lane] = __builtin_amdgcn_exp2f(tot - x) * dtv; ar[192 + lane] = __builtin_amdgcn_exp2f(x);
}
__device__ __forceinline__ float silu_fast(float x) { return x * __builtin_amdgcn_rcpf(1.f + __builtin_amdgcn_exp2f(-x * LOG2E)); }
typedef float f32x2 __attribute__((ext_vector_type(2)));
__device__ __forceinline__ void ssd_conv_load(unsigned (&raw)[19], const bf16* proj, const bf16* zrow, size_t row0, int c0, int t0, int col) {
    const bf16* basep = proj + (row0 + (size_t)(c0 + t0)) * NPROJ + C_XBC + col;
#pragma unroll
    for (int k = 0; k < 19; ++k) { const int T = c0 + t0 - 3 + k; const bf16* rp = (T >= 0) ? basep + (ptrdiff_t)(k - 3) * NPROJ : zrow + col; raw[k] = *(const unsigned*)rp; }
}
template <int KIND> __device__ __forceinline__ void ssd_conv_compute(const unsigned (&raw)[19], LAS unsigned char* lds, int t0, int chl  , int ch) {
    const LAS float* ar = (const LAS float*)(lds + SD_AR); const LAS float* cw = (const LAS float*)(lds + SD_CW) + chl;
    f32x2 w[4];
#pragma unroll
    for (int tap = 0; tap < 4; ++tap) w[tap] = *(const LAS f32x2*)(cw + tap * 320);
    const f32x2 bb = *(const LAS f32x2*)(cw + 4 * 320);
#pragma unroll
    for (int blk = 0; blk < 2; ++blk) {
        float o0[8], o1[8];
#pragma unroll
        for (int tt = 0; tt < 8; ++tt) { const int t = blk * 8 + tt; f32x2 v = bb;
#pragma unroll
            for (int tap = 0; tap < 4; ++tap) v += w[tap] * (f32x2){__uint_as_float(raw[t + tap] << 16), __uint_as_float(raw[t + tap] & 0xffff0000u)};
            o0[tt] = silu_fast(v.x); o1[tt] = silu_fast(v.y); }
        const int s0 = t0 + blk * 8;
        if (KIND == 0) {
            u32x4 a, b; a.x = pk2(o0[0], o0[1]); a.y = pk2(o0[2], o0[3]); a.z = pk2(o0[4], o0[5]); a.w = pk2(o0[6], o0[7]); b.x = pk2(o1[0], o1[1]); b.y = pk2(o1[2], o1[3]); b.z = pk2(o1[4], o1[5]); b.w = pk2(o1[6], o1[7]);
            *(LAS u32x4*)(lds + SD_XT + ch * SD_ROWS + s0 * 2) = a; *(LAS u32x4*)(lds + SD_XT + (ch + 1) * SD_ROWS + s0 * 2) = b;
        } else if (KIND == 1) {
            float s0v[8], s1v[8];
#pragma unroll
            for (int tt = 0; tt < 8; ++tt) { *(LAS unsigned*)(lds + SD_BM + (s0 + tt) * SD_ROWN + ch * 2) = pk2(o0[tt], o1[tt]); const float ww = ar[128 + s0 + tt]; s0v[tt] = o0[tt] * ww; s1v[tt] = o1[tt] * ww; }
            u32x4 a, b; a.x = pk2(s0v[0], s0v[1]); a.y = pk2(s0v[2], s0v[3]); a.z = pk2(s0v[4], s0v[5]); a.w = pk2(s0v[6], s0v[7]); b.x = pk2(s1v[0], s1v[1]); b.y = pk2(s1v[2], s1v[3]); b.z = pk2(s1v[4], s1v[5]); b.w = pk2(s1v[6], s1v[7]);
            *(LAS u32x4*)(lds + SD_BWT + ch * SD_ROWS + s0 * 2) = a; *(LAS u32x4*)(lds + SD_BWT + (ch + 1) * SD_ROWS + s0 * 2) = b;
        } else {
#pragma unroll
            for (int tt = 0; tt < 8; ++tt) { *(LAS unsigned*)(lds + SD_CM + (s0 + tt) * SD_ROWN + ch * 2) = pk2(o0[tt], o1[tt]); const float e = ar[192 + s0 + tt];
                *(LAS unsigned*)(lds + SD_CS + (s0 + tt) * SD_ROWN + ch * 2) = pk2(o0[tt] * e, o1[tt] * e); }
        }
    }
}
__device__ __forceinline__ bf16x8 cat8(s16x4 a, s16x4 b) { return (bf16x8){a[0], a[1], a[2], a[3], b[0], b[1], b[2], b[3]}; }
#define SD_SCHED() __builtin_amdgcn_sched_barrier(0)
template <int HH> __device__ __forceinline__ void ssd_mfma_step(LAS unsigned char* lds, f32x4 (&Hacc)[4], int pt, int c, int rq, float Dk) {
    const LAS float* ar = (const LAS float*)(lds + SD_AR);
    constexpr int S0 = 2 * HH, S1 = 2 * HH + 1;
    const int p = 16 * pt + c;
    const LAS unsigned char* bmp = lds + SD_BM + (32 * HH + c) * SD_ROWN + 16 * rq; const LAS unsigned char* cmp_ = lds + SD_CM + c * SD_ROWN + 16 * rq;
    f32x4 g0[4], g1[4];
#pragma unroll
    for (int lt = 0; lt < 4; ++lt) { g0[lt] = (f32x4){0.f, 0.f, 0.f, 0.f}; g1[lt] = (f32x4){0.f, 0.f, 0.f, 0.f}; }
    bf16x8 fb[2][2], fc[2][4];
#define SD_LOADG(buf, ks) do { fb[buf][0] = *(LAS const bf16x8*)(bmp + 64 * (ks)); fb[buf][1] = *(LAS const bf16x8*)(bmp + 16 * SD_ROWN + 64 * (ks)); \
        _Pragma("unroll") for (int lt = S0; lt < 4; ++lt) fc[buf][lt] = *(LAS const bf16x8*)(cmp_ + 16 * lt * SD_ROWN + 64 * (ks)); } while (0)
    SD_LOADG(0, 0);
#pragma unroll
    for (int ks = 0; ks < 4; ++ks) {
        if (ks + 1 < 4) SD_LOADG((ks + 1) & 1, ks + 1);
        SD_SCHED();
#pragma unroll
        for (int lt = S0; lt < 4; ++lt) { g0[lt] = __builtin_amdgcn_mfma_f32_16x16x32_bf16(fb[ks & 1][0], fc[ks & 1][lt], g0[lt], 0, 0, 0);
            if (lt >= S1) g1[lt] = __builtin_amdgcn_mfma_f32_16x16x32_bf16(fb[ks & 1][1], fc[ks & 1][lt], g1[lt], 0, 0, 0); }
        SD_SCHED();
    }
#undef SD_LOADG
    bf16x8 csf[4][2];
#pragma unroll
    for (int lt = 0; lt < 4; ++lt)
#pragma unroll
        for (int k2 = 0; k2 < 2; ++k2) { const LAS unsigned char* cp = lds + SD_CS + (16 * lt + c) * SD_ROWN + (64 * HH + 32 * k2 + 4 * rq) * 2; csf[lt][k2] = cat8(*(LAS const s16x4*)cp, *(LAS const s16x4*)(cp + 32)); }
    const bf16x8 xb = cat8(*(LAS const s16x4*)(lds + SD_XT + p * SD_ROWS + (32 * HH + 4 * rq) * 2), *(LAS const s16x4*)(lds + SD_XT + p * SD_ROWS + (32 * HH + 16 + 4 * rq) * 2));
    const f32x4 as0 = *(LAS const f32x4*)(ar + 32 * HH + 4 * rq), as1 = *(LAS const f32x4*)(ar + 32 * HH + 16 + 4 * rq);
    const f32x4 dt0 = *(LAS const f32x4*)(ar + 64 + 32 * HH + 4 * rq), dt1 = *(LAS const f32x4*)(ar + 64 + 32 * HH + 16 + 4 * rq);
    float acl[4];
#pragma unroll
    for (int lt = 0; lt < 4; ++lt) acl[lt] = ar[16 * lt + c];
    const float dec = __builtin_amdgcn_exp2f(ar[63]);
    SD_SCHED();
    int dd = c - 4 * rq; asm volatile("" : "+v"(dd));
    bf16x8 hb[2];
#pragma unroll
    for (int k2 = 0; k2 < 2; ++k2) { u32x4 w; w.x = pk2(Hacc[2 * k2][0], Hacc[2 * k2][1]); w.y = pk2(Hacc[2 * k2][2], Hacc[2 * k2][3]); w.z = pk2(Hacc[2 * k2 + 1][0], Hacc[2 * k2 + 1][1]); w.w = pk2(Hacc[2 * k2 + 1][2], Hacc[2 * k2 + 1][3]); hb[k2] = __builtin_bit_cast(bf16x8, w); }
    bf16x8 mf[4];
#pragma unroll
    for (int lt = 0; lt < 4; ++lt) if (lt >= S0) {
        float m0[4], m1[4];
#pragma unroll
        for (int j = 0; j < 4; ++j) {
            float v0 = g0[lt][j] * __builtin_amdgcn_exp2f(fminf(acl[lt] - as0[j], 0.f)) * dt0[j];
            if (lt == S0) { v0 = (j <= dd) ? v0 : 0.f; v0 += (j == dd) ? Dk : 0.f; }
            m0[j] = v0;
            float v1 = 0.f;
            if (lt >= S1) { v1 = g1[lt][j] * __builtin_amdgcn_exp2f(fminf(acl[lt] - as1[j], 0.f)) * dt1[j]; if (lt == S1) { v1 = (j <= dd) ? v1 : 0.f; v1 += (j == dd) ? Dk : 0.f; } }
            m1[j] = v1; }
        u32x4 w; w.x = pk2(m0[0], m0[1]); w.y = pk2(m0[2], m0[3]); w.z = pk2(m1[0], m1[1]); w.w = pk2(m1[2], m1[3]); mf[lt] = __builtin_bit_cast(bf16x8, w);
    }
    SD_SCHED();
    f32x4 y[4];
#pragma unroll
    for (int lt = 0; lt < 4; ++lt) y[lt] = __builtin_amdgcn_mfma_f32_16x16x32_bf16(csf[lt][0], hb[0], (f32x4){0.f, 0.f, 0.f, 0.f}, 0, 0, 0);
#pragma unroll
    for (int lt = 0; lt < 4; ++lt) y[lt] = __builtin_amdgcn_mfma_f32_16x16x32_bf16(csf[lt][1], hb[1], y[lt], 0, 0, 0);
    SD_SCHED();
    bf16x8 bwf[4][2], xn[2];
#pragma unroll
    for (int k2 = 0; k2 < 2; ++k2) xn[k2] = *(LAS const bf16x8*)(lds + SD_XT + p * SD_ROWS + (8 * rq + 32 * k2) * 2);
#pragma unroll
    for (int nt = 0; nt < 4; ++nt)
#pragma unroll
        for (int k2 = 0; k2 < 2; ++k2) bwf[nt][k2] = *(LAS const bf16x8*)(lds + SD_BWT + (64 * HH + 16 * nt + c) * SD_ROWS + (8 * rq + 32 * k2) * 2);
    SD_SCHED();
#pragma unroll
    for (int lt = 0; lt < 4; ++lt) if (lt >= S0) y[lt] = __builtin_amdgcn_mfma_f32_16x16x32_bf16(mf[lt], xb, y[lt], 0, 0, 0);
#pragma unroll
    for (int nt = 0; nt < 4; ++nt) Hacc[nt] = Hacc[nt] * dec;
#pragma unroll
    for (int k2 = 0; k2 < 2; ++k2)
#pragma unroll
        for (int nt = 0; nt < 4; ++nt) Hacc[nt] = __builtin_amdgcn_mfma_f32_16x16x32_bf16(bwf[nt][k2], xn[k2], Hacc[nt], 0, 0, 0);
#pragma unroll
    for (int lt = 0; lt < 4; ++lt)
#pragma unroll
        for (int j = 0; j < 4; ++j) *(LAS float*)(lds + SD_YP + HH * (64 * SD_YROW) + (16 * lt + 4 * rq + j) * SD_YROW + p * 4) = y[lt][j];
}
__device__ __forceinline__ void ssd_mfma_unit(const unsigned char* ws, float* out, bf16* ys, float* ssq, int probe, LAS unsigned char* lds, int b, int hd, int wave, int lane) {
    const bf16* proj = (const bf16*)(ws + WS_PROJ); const float* dtb = (const float*)(ws + WS_DT); const float* prm = (const float*)(ws + WS_PRM);
    const int tid = threadIdx.x, c = lane & 15, rq = lane >> 4, pt = wave & 3, hh = wave >> 2, grp = hd >> 2;
    const size_t row0 = (size_t)b * SEQ; const bf16* zrow = (const bf16*)(ws + WS_WIN) + (size_t)NIN * DM;
    const float Aneg = -__expf(prm[PR_ALOG + hd]), Dk = prm[PR_DSKIP + hd];
    LAS float* ar = (LAS float*)(lds + SD_AR);
    f32x4 Hacc[4];
#pragma unroll
    for (int nt = 0; nt < 4; ++nt) Hacc[nt] = (f32x4){0.f, 0.f, 0.f, 0.f};
    const int kindA = wave < 2 ? 0 : (wave < 6 ? 1 : 2);
    const int tA = kindA == 0 ? tid : (kindA == 1 ? tid - 128 : tid - 384), pairA = kindA == 0 ? (tA & 31) : (tA & 63), runA = kindA == 0 ? (tA >> 5) : (tA >> 6);
    const int colA = kindA == 0 ? hd * 64 + 2 * pairA : (kindA == 1 ? DSSM + grp * DST + 2 * pairA : DSSM + NGRP * DST + grp * DST + 2 * pairA);
    const int tB = tid + 128, pairB = tB & 63, runB = tB >> 6, colB = DSSM + NGRP * DST + grp * DST + 2 * pairB;
    unsigned rawA[19], rawB[19];
    ssd_conv_load(rawA, proj, zrow, row0, 0, 16 * runA, colA);
    if (wave < 2) ssd_conv_load(rawB, proj, zrow, row0, 0, 16 * runB, colB);
    float dtn = (wave == 7) ? dtb[(row0 + lane) * 32 + hd] : 0.f;
    __syncthreads();
    for (int idx = tid; idx < 5 * 320; idx += NTHR) { const int t5 = idx / 320, chl = idx - t5 * 320; const int col = chl < 64 ? hd * 64 + chl : (chl < 192 ? DSSM + grp * DST + (chl - 64) : DSSM + NGRP * DST + grp * DST + (chl - 192));
        ((LAS float*)(lds + SD_CW))[idx] = t5 < 4 ? prm[PR_CONVW + t5 * DCONV + col] : prm[PR_CONVB + col]; }
    if (wave == 7) { ssd_dtarrays(ar, dtn, Aneg, lane); dtn = dtb[(row0 + 64 + lane) * 32 + hd]; }
    __syncthreads();
    const int el = tid >> 3, ep0 = (tid & 7) * 8;
#pragma unroll 1
    for (int c0 = 0; c0 < SEQ; c0 += 64) {
        const bool more = c0 + 64 < SEQ;
        const u32x4 zreg = *(const u32x4*)(proj + (row0 + c0 + el) * NPROJ + C_Z + hd * 64 + ep0);
        if (!(probe & 2)) {
        if (kindA == 0) ssd_conv_compute<0>(rawA, lds, 16 * runA, 2 * pairA, 2 * pairA); else if (kindA == 1) ssd_conv_compute<1>(rawA, lds, 16 * runA, 64 + 2 * pairA, 2 * pairA); else ssd_conv_compute<2>(rawA, lds, 16 * runA, 192 + 2 * pairA, 2 * pairA);
        if (more) ssd_conv_load(rawA, proj, zrow, row0, c0 + 64, 16 * runA, colA);
        if (wave < 2) { ssd_conv_compute<2>(rawB, lds, 16 * runB, 192 + 2 * pairB, 2 * pairB); if (more) ssd_conv_load(rawB, proj, zrow, row0, c0 + 64, 16 * runB, colB); }
        }
        __syncthreads();
        if (!(probe & 4)) { if (hh == 0) ssd_mfma_step<0>(lds, Hacc, pt, c, rq, Dk); else ssd_mfma_step<1>(lds, Hacc, pt, c, rq, Dk); }
        __syncthreads();
        if (!(probe & 8)) {
            const size_t row = row0 + c0 + el;
            const LAS float* y0 = (const LAS float*)(lds + SD_YP + el * SD_YROW + ep0 * 4); const LAS float* y1 = (const LAS float*)(lds + SD_YP + 64 * SD_YROW + el * SD_YROW + ep0 * 4);
            const f32x4 a0 = *(const LAS f32x4*)y0 + *(const LAS f32x4*)y1, a1 = *(const LAS f32x4*)(y0 + 4) + *(const LAS f32x4*)(y1 + 4);
            const u32x4 z = zreg;
            float v[8];
            v[0] = a0[0] * silu_fast(__uint_as_float(z.x << 16)); v[1] = a0[1] * silu_fast(__uint_as_float(z.x & 0xffff0000u)); v[2] = a0[2] * silu_fast(__uint_as_float(z.y << 16)); v[3] = a0[3] * silu_fast(__uint_as_float(z.y & 0xffff0000u));
            v[4] = a1[0] * silu_fast(__uint_as_float(z.z << 16)); v[5] = a1[1] * silu_fast(__uint_as_float(z.z & 0xffff0000u)); v[6] = a1[2] * silu_fast(__uint_as_float(z.w << 16)); v[7] = a1[3] * silu_fast(__uint_as_float(z.w & 0xffff0000u));
            u32x4 w; w.x = pk2(v[0], v[1]); w.y = pk2(v[2], v[3]); w.z = pk2(v[4], v[5]); w.w = pk2(v[6], v[7]);
            *(u32x4*)(ys + row * DSSM + hd * 64 + ep0) = w;
            float ss = (v[0] * v[0] + v[1] * v[1]) + (v[2] * v[2] + v[3] * v[3]) + (v[4] * v[4] + v[5] * v[5]) + (v[6] * v[6] + v[7] * v[7]);
            ss += __shfl_xor(ss, 1); ss += __shfl_xor(ss, 2); ss += __shfl_xor(ss, 4);
            if ((tid & 7) == 0) ssq[row * NSH + hd] = ss;
            if (wave == 7 && more) { ssd_dtarrays(ar, dtn, Aneg, lane); const int cn = c0 + 128 < SEQ ? c0 + 128 : c0; dtn = dtb[(row0 + cn + lane) * 32 + hd]; }
        }
        __syncthreads();
    }
    float* dst = out + O_SP + ((size_t)(b * NSH + hd) * SHD + 16 * pt + c) * DST + 64 * hh + 4 * rq;
#pragma unroll
    for (int nt = 0; nt < 4; ++nt) *(f32x4*)(dst + 16 * nt) = Hacc[nt];
}
constexpr int SS_TEAM = 12288;
constexpr int SS_X = 0, SS_B = 2048, SS_C = 6144, SS_DT = 10240, SS_Y = 10304, SS_BYTES = 12352;
__device__ __forceinline__ void ssd_sample_teams(const unsigned char* ws, float* out, const float* state_conv, const float* state_ssm, LAS unsigned char* lds, int item0  , int nitems) {
    const bf16* proj = (const bf16*)(ws + WS_PROJ); const float* dtb = (const float*)(ws + WS_DT); const float* prm = (const float*)(ws + WS_PRM); bf16* ys = (bf16*)(ws + WS_YS); float* ssq = (float*)(ws + WS_SSQ);
    const int tid = threadIdx.x, team = tid >> 7, t = tid & 127, p = t >> 1, nh = t & 1;
    const int item = item0 + team; const bool act = team < nitems;
    const int sq = act ? item / NSH : 0, hd = act ? item % NSH : 0, grp = hd >> 2; const size_t row0 = (size_t)MP + sq * DECS;
    LAS unsigned char* tl = lds + team * SS_BYTES;
    LAS float* xs = (LAS float*)(tl + SS_X); LAS float* Bs = (LAS float*)(tl + SS_B); LAS float* Cs = (LAS float*)(tl + SS_C); LAS float* dts = (LAS float*)(tl + SS_DT); LAS float* yb = (LAS float*)(tl + SS_Y);
    f32x4 h[16];
    { const f32x4* s4 = (const f32x4*)(state_ssm + ((size_t)(sq * NSH + hd) * SHD + p) * DST + 64 * nh);
#pragma unroll
      for (int j = 0; j < 16; ++j) h[j] = s4[j]; }
    const float Aneg = -__expf(prm[PR_ALOG + hd]), Dk = prm[PR_DSKIP + hd];
#pragma unroll 1
    for (int c = t; c < 320; c += 128) {
        const int xc = c < 64 ? hd * 64 + c : (c < 192 ? DSSM + grp * DST + (c - 64) : DSSM + NGRP * DST + grp * DST + (c - 192));
        float w[4], raw[11];
#pragma unroll
        for (int tap = 0; tap < 4; ++tap) w[tap] = prm[PR_CONVW + tap * DCONV + xc];
        const float bias = prm[PR_CONVB + xc];
#pragma unroll
        for (int k = 0; k < 3; ++k) raw[k] = state_conv[(size_t)(sq * 3 + k) * DCONV + xc];
#pragma unroll
        for (int k = 0; k < DECS; ++k) raw[3 + k] = bf2f(proj[(row0 + k) * NPROJ + C_XBC + xc]);
        LAS float* dstp = c < 64 ? xs + c : (c < 192 ? Bs + (c - 64) : Cs + (c - 192)); const int dstride = c < 64 ? 64 : 128;
#pragma unroll
        for (int tk = 0; tk < DECS; ++tk) { const float acc = bias + w[0] * raw[tk] + w[1] * raw[tk + 1] + w[2] * raw[tk + 2] + w[3] * raw[tk + 3]; dstp[tk * dstride] = siluf_(acc); }
    }
    if (t < DECS) { const float dtv = dtb[(row0 + t) * 32 + hd]; dts[t] = dtv; dts[8 + t] = __expf(dtv * Aneg); }
    __syncthreads();
#pragma unroll 1
    for (int tk = 0; tk < DECS; ++tk) {
        const float dA = dts[8 + tk], xv = xs[tk * 64 + p], dtx = dts[tk] * xv;
        const LAS f32x4* b4 = (const LAS f32x4*)(Bs + tk * 128 + 64 * nh); const LAS f32x4* c4 = (const LAS f32x4*)(Cs + tk * 128 + 64 * nh);
        f32x4 a4 = {0.f, 0.f, 0.f, 0.f};
#pragma unroll
        for (int j = 0; j < 16; ++j) { h[j] = h[j] * dA + b4[j] * dtx; a4 += h[j] * c4[j]; }
        float acc = (a4[0] + a4[1]) + (a4[2] + a4[3]);
        acc += __shfl_xor(acc, 1);
        if (nh == 0) yb[tk * 64 + p] = acc + Dk * xv;
    }
    if (act) { f32x4* d4 = (f32x4*)(out + O_SS + ((size_t)(sq * NSH + hd) * SHD + p) * DST + 64 * nh);
#pragma unroll
        for (int j = 0; j < 16; ++j) d4[j] = h[j]; }
    __syncthreads();
    { const int tk = t >> 4, p0 = (t & 15) * 4; const size_t row = row0 + tk;
      const f32x4 yv = *(const LAS f32x4*)(yb + tk * 64 + p0); const u32x2 z = *(const u32x2*)(proj + row * NPROJ + C_Z + hd * 64 + p0);
      const float v0 = yv[0] * siluf_(__uint_as_float(z.x << 16)), v1 = yv[1] * siluf_(__uint_as_float(z.x & 0xffff0000u)), v2 = yv[2] * siluf_(__uint_as_float(z.y << 16)), v3 = yv[3] * siluf_(__uint_as_float(z.y & 0xffff0000u));
      float ss = (v0 * v0 + v1 * v1) + (v2 * v2 + v3 * v3);
      ss += __shfl_xor(ss, 1); ss += __shfl_xor(ss, 2); ss += __shfl_xor(ss, 4); ss += __shfl_xor(ss, 8);
      if (act) { u32x2 w; w.x = pk2(v0, v1); w.y = pk2(v2, v3); *(u32x2*)(ys + row * DSSM + hd * 64 + p0) = w; if ((t & 15) == 0) ssq[row * NSH + hd] = ss; } }
    __syncthreads();
}
template <int NKS  > __device__ __forceinline__ f32x2 skinny_tile(const bf16* A, const bf16* Wt, int tile, LAS unsigned char* lds, int wave, int lane) {
    constexpr int K = 256 * NKS;
    const int c = lane & 15, rq = lane >> 4, rb = tile >> 4, cb = tile & 15, k0 = wave * (32 * NKS);
    const bf16* ap = A + (size_t)(16 * rb + c) * K + k0 + 8 * rq; const bf16* wp = Wt + (size_t)(64 * cb + c) * K + k0 + 8 * rq;
    f32x4 acc[4];
#pragma unroll
    for (int nt = 0; nt < 4; ++nt) acc[nt] = (f32x4){0.f, 0.f, 0.f, 0.f};
#pragma unroll
    for (int ks = 0; ks < NKS; ++ks) { const bf16x8 af = *(const bf16x8*)(ap + 32 * ks);
#pragma unroll
        for (int nt = 0; nt < 4; ++nt) acc[nt] = __builtin_amdgcn_mfma_f32_16x16x32_bf16(af, *(const bf16x8*)(wp + (size_t)(16 * nt) * K + 32 * ks), acc[nt], 0, 0, 0); }
    LAS float* P = (LAS float*)lds;
#pragma unroll
    for (int nt = 0; nt < 4; ++nt)
#pragma unroll
        for (int j = 0; j < 4; ++j) P[(wave * 16 + 4 * rq + j) * 64 + 16 * nt + c] = acc[nt][j];
    __syncthreads();
    const int tid = threadIdx.x; f32x2 r = {0.f, 0.f};
#pragma unroll
    for (int w = 0; w < 8; ++w) r += *(const LAS f32x2*)(P + (w * 16 + (tid >> 5)) * 64 + 2 * (tid & 31));
    __syncthreads();
    return r;
}
__device__ __forceinline__ void skinny_p3(const unsigned char* ws, LAS unsigned char* lds, int G, int wave, int lane) {
    const bf16* proj = (const bf16*)(ws + WS_PROJ); const bf16* ya = (const bf16*)(ws + WS_YA) + (size_t)MP * DA; const bf16* ysn = (const bf16*)(ws + WS_YS) + (size_t)MP * DSSM; bf16* mrg = (bf16*)(ws + WS_MRG);
    for (int tile = blockIdx.x; tile < 256; tile += G) {
        const size_t row = (size_t)MP + 16 * (tile >> 4) + (threadIdx.x >> 5); const int col = 64 * (tile & 15) + 2 * (threadIdx.x & 31);
        const f32x2 a = skinny_tile<3>(ya, (const bf16*)(ws + WS_WA), tile, lds, wave, lane);
        const f32x2 b = skinny_tile<8>(ysn, (const bf16*)(ws + WS_WB), tile, lds, wave, lane);
        const unsigned ga = *(const unsigned*)(proj + row * NPROJ + C_GA + col), gb = *(const unsigned*)(proj + row * NPROJ + C_GB + col);
        const float m0 = sigmoidf_(__uint_as_float(ga << 16)) * a.x + sigmoidf_(__uint_as_float(gb << 16)) * b.x, m1 = sigmoidf_(__uint_as_float(ga & 0xffff0000u)) * a.y + sigmoidf_(__uint_as_float(gb & 0xffff0000u)) * b.y;
        *(unsigned*)(mrg + row * DM + col) = pk2(m0, m1);
    }
}
__device__ __forceinline__ void skinny_p4(const unsigned char* ws, const float* x_sample, float* out, LAS unsigned char* lds, int G, int wave, int lane) {
    const bf16* mrg = (const bf16*)(ws + WS_MRG) + (size_t)MP * DM;
    for (int tile = blockIdx.x; tile < 256; tile += G) {
        const int r = 16 * (tile >> 4) + (threadIdx.x >> 5), col = 64 * (tile & 15) + 2 * (threadIdx.x & 31);
        const f32x2 o = skinny_tile<4>(mrg, (const bf16*)(ws + WS_WO), tile, lds, wave, lane);
        const f32x2 xv = *(const f32x2*)(x_sample + (size_t)r * DM + col);
        *(f32x2*)(out + O_YS + (size_t)r * DM + col) = xv + o;
    }
}
__device__ __forceinline__ void p0_transpose_item(const float* W, int K, int N, bf16* WT, int k0, int n0, int dst_row0, const float* kscale, LAS float* scr, int lane) {
#pragma unroll 8
    for (int i = 0; i < 32; ++i) { const int kk = 2 * i + (lane >> 5); float v = W[(size_t)(k0 + kk) * N + n0 + (lane & 31)]; if (kscale) v *= kscale[k0 + kk]; scr[kk * 33 + (lane & 31)] = v; }
    LDS_WAIT(); asm volatile("" ::: "memory");
    const int c = lane & 7;
#pragma unroll
    for (int j = 0; j < 4; ++j) { const int n = (lane >> 3) + 8 * j; const LAS float* s = scr + (8 * c) * 33 + n;
        u32x4 o; o.x = pk2(s[0 * 33], s[1 * 33]); o.y = pk2(s[2 * 33], s[3 * 33]); o.z = pk2(s[4 * 33], s[5 * 33]); o.w = pk2(s[6 * 33], s[7 * 33]);
        *(u32x4*)(WT + (size_t)(dst_row0 + n) * K + k0 + 8 * c) = o; }
    LDS_WAIT(); asm volatile("" ::: "memory");
}
__device__ __forceinline__ void p0_prologue(const Args& a, LAS unsigned char* lds, int gw, int NGW, int wave, int lane) {
    bf16* win_t = (bf16*)(a.ws + WS_WIN); bf16* wa_t = (bf16*)(a.ws + WS_WA); bf16* wb_t = (bf16*)(a.ws + WS_WB); bf16* wo_t = (bf16*)(a.ws + WS_WO); bf16* hb = (bf16*)(a.ws + WS_HB);
    LAS float* scr = (LAS float*)(lds + wave * 16384);
    constexpr int I_IN = (DM / 64) * (NIN / 32), I_A = (DA / 64) * (DM / 32), I_B = (DSSM / 64) * (DM / 32), I_O = (DM / 64) * (DM / 32);
    for (int it = gw; it < I_IN + I_A + I_B + I_O; it += NGW) {
        int r = it;
        if (r < I_IN) { const int nblk = NIN / 32, kb = r / nblk, nb = r % nblk, n0 = nb * 32; const int dst = (n0 < 9216) ? n0 : (n0 == 9216 ? 11264 : n0 - 32);
            p0_transpose_item(a.w_in, DM, NIN, win_t, kb * 64, n0, dst, nullptr, scr, lane); continue; } r -= I_IN;
        if (r < I_A) { const int nblk = DM / 32, kb = r / nblk, nb = r % nblk; p0_transpose_item(a.w_a, DA, DM, wa_t, kb * 64, nb * 32, nb * 32, nullptr, scr, lane); continue; } r -= I_A;
        if (r < I_B) { const int nblk = DM / 32, kb = r / nblk, nb = r % nblk; p0_transpose_item(a.w_b, DSSM, DM, wb_t, kb * 64, nb * 32, nb * 32, a.ssm_norm, scr, lane); continue; } r -= I_B;
        { const int nblk = DM / 32, kb = r / nblk, nb = r % nblk; p0_transpose_item(a.w_out, DM, DM, wo_t, kb * 64, nb * 32, nb * 32, nullptr, scr, lane); }
    }
    { float* prm = (float*)(a.ws + WS_PRM); const int gt = gw * 64 + lane, NGT = NGW * 64;
      for (int i = gt; i < PR_END; i += NGT) { float v = 0.f;
          if (i < PR_CONVB) v = a.conv_w[i]; else if (i < PR_DTB) v = a.conv_b[i - PR_CONVB]; else if (i < PR_ALOG) v = a.dt_bias[i - PR_DTB]; else if (i < PR_DSKIP) v = a.a_log[i - PR_ALOG];
          else if (i < PR_RELB) v = a.d_skip[i - PR_DSKIP]; else if (i < PR_RELB + 384) v = a.rel_bias[i - PR_RELB]; else if (i >= PR_FNORM) v = a.final_norm[i - PR_FNORM];
          prm[i] = v; } }
    { u32x4* z = (u32x4*)(win_t + (size_t)11296 * DM); const int n16 = 224 * DM * 2 / 16; for (int i = gw * 64 + lane; i < n16; i += NGW * 64) z[i] = (u32x4){0u, 0u, 0u, 0u}; }
    for (int m = gw; m < MT; m += NGW) {
        const float* xrow = (m < MP) ? a.x_prompt + (size_t)m * DM : a.x_sample + (size_t)(m - MP) * DM;
        const f32x4* xr = (const f32x4*)xrow + lane; const f32x4* gr = (const f32x4*)a.norm_g + lane;
        f32x4 v[4]; float s = 0.f;
#pragma unroll
        for (int j = 0; j < 4; ++j) { v[j] = xr[64 * j]; s += (v[j].x * v[j].x + v[j].y * v[j].y) + (v[j].z * v[j].z + v[j].w * v[j].w); }
        const float rstd = rsqrtf(wave_sum(s) * (1.f / DM) + 1e-6f);
        unsigned long long* o8 = (unsigned long long*)(hb + (size_t)m * DM) + lane;
#pragma unroll
        for (int j = 0; j < 4; ++j) { const f32x4 g = gr[64 * j]; o8[64 * j] = (unsigned long long)pk2(v[j].x * rstd * g.x, v[j].y * rstd * g.y) | ((unsigned long long)pk2(v[j].z * rstd * g.z, v[j].w * rstd * g.w) << 32); }
    }
}

template <bool SAMP> __device__ __forceinline__ const void* kv_ptr(const Args& a, const bf16* proj, int colkv, const float* cache, int seq, int tpos, int off, int h, bool& valid, bool& isf32) {
    if (!SAMP) { const int kt = tpos - off; valid = kt >= 0; isf32 = false; return proj + (size_t)(seq * SEQ + (valid ? kt : 0)) * NPROJ + colkv + h * HD; }
    const int idx = KVB + tpos - off; valid = true;
    if (idx >= KVB) { isf32 = false; return proj + (size_t)(MP + seq * DECS + (idx - KVB)) * NPROJ + colkv + h * HD; }
    isf32 = true; return cache + ((size_t)(seq * KVB + idx) * NH + h) * HD;
}
template <bool SAMP> __device__ __forceinline__ void attn_slow_item(const Args& a, const bf16* proj, bf16* ya, LAS float* sl, int row, int h, int lane) {
    const float* prm = (const float*)(a.ws + WS_PRM);
    const int seq = SAMP ? (row - MP) / DECS : row / SEQ, tpos = SAMP ? (row - MP) % DECS : row % SEQ;
    float q[64];
    { const u32x4* qp = (const u32x4*)(proj + (size_t)row * NPROJ + C_Q + h * HD);
#pragma unroll
      for (int i = 0; i < 8; ++i) { const u32x4 w = qp[i]; q[8 * i + 0] = __uint_as_float(w.x << 16); q[8 * i + 1] = __uint_as_float(w.x & 0xffff0000u); q[8 * i + 2] = __uint_as_float(w.y << 16); q[8 * i + 3] = __uint_as_float(w.y & 0xffff0000u);
          q[8 * i + 4] = __uint_as_float(w.z << 16); q[8 * i + 5] = __uint_as_float(w.z & 0xffff0000u); q[8 * i + 6] = __uint_as_float(w.w << 16); q[8 * i + 7] = __uint_as_float(w.w & 0xffff0000u); } }
    float mx = -INFINITY;
#pragma unroll 1
    for (int e = lane; e < 387; e += 64) {
        float sc = -INFINITY;
        const int g = e / 129, j = e - g * 129, off = j << (2 * g); bool valid, isf32;
        const void* kp = kv_ptr<SAMP>(a, proj, C_K, a.cache_k, seq, tpos, off, h, valid, isf32);
        if (valid) { float d = 0.f;
            if (isf32) { const f32x4* k4 = (const f32x4*)kp;
#pragma unroll
                for (int i = 0; i < 16; ++i) { const f32x4 kk = k4[i]; d += q[4 * i] * kk.x + q[4 * i + 1] * kk.y + q[4 * i + 2] * kk.z + q[4 * i + 3] * kk.w; } }
            else { const u32x4* k4 = (const u32x4*)kp;
#pragma unroll
                for (int i = 0; i < 8; ++i) { const u32x4 w = k4[i];
                    d += q[8 * i + 0] * __uint_as_float(w.x << 16) + q[8 * i + 1] * __uint_as_float(w.x & 0xffff0000u) + q[8 * i + 2] * __uint_as_float(w.y << 16) + q[8 * i + 3] * __uint_as_float(w.y & 0xffff0000u)
                       + q[8 * i + 4] * __uint_as_float(w.z << 16) + q[8 * i + 5] * __uint_as_float(w.z & 0xffff0000u) + q[8 * i + 6] * __uint_as_float(w.w << 16) + q[8 * i + 7] * __uint_as_float(w.w & 0xffff0000u); } }
            sc = d * 0.125f + prm[PR_RELB + t5_bucket(off) * NH + h]; }
        sl[e] = sc; mx = fmaxf(mx, sc);
    }
    mx = wave_max(mx);
    float sum = 0.f;
#pragma unroll 1
    for (int e = lane; e < 387; e += 64) { const float sc = sl[e]; const float pe = (sc == -INFINITY) ? 0.f : __expf(sc - mx); sl[e] = pe; sum += pe; }
    sum = wave_sum(sum);
    LDS_WAIT(); asm volatile("" ::: "memory");
    float o = 0.f;
#pragma unroll 4
    for (int e = 0; e < 387; ++e) {
        const int g = e / 129, j = e - g * 129, off = j << (2 * g); bool valid, isf32;
        const void* vp = kv_ptr<SAMP>(a, proj, C_V, a.cache_v, seq, tpos, off, h, valid, isf32);
        const float pe = sl[e];
        if (valid) { const float vv = isf32 ? ((const float*)vp)[lane] : bf2f(((const bf16*)vp)[lane]); o += pe * vv; }
    }
    LDS_WAIT(); asm volatile("" ::: "memory");
    const float gv = bf2f(proj[(size_t)row * NPROJ + C_G + h * HD + lane]);
    ya[(size_t)row * DA + h * HD + lane] = (bf16)f2bf(o / sum * siluf_(gv));
}

__device__ __forceinline__ void ssd_slow_item(const Args& a, LAS unsigned char* lds, int item) {
    const bf16* proj = (const bf16*)(a.ws + WS_PROJ); const float* dtb = (const float*)(a.ws + WS_DT); bf16* ys = (bf16*)(a.ws + WS_YS); float* ssq = (float*)(a.ws + WS_SSQ);
    const int tid = threadIdx.x, lane = tid & 63, wid = tid >> 6;
    const bool samp = item >= NBATCH * NSH; const int it2 = samp ? item - NBATCH * NSH : item; const int sq = it2 / NSH, hd = it2 % NSH, grp = hd / 4;
    const int L = samp ? DECS : SEQ, row0 = samp ? MP + sq * DECS : sq * SEQ;
    const int p = tid >> 3, n0 = (tid & 7) * 16;
    float h[16];
    if (samp) { const f32x4* s4 = (const f32x4*)(a.state_ssm + ((size_t)(sq * NSH + hd) * SHD + p) * DST + n0);
#pragma unroll
        for (int j = 0; j < 4; ++j) { const f32x4 v = s4[j]; h[4 * j] = v.x; h[4 * j + 1] = v.y; h[4 * j + 2] = v.z; h[4 * j + 3] = v.w; } }
    else {
#pragma unroll
        for (int j = 0; j < 16; ++j) h[j] = 0.f; }
    const float* prm = (const float*)(a.ws + WS_PRM);
    const float Aneg = -__expf(prm[PR_ALOG + hd]), Dk = prm[PR_DSKIP + hd];
    LAS float* xs = (LAS float*)lds;
    LAS float* Bs = xs + 64 * 64;
    LAS float* Cs = Bs + 64 * 128;
    LAS float* dts = Cs + 64 * 128;
    LAS float* dAs = dts + 64;
    LAS float* yb = dAs + 64;
    for (int c0 = 0; c0 < L; c0 += 64) {
        const int tc = (L - c0) < 64 ? (L - c0) : 64;
        for (int idx = tid; idx < tc * 320; idx += NTHR) {
            const int t = idx / 320, c = idx - t * 320;
            const int xc = c < 64 ? hd * 64 + c : (c < 192 ? DSSM + grp * DST + (c - 64) : DSSM + NGRP * DST + grp * DST + (c - 192));
            float acc = prm[PR_CONVB + xc];
#pragma unroll
            for (int tap = 0; tap < 4; ++tap) { const int tt = c0 + t - 3 + tap; float v;
                if (tt >= 0) v = bf2f(proj[(size_t)(row0 + tt) * NPROJ + C_XBC + xc]);
                else v = samp ? a.state_conv[(size_t)(sq * 3 + 3 + tt) * DCONV + xc] : 0.f;
                acc += prm[PR_CONVW + tap * DCONV + xc] * v; }
            const float val = siluf_(acc);
            if (c < 64) xs[t * 64 + c] = val; else if (c < 192) Bs[t * 128 + (c - 64)] = val; else Cs[t * 128 + (c - 192)] = val;
        }
        if (tid < tc) { const float dtv = dtb[(size_t)(row0 + c0 + tid) * 32 + hd]; dts[tid] = dtv; dAs[tid] = __expf(dtv * Aneg); }
        __syncthreads();
        for (int t = 0; t < tc; ++t) {
            const float dA = dAs[t], xv = xs[t * 64 + p], dtx = dts[t] * xv; float acc = 0.f;
            const LAS f32x4* b4 = (const LAS f32x4*)(Bs + t * 128 + n0); const LAS f32x4* c4 = (const LAS f32x4*)(Cs + t * 128 + n0);
#pragma unroll
            for (int j = 0; j < 4; ++j) { const f32x4 bb = b4[j], cc = c4[j];
                h[4 * j] = dA * h[4 * j] + dtx * bb.x; h[4 * j + 1] = dA * h[4 * j + 1] + dtx * bb.y; h[4 * j + 2] = dA * h[4 * j + 2] + dtx * bb.z; h[4 * j + 3] = dA * h[4 * j + 3] + dtx * bb.w;
                acc += h[4 * j] * cc.x + h[4 * j + 1] * cc.y + h[4 * j + 2] * cc.z + h[4 * j + 3] * cc.w; }
            acc += __shfl_xor(acc, 1); acc += __shfl_xor(acc, 2); acc += __shfl_xor(acc, 4);
            if ((tid & 7) == 0) yb[t * 64 + p] = acc + Dk * xv;
        }
        __syncthreads();
        for (int t = wid; t < tc; t += NWAVES) {
            const int row = row0 + c0 + t; const float z = bf2f(proj[(size_t)row * NPROJ + C_Z + hd * 64 + lane]);
            const float val = yb[t * 64 + lane] * siluf_(z);
            ys[(size_t)row * DSSM + hd * 64 + lane] = (bf16)f2bf(val);
            const float ss = wave_sum(val * val); if (lane == 0) ssq[(size_t)row * NSH + hd] = ss;
        }
        __syncthreads();
    }
    float* dst = a.out + (samp ? O_SS : O_SP) + ((size_t)(sq * NSH + hd) * SHD + p) * DST + n0;
#pragma unroll
    for (int j = 0; j < 4; ++j) ((f32x4*)dst)[j] = (f32x4){h[4 * j], h[4 * j + 1], h[4 * j + 2], h[4 * j + 3]};
}

__device__ __forceinline__ void p2_ssd_prompt(const Args& a, LAS unsigned char* lds, int G, int wave, int lane) {
    for (int item = blockIdx.x; item < NBATCH * NSH; item += G) ssd_mfma_unit(a.ws, a.probe ? (float*)(a.ws + WS_TMP) - O_SP : a.out, a.probe ? (bf16*)(a.ws + WS_MRG) - 0 : (bf16*)(a.ws + WS_YS), a.probe ? (float*)(a.ws + WS_SSQ) + (size_t)MT * NSH : (float*)(a.ws + WS_SSQ), a.probe, lds, item / NSH, item % NSH, wave, lane);
}
__device__ __forceinline__ void p2_ssd_sample(const Args& a, LAS unsigned char* lds, int G) {
    for (int i0 = blockIdx.x * 4; i0 < DECB * NSH; i0 += G * 4) { const int n = DECB * NSH - i0; ssd_sample_teams(a.ws, a.out, a.state_conv, a.state_ssm, lds, i0, n < 4 ? n : 4); }
}
__device__ __forceinline__ void p2_attn_prompt(const Args& a, LAS unsigned char* lds, int G, int wave, int lane) {
    for (int k = 0; ; ++k) { const int v = (G == 256) ? (k < 3 ? (int)((blockIdx.x % 8) * 96 + (blockIdx.x / 8) + 32 * k) : 768) : (int)(blockIdx.x + k * G); if (v >= 768) break;
        const int bh = v >> 3, sb = v & 7; attn_unit(a.ws, lds, bh / NH, bh % NH, sb * 256, wave, lane); }
}
__device__ __forceinline__ void p2_attn_sample(const Args& a, LAS unsigned char* lds, int G, int wave, int lane) {
    const bf16* proj = (const bf16*)(a.ws + WS_PROJ);
    for (int u = blockIdx.x; u < DECB * NH; u += G) attn_sample_unit(a.ws, a.cache_k, a.cache_v, lds, u / NH, u % NH, wave, lane);
    const int gt = blockIdx.x * NTHR + threadIdx.x, NGT = G * NTHR;
    for (int i = gt; i < (NBATCH + DECB) * 3 * DCONV; i += NGT) { const int c = i % DCONV, r = (i / DCONV) % 3, sq = i / (3 * DCONV);
        if (sq < NBATCH) a.out[O_CP + (size_t)(sq * 3 + r) * DCONV + c] = bf2f(proj[(size_t)(sq * SEQ + SEQ - 3 + r) * NPROJ + C_XBC + c]);
        else { const int s2 = sq - NBATCH; a.out[O_CS + (size_t)(s2 * 3 + r) * DCONV + c] = bf2f(proj[(size_t)(MP + s2 * DECS + DECS - 3 + r) * NPROJ + C_XBC + c]); } }
}
__device__ __forceinline__ void p25_norm(const Args& a, int gw, int NGW, int lane) {
    bf16* ys = (bf16*)(a.ws + WS_YS); const float* ssq = (const float*)(a.ws + WS_SSQ);
    for (int m = gw; m < MT; m += NGW) {
        const float sv = (lane < 32) ? ssq[(size_t)m * NSH + lane] : 0.f;
        float gs = sv + __shfl_xor(sv, 1); gs += __shfl_xor(gs, 2);
        const float rstd = rsqrtf(gs * (1.f / 256.f) + 1e-5f);
        u32x4* r4 = (u32x4*)(ys + (size_t)m * DSSM);
#pragma unroll
        for (int j = 0; j < 4; ++j) { const int ci = j * 64 + lane, g = ci >> 5; const float sc = __shfl(rstd, 4 * g); u32x4 w = r4[ci];
            w.x = pk2(__uint_as_float(w.x << 16) * sc, __uint_as_float(w.x & 0xffff0000u) * sc); w.y = pk2(__uint_as_float(w.y << 16) * sc, __uint_as_float(w.y & 0xffff0000u) * sc);
            w.z = pk2(__uint_as_float(w.z << 16) * sc, __uint_as_float(w.z & 0xffff0000u) * sc); w.w = pk2(__uint_as_float(w.w << 16) * sc, __uint_as_float(w.w & 0xffff0000u) * sc); r4[ci] = w; }
    }
}
__device__ __forceinline__ void p5_final_norm(const Args& a, int gw, int NGW, int lane) {
    for (int m = gw; m < MT; m += NGW) {
        f32x4* xr = (f32x4*)(a.out + (size_t)m * DM) + lane; const f32x4* gr = (const f32x4*)((const float*)(a.ws + WS_PRM) + PR_FNORM) + lane;
        f32x4 v[4]; float s = 0.f;
#pragma unroll
        for (int j = 0; j < 4; ++j) { v[j] = xr[64 * j]; s += (v[j].x * v[j].x + v[j].y * v[j].y) + (v[j].z * v[j].z + v[j].w * v[j].w); }
        const float rstd = rsqrtf(wave_sum(s) * (1.f / DM) + 1e-6f);
#pragma unroll
        for (int j = 0; j < 4; ++j) { const f32x4 g = gr[64 * j]; xr[64 * j] = v[j] * rstd * g; }
    }
}
#define GEMM_PHASE(EpiT, Aptr, Bptr, Mrows, Ncols, Kdim, Eobj) do { pg8::Gemm g_{(const pg8::bf16_t*)(Aptr), (const pg8::bf16_t*)(Bptr), (Mrows), (Ncols), (Kdim)}; pg8::StaticOrder S_; S_.init((Mrows), (Ncols), G, (int)blockIdx.x); \
    pg8::gemm_phase<EpiT, pg8::StaticOrder, true, true>(lds, g_, S_, (Eobj)); } while (0)

constexpr int NPHASE = 10;
__global__ void __launch_bounds__(NTHR, 2) fwd_megakernel(Args a) {
    extern __shared__ __attribute__((aligned(16))) unsigned char lds_raw[];
    LAS unsigned char* lds = (LAS unsigned char*)lds_raw;
    cg::grid_group grid = cg::this_grid();
    const int tid = threadIdx.x, lane = tid & 63, wave = __builtin_amdgcn_readfirstlane(tid >> 6);
    const int G = gridDim.x, gw = blockIdx.x * NWAVES + wave, NGW = G * NWAVES;
    unsigned char* ws = a.ws;

#define IN(k) (a.ph_lo <= (k) && (k) < a.ph_hi)
#define SEAM(k) do { if (IN(k) && IN((k) + 1)) grid.sync(); } while (0)
    if (IN(0)) {
        p0_prologue(a, lds, gw, NGW, wave, lane);
        if (blockIdx.x == 0 && tid == 0) { const float** pp = (const float**)(ws + WS_ARGS); pp[0] = a.x_prompt; pp[1] = a.x_sample; pp[2] = a.cache_k; pp[3] = a.cache_v; pp[4] = a.state_conv; pp[5] = a.state_ssm; }
    }
    SEAM(0);
    if (IN(1)) { pg8::EpiInProj E{(pg8::bf16_t*)(ws + WS_PROJ), (float*)(ws + WS_DT), (const float*)(ws + WS_PRM) + PR_DTB, a.out + O_KP, a.out + O_VP, a.out + O_KS, a.out + O_VS};
      GEMM_PHASE(pg8::EpiInProj, ws + WS_HB, ws + WS_WIN, MT, NPAD, DM, E); }
    SEAM(1);
    if (IN(2)) { Args b{}; b.ws = ws; b.out = a.out; b.probe = a.probe; p2_ssd_prompt(b, lds, G, wave, lane); }
    if (IN(3)) { Args b{}; b.ws = ws; b.out = a.out; b.state_conv = ld_ptr(ws, 4); b.state_ssm = ld_ptr(ws, 5); p2_ssd_sample(b, lds, G); }
    if (IN(4)) { Args b{}; b.ws = ws; b.out = a.out; p2_attn_prompt(b, lds, G, wave, lane); }
    if (IN(5)) { Args b{}; b.ws = ws; b.out = a.out; b.cache_k = ld_ptr(ws, 2); b.cache_v = ld_ptr(ws, 3); p2_attn_sample(b, lds, G, wave, lane); }
    SEAM(5);
    if (IN(6)) p25_norm(a, gw, NGW, lane);
    SEAM(6);
    if (IN(7)) {
    skinny_p3(ws, lds, G, wave, lane);
    { pg8::EpiGateA E{(const pg8::bf16_t*)(ws + WS_PROJ), (float*)(ws + WS_TMP)}; GEMM_PHASE(pg8::EpiGateA, ws + WS_YA, ws + WS_WA, MP, DM, DA, E); }
    { pg8::EpiGateB E{(const pg8::bf16_t*)(ws + WS_PROJ), (const float*)(ws + WS_TMP), (pg8::bf16_t*)(ws + WS_MRG)}; GEMM_PHASE(pg8::EpiGateB, ws + WS_YS, ws + WS_WB, MP, DM, DSSM, E); }
    }
    SEAM(7);
    if (IN(8)) { skinny_p4(ws, ld_ptr(ws, 1), a.out, lds, G, wave, lane); pg8::EpiOut E{ld_ptr(ws, 0), ld_ptr(ws, 1), a.out + O_YP}; GEMM_PHASE(pg8::EpiOut, ws + WS_MRG, ws + WS_WO, MP, DM, DM, E); }
    SEAM(8);
    if (IN(9)) p5_final_norm(a, gw, NGW, lane);
#undef IN
#undef SEAM
}

extern "C" void kernel_launch(void* const* d_in, const int* in_sizes, int n_in, void* d_out, int out_size, void* d_ws, size_t ws_size, hipStream_t stream) {
    static int grid_blocks = 0;
    if (grid_blocks == 0) {
        if (n_in != 19 || (size_t)out_size != O_END || ws_size < WS_END) { fprintf(stderr, "kernel_launch: unexpected shapes: n_in %d out %d (want %zu) ws %zu (want >= %zu)\n", n_in, out_size, (size_t)O_END, ws_size, (size_t)WS_END); grid_blocks = -1; return; }
        int dev = 0, cus = 0, per_cu = 0;
        hipGetDevice(&dev); hipDeviceGetAttribute(&cus, hipDeviceAttributeMultiprocessorCount, dev);
        if (hipFuncSetAttribute((const void*)fwd_megakernel, hipFuncAttributeMaxDynamicSharedMemorySize, LDS_BYTES) != hipSuccess) { fprintf(stderr, "kernel_launch: hipFuncSetAttribute failed\n"); grid_blocks = -1; return; }
        if (hipOccupancyMaxActiveBlocksPerMultiprocessor(&per_cu, (const void*)fwd_megakernel, NTHR, LDS_BYTES) != hipSuccess || per_cu < 1) { fprintf(stderr, "kernel_launch: occupancy query failed (%d)\n", per_cu); (void)hipGetLastError(); per_cu = 1; }
        if (per_cu > 1) per_cu = 1;
        grid_blocks = cus * per_cu;
        fprintf(stderr, "kernel_launch: grid %d (cus %d)\n", grid_blocks, cus);
    }
    if (grid_blocks < 0) return;
    Args a{};
    a.x_prompt = (const float*)d_in[0]; a.x_sample = (const float*)d_in[1]; a.cache_k = (const float*)d_in[2]; a.cache_v = (const float*)d_in[3]; a.state_conv = (const float*)d_in[4]; a.state_ssm = (const float*)d_in[5];
    a.norm_g = (const float*)d_in[6]; a.w_in = (const float*)d_in[7]; a.conv_w = (const float*)d_in[8]; a.conv_b = (const float*)d_in[9]; a.dt_bias = (const float*)d_in[10]; a.a_log = (const float*)d_in[11];
    a.d_skip = (const float*)d_in[12]; a.ssm_norm = (const float*)d_in[13]; a.w_a = (const float*)d_in[14]; a.w_b = (const float*)d_in[15]; a.w_out = (const float*)d_in[16]; a.rel_bias = (const float*)d_in[17]; a.final_norm = (const float*)d_in[18];
    a.out = (float*)d_out; a.ws = (unsigned char*)d_ws;
#ifndef PROBE_LO
    const int ranges[1][2] = {{0, NPHASE}}; const int nr = 1;
#else
    const int ranges[2][2] = {{0, NPHASE}, {PROBE_LO, PROBE_HI}}; const int nr = 2;
#endif
    for (int r = 0; r < nr; ++r) {
        a.ph_lo = ranges[r][0]; a.ph_hi = ranges[r][1];
#ifdef PROBE_FLAGS
        a.probe = r ? PROBE_FLAGS : 0;
#endif
        void* args[] = {&a};
        hipError_t e = hipLaunchCooperativeKernel((const void*)fwd_megakernel, dim3(grid_blocks), dim3(NTHR), args, LDS_BYTES, stream);
        if (e != hipSuccess) fprintf(stderr, "kernel_launch: cooperative launch failed: %s (grid %d)\n", hipGetErrorString(e), grid_blocks);
    }
}
```

```cpp
#include <hip/hip_runtime.h>
#include <hip/hip_cooperative_groups.h>
#include <cstdio>
#include <cstdint>
namespace cg = cooperative_groups;
namespace pg8 {
#define PG8_LAS __attribute__((address_space(3)))
typedef unsigned short bf16_t;
typedef short bf16x8 __attribute__((ext_vector_type(8)));
typedef float f32x4 __attribute__((ext_vector_type(4)));
typedef unsigned u32x4 __attribute__((ext_vector_type(4)));
constexpr int BM = 256, BK = 64, HALF = 128, HTB = HALF * BK * 2  , STAGE_BYTES = 8 * HTB, NXCD = 8, WGM = 8;

__host__ __device__ __forceinline__ int lds_byte(int r, int c) { const int st = (r >> 4) * 2 + (c >> 5), rr = r & 15, cc = c & 31, ob = rr * 64 + cc * 2; return st * 1024 + (ob ^ (((ob >> 9) & 1) << 5)); }
__host__ __device__ __forceinline__ void stage_rc(int b, int& R, int& C) { const int st = b / 1024, sb = b % 1024, swz = sb ^ (((sb >> 9) & 1) << 5); R = (st >> 1) * 16 + swz / 64; C = (st & 1) * 32 + (swz % 64) / 2; }
__host__ __device__ __forceinline__ int perm32(int rho) { const int n = rho >> 4, i = rho & 15; return 8 * (i >> 2) + 4 * n + (i & 3); }

struct Unit { int pm, pn; };
struct Gemm { const bf16_t* A; const bf16_t* Bt; int M, N, K; };

struct StaticOrder {
    int nM, nN, nwg, G, c;
    __host__ __device__ void init(int M, int N, int G_, int c_) { nM = M / BM; nN = N / BM; nwg = nM * nN; G = G_; c = c_; }
    __host__ __device__ bool next(int i, Unit& u) const {
        const long L = (long)i * G + c; if (L >= nwg) return false;
        int wgid = (int)L; { const int q = nwg / NXCD, r = nwg % NXCD, xcd = wgid % NXCD, off = wgid / NXCD; wgid = (xcd < r ? xcd * (q + 1) : r * (q + 1) + (xcd - r) * q) + off; }
        const int nig = WGM * nN, gid = wgid / nig, fm = gid * WGM, gsz = (nM - fm) < WGM ? (nM - fm) : WGM;
        u.pm = fm + ((wgid % nig) % gsz); u.pn = (wgid % nig) / gsz; return true;
    }
    __device__ __forceinline__ void a_ready(const Unit&) const {}
    __device__ __forceinline__ void done(const Unit&) const {}
};

__device__ __forceinline__ unsigned cvt_pk_bf16(float lo, float hi) { unsigned r; asm volatile("v_cvt_pk_bf16_f32 %0, %1, %2" : "=v"(r) : "v"(lo), "v"(hi)); return r; }
__device__ __forceinline__ float e_bf2f(unsigned short b) { return __uint_as_float(((unsigned)b) << 16); }
__device__ __forceinline__ float e_sigmoid(float x) { return 1.f / (1.f + __expf(-x)); }
__device__ __forceinline__ float e_softplus(float x) { return fmaxf(x, 0.f) + log1pf(__expf(-fabsf(x))); }

struct EpiInProj {
    static constexpr bool PERM = true, AFTER_DRAIN = false;
    bf16_t* proj; float* dt; const float* dt_bias; float* kp; float* vp; float* ks; float* vs;
    __device__ __forceinline__ void operator()(const f32x4 (&acc)[2][2][4][2], const Unit& u, int wr, int wc, int fr, int fq) const {
        const int row0 = u.pm * BM + wr * 64 + fr;
        if (u.pn < 44) {
            const int col0 = u.pn * BM + wc * 32 + 8 * fq;
            const bool isk = (u.pn >= 3 && u.pn < 6), isv = (u.pn >= 6 && u.pn < 9);
#pragma unroll
            for (int ai = 0; ai < 2; ++ai)
#pragma unroll
                for (int m = 0; m < 4; ++m) { const int row = row0 + ai * HALF + m * 16; bf16_t* rowp = proj + (size_t)row * 11264 + col0;
#pragma unroll
                    for (int bj = 0; bj < 2; ++bj) { const f32x4 v0 = acc[ai][bj][m][0], v1 = acc[ai][bj][m][1];
                        u32x4 w; w.x = cvt_pk_bf16(v0[0], v0[1]); w.y = cvt_pk_bf16(v0[2], v0[3]); w.z = cvt_pk_bf16(v1[0], v1[1]); w.w = cvt_pk_bf16(v1[2], v1[3]);
                        *(u32x4*)(rowp + bj * HALF) = w;
                        if (isk || isv) { const int c = col0 + bj * HALF - (isk ? 768 : 1536);
                            float* dst = (u.pm < 64) ? ((isk ? kp : vp) + (size_t)row * 768 + c) : ((isk ? ks : vs) + (size_t)(row - 16384) * 768 + c);
                            *(f32x4*)dst = v0; *(f32x4*)(dst + 4) = v1; } } }
        } else if (wc == 0) {
            const f32x4 b0 = *(const f32x4*)(dt_bias + 8 * fq), b1 = *(const f32x4*)(dt_bias + 8 * fq + 4);
#pragma unroll
            for (int ai = 0; ai < 2; ++ai)
#pragma unroll
                for (int m = 0; m < 4; ++m) { const int row = row0 + ai * HALF + m * 16; const f32x4 v0 = acc[ai][0][m][0] + b0, v1 = acc[ai][0][m][1] + b1;
                    f32x4 o0, o1;
#pragma unroll
                    for (int j = 0; j < 4; ++j) { o0[j] = e_softplus(v0[j]); o1[j] = e_softplus(v1[j]); }
                    float* dst = dt + (size_t)row * 32 + 8 * fq; *(f32x4*)dst = o0; *(f32x4*)(dst + 4) = o1; }
        }
    }
};
struct EpiGateA {
    static constexpr bool PERM = true, AFTER_DRAIN = false;
    const bf16_t* proj; float* tmp;
    __device__ __forceinline__ void operator()(const f32x4 (&acc)[2][2][4][2], const Unit& u, int wr, int wc, int fr, int fq) const {
        const int row0 = u.pm * BM + wr * 64 + fr, col0 = u.pn * BM + wc * 32 + 8 * fq;
#pragma unroll
        for (int ai = 0; ai < 2; ++ai)
#pragma unroll
            for (int m = 0; m < 4; ++m) { const int row = row0 + ai * HALF + m * 16;
#pragma unroll
                for (int bj = 0; bj < 2; ++bj) { const int c = col0 + bj * HALF; const u32x4 g = *(const u32x4*)(proj + (size_t)row * 11264 + 9216 + c);
                    const f32x4 v0 = acc[ai][bj][m][0], v1 = acc[ai][bj][m][1]; f32x4 o0, o1;
                    o0[0] = e_sigmoid(__uint_as_float(g.x << 16)) * v0[0]; o0[1] = e_sigmoid(__uint_as_float(g.x & 0xffff0000u)) * v0[1];
                    o0[2] = e_sigmoid(__uint_as_float(g.y << 16)) * v0[2]; o0[3] = e_sigmoid(__uint_as_float(g.y & 0xffff0000u)) * v0[3];
                    o1[0] = e_sigmoid(__uint_as_float(g.z << 16)) * v1[0]; o1[1] = e_sigmoid(__uint_as_float(g.z & 0xffff0000u)) * v1[1];
                    o1[2] = e_sigmoid(__uint_as_float(g.w << 16)) * v1[2]; o1[3] = e_sigmoid(__uint_as_float(g.w & 0xffff0000u)) * v1[3];
                    float* dst = tmp + (size_t)row * 1024 + c; *(f32x4*)dst = o0; *(f32x4*)(dst + 4) = o1; } }
    }
};
struct EpiGateB {
    static constexpr bool PERM = true, AFTER_DRAIN = false;
    const bf16_t* proj; const float* tmp; bf16_t* mrg;
    __device__ __forceinline__ void operator()(const f32x4 (&acc)[2][2][4][2], const Unit& u, int wr, int wc, int fr, int fq) const {
        const int row0 = u.pm * BM + wr * 64 + fr, col0 = u.pn * BM + wc * 32 + 8 * fq;
#pragma unroll
        for (int ai = 0; ai < 2; ++ai)
#pragma unroll
            for (int m = 0; m < 4; ++m) { const int row = row0 + ai * HALF + m * 16;
#pragma unroll
                for (int bj = 0; bj < 2; ++bj) { const int c = col0 + bj * HALF; const u32x4 g = *(const u32x4*)(proj + (size_t)row * 11264 + 10240 + c);
                    const float* src = tmp + (size_t)row * 1024 + c; const f32x4 t0 = *(const f32x4*)src, t1 = *(const f32x4*)(src + 4);
                    const f32x4 v0 = acc[ai][bj][m][0], v1 = acc[ai][bj][m][1]; f32x4 o0, o1;
                    o0[0] = t0[0] + e_sigmoid(__uint_as_float(g.x << 16)) * v0[0]; o0[1] = t0[1] + e_sigmoid(__uint_as_float(g.x & 0xffff0000u)) * v0[1];
                    o0[2] = t0[2] + e_sigmoid(__uint_as_float(g.y << 16)) * v0[2]; o0[3] = t0[3] + e_sigmoid(__uint_as_float(g.y & 0xffff0000u)) * v0[3];
                    o1[0] = t1[0] + e_sigmoid(__uint_as_float(g.z << 16)) * v1[0]; o1[1] = t1[1] + e_sigmoid(__uint_as_float(g.z & 0xffff0000u)) * v1[1];
                    o1[2] = t1[2] + e_sigmoid(__uint_as_float(g.w << 16)) * v1[2]; o1[3] = t1[3] + e_sigmoid(__uint_as_float(g.w & 0xffff0000u)) * v1[3];
                    u32x4 w; w.x = cvt_pk_bf16(o0[0], o0[1]); w.y = cvt_pk_bf16(o0[2], o0[3]); w.z = cvt_pk_bf16(o1[0], o1[1]); w.w = cvt_pk_bf16(o1[2], o1[3]);
                    *(u32x4*)(mrg + (size_t)row * 1024 + c) = w; } }
    }
};
struct EpiOut {
    static constexpr bool PERM = false, AFTER_DRAIN = false;
    const float* xp; const float* xs; float* out;
    __device__ __forceinline__ void operator()(const f32x4 (&acc)[2][2][4][2], const Unit& u, int wr, int wc, int fr, int fq) const {
        const int row0 = u.pm * BM + wr * 64 + fr, col0 = u.pn * BM + wc * 32 + 4 * fq;
#pragma unroll
        for (int ai = 0; ai < 2; ++ai)
#pragma unroll
            for (int m = 0; m < 4; ++m) { const int row = row0 + ai * HALF + m * 16;
                const float* xr = (u.pm < 64) ? xp + (size_t)row * 1024 : xs + (size_t)(row - 16384) * 1024; float* orow = out + (size_t)row * 1024;
#pragma unroll
                for (int bj = 0; bj < 2; ++bj)
#pragma unroll
                    for (int n = 0; n < 2; ++n) { const int c = col0 + bj * HALF + n * 16; *(f32x4*)(orow + c) = *(const f32x4*)(xr + c) + acc[ai][bj][m][n]; } }
    }
};

template <class Epi, class Sched, bool ALIGN_EPI = false, bool SP2 = false>
__device__ __forceinline__ void gemm_phase(PG8_LAS unsigned char* lds, const Gemm g, const Sched& S, const Epi& E) {
    int tid_ = threadIdx.x; asm volatile("" : "+v"(tid_));
    const int tid = tid_, wid = __builtin_amdgcn_readfirstlane(tid >> 6), lane = tid & 63, wr = wid >> 2, wc = wid & 3, fr = lane & 15, fq = lane >> 4;
    const int K = g.K, nt = K / BK;
    unsigned voffA[2], voffB[2];
#pragma unroll
    for (int i = 0; i < 2; ++i) { int R, C; stage_rc(tid * 16 + i * 8192, R, C); const int Rb = Epi::PERM ? ((R & ~31) + perm32(R & 31)) : R;
        voffA[i] = (unsigned)(R * K + C) * 2u; voffB[i] = (unsigned)(Rb * K + C) * 2u; }
    const size_t kstep = (size_t)(BK * 2);
    const size_t hstep = (size_t)HALF * K * 2;
    const size_t tstep = 2 * hstep;
    const unsigned ldsw = (unsigned)wid * 1024u;
    const int aoff = lds_byte(wr * 64 + fr, fq * 8), boff = lds_byte(wc * 32 + fr, fq * 8);
#define PG8_SA(b, h) (((b) * 2 + (h)) * HTB)
#define PG8_SB(b, h) ((4 + (b) * 2 + (h)) * HTB)
#define PG8_STAGE(bufoff, gbase, voff) do { _Pragma("unroll") for (int _i = 0; _i < 2; ++_i) \
        __builtin_amdgcn_global_load_lds((const unsigned*)((const char*)(gbase) + (voff)[_i]), (PG8_LAS unsigned*)(lds + (bufoff) + ldsw + _i * 8192), 16, 0, 0); } while (0)
#define PG8_LDA(dst, b, h) do { _Pragma("unroll") for (int m = 0; m < 4; ++m) _Pragma("unroll") for (int k = 0; k < 2; ++k) dst[m][k] = *(const PG8_LAS bf16x8*)(lds + PG8_SA(b, h) + aoff + m * 2048 + k * 1024); } while (0)
#define PG8_LDB(dst, b, h) do { _Pragma("unroll") for (int n = 0; n < 2; ++n) _Pragma("unroll") for (int k = 0; k < 2; ++k) dst[n][k] = *(const PG8_LAS bf16x8*)(lds + PG8_SB(b, h) + boff + n * 2048 + k * 1024); } while (0)
#define PG8_MMA(ai, bj, At, Bt) do { __builtin_amdgcn_s_setprio(1); _Pragma("unroll") for (int m = 0; m < 4; ++m) _Pragma("unroll") for (int n = 0; n < 2; ++n) _Pragma("unroll") for (int k = 0; k < 2; ++k) \
        acc[ai][bj][m][n] = __builtin_amdgcn_mfma_f32_16x16x32_bf16(Bt[n][k], At[m][k], acc[ai][bj][m][n], 0, 0, 0); __builtin_amdgcn_s_setprio(0); } while (0)
#define PG8_WAIT_V(n) asm volatile("s_waitcnt vmcnt(" #n ")" ::: "memory")
#define PG8_WAIT_L(n) asm volatile("s_waitcnt lgkmcnt(" #n ")" ::: "memory")
#define PG8_BAR __builtin_amdgcn_s_barrier()
#define PG8_SCHED __builtin_amdgcn_sched_barrier(0)
    Unit cur, nxt; int ui = 0;
    if (!S.next(0, cur)) return;
    f32x4 acc[2][2][4][2];
#pragma unroll
    for (int a = 0; a < 2; ++a)
#pragma unroll
        for (int b = 0; b < 2; ++b)
#pragma unroll
            for (int m = 0; m < 4; ++m)
#pragma unroll
                for (int n = 0; n < 2; ++n) acc[a][b][m][n] = (f32x4){0.f, 0.f, 0.f, 0.f};
    bf16x8 At[4][2], B0[2][2], B1[2][2];
    const char* cA = (const char*)g.A + (size_t)cur.pm * tstep; const char* cB = (const char*)g.Bt + (size_t)cur.pn * tstep;
    S.a_ready(cur);
    if constexpr (SP2) {
        PG8_STAGE(PG8_SB(0, 0), cB, voffB); PG8_STAGE(PG8_SB(0, 1), cB + hstep, voffB); PG8_STAGE(PG8_SA(0, 0), cA, voffA); PG8_STAGE(PG8_SA(0, 1), cA + hstep, voffA);
        if (wr == 1) PG8_BAR;
        PG8_WAIT_V(2); PG8_BAR;
        PG8_STAGE(PG8_SB(1, 0), cB + kstep, voffB); PG8_STAGE(PG8_SA(1, 0), cA + kstep, voffA); PG8_STAGE(PG8_SB(1, 1), cB + hstep + kstep, voffB);
        PG8_WAIT_V(6); PG8_BAR;
    } else {
        PG8_STAGE(PG8_SB(0, 0), cB, voffB); PG8_STAGE(PG8_SA(0, 0), cA, voffA); PG8_STAGE(PG8_SB(0, 1), cB + hstep, voffB); PG8_STAGE(PG8_SA(0, 1), cA + hstep, voffA);
        if (wr == 1) PG8_BAR;
        PG8_WAIT_V(4); PG8_BAR;
        PG8_STAGE(PG8_SB(1, 0), cB + kstep, voffB); PG8_STAGE(PG8_SA(1, 0), cA + kstep, voffA); PG8_STAGE(PG8_SB(1, 1), cB + hstep + kstep, voffB);
        PG8_WAIT_V(6); PG8_BAR;
    }
    for (;;) {
        const bool has_next = S.next(ui + 1, nxt);
        const char* nA = has_next ? (const char*)g.A + (size_t)nxt.pm * tstep : cA; const char* nB = has_next ? (const char*)g.Bt + (size_t)nxt.pn * tstep : cB;
        for (int t = 0; t < nt; t += 2) {
            const bool last = (t == nt - 2);
            const char* a1 = cA + (size_t)(t + 1) * kstep;
            const char* a2 = last ? nA : cA + (size_t)(t + 2) * kstep; const char* b2 = last ? nB : cB + (size_t)(t + 2) * kstep;
            const char* a3 = a2 + kstep; const char* b3 = b2 + kstep;
            if (last && has_next) S.a_ready(nxt);
            if constexpr (SP2) {
            PG8_LDB(B0, 0, 0); PG8_LDB(B1, 0, 1); PG8_SCHED; PG8_LDA(At, 0, 0); PG8_STAGE(PG8_SA(1, 1), a1 + hstep, voffA);
            PG8_WAIT_V(8); PG8_WAIT_L(0); PG8_BAR; PG8_MMA(0, 0, At, B0); PG8_MMA(0, 1, At, B1); PG8_BAR; PG8_SCHED;
            PG8_LDA(At, 0, 1); PG8_STAGE(PG8_SB(0, 0), b2, voffB); PG8_STAGE(PG8_SB(0, 1), b2 + hstep, voffB); PG8_STAGE(PG8_SA(0, 0), a2, voffA);
            PG8_WAIT_V(8); PG8_WAIT_L(0); PG8_BAR; PG8_MMA(1, 0, At, B0); PG8_MMA(1, 1, At, B1); PG8_BAR; PG8_SCHED;
            PG8_LDB(B0, 1, 0); PG8_LDB(B1, 1, 1); PG8_SCHED; PG8_LDA(At, 1, 0); PG8_STAGE(PG8_SA(0, 1), a2 + hstep, voffA);
            PG8_WAIT_V(8); PG8_WAIT_L(0); PG8_BAR; PG8_MMA(0, 0, At, B0); PG8_MMA(0, 1, At, B1); PG8_BAR; PG8_SCHED;
            PG8_LDA(At, 1, 1); PG8_STAGE(PG8_SB(1, 0), b3, voffB); PG8_STAGE(PG8_SB(1, 1), b3 + hstep, voffB); PG8_STAGE(PG8_SA(1, 0), a3, voffA);
            PG8_WAIT_V(8); PG8_WAIT_L(0); PG8_BAR; PG8_MMA(1, 0, At, B0); PG8_MMA(1, 1, At, B1); PG8_BAR; PG8_SCHED;
            } else {
            PG8_LDB(B0, 0, 0); PG8_SCHED; PG8_LDA(At, 0, 0); PG8_STAGE(PG8_SA(1, 1), a1 + hstep, voffA);
            PG8_WAIT_L(8); PG8_BAR; PG8_WAIT_L(0); PG8_MMA(0, 0, At, B0); PG8_BAR; PG8_SCHED;
            PG8_LDB(B1, 0, 1); PG8_STAGE(PG8_SB(0, 0), b2, voffB);
            PG8_BAR; PG8_WAIT_L(0); PG8_MMA(0, 1, At, B1); PG8_BAR;
            PG8_LDA(At, 0, 1); PG8_STAGE(PG8_SA(0, 0), a2, voffA);
            PG8_BAR; PG8_WAIT_L(0); PG8_MMA(1, 0, At, B0); PG8_BAR; PG8_SCHED;
            PG8_STAGE(PG8_SB(0, 1), b2 + hstep, voffB);
            PG8_WAIT_V(6); PG8_BAR; PG8_MMA(1, 1, At, B1); PG8_BAR;
            PG8_LDB(B0, 1, 0); PG8_SCHED; PG8_LDA(At, 1, 0); PG8_STAGE(PG8_SA(0, 1), a2 + hstep, voffA);
            PG8_WAIT_L(8); PG8_BAR; PG8_WAIT_L(0); PG8_MMA(0, 0, At, B0); PG8_BAR; PG8_SCHED;
            PG8_LDB(B1, 1, 1); PG8_STAGE(PG8_SB(1, 0), b3, voffB);
            PG8_BAR; PG8_WAIT_L(0); PG8_MMA(0, 1, At, B1); PG8_BAR;
            PG8_LDA(At, 1, 1); PG8_STAGE(PG8_SA(1, 0), a3, voffA);
            PG8_BAR; PG8_WAIT_L(0); PG8_MMA(1, 0, At, B0); PG8_BAR; PG8_SCHED;
            PG8_STAGE(PG8_SB(1, 1), b3 + hstep, voffB);
            PG8_WAIT_V(6); PG8_BAR; PG8_MMA(1, 1, At, B1); PG8_BAR;
            }
        }
        if constexpr (ALIGN_EPI) { if (wr == 0) PG8_BAR; }
        if constexpr (!Epi::AFTER_DRAIN) { E(acc, cur, wr, wc, fr, fq); S.done(cur); }
        if (!has_next) break;
#pragma unroll
        for (int a = 0; a < 2; ++a)
#pragma unroll
            for (int b = 0; b < 2; ++b)
#pragma unroll
                for (int m = 0; m < 4; ++m)
#pragma unroll
                    for (int n = 0; n < 2; ++n) acc[a][b][m][n] = (f32x4){0.f, 0.f, 0.f, 0.f};
        cur = nxt; cA = nA; cB = nB; ++ui;
        if constexpr (ALIGN_EPI) { if (wr == 1) PG8_BAR; }
    }
    PG8_WAIT_V(0);
    if constexpr (!ALIGN_EPI) { if (wr == 0) PG8_BAR; }
    PG8_BAR;
    if constexpr (Epi::AFTER_DRAIN) { E.fused(acc, cur, wr, wc, fr, fq, lds, wid, lane); S.done(cur); }
#undef PG8_SA
#undef PG8_SB
#undef PG8_STAGE
#undef PG8_LDA
#undef PG8_LDB
#undef PG8_MMA
#undef PG8_WAIT_V
#undef PG8_WAIT_L
#undef PG8_BAR
#undef PG8_SCHED
}
}

#define LAS __attribute__((address_space(3)))
typedef unsigned short bf16;
typedef float f32x4 __attribute__((ext_vector_type(4)));
typedef unsigned u32x4 __attribute__((ext_vector_type(4)));
typedef unsigned u32x2 __attribute__((ext_vector_type(2)));
constexpr int NWAVES = 8, NTHR = 512;
constexpr int DM = 1024, NBATCH = 8, SEQ = 2048, MP = NBATCH * SEQ, DECB = 32, DECS = 8, MS = DECB * DECS, MT = MP + MS;
constexpr int NH = 12, HD = 64, DA = NH * HD;
constexpr int DSSM = 2048, NSH = 32, SHD = 64, NGRP = 8, DST = 128, DCONV = 4096;
constexpr int PAST = 16384, KVB = 2048;
constexpr int NIN = 11296, NPROJ = 11264, NPAD = 11520;
constexpr int C_Q = 0, C_K = 768, C_V = 1536, C_G = 2304, C_Z = 3072, C_XBC = 5120, C_GA = 9216, C_GB = 10240;
constexpr size_t MiB = 1u << 20;
constexpr size_t WS_ARGS = 1 * MiB - 4096, WS_PRM = 1 * MiB, WS_WIN = 2 * MiB, WS_WA = 26 * MiB, WS_WB = 28 * MiB, WS_WO = 32 * MiB, WS_HB = 36 * MiB, WS_DT = 70 * MiB, WS_PROJ = 74 * MiB,
                 WS_YA = 432 * MiB, WS_YS = 458 * MiB, WS_SSQ = 524 * MiB, WS_TMP = 528 * MiB, WS_MRG = 594 * MiB, WS_END = 628 * MiB;
constexpr size_t O_YP = 0, O_YS = O_YP + (size_t)MP * DM, O_KP = O_YS + (size_t)MS * DM, O_VP = O_KP + (size_t)MP * DA, O_CP = O_VP + (size_t)MP * DA,
                 O_SP = O_CP + (size_t)NBATCH * 3 * DCONV, O_KS = O_SP + (size_t)NBATCH * NSH * SHD * DST, O_VS = O_KS + (size_t)MS * DA, O_CS = O_VS + (size_t)MS * DA,
                 O_SS = O_CS + (size_t)DECB * 3 * DCONV, O_END = O_SS + (size_t)DECB * NSH * SHD * DST;
constexpr int LDS_BYTES = 147456;
constexpr int PR_CONVW = 0, PR_CONVB = 16384, PR_DTB = 20480, PR_ALOG = 20512, PR_DSKIP = 20544, PR_RELB = 20576, PR_FNORM = 20992, PR_END = 22016;

struct Args {
    const float *x_prompt, *x_sample, *cache_k, *cache_v, *state_conv, *state_ssm, *norm_g, *w_in, *conv_w, *conv_b, *dt_bias, *a_log, *d_skip, *ssm_norm, *w_a, *w_b, *w_out, *rel_bias, *final_norm;
    float* out; unsigned char* ws;
    int ph_lo, ph_hi, probe, pad_;
};

__device__ __forceinline__ float bf2f(bf16 b) { return __uint_as_float(((unsigned)b) << 16); }
__device__ __forceinline__ unsigned f2bf(float f) { unsigned u = __float_as_uint(f); return (u + 0x7fffu + ((u >> 16) & 1u)) >> 16; }
typedef float f32x2_t __attribute__((ext_vector_type(2))); typedef __bf16 bf16x2_t __attribute__((ext_vector_type(2)));
__device__ __forceinline__ unsigned pk2(float lo, float hi) { const f32x2_t v = {lo, hi}; return __builtin_bit_cast(unsigned, __builtin_convertvector(v, bf16x2_t)); }
__device__ __forceinline__ float sigmoidf_(float x) { return 1.f / (1.f + __expf(-x)); }
__device__ __forceinline__ float siluf_(float x) { return x / (1.f + __expf(-x)); }
__device__ __forceinline__ float softplusf_(float x) { return fmaxf(x, 0.f) + log1pf(__expf(-fabsf(x))); }
__device__ __forceinline__ float wave_sum(float v) {
#pragma unroll
    for (int o = 1; o < 64; o <<= 1) v += __shfl_xor(v, o);
    return v;
}
__device__ __forceinline__ float wave_max(float v) {
#pragma unroll
    for (int o = 1; o < 64; o <<= 1) v = fmaxf(v, __shfl_xor(v, o));
    return v;
}
__device__ __forceinline__ int t5_bucket(int off) {
    if (off < 16) return off;
    return 16 + (off >= 22) + (off >= 30) + (off >= 40) + (off >= 54) + (off >= 73) + (off >= 99) + (off >= 134) + (off >= 182) + (off >= 246) + (off >= 332) + (off >= 450) + (off >= 609) + (off >= 825) + (off >= 1117) + (off >= 1513);
}
__device__ __forceinline__ const float* ld_ptr(const unsigned char* ws, int idx) { const unsigned long long v = ((const unsigned long long*)(ws + WS_ARGS))[idx];
    const unsigned lo = __builtin_amdgcn_readfirstlane((unsigned)v), hi = __builtin_amdgcn_readfirstlane((unsigned)(v >> 32)); return (const float*)(((unsigned long long)hi << 32) | lo); }
#define LDS_WAIT() asm volatile("s_waitcnt lgkmcnt(0)" ::: "memory")
typedef short bf16x8 __attribute__((ext_vector_type(8)));
typedef short s16x4 __attribute__((ext_vector_type(4)));
constexpr int AT_ST = 0, AT_STROW = 272, AT_ML = 69632, AT_BIAS = 71680, AT_V = 73728, AT_VROW = 144, AT_VBYTES = 32 * AT_VROW, AT_VWAVE = 2 * AT_VBYTES;
constexpr float LOG2E = 1.4426950408889634f;
__device__ __forceinline__ s16x4 lds_tr16(LAS const unsigned char* p) { return __builtin_bit_cast(s16x4, __builtin_amdgcn_ds_read_tr16_b64_v4i16((LAS s16x4*)p)); }

template <bool SAMP> __device__ __forceinline__ void attn_item(const bf16* base, const float* ck, const float* cv, int P0, int stride, const LAS float* bias2, LAS unsigned char* vst, int lane, float& m_out, float& l_out, f32x4 (&o)[4]) {
    const int c = lane & 15, rq = lane >> 4;
    bf16x8 qf[2];
    { int qrow = P0 + stride * c; if (SAMP) { qrow -= KVB; qrow = qrow > DECS - 1 ? DECS - 1 : qrow; }
      const bf16* qp = base + (size_t)qrow * NPROJ + C_Q + rq * 8; qf[0] = *(const bf16x8*)qp; qf[1] = *(const bf16x8*)(qp + 32); }
    u32x4 vh[SAMP ? 1 : 5][4]; f32x4 vq[SAMP ? 2 : 1][SAMP ? 8 : 1];
#define AT_STEP_VALID0(ks) ((P0 + stride * (16 * ((2 * (ks) + 1 < 9) ? 2 * (ks) + 1 : 8) + 15 - 128)) >= 0)
    if (!SAMP) {
#pragma unroll
        for (int ks = 0; ks < 5; ++ks) if (AT_STEP_VALID0(ks)) {
#pragma unroll
            for (int i = 0; i < 4; ++i) { int kpos = P0 + stride * (32 * ks + 8 * i + (lane >> 3) - 128); kpos = kpos < 0 ? 0 : (kpos > SEQ - 1 ? SEQ - 1 : kpos);
                vh[ks][i] = *(const u32x4*)(base + (size_t)kpos * NPROJ + C_V + (lane & 7) * 8); } }
    } else {
#pragma unroll
        for (int i = 0; i < 4; ++i) { int kpos = P0 + stride * (8 * i + (lane >> 3)) - KVB; kpos = kpos < 0 ? 0 : (kpos > DECS - 1 ? DECS - 1 : kpos);
            vh[0][i] = *(const u32x4*)(base + (size_t)kpos * NPROJ + C_V + (lane & 7) * 8); }
    }
#undef AT_STEP_VALID0
    f32x4 sc[9];
#pragma unroll
    for (int kt = 0; kt < 9; ++kt) {
        const bool tile_valid = (P0 + stride * (16 * kt + 15 - 128)) >= 0;
        if (tile_valid) {
            int kpos = P0 + stride * (16 * kt + c - 128); kpos = kpos < 0 ? 0 : kpos;
            bf16x8 k0, k1;
            if (SAMP && kt < 8) { const float* kp = ck + (size_t)kpos * (NH * HD) + rq * 8;
                const f32x4 a0 = *(const f32x4*)kp, a1 = *(const f32x4*)(kp + 4), b0 = *(const f32x4*)(kp + 32), b1 = *(const f32x4*)(kp + 36);
                u32x4 w0, w1; w0.x = pk2(a0[0], a0[1]); w0.y = pk2(a0[2], a0[3]); w0.z = pk2(a1[0], a1[1]); w0.w = pk2(a1[2], a1[3]); w1.x = pk2(b0[0], b0[1]); w1.y = pk2(b0[2], b0[3]); w1.z = pk2(b1[0], b1[1]); w1.w = pk2(b1[2], b1[3]);
                k0 = __builtin_bit_cast(bf16x8, w0); k1 = __builtin_bit_cast(bf16x8, w1);
            } else { if (SAMP) { kpos -= KVB; kpos = kpos > DECS - 1 ? DECS - 1 : kpos; }
                const bf16* kp = base + (size_t)kpos * NPROJ + C_K + rq * 8; k0 = *(const bf16x8*)kp; k1 = *(const bf16x8*)(kp + 32); }
            f32x4 acc = {0.f, 0.f, 0.f, 0.f};
            acc = __builtin_amdgcn_mfma_f32_16x16x32_bf16(k0, qf[0], acc, 0, 0, 0);
            acc = __builtin_amdgcn_mfma_f32_16x16x32_bf16(k1, qf[1], acc, 0, 0, 0);
#pragma unroll
            for (int j = 0; j < 4; ++j) { const int kidx = 16 * kt + 4 * rq + j, jj = c + 128 - kidx, kp2 = P0 + stride * (kidx - 128);
                const bool valid = (jj >= 0) && (jj <= 128) && (kp2 >= 0); const int jc = jj < 0 ? 0 : (jj > 128 ? 128 : jj);
                sc[kt][j] = valid ? acc[j] * (0.125f * LOG2E) + bias2[jc] : -INFINITY; }
        } else sc[kt] = (f32x4){-INFINITY, -INFINITY, -INFINITY, -INFINITY};
        if (SAMP && (kt == 2 || kt == 5)) __builtin_amdgcn_sched_barrier(0);
    }
    if (SAMP) {
        __builtin_amdgcn_sched_barrier(0);
#pragma unroll
        for (int ks = 0; ks < 2; ++ks)
#pragma unroll
            for (int i = 0; i < 8; ++i) { int kpos = P0 + stride * (32 * ks + 4 * i + (lane >> 4) - 128); kpos = kpos < 0 ? 0 : kpos;
                vq[ks][i] = *(const f32x4*)(cv + (size_t)kpos * (NH * HD) + (lane & 15) * 4); }
    }
    float m = -INFINITY;
#pragma unroll
    for (int kt = 0; kt < 9; ++kt) m = fmaxf(fmaxf(fmaxf(m, sc[kt][0]), fmaxf(sc[kt][1], sc[kt][2])), sc[kt][3]);
    m = fmaxf(m, __shfl_xor(m, 16)); m = fmaxf(m, __shfl_xor(m, 32));
    float l = 0.f;
#pragma unroll
    for (int kt = 0; kt < 9; ++kt)
#pragma unroll
        for (int j = 0; j < 4; ++j) { const float p = __builtin_amdgcn_exp2f(sc[kt][j] - m); sc[kt][j] = p; l += p; }
    l += __shfl_xor(l, 16); l += __shfl_xor(l, 32);
#pragma unroll
    for (int dt = 0; dt < 4; ++dt) o[dt] = (f32x4){0.f, 0.f, 0.f, 0.f};
    LAS const unsigned char* vr = vst + (4 * rq + ((lane & 15) >> 2)) * AT_VROW + (lane & 3) * 8;
#define AT_STEP_VALID(ks) ((P0 + stride * (16 * ((2 * (ks) + 1 < 9) ? 2 * (ks) + 1 : 8) + 15 - 128)) >= 0)
#define AT_VWRITE(ks) do { if (AT_STEP_VALID(ks)) { LAS unsigned char* vb_ = vst + ((ks) & 1) * AT_VBYTES; \
        if (SAMP && (ks) < 4) { _Pragma("unroll") for (int i = 0; i < 8; ++i) { const f32x4 v = vq[(ks) & 1][i]; u32x2 w; w.x = pk2(v[0], v[1]); w.y = pk2(v[2], v[3]); *(LAS u32x2*)(vb_ + (4 * i + (lane >> 4)) * AT_VROW + (lane & 15) * 8) = w; } } \
        else { _Pragma("unroll") for (int i = 0; i < 4; ++i) *(LAS u32x4*)(vb_ + (8 * i + (lane >> 3)) * AT_VROW + (lane & 7) * 16) = vh[SAMP ? 0 : (ks)][i]; } } } while (0)
#define AT_VLOADF(ks) do { if (AT_STEP_VALID(ks)) { _Pragma("unroll") for (int i = 0; i < 8; ++i) { int kpos = P0 + stride * (32 * (ks) + 4 * i + (lane >> 4) - 128); kpos = kpos < 0 ? 0 : kpos; \
        vq[(ks) & 1][i] = *(const f32x4*)(cv + (size_t)kpos * (NH * HD) + (lane & 15) * 4); } } } while (0)
    AT_VWRITE(0);
#pragma unroll
    for (int ks = 0; ks < 5; ++ks) {
        if (SAMP && ks + 2 < 4) {   }
        if (ks + 1 < 5) AT_VWRITE(ks + 1);
        if (SAMP && ks + 2 < 4) AT_VLOADF(ks + 2);
        if (AT_STEP_VALID(ks)) {
            bf16x8 pb;
            { const f32x4 pa = sc[2 * ks]; const f32x4 pz = (2 * ks + 1 < 9) ? sc[(2 * ks + 1 < 9) ? 2 * ks + 1 : 8] : (f32x4){0.f, 0.f, 0.f, 0.f};
              u32x4 w; w.x = pk2(pa[0], pa[1]); w.y = pk2(pa[2], pa[3]); w.z = pk2(pz[0], pz[1]); w.w = pk2(pz[2], pz[3]); pb = __builtin_bit_cast(bf16x8, w); }
            LAS const unsigned char* vrb = vr + (ks & 1) * AT_VBYTES;
#pragma unroll
            for (int dt = 0; dt < 4; ++dt) { const s16x4 lo = lds_tr16(vrb + dt * 32), hi = lds_tr16(vrb + dt * 32 + 16 * AT_VROW);
                const bf16x8 vf = (bf16x8){lo[0], lo[1], lo[2], lo[3], hi[0], hi[1], hi[2], hi[3]};
                o[dt] = __builtin_amdgcn_mfma_f32_16x16x32_bf16(vf, pb, o[dt], 0, 0, 0); }
        }
    }
#undef AT_VWRITE
#undef AT_VLOADF
#undef AT_STEP_VALID
    m_out = m; l_out = l;
}
__device__ __forceinline__ void attn_merge(int mode, LAS unsigned char* lds, int ql, int lane, float m, float l, f32x4 (&o)[4], const bf16* gp  , bf16* yp  ) {
    const int rq = lane >> 4;
    LAS float* ml = (LAS float*)(lds + AT_ML) + ql * 2; LAS unsigned char* st = lds + AT_ST + ql * AT_STROW + rq * 16;
    if (mode == 0) {
#pragma unroll
        for (int dt = 0; dt < 4; ++dt) *(LAS f32x4*)(st + dt * 64) = o[dt];
        if (rq == 0) { ml[0] = m; ml[1] = l; }
    } else {
        const float M = ml[0], L = ml[1]; const float Mn = fmaxf(M, m), ca = __builtin_amdgcn_exp2f(M - Mn), cb = __builtin_amdgcn_exp2f(m - Mn); const float Ln = L * ca + l * cb;
        f32x4 on[4];
#pragma unroll
        for (int dt = 0; dt < 4; ++dt) on[dt] = *(LAS const f32x4*)(st + dt * 64) * ca + o[dt] * cb;
        if (mode == 1) {
            LDS_WAIT(); asm volatile("" ::: "memory");
#pragma unroll
            for (int dt = 0; dt < 4; ++dt) *(LAS f32x4*)(st + dt * 64) = on[dt];
            if (rq == 0) { ml[0] = Mn; ml[1] = Ln; }
        } else {
            const float inv = 1.f / Ln;
#pragma unroll
            for (int dt = 0; dt < 4; ++dt) { const u32x2 g = *(const u32x2*)(gp + 16 * dt + 4 * rq);
                const float g0 = __uint_as_float(g.x << 16), g1 = __uint_as_float(g.x & 0xffff0000u), g2 = __uint_as_float(g.y << 16), g3 = __uint_as_float(g.y & 0xffff0000u);
                u32x2 w; w.x = pk2(on[dt][0] * inv * siluf_(g0), on[dt][1] * inv * siluf_(g1)); w.y = pk2(on[dt][2] * inv * siluf_(g2), on[dt][3] * inv * siluf_(g3));
                *(u32x2*)(yp + 16 * dt + 4 * rq) = w; }
        }
    }
}
__device__ __forceinline__ void attn_unit(const unsigned char* ws, LAS unsigned char* lds, int b, int h, int s, int wave, int lane) {
    const bf16* proj = (const bf16*)(ws + WS_PROJ); bf16* ya = (bf16*)(ws + WS_YA); const float* prm = (const float*)(ws + WS_PRM);
    const bf16* base = proj + (size_t)b * SEQ * NPROJ + h * HD;
    LAS float* bias2 = (LAS float*)(lds + AT_BIAS); LAS unsigned char* vst = lds + AT_V + wave * AT_VWAVE;
    for (int idx = threadIdx.x; idx < 3 * 129; idx += NTHR) { const int g = idx / 129, j = idx - g * 129; bias2[g * 132 + j] = prm[PR_RELB + t5_bucket(j << (2 * g)) * NH + h] * LOG2E; }
    const int c = lane & 15;
#pragma unroll 1
    for (int it = 0; it < 6; ++it) {
        if ((it & 1) == 0) __syncthreads();
        const int id = 2 * wave + (it & 1), mode = it >> 1;
        int q0, stride;
        if (mode == 0) { q0 = id; stride = 16; } else if (mode == 1) { q0 = (id >> 2) + 64 * (id & 3); stride = 4; } else { q0 = 16 * id; stride = 1; }
        float m, l; f32x4 o[4];
        attn_item<false>(base, nullptr, nullptr, s + q0, stride, bias2 + (2 - mode) * 132, vst, lane, m, l, o);
        const int ql = q0 + stride * c; const size_t row = (size_t)b * SEQ + s + ql;
        attn_merge(mode, lds, ql, lane, m, l, o, proj + row * NPROJ + C_G + h * HD, ya + row * DA + h * HD);
    }
    __syncthreads();
}

constexpr int AS_SLOT = 0, AS_SLOTF = 68;
__device__ __forceinline__ void attn_sample_unit(const unsigned char* ws, const float* cache_k, const float* cache_v, LAS unsigned char* lds, int sq, int h, int wave, int lane) {
    const bf16* proj = (const bf16*)(ws + WS_PROJ); bf16* ya = (bf16*)(ws + WS_YA); const float* prm = (const float*)(ws + WS_PRM);
    const bf16* base = proj + (size_t)(MP + sq * DECS) * NPROJ + h * HD; const float* ck = cache_k + ((size_t)sq * KVB * NH + h) * HD; const float* cv = cache_v + ((size_t)sq * KVB * NH + h) * HD;
    LAS float* bias2 = (LAS float*)(lds + AT_BIAS); LAS unsigned char* vst = lds + AT_V + wave * AT_VWAVE; LAS float* slots = (LAS float*)(lds + AS_SLOT);
    for (int idx = threadIdx.x; idx < 3 * 129; idx += NTHR) { const int g = idx / 129, j = idx - g * 129; bias2[g * 132 + j] = prm[PR_RELB + t5_bucket(j << (2 * g)) * NH + h] * LOG2E; }
    __syncthreads();
    const int c = lane & 15, rq = lane >> 4;
#pragma unroll 1
    for (int id = wave; id < 13; id += NWAVES) {
        const int g = id == 0 ? 0 : (id < 5 ? 1 : 2), r = id == 0 ? 0 : (id < 5 ? id - 1 : id - 5), stride = 1 << (2 * g), nq = (DECS - r + stride - 1) / stride;
        float m, l; f32x4 o[4];
        attn_item<true>(base, ck, cv, KVB + r, stride, bias2 + g * 132, vst, lane, m, l, o);
        if (c < nq) { LAS float* sl = slots + ((r + stride * c) * 3 + g) * AS_SLOTF;
#pragma unroll
            for (int dt = 0; dt < 4; ++dt) *(LAS f32x4*)(sl + 16 * dt + 4 * rq) = o[dt];
            if (rq == 0) { sl[64] = m; sl[65] = l; } }
    }
    __syncthreads();
    { const int i = threadIdx.x >> 6, d = lane; const LAS float* s0 = slots + (i * 3) * AS_SLOTF; const LAS float* s1 = s0 + AS_SLOTF; const LAS float* s2 = s1 + AS_SLOTF;
      const float m0 = s0[64], m1 = s1[64], m2 = s2[64], M = fmaxf(m0, fmaxf(m1, m2));
      const float c0 = __builtin_amdgcn_exp2f(m0 - M), c1 = __builtin_amdgcn_exp2f(m1 - M), c2 = __builtin_amdgcn_exp2f(m2 - M);
      const float L = s0[65] * c0 + s1[65] * c1 + s2[65] * c2, O = s0[d] * c0 + s1[d] * c1 + s2[d] * c2;
      const size_t row = (size_t)MP + sq * DECS + i; const float gv = bf2f(proj[row * NPROJ + C_G + h * HD + d]);
      ya[row * DA + h * HD + d] = (bf16)f2bf(O / L * siluf_(gv)); }
    __syncthreads();
}
constexpr int SD_BM = 0, SD_CM = 17408, SD_CS = 34816, SD_ROWN = 272, SD_BWT = 52224, SD_XT = 70656, SD_ROWS = 144, SD_YP = 79872, SD_YROW = 272, SD_AR = 114688, SD_CW = 115712;
__device__ __forceinline__ void ssd_dtarrays(LAS float* ar, float dtv, float Aneg, int lane) {
    asm volatile("" : "+v"(lane));
    float x = dtv * Aneg * LOG2E;
#pragma unroll
    for (int o = 1; o < 64; o <<= 1) { const float y = __shfl_up(x, o); if (lane >= o) x += y; }
    const float tot = __shfl(x, 63);
    ar[lane] = x; ar[64 + lane] = dtv; ar[128 + lane] = __builtin_amdgcn_exp2f(tot - x) * dtv; ar[192 + lane] = __builtin_amdgcn_exp2f(x);
}
__device__ __forceinline__ float silu_fast(float x) { return x * __builtin_amdgcn_rcpf(1.f + __builtin_amdgcn_exp2f(-x * LOG2E)); }
typedef float f32x2 __attribute__((ext_vector_type(2)));
__device__ __forceinline__ void ssd_conv_load(unsigned (&raw)[19], const bf16* proj, const bf16* zrow, size_t row0, int c0, int t0, int col) {
    const bf16* basep = proj + (row0 + (size_t)(c0 + t0)) * NPROJ + C_XBC + col;
#pragma unroll
    for (int k = 0; k < 19; ++k) { const int T = c0 + t0 - 3 + k; const bf16* rp = (T >= 0) ? basep + (ptrdiff_t)(k - 3) * NPROJ : zrow + col; raw[k] = *(const unsigned*)rp; }
}
template <int KIND> __device__ __forceinline__ void ssd_conv_compute(const unsigned (&raw)[19], LAS unsigned char* lds, int t0, int chl  , int ch) {
    const LAS float* ar = (const LAS float*)(lds + SD_AR); const LAS float* cw = (const LAS float*)(lds + SD_CW) + chl;
    f32x2 w[4];
#pragma unroll
    for (int tap = 0; tap < 4; ++tap) w[tap] = *(const LAS f32x2*)(cw + tap * 320);
    const f32x2 bb = *(const LAS f32x2*)(cw + 4 * 320);
#pragma unroll
    for (int blk = 0; blk < 2; ++blk) {
        float o0[8], o1[8];
#pragma unroll
        for (int tt = 0; tt < 8; ++tt) { const int t = blk * 8 + tt; f32x2 v = bb;
#pragma unroll
            for (int tap = 0; tap < 4; ++tap) v += w[tap] * (f32x2){__uint_as_float(raw[t + tap] << 16), __uint_as_float(raw[t + tap] & 0xffff0000u)};
            o0[tt] = silu_fast(v.x); o1[tt] = silu_fast(v.y); }
        const int s0 = t0 + blk * 8;
        if (KIND == 0) {
            u32x4 a, b; a.x = pk2(o0[0], o0[1]); a.y = pk2(o0[2], o0[3]); a.z = pk2(o0[4], o0[5]); a.w = pk2(o0[6], o0[7]); b.x = pk2(o1[0], o1[1]); b.y = pk2(o1[2], o1[3]); b.z = pk2(o1[4], o1[5]); b.w = pk2(o1[6], o1[7]);
            *(LAS u32x4*)(lds + SD_XT + ch * SD_ROWS + s0 * 2) = a; *(LAS u32x4*)(lds + SD_XT + (ch + 1) * SD_ROWS + s0 * 2) = b;
        } else if (KIND == 1) {
            float s0v[8], s1v[8];
#pragma unroll
            for (int tt = 0; tt < 8; ++tt) { *(LAS unsigned*)(lds + SD_BM + (s0 + tt) * SD_ROWN + ch * 2) = pk2(o0[tt], o1[tt]); const float ww = ar[128 + s0 + tt]; s0v[tt] = o0[tt] * ww; s1v[tt] = o1[tt] * ww; }
            u32x4 a, b; a.x = pk2(s0v[0], s0v[1]); a.y = pk2(s0v[2], s0v[3]); a.z = pk2(s0v[4], s0v[5]); a.w = pk2(s0v[6], s0v[7]); b.x = pk2(s1v[0], s1v[1]); b.y = pk2(s1v[2], s1v[3]); b.z = pk2(s1v[4], s1v[5]); b.w = pk2(s1v[6], s1v[7]);
            *(LAS u32x4*)(lds + SD_BWT + ch * SD_ROWS + s0 * 2) = a; *(LAS u32x4*)(lds + SD_BWT + (ch + 1) * SD_ROWS + s0 * 2) = b;
        } else {
#pragma unroll
            for (int tt = 0; tt < 8; ++tt) { *(LAS unsigned*)(lds + SD_CM + (s0 + tt) * SD_ROWN + ch * 2) = pk2(o0[tt], o1[tt]); const float e = ar[192 + s0 + tt];
                *(LAS unsigned*)(lds + SD_CS + (s0 + tt) * SD_ROWN + ch * 2) = pk2(o0[tt] * e, o1[tt] * e); }
        }
    }
}
__device__ __forceinline__ bf16x8 cat8(s16x4 a, s16x4 b) { return (bf16x8){a[0], a[1], a[2], a[3], b[0], b[1], b[2], b[3]}; }
#define SD_SCHED() __builtin_amdgcn_sched_barrier(0)
template <int HH> __device__ __forceinline__ void ssd_mfma_step(LAS unsigned char* lds, f32x4 (&Hacc)[4], int pt, int c, int rq, float Dk) {
    const LAS float* ar = (const LAS float*)(lds + SD_AR);
    constexpr int S0 = 2 * HH, S1 = 2 * HH + 1;
    const int p = 16 * pt + c;
    const LAS unsigned char* bmp = lds + SD_BM + (32 * HH + c) * SD_ROWN + 16 * rq; const LAS unsigned char* cmp_ = lds + SD_CM + c * SD_ROWN + 16 * rq;
    f32x4 g0[4], g1[4];
#pragma unroll
    for (int lt = 0; lt < 4; ++lt) { g0[lt] = (f32x4){0.f, 0.f, 0.f, 0.f}; g1[lt] = (f32x4){0.f, 0.f, 0.f, 0.f}; }
    bf16x8 fb[2][2], fc[2][4];
#define SD_LOADG(buf, ks) do { fb[buf][0] = *(LAS const bf16x8*)(bmp + 64 * (ks)); fb[buf][1] = *(LAS const bf16x8*)(bmp + 16 * SD_ROWN + 64 * (ks)); \
        _Pragma("unroll") for (int lt = S0; lt < 4; ++lt) fc[buf][lt] = *(LAS const bf16x8*)(cmp_ + 16 * lt * SD_ROWN + 64 * (ks)); } while (0)
    SD_LOADG(0, 0);
#pragma unroll
    for (int ks = 0; ks < 4; ++ks) {
        if (ks + 1 < 4) SD_LOADG((ks + 1) & 1, ks + 1);
        SD_SCHED();
#pragma unroll
        for (int lt = S0; lt < 4; ++lt) { g0[lt] = __builtin_amdgcn_mfma_f32_16x16x32_bf16(fb[ks & 1][0], fc[ks & 1][lt], g0[lt], 0, 0, 0);
            if (lt >= S1) g1[lt] = __builtin_amdgcn_mfma_f32_16x16x32_bf16(fb[ks & 1][1], fc[ks & 1][lt], g1[lt], 0, 0, 0); }
        SD_SCHED();
    }
#undef SD_LOADG
    bf16x8 csf[4][2];
#pragma unroll
    for (int lt = 0; lt < 4; ++lt)
#pragma unroll
        for (int k2 = 0; k2 < 2; ++k2) { const LAS unsigned char* cp = lds + SD_CS + (16 * lt + c) * SD_ROWN + (64 * HH + 32 * k2 + 4 * rq) * 2; csf[lt][k2] = cat8(*(LAS const s16x4*)cp, *(LAS const s16x4*)(cp + 32)); }
    const bf16x8 xb = cat8(*(LAS const s16x4*)(lds + SD_XT + p * SD_ROWS + (32 * HH + 4 * rq) * 2), *(LAS const s16x4*)(lds + SD_XT + p * SD_ROWS + (32 * HH + 16 + 4 * rq) * 2));
    const f32x4 as0 = *(LAS const f32x4*)(ar + 32 * HH + 4 * rq), as1 = *(LAS const f32x4*)(ar + 32 * HH + 16 + 4 * rq);
    const f32x4 dt0 = *(LAS const f32x4*)(ar + 64 + 32 * HH + 4 * rq), dt1 = *(LAS const f32x4*)(ar + 64 + 32 * HH + 16 + 4 * rq);
    float acl[4];
#pragma unroll
    for (int lt = 0; lt < 4; ++lt) acl[lt] = ar[16 * lt + c];
    const float dec = __builtin_amdgcn_exp2f(ar[63]);
    SD_SCHED();
    int dd = c - 4 * rq; asm volatile("" : "+v"(dd));
    bf16x8 hb[2];
#pragma unroll
    for (int k2 = 0; k2 < 2; ++k2) { u32x4 w; w.x = pk2(Hacc[2 * k2][0], Hacc[2 * k2][1]); w.y = pk2(Hacc[2 * k2][2], Hacc[2 * k2][3]); w.z = pk2(Hacc[2 * k2 + 1][0], Hacc[2 * k2 + 1][1]); w.w = pk2(Hacc[2 * k2 + 1][2], Hacc[2 * k2 + 1][3]); hb[k2] = __builtin_bit_cast(bf16x8, w); }
    bf16x8 mf[4];
#pragma unroll
    for (int lt = 0; lt < 4; ++lt) if (lt >= S0) {
        float m0[4], m1[4];
#pragma unroll
        for (int j = 0; j < 4; ++j) {
            float v0 = g0[lt][j] * __builtin_amdgcn_exp2f(fminf(acl[lt] - as0[j], 0.f)) * dt0[j];
            if (lt == S0) { v0 = (j <= dd) ? v0 : 0.f; v0 += (j == dd) ? Dk : 0.f; }
            m0[j] = v0;
            float v1 = 0.f;
            if (lt >= S1) { v1 = g1[lt][j] * __builtin_amdgcn_exp2f(fminf(acl[lt] - as1[j], 0.f)) * dt1[j]; if (lt == S1) { v1 = (j <= dd) ? v1 : 0.f; v1 += (j == dd) ? Dk : 0.f; } }
            m1[j] = v1; }
        u32x4 w; w.x = pk2(m0[0], m0[1]); w.y = pk2(m0[2], m0[3]); w.z = pk2(m1[0], m1[1]); w.w = pk2(m1[2], m1[3]); mf[lt] = __builtin_bit_cast(bf16x8, w);
    }
    SD_SCHED();
    f32x4 y[4];
#pragma unroll
    for (int lt = 0; lt < 4; ++lt) y[lt] = __builtin_amdgcn_mfma_f32_16x16x32_bf16(csf[lt][0], hb[0], (f32x4){0.f, 0.f, 0.f, 0.f}, 0, 0, 0);
#pragma unroll
    for (int lt = 0; lt < 4; ++lt) y[lt] = __builtin_amdgcn_mfma_f32_16x16x32_bf16(csf[lt][1], hb[1], y[lt], 0, 0, 0);
    SD_SCHED();
    bf16x8 bwf[4][2], xn[2];
#pragma unroll
    for (int k2 = 0; k2 < 2; ++k2) xn[k2] = *(LAS const bf16x8*)(lds + SD_XT + p * SD_ROWS + (8 * rq + 32 * k2) * 2);
#pragma unroll
    for (int nt = 0; nt < 4; ++nt)
#pragma unroll
        for (int k2 = 0; k2 < 2; ++k2) bwf[nt][k2] = *(LAS const bf16x8*)(lds + SD_BWT + (64 * HH + 16 * nt + c) * SD_ROWS + (8 * rq + 32 * k2) * 2);
    SD_SCHED();
#pragma unroll
    for (int lt = 0; lt < 4; ++lt) if (lt >= S0) y[lt] = __builtin_amdgcn_mfma_f32_16x16x32_bf16(mf[lt], xb, y[lt], 0, 0, 0);
#pragma unroll
    for (int nt = 0; nt < 4; ++nt) Hacc[nt] = Hacc[nt] * dec;
#pragma unroll
    for (int k2 = 0; k2 < 2; ++k2)
#pragma unroll
        for (int nt = 0; nt < 4; ++nt) Hacc[nt] = __builtin_amdgcn_mfma_f32_16x16x32_bf16(bwf[nt][k2], xn[k2], Hacc[nt], 0, 0, 0);
#pragma unroll
    for (int lt = 0; lt < 4; ++lt)
#pragma unroll
        for (int j = 0; j < 4; ++j) *(LAS float*)(lds + SD_YP + HH * (64 * SD_YROW) + (16 * lt + 4 * rq + j) * SD_YROW + p * 4) = y[lt][j];
}
__device__ __forceinline__ void ssd_mfma_unit(const unsigned char* ws, float* out, bf16* ys, float* ssq, int probe, LAS unsigned char* lds, int b, int hd, int wave, int lane) {
    const bf16* proj = (const bf16*)(ws + WS_PROJ); const float* dtb = (const float*)(ws + WS_DT); const float* prm = (const float*)(ws + WS_PRM);
    const int tid = threadIdx.x, c = lane & 15, rq = lane >> 4, pt = wave & 3, hh = wave >> 2, grp = hd >> 2;
    const size_t row0 = (size_t)b * SEQ; const bf16* zrow = (const bf16*)(ws + WS_WIN) + (size_t)NIN * DM;
    const float Aneg = -__expf(prm[PR_ALOG + hd]), Dk = prm[PR_DSKIP + hd];
    LAS float* ar = (LAS float*)(lds + SD_AR);
    f32x4 Hacc[4];
#pragma unroll
    for (int nt = 0; nt < 4; ++nt) Hacc[nt] = (f32x4){0.f, 0.f, 0.f, 0.f};
    const int kindA = wave < 2 ? 0 : (wave < 6 ? 1 : 2);
    const int tA = kindA == 0 ? tid : (kindA == 1 ? tid - 128 : tid - 384), pairA = kindA == 0 ? (tA & 31) : (tA & 63), runA = kindA == 0 ? (tA >> 5) : (tA >> 6);
    const int colA = kindA == 0 ? hd * 64 + 2 * pairA : (kindA == 1 ? DSSM + grp * DST + 2 * pairA : DSSM + NGRP * DST + grp * DST + 2 * pairA);
    const int tB = tid + 128, pairB = tB & 63, runB = tB >> 6, colB = DSSM + NGRP * DST + grp * DST + 2 * pairB;
    unsigned rawA[19], rawB[19];
    ssd_conv_load(rawA, proj, zrow, row0, 0, 16 * runA, colA);
    if (wave < 2) ssd_conv_load(rawB, proj, zrow, row0, 0, 16 * runB, colB);
    float dtn = (wave == 7) ? dtb[(row0 + lane) * 32 + hd] : 0.f;
    __syncthreads();
    for (int idx = tid; idx < 5 * 320; idx += NTHR) { const int t5 = idx / 320, chl = idx - t5 * 320; const int col = chl < 64 ? hd * 64 + chl : (chl < 192 ? DSSM + grp * DST + (chl - 64) : DSSM + NGRP * DST + grp * DST + (chl - 192));
        ((LAS float*)(lds + SD_CW))[idx] = t5 < 4 ? prm[PR_CONVW + t5 * DCONV + col] : prm[PR_CONVB + col]; }
    if (wave == 7) { ssd_dtarrays(ar, dtn, Aneg, lane); dtn = dtb[(row0 + 64 + lane) * 32 + hd]; }
    __syncthreads();
    const int el = tid >> 3, ep0 = (tid & 7) * 8;
#pragma unroll 1
    for (int c0 = 0; c0 < SEQ; c0 += 64) {
        const bool more = c0 + 64 < SEQ;
        const u32x4 zreg = *(const u32x4*)(proj + (row0 + c0 + el) * NPROJ + C_Z + hd * 64 + ep0);
        if (!(probe & 2)) {
        if (kindA == 0) ssd_conv_compute<0>(rawA, lds, 16 * runA, 2 * pairA, 2 * pairA); else if (kindA == 1) ssd_conv_compute<1>(rawA, lds, 16 * runA, 64 + 2 * pairA, 2 * pairA); else ssd_conv_compute<2>(rawA, lds, 16 * runA, 192 + 2 * pairA, 2 * pairA);
        if (more) ssd_conv_load(rawA, proj, zrow, row0, c0 + 64, 16 * runA, colA);
        if (wave < 2) { ssd_conv_compute<2>(rawB, lds, 16 * runB, 192 + 2 * pairB, 2 * pairB); if (more) ssd_conv_load(rawB, proj, zrow, row0, c0 + 64, 16 * runB, colB); }
        }
        __syncthreads();
        if (!(probe & 4)) { if (hh == 0) ssd_mfma_step<0>(lds, Hacc, pt, c, rq, Dk); else ssd_mfma_step<1>(lds, Hacc, pt, c, rq, Dk); }
        __syncthreads();
        if (!(probe & 8)) {
            const size_t row = row0 + c0 + el;
            const LAS float* y0 = (const LAS float*)(lds + SD_YP + el * SD_YROW + ep0 * 4); const LAS float* y1 = (const LAS float*)(lds + SD_YP + 64 * SD_YROW + el * SD_YROW + ep0 * 4);
            const f32x4 a0 = *(const LAS f32x4*)y0 + *(const LAS f32x4*)y1, a1 = *(const LAS f32x4*)(y0 + 4) + *(const LAS f32x4*)(y1 + 4);
            const u32x4 z = zreg;
            float v[8];
            v[0] = a0[0] * silu_fast(__uint_as_float(z.x << 16)); v[1] = a0[1] * silu_fast(__uint_as_float(z.x & 0xffff0000u)); v[2] = a0[2] * silu_fast(__uint_as_float(z.y << 16)); v[3] = a0[3] * silu_fast(__uint_as_float(z.y & 0xffff0000u));
            v[4] = a1[0] * silu_fast(__uint_as_float(z.z << 16)); v[5] = a1[1] * silu_fast(__uint_as_float(z.z & 0xffff0000u)); v[6] = a1[2] * silu_fast(__uint_as_float(z.w << 16)); v[7] = a1[3] * silu_fast(__uint_as_float(z.w & 0xffff0000u));
            u32x4 w; w.x = pk2(v[0], v[1]); w.y = pk2(v[2], v[3]); w.z = pk2(v[4], v[5]); w.w = pk2(v[6], v[7]);
            *(u32x4*)(ys + row * DSSM + hd * 64 + ep0) = w;
            float ss = (v[0] * v[0] + v[1] * v[1]) + (v[2] * v[2] + v[3] * v[3]) + (v[4] * v[4] + v[5] * v[5]) + (v[6] * v[6] + v[7] * v[7]);
            ss += __shfl_xor(ss, 1); ss += __shfl_xor(ss, 2); ss += __shfl_xor(ss, 4);
            if ((tid & 7) == 0) ssq[row * NSH + hd] = ss;
            if (wave == 7 && more) { ssd_dtarrays(ar, dtn, Aneg, lane); const int cn = c0 + 128 < SEQ ? c0 + 128 : c0; dtn = dtb[(row0 + cn + lane) * 32 + hd]; }
        }
        __syncthreads();
    }
    float* dst = out + O_SP + ((size_t)(b * NSH + hd) * SHD + 16 * pt + c) * DST + 64 * hh + 4 * rq;
#pragma unroll
    for (int nt = 0; nt < 4; ++nt) *(f32x4*)(dst + 16 * nt) = Hacc[nt];
}
constexpr int SS_TEAM = 12288;
constexpr int SS_X = 0, SS_B = 2048, SS_C = 6144, SS_DT = 10240, SS_Y = 10304, SS_BYTES = 12352;
__device__ __forceinline__ void ssd_sample_teams(const unsigned char* ws, float* out, const float* state_conv, const float* state_ssm, LAS unsigned char* lds, int item0  , int nitems) {
    const bf16* proj = (const bf16*)(ws + WS_PROJ); const float* dtb = (const float*)(ws + WS_DT); const float* prm = (const float*)(ws + WS_PRM); bf16* ys = (bf16*)(ws + WS_YS); float* ssq = (float*)(ws + WS_SSQ);
    const int tid = threadIdx.x, team = tid >> 7, t = tid & 127, p = t >> 1, nh = t & 1;
    const int item = item0 + team; const bool act = team < nitems;
    const int sq = act ? item / NSH : 0, hd = act ? item % NSH : 0, grp = hd >> 2; const size_t row0 = (size_t)MP + sq * DECS;
    LAS unsigned char* tl = lds + team * SS_BYTES;
    LAS float* xs = (LAS float*)(tl + SS_X); LAS float* Bs = (LAS float*)(tl + SS_B); LAS float* Cs = (LAS float*)(tl + SS_C); LAS float* dts = (LAS float*)(tl + SS_DT); LAS float* yb = (LAS float*)(tl + SS_Y);
    f32x4 h[16];
    { const f32x4* s4 = (const f32x4*)(state_ssm + ((size_t)(sq * NSH + hd) * SHD + p) * DST + 64 * nh);
#pragma unroll
      for (int j = 0; j < 16; ++j) h[j] = s4[j]; }
    const float Aneg = -__expf(prm[PR_ALOG + hd]), Dk = prm[PR_DSKIP + hd];
#pragma unroll 1
    for (int c = t; c < 320; c += 128) {
        const int xc = c < 64 ? hd * 64 + c : (c < 192 ? DSSM + grp * DST + (c - 64) : DSSM + NGRP * DST + grp * DST + (c - 192));
        float w[4], raw[11];
#pragma unroll
        for (int tap = 0; tap < 4; ++tap) w[tap] = prm[PR_CONVW + tap * DCONV + xc];
        const float bias = prm[PR_CONVB + xc];
#pragma unroll
        for (int k = 0; k < 3; ++k) raw[k] = state_conv[(size_t)(sq * 3 + k) * DCONV + xc];
#pragma unroll
        for (int k = 0; k < DECS; ++k) raw[3 + k] = bf2f(proj[(row0 + k) * NPROJ + C_XBC + xc]);
        LAS float* dstp = c < 64 ? xs + c : (c < 192 ? Bs + (c - 64) : Cs + (c - 192)); const int dstride = c < 64 ? 64 : 128;
#pragma unroll
        for (int tk = 0; tk < DECS; ++tk) { const float acc = bias + w[0] * raw[tk] + w[1] * raw[tk + 1] + w[2] * raw[tk + 2] + w[3] * raw[tk + 3]; dstp[tk * dstride] = siluf_(acc); }
    }
    if (t < DECS) { const float dtv = dtb[(row0 + t) * 32 + hd]; dts[t] = dtv; dts[8 + t] = __expf(dtv * Aneg); }
    __syncthreads();
#pragma unroll 1
    for (int tk = 0; tk < DECS; ++tk) {
        const float dA = dts[8 + tk], xv = xs[tk * 64 + p], dtx = dts[tk] * xv;
        const LAS f32x4* b4 = (const LAS f32x4*)(Bs + tk * 128 + 64 * nh); const LAS f32x4* c4 = (const LAS f32x4*)(Cs + tk * 128 + 64 * nh);
        f32x4 a4 = {0.f, 0.f, 0.f, 0.f};
#pragma unroll
        for (int j = 0; j < 16; ++j) { h[j] = h[j] * dA + b4[j] * dtx; a4 += h[j] * c4[j]; }
        float acc = (a4[0] + a4[1]) + (a4[2] + a4[3]);
        acc += __shfl_xor(acc, 1);
        if (nh == 0) yb[tk * 64 + p] = acc + Dk * xv;
    }
    if (act) { f32x4* d4 = (f32x4*)(out + O_SS + ((size_t)(sq * NSH + hd) * SHD + p) * DST + 64 * nh);
#pragma unroll
        for (int j = 0; j < 16; ++j) d4[j] = h[j]; }
    __syncthreads();
    { const int tk = t >> 4, p0 = (t & 15) * 4; const size_t row = row0 + tk;
      const f32x4 yv = *(const LAS f32x4*)(yb + tk * 64 + p0); const u32x2 z = *(const u32x2*)(proj + row * NPROJ + C_Z + hd * 64 + p0);
      const float v0 = yv[0] * siluf_(__uint_as_float(z.x << 16)), v1 = yv[1] * siluf_(__uint_as_float(z.x & 0xffff0000u)), v2 = yv[2] * siluf_(__uint_as_float(z.y << 16)), v3 = yv[3] * siluf_(__uint_as_float(z.y & 0xffff0000u));
      float ss = (v0 * v0 + v1 * v1) + (v2 * v2 + v3 * v3);
      ss += __shfl_xor(ss, 1); ss += __shfl_xor(ss, 2); ss += __shfl_xor(ss, 4); ss += __shfl_xor(ss, 8);
      if (act) { u32x2 w; w.x = pk2(v0, v1); w.y = pk2(v2, v3); *(u32x2*)(ys + row * DSSM + hd * 64 + p0) = w; if ((t & 15) == 0) ssq[row * NSH + hd] = ss; } }
    __syncthreads();
}
template <int NKS  > __device__ __forceinline__ f32x2 skinny_tile(const bf16* A, const bf16* Wt, int tile, LAS unsigned char* lds, int wave, int lane) {
    constexpr int K = 256 * NKS;
    const int c = lane & 15, rq = lane >> 4, rb = tile >> 4, cb = tile & 15, k0 = wave * (32 * NKS);
    const bf16* ap = A + (size_t)(16 * rb + c) * K + k0 + 8 * rq; const bf16* wp = Wt + (size_t)(64 * cb + c) * K + k0 + 8 * rq;
    f32x4 acc[4];
#pragma unroll
    for (int nt = 0; nt < 4; ++nt) acc[nt] = (f32x4){0.f, 0.f, 0.f, 0.f};
#pragma unroll
    for (int ks = 0; ks < NKS; ++ks) { const bf16x8 af = *(const bf16x8*)(ap + 32 * ks);
#pragma unroll
        for (int nt = 0; nt < 4; ++nt) acc[nt] = __builtin_amdgcn_mfma_f32_16x16x32_bf16(af, *(const bf16x8*)(wp + (size_t)(16 * nt) * K + 32 * ks), acc[nt], 0, 0, 0); }
    LAS float* P = (LAS float*)lds;
#pragma unroll
    for (int nt = 0; nt < 4; ++nt)
#pragma unroll
        for (int j = 0; j < 4; ++j) P[(wave * 16 + 4 * rq + j) * 64 + 16 * nt + c] = acc[nt][j];
    __syncthreads();
    const int tid = threadIdx.x; f32x2 r = {0.f, 0.f};
#pragma unroll
    for (int w = 0; w < 8; ++w) r += *(const LAS f32x2*)(P + (w * 16 + (tid >> 5)) * 64 + 2 * (tid & 31));
    __syncthreads();
    return r;
}
__device__ __forceinline__ void skinny_p3(const unsigned char* ws, LAS unsigned char* lds, int G, int wave, int lane) {
    const bf16* proj = (const bf16*)(ws + WS_PROJ); const bf16* ya = (const bf16*)(ws + WS_YA) + (size_t)MP * DA; const bf16* ysn = (const bf16*)(ws + WS_YS) + (size_t)MP * DSSM; bf16* mrg = (bf16*)(ws + WS_MRG);
    for (int tile = blockIdx.x; tile < 256; tile += G) {
        const size_t row = (size_t)MP + 16 * (tile >> 4) + (threadIdx.x >> 5); const int col = 64 * (tile & 15) + 2 * (threadIdx.x & 31);
        const f32x2 a = skinny_tile<3>(ya, (const bf16*)(ws + WS_WA), tile, lds, wave, lane);
        const f32x2 b = skinny_tile<8>(ysn, (const bf16*)(ws + WS_WB), tile, lds, wave, lane);
        const unsigned ga = *(const unsigned*)(proj + row * NPROJ + C_GA + col), gb = *(const unsigned*)(proj + row * NPROJ + C_GB + col);
        const float m0 = sigmoidf_(__uint_as_float(ga << 16)) * a.x + sigmoidf_(__uint_as_float(gb << 16)) * b.x, m1 = sigmoidf_(__uint_as_float(ga & 0xffff0000u)) * a.y + sigmoidf_(__uint_as_float(gb & 0xffff0000u)) * b.y;
        *(unsigned*)(mrg + row * DM + col) = pk2(m0, m1);
    }
}
__device__ __forceinline__ void skinny_p4(const unsigned char* ws, const float* x_sample, float* out, LAS unsigned char* lds, int G, int wave, int lane) {
    const bf16* mrg = (const bf16*)(ws + WS_MRG) + (size_t)MP * DM;
    for (int tile = blockIdx.x; tile < 256; tile += G) {
        const int r = 16 * (tile >> 4) + (threadIdx.x >> 5), col = 64 * (tile & 15) + 2 * (threadIdx.x & 31);
        const f32x2 o = skinny_tile<4>(mrg, (const bf16*)(ws + WS_WO), tile, lds, wave, lane);
        const f32x2 xv = *(const f32x2*)(x_sample + (size_t)r * DM + col);
        *(f32x2*)(out + O_YS + (size_t)r * DM + col) = xv + o;
    }
}
__device__ __forceinline__ void p0_transpose_item(const float* W, int K, int N, bf16* WT, int k0, int n0, int dst_row0, const float* kscale, LAS float* scr, int lane) {
#pragma unroll 8
    for (int i = 0; i < 32; ++i) { const int kk = 2 * i + (lane >> 5); float v = W[(size_t)(k0 + kk) * N + n0 + (lane & 31)]; if (kscale) v *= kscale[k0 + kk]; scr[kk * 33 + (lane & 31)] = v; }
    LDS_WAIT(); asm volatile("" ::: "memory");
    const int c = lane & 7;
#pragma unroll
    for (int j = 0; j < 4; ++j) { const int n = (lane >> 3) + 8 * j; const LAS float* s = scr + (8 * c) * 33 + n;
        u32x4 o; o.x = pk2(s[0 * 33], s[1 * 33]); o.y = pk2(s[2 * 33], s[3 * 33]); o.z = pk2(s[4 * 33], s[5 * 33]); o.w = pk2(s[6 * 33], s[7 * 33]);
        *(u32x4*)(WT + (size_t)(dst_row0 + n) * K + k0 + 8 * c) = o; }
    LDS_WAIT(); asm volatile("" ::: "memory");
}
__device__ __forceinline__ void p0_prologue(const Args& a, LAS unsigned char* lds, int gw, int NGW, int wave, int lane) {
    bf16* win_t = (bf16*)(a.ws + WS_WIN); bf16* wa_t = (bf16*)(a.ws + WS_WA); bf16* wb_t = (bf16*)(a.ws + WS_WB); bf16* wo_t = (bf16*)(a.ws + WS_WO); bf16* hb = (bf16*)(a.ws + WS_HB);
    LAS float* scr = (LAS float*)(lds + wave * 16384);
    constexpr int I_IN = (DM / 64) * (NIN / 32), I_A = (DA / 64) * (DM / 32), I_B = (DSSM / 64) * (DM / 32), I_O = (DM / 64) * (DM / 32);
    for (int it = gw; it < I_IN + I_A + I_B + I_O; it += NGW) {
        int r = it;
        if (r < I_IN) { const int nblk = NIN / 32, kb = r / nblk, nb = r % nblk, n0 = nb * 32; const int dst = (n0 < 9216) ? n0 : (n0 == 9216 ? 11264 : n0 - 32);
            p0_transpose_item(a.w_in, DM, NIN, win_t, kb * 64, n0, dst, nullptr, scr, lane); continue; } r -= I_IN;
        if (r < I_A) { const int nblk = DM / 32, kb = r / nblk, nb = r % nblk; p0_transpose_item(a.w_a, DA, DM, wa_t, kb * 64, nb * 32, nb * 32, nullptr, scr, lane); continue; } r -= I_A;
        if (r < I_B) { const int nblk = DM / 32, kb = r / nblk, nb = r % nblk; p0_transpose_item(a.w_b, DSSM, DM, wb_t, kb * 64, nb * 32, nb * 32, a.ssm_norm, scr, lane); continue; } r -= I_B;
        { const int nblk = DM / 32, kb = r / nblk, nb = r % nblk; p0_transpose_item(a.w_out, DM, DM, wo_t, kb * 64, nb * 32, nb * 32, nullptr, scr, lane); }
    }
    { float* prm = (float*)(a.ws + WS_PRM); const int gt = gw * 64 + lane, NGT = NGW * 64;
      for (int i = gt; i < PR_END; i += NGT) { float v = 0.f;
          if (i < PR_CONVB) v = a.conv_w[i]; else if (i < PR_DTB) v = a.conv_b[i - PR_CONVB]; else if (i < PR_ALOG) v = a.dt_bias[i - PR_DTB]; else if (i < PR_DSKIP) v = a.a_log[i - PR_ALOG];
          else if (i < PR_RELB) v = a.d_skip[i - PR_DSKIP]; else if (i < PR_RELB + 384) v = a.rel_bias[i - PR_RELB]; else if (i >= PR_FNORM) v = a.final_norm[i - PR_FNORM];
          prm[i] = v; } }
    { u32x4* z = (u32x4*)(win_t + (size_t)11296 * DM); const int n16 = 224 * DM * 2 / 16; for (int i = gw * 64 + lane; i < n16; i += NGW * 64) z[i] = (u32x4){0u, 0u, 0u, 0u}; }
    for (int m = gw; m < MT; m += NGW) {
        const float* xrow = (m < MP) ? a.x_prompt + (size_t)m * DM : a.x_sample + (size_t)(m - MP) * DM;
        const f32x4* xr = (const f32x4*)xrow + lane; const f32x4* gr = (const f32x4*)a.norm_g + lane;
        f32x4 v[4]; float s = 0.f;
#pragma unroll
        for (int j = 0; j < 4; ++j) { v[j] = xr[64 * j]; s += (v[j].x * v[j].x + v[j].y * v[j].y) + (v[j].z * v[j].z + v[j].w * v[j].w); }
        const float rstd = rsqrtf(wave_sum(s) * (1.f / DM) + 1e-6f);
        unsigned long long* o8 = (unsigned long long*)(hb + (size_t)m * DM) + lane;
#pragma unroll
        for (int j = 0; j < 4; ++j) { const f32x4 g = gr[64 * j]; o8[64 * j] = (unsigned long long)pk2(v[j].x * rstd * g.x, v[j].y * rstd * g.y) | ((unsigned long long)pk2(v[j].z * rstd * g.z, v[j].w * rstd * g.w) << 32); }
    }
}

template <bool SAMP> __device__ __forceinline__ const void* kv_ptr(const Args& a, const bf16* proj, int colkv, const float* cache, int seq, int tpos, int off, int h, bool& valid, bool& isf32) {
    if (!SAMP) { const int kt = tpos - off; valid = kt >= 0; isf32 = false; return proj + (size_t)(seq * SEQ + (valid ? kt : 0)) * NPROJ + colkv + h * HD; }
    const int idx = KVB + tpos - off; valid = true;
    if (idx >= KVB) { isf32 = false; return proj + (size_t)(MP + seq * DECS + (idx - KVB)) * NPROJ + colkv + h * HD; }
    isf32 = true; return cache + ((size_t)(seq * KVB + idx) * NH + h) * HD;
}
template <bool SAMP> __device__ __forceinline__ void attn_slow_item(const Args& a, const bf16* proj, bf16* ya, LAS float* sl, int row, int h, int lane) {
    const float* prm = (const float*)(a.ws + WS_PRM);
    const int seq = SAMP ? (row - MP) / DECS : row / SEQ, tpos = SAMP ? (row - MP) % DECS : row % SEQ;
    float q[64];
    { const u32x4* qp = (const u32x4*)(proj + (size_t)row * NPROJ + C_Q + h * HD);
#pragma unroll
      for (int i = 0; i < 8; ++i) { const u32x4 w = qp[i]; q[8 * i + 0] = __uint_as_float(w.x << 16); q[8 * i + 1] = __uint_as_float(w.x & 0xffff0000u); q[8 * i + 2] = __uint_as_float(w.y << 16); q[8 * i + 3] = __uint_as_float(w.y & 0xffff0000u);
          q[8 * i + 4] = __uint_as_float(w.z << 16); q[8 * i + 5] = __uint_as_float(w.z & 0xffff0000u); q[8 * i + 6] = __uint_as_float(w.w << 16); q[8 * i + 7] = __uint_as_float(w.w & 0xffff0000u); } }
    float mx = -INFINITY;
#pragma unroll 1
    for (int e = lane; e < 387; e += 64) {
        float sc = -INFINITY;
        const int g = e / 129, j = e - g * 129, off = j << (2 * g); bool valid, isf32;
        const void* kp = kv_ptr<SAMP>(a, proj, C_K, a.cache_k, seq, tpos, off, h, valid, isf32);
        if (valid) { float d = 0.f;
            if (isf32) { const f32x4* k4 = (const f32x4*)kp;
#pragma unroll
                for (int i = 0; i < 16; ++i) { const f32x4 kk = k4[i]; d += q[4 * i] * kk.x + q[4 * i + 1] * kk.y + q[4 * i + 2] * kk.z + q[4 * i + 3] * kk.w; } }
            else { const u32x4* k4 = (const u32x4*)kp;
#pragma unroll
                for (int i = 0; i < 8; ++i) { const u32x4 w = k4[i];
                    d += q[8 * i + 0] * __uint_as_float(w.x << 16) + q[8 * i + 1] * __uint_as_float(w.x & 0xffff0000u) + q[8 * i + 2] * __uint_as_float(w.y << 16) + q[8 * i + 3] * __uint_as_float(w.y & 0xffff0000u)
                       + q[8 * i + 4] * __uint_as_float(w.z << 16) + q[8 * i + 5] * __uint_as_float(w.z & 0xffff0000u) + q[8 * i + 6] * __uint_as_float(w.w << 16) + q[8 * i + 7] * __uint_as_float(w.w & 0xffff0000u); } }
            sc = d * 0.125f + prm[PR_RELB + t5_bucket(off) * NH + h]; }
        sl[e] = sc; mx = fmaxf(mx, sc);
    }
    mx = wave_max(mx);
    float sum = 0.f;
#pragma unroll 1
    for (int e = lane; e < 387; e += 64) { const float sc = sl[e]; const float pe = (sc == -INFINITY) ? 0.f : __expf(sc - mx); sl[e] = pe; sum += pe; }
    sum = wave_sum(sum);
    LDS_WAIT(); asm volatile("" ::: "memory");
    float o = 0.f;
#pragma unroll 4
    for (int e = 0; e < 387; ++e) {
        const int g = e / 129, j = e - g * 129, off = j << (2 * g); bool valid, isf32;
        const void* vp = kv_ptr<SAMP>(a, proj, C_V, a.cache_v, seq, tpos, off, h, valid, isf32);
        const float pe = sl[e];
        if (valid) { const float vv = isf32 ? ((const float*)vp)[lane] : bf2f(((const bf16*)vp)[lane]); o += pe * vv; }
    }
    LDS_WAIT(); asm volatile("" ::: "memory");
    const float gv = bf2f(proj[(size_t)row * NPROJ + C_G + h * HD + lane]);
    ya[(size_t)row * DA + h * HD + lane] = (bf16)f2bf(o / sum * siluf_(gv));
}

__device__ __forceinline__ void ssd_slow_item(const Args& a, LAS unsigned char* lds, int item) {
    const bf16* proj = (const bf16*)(a.ws + WS_PROJ); const float* dtb = (const float*)(a.ws + WS_DT); bf16* ys = (bf16*)(a.ws + WS_YS); float* ssq = (float*)(a.ws + WS_SSQ);
    const int tid = threadIdx.x, lane = tid & 63, wid = tid >> 6;
    const bool samp = item >= NBATCH * NSH; const int it2 = samp ? item - NBATCH * NSH : item; const int sq = it2 / NSH, hd = it2 % NSH, grp = hd / 4;
    const int L = samp ? DECS : SEQ, row0 = samp ? MP + sq * DECS : sq * SEQ;
    const int p = tid >> 3, n0 = (tid & 7) * 16;
    float h[16];
    if (samp) { const f32x4* s4 = (const f32x4*)(a.state_ssm + ((size_t)(sq * NSH + hd) * SHD + p) * DST + n0);
#pragma unroll
        for (int j = 0; j < 4; ++j) { const f32x4 v = s4[j]; h[4 * j] = v.x; h[4 * j + 1] = v.y; h[4 * j + 2] = v.z; h[4 * j + 3] = v.w; } }
    else {
#pragma unroll
        for (int j = 0; j < 16; ++j) h[j] = 0.f; }
    const float* prm = (const float*)(a.ws + WS_PRM);
    const float Aneg = -__expf(prm[PR_ALOG + hd]), Dk = prm[PR_DSKIP + hd];
    LAS float* xs = (LAS float*)lds;
    LAS float* Bs = xs + 64 * 64;
    LAS float* Cs = Bs + 64 * 128;
    LAS float* dts = Cs + 64 * 128;
    LAS float* dAs = dts + 64;
    LAS float* yb = dAs + 64;
    for (int c0 = 0; c0 < L; c0 += 64) {
        const int tc = (L - c0) < 64 ? (L - c0) : 64;
        for (int idx = tid; idx < tc * 320; idx += NTHR) {
            const int t = idx / 320, c = idx - t * 320;
            const int xc = c < 64 ? hd * 64 + c : (c < 192 ? DSSM + grp * DST + (c - 64) : DSSM + NGRP * DST + grp * DST + (c - 192));
            float acc = prm[PR_CONVB + xc];
#pragma unroll
            for (int tap = 0; tap < 4; ++tap) { const int tt = c0 + t - 3 + tap; float v;
                if (tt >= 0) v = bf2f(proj[(size_t)(row0 + tt) * NPROJ + C_XBC + xc]);
                else v = samp ? a.state_conv[(size_t)(sq * 3 + 3 + tt) * DCONV + xc] : 0.f;
                acc += prm[PR_CONVW + tap * DCONV + xc] * v; }
            const float val = siluf_(acc);
            if (c < 64) xs[t * 64 + c] = val; else if (c < 192) Bs[t * 128 + (c - 64)] = val; else Cs[t * 128 + (c - 192)] = val;
        }
        if (tid < tc) { const float dtv = dtb[(size_t)(row0 + c0 + tid) * 32 + hd]; dts[tid] = dtv; dAs[tid] = __expf(dtv * Aneg); }
        __syncthreads();
        for (int t = 0; t < tc; ++t) {
            const float dA = dAs[t], xv = xs[t * 64 + p], dtx = dts[t] * xv; float acc = 0.f;
            const LAS f32x4* b4 = (const LAS f32x4*)(Bs + t * 128 + n0); const LAS f32x4* c4 = (const LAS f32x4*)(Cs + t * 128 + n0);
#pragma unroll
            for (int j = 0; j < 4; ++j) { const f32x4 bb = b4[j], cc = c4[j];
                h[4 * j] = dA * h[4 * j] + dtx * bb.x; h[4 * j + 1] = dA * h[4 * j + 1] + dtx * bb.y; h[4 * j + 2] = dA * h[4 * j + 2] + dtx * bb.z; h[4 * j + 3] = dA * h[4 * j + 3] + dtx * bb.w;
                acc += h[4 * j] * cc.x + h[4 * j + 1] * cc.y + h[4 * j + 2] * cc.z + h[4 * j + 3] * cc.w; }
            acc += __shfl_xor(acc, 1); acc += __shfl_xor(acc, 2); acc += __shfl_xor(acc, 4);
            if ((tid & 7) == 0) yb[t * 64 + p] = acc + Dk * xv;
        }
        __syncthreads();
        for (int t = wid; t < tc; t += NWAVES) {
            const int row = row0 + c0 + t; const float z = bf2f(proj[(size_t)row * NPROJ + C_Z + hd * 64 + lane]);
            const float val = yb[t * 64 + lane] * siluf_(z);
            ys[(size_t)row * DSSM + hd * 64 + lane] = (bf16)f2bf(val);
            const float ss = wave_sum(val * val); if (lane == 0) ssq[(size_t)row * NSH + hd] = ss;
        }
        __syncthreads();
    }
    float* dst = a.out + (samp ? O_SS : O_SP) + ((size_t)(sq * NSH + hd) * SHD + p) * DST + n0;
#pragma unroll
    for (int j = 0; j < 4; ++j) ((f32x4*)dst)[j] = (f32x4){h[4 * j], h[4 * j + 1], h[4 * j + 2], h[4 * j + 3]};
}

__device__ __forceinline__ void p2_ssd_prompt(const Args& a, LAS unsigned char* lds, int G, int wave, int lane) {
    for (int item = blockIdx.x; item < NBATCH * NSH; item += G) ssd_mfma_unit(a.ws, a.probe ? (float*)(a.ws + WS_TMP) - O_SP : a.out, a.probe ? (bf16*)(a.ws + WS_MRG) - 0 : (bf16*)(a.ws + WS_YS), a.probe ? (float*)(a.ws + WS_SSQ) + (size_t)MT * NSH : (float*)(a.ws + WS_SSQ), a.probe, lds, item / NSH, item % NSH, wave, lane);
}
__device__ __forceinline__ void p2_ssd_sample(const Args& a, LAS unsigned char* lds, int G) {
    for (int i0 = blockIdx.x * 4; i0 < DECB * NSH; i0 += G * 4) { const int n = DECB * NSH - i0; ssd_sample_teams(a.ws, a.out, a.state_conv, a.state_ssm, lds, i0, n < 4 ? n : 4); }
}
__device__ __forceinline__ void p2_attn_prompt(const Args& a, LAS unsigned char* lds, int G, int wave, int lane) {
    for (int k = 0; ; ++k) { const int v = (G == 256) ? (k < 3 ? (int)((blockIdx.x % 8) * 96 + (blockIdx.x / 8) + 32 * k) : 768) : (int)(blockIdx.x + k * G); if (v >= 768) break;
        const int bh = v >> 3, sb = v & 7; attn_unit(a.ws, lds, bh / NH, bh % NH, sb * 256, wave, lane); }
}
__device__ __forceinline__ void p2_attn_sample(const Args& a, LAS unsigned char* lds, int G, int wave, int lane) {
    const bf16* proj = (const bf16*)(a.ws + WS_PROJ);
    for (int u = blockIdx.x; u < DECB * NH; u += G) attn_sample_unit(a.ws, a.cache_k, a.cache_v, lds, u / NH, u % NH, wave, lane);
    const int gt = blockIdx.x * NTHR + threadIdx.x, NGT = G * NTHR;
    for (int i = gt; i < (NBATCH + DECB) * 3 * DCONV; i += NGT) { const int c = i % DCONV, r = (i / DCONV) % 3, sq = i / (3 * DCONV);
        if (sq < NBATCH) a.out[O_CP + (size_t)(sq * 3 + r) * DCONV + c] = bf2f(proj[(size_t)(sq * SEQ + SEQ - 3 + r) * NPROJ + C_XBC + c]);
        else { const int s2 = sq - NBATCH; a.out[O_CS + (size_t)(s2 * 3 + r) * DCONV + c] = bf2f(proj[(size_t)(MP + s2 * DECS + DECS - 3 + r) * NPROJ + C_XBC + c]); } }
}
__device__ __forceinline__ void p25_norm(const Args& a, int gw, int NGW, int lane) {
    bf16* ys = (bf16*)(a.ws + WS_YS); const float* ssq = (const float*)(a.ws + WS_SSQ);
    for (int m = gw; m < MT; m += NGW) {
        const float sv = (lane < 32) ? ssq[(size_t)m * NSH + lane] : 0.f;
        float gs = sv + __shfl_xor(sv, 1); gs += __shfl_xor(gs, 2);
        const float rstd = rsqrtf(gs * (1.f / 256.f) + 1e-5f);
        u32x4* r4 = (u32x4*)(ys + (size_t)m * DSSM);
#pragma unroll
        for (int j = 0; j < 4; ++j) { const int ci = j * 64 + lane, g = ci >> 5; const float sc = __shfl(rstd, 4 * g); u32x4 w = r4[ci];
            w.x = pk2(__uint_as_float(w.x << 16) * sc, __uint_as_float(w.x & 0xffff0000u) * sc); w.y = pk2(__uint_as_float(w.y << 16) * sc, __uint_as_float(w.y & 0xffff0000u) * sc);
            w.z = pk2(__uint_as_float(w.z << 16) * sc, __uint_as_float(w.z & 0xffff0000u) * sc); w.w = pk2(__uint_as_float(w.w << 16) * sc, __uint_as_float(w.w & 0xffff0000u) * sc); r4[ci] = w; }
    }
}
__device__ __forceinline__ void p5_final_norm(const Args& a, int gw, int NGW, int lane) {
    for (int m = gw; m < MT; m += NGW) {
        f32x4* xr = (f32x4*)(a.out + (size_t)m * DM) + lane; const f32x4* gr = (const f32x4*)((const float*)(a.ws + WS_PRM) + PR_FNORM) + lane;
        f32x4 v[4]; float s = 0.f;
#pragma unroll
        for (int j = 0; j < 4; ++j) { v[j] = xr[64 * j]; s += (v[j].x * v[j].x + v[j].y * v[j].y) + (v[j].z * v[j].z + v[j].w * v[j].w); }
        const float rstd = rsqrtf(wave_sum(s) * (1.f / DM) + 1e-6f);
#pragma unroll
        for (int j = 0; j < 4; ++j) { const f32x4 g = gr[64 * j]; xr[64 * j] = v[j] * rstd * g; }
    }
}
#define GEMM_PHASE(EpiT, Aptr, Bptr, Mrows, Ncols, Kdim, Eobj) do { pg8::Gemm g_{(const pg8::bf16_t*)(Aptr), (const pg8::bf16_t*)(Bptr), (Mrows), (Ncols), (Kdim)}; pg8::StaticOrder S_; S_.init((Mrows), (Ncols), G, (int)blockIdx.x); \
    pg8::gemm_phase<EpiT, pg8::StaticOrder, true, true>(lds, g_, S_, (Eobj)); } while (0)

constexpr int NPHASE = 10;
__global__ void __launch_bounds__(NTHR, 2) fwd_megakernel(Args a) {
    extern __shared__ __attribute__((aligned(16))) unsigned char lds_raw[];
    LAS unsigned char* lds = (LAS unsigned char*)lds_raw;
    cg::grid_group grid = cg::this_grid();
    const int tid = threadIdx.x, lane = tid & 63, wave = __builtin_amdgcn_readfirstlane(tid >> 6);
    const int G = gridDim.x, gw = blockIdx.x * NWAVES + wave, NGW = G * NWAVES;
    unsigned char* ws = a.ws;

#define IN(k) (a.ph_lo <= (k) && (k) < a.ph_hi)
#define SEAM(k) do { if (IN(k) && IN((k) + 1)) grid.sync(); } while (0)
    if (IN(0)) {
        p0_prologue(a, lds, gw, NGW, wave, lane);
        if (blockIdx.x == 0 && tid == 0) { const float** pp = (const float**)(ws + WS_ARGS); pp[0] = a.x_prompt; pp[1] = a.x_sample; pp[2] = a.cache_k; pp[3] = a.cache_v; pp[4] = a.state_conv; pp[5] = a.state_ssm; }
    }
    SEAM(0);
    if (IN(1)) { pg8::EpiInProj E{(pg8::bf16_t*)(ws + WS_PROJ), (float*)(ws + WS_DT), (const float*)(ws + WS_PRM) + PR_DTB, a.out + O_KP, a.out + O_VP, a.out + O_KS, a.out + O_VS};
      GEMM_PHASE(pg8::EpiInProj, ws + WS_HB, ws + WS_WIN, MT, NPAD, DM, E); }
    SEAM(1);
    if (IN(2)) { Args b{}; b.ws = ws; b.out = a.out; b.probe = a.probe; p2_ssd_prompt(b, lds, G, wave, lane); }
    if (IN(3)) { Args b{}; b.ws = ws; b.out = a.out; b.state_conv = ld_ptr(ws, 4); b.state_ssm = ld_ptr(ws, 5); p2_ssd_sample(b, lds, G); }
    if (IN(4)) { Args b{}; b.ws = ws; b.out = a.out; p2_attn_prompt(b, lds, G, wave, lane); }
    if (IN(5)) { Args b{}; b.ws = ws; b.out = a.out; b.cache_k = ld_ptr(ws, 2); b.cache_v = ld_ptr(ws, 3); p2_attn_sample(b, lds, G, wave, lane); }
    SEAM(5);
    if (IN(6)) p25_norm(a, gw, NGW, lane);
    SEAM(6);
    if (IN(7)) {
    skinny_p3(ws, lds, G, wave, lane);
    { pg8::EpiGateA E{(const pg8::bf16_t*)(ws + WS_PROJ), (float*)(ws + WS_TMP)}; GEMM_PHASE(pg8::EpiGateA, ws + WS_YA, ws + WS_WA, MP, DM, DA, E); }
    { pg8::EpiGateB E{(const pg8::bf16_t*)(ws + WS_PROJ), (const float*)(ws + WS_TMP), (pg8::bf16_t*)(ws + WS_MRG)}; GEMM_PHASE(pg8::EpiGateB, ws + WS_YS, ws + WS_WB, MP, DM, DSSM, E); }
    }
    SEAM(7);
    if (IN(8)) { skinny_p4(ws, ld_ptr(ws, 1), a.out, lds, G, wave, lane); pg8::EpiOut E{ld_ptr(ws, 0), ld_ptr(ws, 1), a.out + O_YP}; GEMM_PHASE(pg8::EpiOut, ws + WS_MRG, ws + WS_WO, MP, DM, DM, E); }
    SEAM(8);
    if (IN(9)) p5_final_norm(a, gw, NGW, lane);
#undef IN
#undef SEAM
}

extern "C" void kernel_launch(void* const* d_in, const int* in_sizes, int n_in, void* d_out, int out_size, void* d_ws, size_t ws_size, hipStream_t stream) {
    static int grid_blocks = 0;
    if (grid_blocks == 0) {
        if (n_in != 19 || (size_t)out_size != O_END || ws_size < WS_END) { fprintf(stderr, "kernel_launch: unexpected shapes: n_in %d out %d (want %zu) ws %zu (want >= %zu)\n", n_in, out_size, (size_t)O_END, ws_size, (size_t)WS_END); grid_blocks = -1; return; }
        int dev = 0, cus = 0, per_cu = 0;
        hipGetDevice(&dev); hipDeviceGetAttribute(&cus, hipDeviceAttributeMultiprocessorCount, dev);
        if (hipFuncSetAttribute((const void*)fwd_megakernel, hipFuncAttributeMaxDynamicSharedMemorySize, LDS_BYTES) != hipSuccess) { fprintf(stderr, "kernel_launch: hipFuncSetAttribute failed\n"); grid_blocks = -1; return; }
        if (hipOccupancyMaxActiveBlocksPerMultiprocessor(&per_cu, (const void*)fwd_megakernel, NTHR, LDS_BYTES) != hipSuccess || per_cu < 1) { fprintf(stderr, "kernel_launch: occupancy query failed (%d)\n", per_cu); (void)hipGetLastError(); per_cu = 1; }
        if (per_cu > 1) per_cu = 1;
        grid_blocks = cus * per_cu;
        fprintf(stderr, "kernel_launch: grid %d (cus %d)\n", grid_blocks, cus);
    }
    if (grid_blocks < 0) return;
    Args a{};
    a.x_prompt = (const float*)d_in[0]; a.x_sample = (const float*)d_in[1]; a.cache_k = (const float*)d_in[2]; a.cache_v = (const float*)d_in[3]; a.state_conv = (const float*)d_in[4]; a.state_ssm = (const float*)d_in[5];
    a.norm_g = (const float*)d_in[6]; a.w_in = (const float*)d_in[7]; a.conv_w = (const float*)d_in[8]; a.conv_b = (const float*)d_in[9]; a.dt_bias = (const float*)d_in[10]; a.a_log = (const float*)d_in[11];
    a.d_skip = (const float*)d_in[12]; a.ssm_norm = (const float*)d_in[13]; a.w_a = (const float*)d_in[14]; a.w_b = (const float*)d_in[15]; a.w_out = (const float*)d_in[16]; a.rel_bias = (const float*)d_in[17]; a.final_norm = (const float*)d_in[18];
    a.out = (float*)d_out; a.ws = (unsigned char*)d_ws;
#ifndef PROBE_LO
    const int ranges[1][2] = {{0, NPHASE}}; const int nr = 1;
#else
    const int ranges[2][2] = {{0, NPHASE}, {PROBE_LO, PROBE_HI}}; const int nr = 2;
#endif
    for (int r = 0; r < nr; ++r) {
        a.ph_lo = ranges[r][0]; a.ph_hi = ranges[r][1];
#ifdef PROBE_FLAGS
        a.probe = r ? PROBE_FLAGS : 0;
#endif
        void* args[] = {&a};
        hipError_t e = hipLaunchCooperativeKernel((const void*)fwd_megakernel, dim3(grid_blocks), dim3(NTHR), args, LDS_BYTES, stream);
        if (e != hipSuccess) fprintf(stderr, "kernel_launch: cooperative launch failed: %s (grid %d)\n", hipGetErrorString(e), grid_blocks);
    }
}
```

```cpp
#include <hip/hip_runtime.h>
#include <hip/hip_cooperative_groups.h>
#include <cstdio>
#include <cstdint>
namespace cg = cooperative_groups;
namespace pg8 {
#define PG8_LAS __attribute__((address_space(3)))
typedef unsigned short bf16_t;
typedef short bf16x8 __attribute__((ext_vector_type(8)));
typedef float f32x4 __attribute__((ext_vector_type(4)));
typedef unsigned u32x4 __attribute__((ext_vector_type(4)));
constexpr int BM = 256, BK = 64, HALF = 128, HTB = HALF * BK * 2  , STAGE_BYTES = 8 * HTB, NXCD = 8, WGM = 8;

__host__ __device__ __forceinline__ int lds_byte(int r, int c) { const int st = (r >> 4) * 2 + (c >> 5), rr = r & 15, cc = c & 31, ob = rr * 64 + cc * 2; return st * 1024 + (ob ^ (((ob >> 9) & 1) << 5)); }
__host__ __device__ __forceinline__ void stage_rc(int b, int& R, int& C) { const int st = b / 1024, sb = b % 1024, swz = sb ^ (((sb >> 9) & 1) << 5); R = (st >> 1) * 16 + swz / 64; C = (st & 1) * 32 + (swz % 64) / 2; }
__host__ __device__ __forceinline__ int perm32(int rho) { const int n = rho >> 4, i = rho & 15; return 8 * (i >> 2) + 4 * n + (i & 3); }

struct Unit { int pm, pn; };
struct Gemm { const bf16_t* A; const bf16_t* Bt; int M, N, K; };

struct StaticOrder {
    int nM, nN, nwg, G, c;
    __host__ __device__ void init(int M, int N, int G_, int c_) { nM = M / BM; nN = N / BM; nwg = nM * nN; G = G_; c = c_; }
    __host__ __device__ bool next(int i, Unit& u) const {
        const long L = (long)i * G + c; if (L >= nwg) return false;
        int wgid = (int)L; { const int q = nwg / NXCD, r = nwg % NXCD, xcd = wgid % NXCD, off = wgid / NXCD; wgid = (xcd < r ? xcd * (q + 1) : r * (q + 1) + (xcd - r) * q) + off; }
        const int nig = WGM * nN, gid = wgid / nig, fm = gid * WGM, gsz = (nM - fm) < WGM ? (nM - fm) : WGM;
        u.pm = fm + ((wgid % nig) % gsz); u.pn = (wgid % nig) / gsz; return true;
    }
    __device__ __forceinline__ void a_ready(const Unit&) const {}
    __device__ __forceinline__ void done(const Unit&) const {}
};

constexpr int PROJ_PITCH = 11328;
__device__ __forceinline__ unsigned cvt_pk_bf16(float lo, float hi) { unsigned r; asm volatile("v_cvt_pk_bf16_f32 %0, %1, %2" : "=v"(r) : "v"(lo), "v"(hi)); return r; }
__device__ __forceinline__ float e_bf2f(unsigned short b) { return __uint_as_float(((unsigned)b) << 16); }
__device__ __forceinline__ float e_sigmoid(float x) { return 1.f / (1.f + __expf(-x)); }
__device__ __forceinline__ float e_softplus(float x) { return fmaxf(x, 0.f) + log1pf(__expf(-fabsf(x))); }

struct EpiInProj {
    static constexpr bool PERM = true, AFTER_DRAIN = false;
    bf16_t* proj; float* dt; const float* dt_bias; float* kp; float* vp; float* ks; float* vs;
    __device__ __forceinline__ void operator()(const f32x4 (&acc)[2][2][4][2], const Unit& u, int wr, int wc, int fr, int fq) const {
        const int row0 = u.pm * BM + wr * 64 + fr;
        if (u.pn < 44) {
            const int col0 = u.pn * BM + wc * 32 + 8 * fq;
            const bool isk = (u.pn >= 3 && u.pn < 6), isv = (u.pn >= 6 && u.pn < 9);
#pragma unroll
            for (int ai = 0; ai < 2; ++ai)
#pragma unroll
                for (int m = 0; m < 4; ++m) { const int row = row0 + ai * HALF + m * 16; bf16_t* rowp = proj + (size_t)row * PROJ_PITCH + col0;
#pragma unroll
                    for (int bj = 0; bj < 2; ++bj) { const f32x4 v0 = acc[ai][bj][m][0], v1 = acc[ai][bj][m][1];
                        u32x4 w; w.x = cvt_pk_bf16(v0[0], v0[1]); w.y = cvt_pk_bf16(v0[2], v0[3]); w.z = cvt_pk_bf16(v1[0], v1[1]); w.w = cvt_pk_bf16(v1[2], v1[3]);
                        *(u32x4*)(rowp + bj * HALF) = w;
                        if (isk || isv) { const int c = col0 + bj * HALF - (isk ? 768 : 1536);
                            float* dst = (u.pm < 64) ? ((isk ? kp : vp) + (size_t)row * 768 + c) : ((isk ? ks : vs) + (size_t)(row - 16384) * 768 + c);
                            *(f32x4*)dst = v0; *(f32x4*)(dst + 4) = v1; } } }
        } else if (wc == 0) {
            const f32x4 b0 = *(const f32x4*)(dt_bias + 8 * fq), b1 = *(const f32x4*)(dt_bias + 8 * fq + 4);
#pragma unroll
            for (int ai = 0; ai < 2; ++ai)
#pragma unroll
                for (int m = 0; m < 4; ++m) { const int row = row0 + ai * HALF + m * 16; const f32x4 v0 = acc[ai][0][m][0] + b0, v1 = acc[ai][0][m][1] + b1;
                    f32x4 o0, o1;
#pragma unroll
                    for (int j = 0; j < 4; ++j) { o0[j] = e_softplus(v0[j]); o1[j] = e_softplus(v1[j]); }
                    float* dst = dt + (size_t)row * 32 + 8 * fq; *(f32x4*)dst = o0; *(f32x4*)(dst + 4) = o1; }
        }
    }
};
struct EpiGateA {
    static constexpr bool PERM = true, AFTER_DRAIN = false;
    const bf16_t* proj; float* tmp;
    __device__ __forceinline__ void operator()(const f32x4 (&acc)[2][2][4][2], const Unit& u, int wr, int wc, int fr, int fq) const {
        const int row0 = u.pm * BM + wr * 64 + fr, col0 = u.pn * BM + wc * 32 + 8 * fq;
#pragma unroll
        for (int ai = 0; ai < 2; ++ai)
#pragma unroll
            for (int m = 0; m < 4; ++m) { const int row = row0 + ai * HALF + m * 16;
#pragma unroll
                for (int bj = 0; bj < 2; ++bj) { const int c = col0 + bj * HALF; const u32x4 g = *(const u32x4*)(proj + (size_t)row * PROJ_PITCH + 9216 + c);
                    const f32x4 v0 = acc[ai][bj][m][0], v1 = acc[ai][bj][m][1]; f32x4 o0, o1;
                    o0[0] = e_sigmoid(__uint_as_float(g.x << 16)) * v0[0]; o0[1] = e_sigmoid(__uint_as_float(g.x & 0xffff0000u)) * v0[1];
                    o0[2] = e_sigmoid(__uint_as_float(g.y << 16)) * v0[2]; o0[3] = e_sigmoid(__uint_as_float(g.y & 0xffff0000u)) * v0[3];
                    o1[0] = e_sigmoid(__uint_as_float(g.z << 16)) * v1[0]; o1[1] = e_sigmoid(__uint_as_float(g.z & 0xffff0000u)) * v1[1];
                    o1[2] = e_sigmoid(__uint_as_float(g.w << 16)) * v1[2]; o1[3] = e_sigmoid(__uint_as_float(g.w & 0xffff0000u)) * v1[3];
                    float* dst = tmp + (size_t)row * 1024 + c; *(f32x4*)dst = o0; *(f32x4*)(dst + 4) = o1; } }
    }
};
struct EpiGateB {
    static constexpr bool PERM = true, AFTER_DRAIN = false;
    const bf16_t* proj; const float* tmp; bf16_t* mrg;
    __device__ __forceinline__ void operator()(const f32x4 (&acc)[2][2][4][2], const Unit& u, int wr, int wc, int fr, int fq) const {
        const int row0 = u.pm * BM + wr * 64 + fr, col0 = u.pn * BM + wc * 32 + 8 * fq;
#pragma unroll
        for (int ai = 0; ai < 2; ++ai)
#pragma unroll
            for (int m = 0; m < 4; ++m) { const int row = row0 + ai * HALF + m * 16;
#pragma unroll
                for (int bj = 0; bj < 2; ++bj) { const int c = col0 + bj * HALF; const u32x4 g = *(const u32x4*)(proj + (size_t)row * PROJ_PITCH + 10240 + c);
                    const float* src = tmp + (size_t)row * 1024 + c; const f32x4 t0 = *(const f32x4*)src, t1 = *(const f32x4*)(src + 4);
                    const f32x4 v0 = acc[ai][bj][m][0], v1 = acc[ai][bj][m][1]; f32x4 o0, o1;
                    o0[0] = t0[0] + e_sigmoid(__uint_as_float(g.x << 16)) * v0[0]; o0[1] = t0[1] + e_sigmoid(__uint_as_float(g.x & 0xffff0000u)) * v0[1];
                    o0[2] = t0[2] + e_sigmoid(__uint_as_float(g.y << 16)) * v0[2]; o0[3] = t0[3] + e_sigmoid(__uint_as_float(g.y & 0xffff0000u)) * v0[3];
                    o1[0] = t1[0] + e_sigmoid(__uint_as_float(g.z << 16)) * v1[0]; o1[1] = t1[1] + e_sigmoid(__uint_as_float(g.z & 0xffff0000u)) * v1[1];
                    o1[2] = t1[2] + e_sigmoid(__uint_as_float(g.w << 16)) * v1[2]; o1[3] = t1[3] + e_sigmoid(__uint_as_float(g.w & 0xffff0000u)) * v1[3];
                    u32x4 w; w.x = cvt_pk_bf16(o0[0], o0[1]); w.y = cvt_pk_bf16(o0[2], o0[3]); w.z = cvt_pk_bf16(o1[0], o1[1]); w.w = cvt_pk_bf16(o1[2], o1[3]);
                    *(u32x4*)(mrg + (size_t)row * 1024 + c) = w; } }
    }
};
struct EpiOut {
    static constexpr bool PERM = false, AFTER_DRAIN = false;
    const float* xp; const float* xs; float* out;
    __device__ __forceinline__ void operator()(const f32x4 (&acc)[2][2][4][2], const Unit& u, int wr, int wc, int fr, int fq) const {
        const int row0 = u.pm * BM + wr * 64 + fr, col0 = u.pn * BM + wc * 32 + 4 * fq;
#pragma unroll
        for (int ai = 0; ai < 2; ++ai)
#pragma unroll
            for (int m = 0; m < 4; ++m) { const int row = row0 + ai * HALF + m * 16;
                const float* xr = (u.pm < 64) ? xp + (size_t)row * 1024 : xs + (size_t)(row - 16384) * 1024; float* orow = out + (size_t)row * 1024;
#pragma unroll
                for (int bj = 0; bj < 2; ++bj)
#pragma unroll
                    for (int n = 0; n < 2; ++n) { const int c = col0 + bj * HALF + n * 16; *(f32x4*)(orow + c) = *(const f32x4*)(xr + c) + acc[ai][bj][m][n]; } }
    }
};

template <class Epi, class Sched, bool ALIGN_EPI = false, bool SP2 = false>
__device__ __forceinline__ void gemm_phase(PG8_LAS unsigned char* lds, const Gemm g, const Sched& S, const Epi& E) {
    int tid_ = threadIdx.x; asm volatile("" : "+v"(tid_));
    const int tid = tid_, wid = __builtin_amdgcn_readfirstlane(tid >> 6), lane = tid & 63, wr = wid >> 2, wc = wid & 3, fr = lane & 15, fq = lane >> 4;
    const int K = g.K, nt = K / BK;
    unsigned voffA[2], voffB[2];
#pragma unroll
    for (int i = 0; i < 2; ++i) { int R, C; stage_rc(tid * 16 + i * 8192, R, C); const int Rb = Epi::PERM ? ((R & ~31) + perm32(R & 31)) : R;
        voffA[i] = (unsigned)(R * K + C) * 2u; voffB[i] = (unsigned)(Rb * K + C) * 2u; }
    const size_t kstep = (size_t)(BK * 2);
    const size_t hstep = (size_t)HALF * K * 2;
    const size_t tstep = 2 * hstep;
    const unsigned ldsw = (unsigned)wid * 1024u;
    const int aoff = lds_byte(wr * 64 + fr, fq * 8), boff = lds_byte(wc * 32 + fr, fq * 8);
#define PG8_SA(b, h) (((b) * 2 + (h)) * HTB)
#define PG8_SB(b, h) ((4 + (b) * 2 + (h)) * HTB)
#define PG8_STAGE(bufoff, gbase, voff) do { _Pragma("unroll") for (int _i = 0; _i < 2; ++_i) \
        __builtin_amdgcn_global_load_lds((const unsigned*)((const char*)(gbase) + (voff)[_i]), (PG8_LAS unsigned*)(lds + (bufoff) + ldsw + _i * 8192), 16, 0, 0); } while (0)
#define PG8_LDA(dst, b, h) do { _Pragma("unroll") for (int m = 0; m < 4; ++m) _Pragma("unroll") for (int k = 0; k < 2; ++k) dst[m][k] = *(const PG8_LAS bf16x8*)(lds + PG8_SA(b, h) + aoff + m * 2048 + k * 1024); } while (0)
#define PG8_LDB(dst, b, h) do { _Pragma("unroll") for (int n = 0; n < 2; ++n) _Pragma("unroll") for (int k = 0; k < 2; ++k) dst[n][k] = *(const PG8_LAS bf16x8*)(lds + PG8_SB(b, h) + boff + n * 2048 + k * 1024); } while (0)
#define PG8_MMA(ai, bj, At, Bt) do { __builtin_amdgcn_s_setprio(1); _Pragma("unroll") for (int m = 0; m < 4; ++m) _Pragma("unroll") for (int n = 0; n < 2; ++n) _Pragma("unroll") for (int k = 0; k < 2; ++k) \
        acc[ai][bj][m][n] = __builtin_amdgcn_mfma_f32_16x16x32_bf16(Bt[n][k], At[m][k], acc[ai][bj][m][n], 0, 0, 0); __builtin_amdgcn_s_setprio(0); } while (0)
#define PG8_WAIT_V(n) asm volatile("s_waitcnt vmcnt(" #n ")" ::: "memory")
#define PG8_WAIT_L(n) asm volatile("s_waitcnt lgkmcnt(" #n ")" ::: "memory")
#define PG8_BAR __builtin_amdgcn_s_barrier()
#define PG8_SCHED __builtin_amdgcn_sched_barrier(0)
    Unit cur, nxt; int ui = 0;
    if (!S.next(0, cur)) return;
    f32x4 acc[2][2][4][2];
#pragma unroll
    for (int a = 0; a < 2; ++a)
#pragma unroll
        for (int b = 0; b < 2; ++b)
#pragma unroll
            for (int m = 0; m < 4; ++m)
#pragma unroll
                for (int n = 0; n < 2; ++n) acc[a][b][m][n] = (f32x4){0.f, 0.f, 0.f, 0.f};
    bf16x8 At[4][2], B0[2][2], B1[2][2];
    const char* cA = (const char*)g.A + (size_t)cur.pm * tstep; const char* cB = (const char*)g.Bt + (size_t)cur.pn * tstep;
    S.a_ready(cur);
    if constexpr (SP2) {
        PG8_STAGE(PG8_SB(0, 0), cB, voffB); PG8_STAGE(PG8_SB(0, 1), cB + hstep, voffB); PG8_STAGE(PG8_SA(0, 0), cA, voffA); PG8_STAGE(PG8_SA(0, 1), cA + hstep, voffA);
        if (wr == 1) PG8_BAR;
        PG8_WAIT_V(2); PG8_BAR;
        PG8_STAGE(PG8_SB(1, 0), cB + kstep, voffB); PG8_STAGE(PG8_SA(1, 0), cA + kstep, voffA); PG8_STAGE(PG8_SB(1, 1), cB + hstep + kstep, voffB);
        PG8_WAIT_V(6); PG8_BAR;
    } else {
        PG8_STAGE(PG8_SB(0, 0), cB, voffB); PG8_STAGE(PG8_SA(0, 0), cA, voffA); PG8_STAGE(PG8_SB(0, 1), cB + hstep, voffB); PG8_STAGE(PG8_SA(0, 1), cA + hstep, voffA);
        if (wr == 1) PG8_BAR;
        PG8_WAIT_V(4); PG8_BAR;
        PG8_STAGE(PG8_SB(1, 0), cB + kstep, voffB); PG8_STAGE(PG8_SA(1, 0), cA + kstep, voffA); PG8_STAGE(PG8_SB(1, 1), cB + hstep + kstep, voffB);
        PG8_WAIT_V(6); PG8_BAR;
    }
    for (;;) {
        const bool has_next = S.next(ui + 1, nxt);
        const char* nA = has_next ? (const char*)g.A + (size_t)nxt.pm * tstep : cA; const char* nB = has_next ? (const char*)g.Bt + (size_t)nxt.pn * tstep : cB;
        for (int t = 0; t < nt; t += 2) {
            const bool last = (t == nt - 2);
            const char* a1 = cA + (size_t)(t + 1) * kstep;
            const char* a2 = last ? nA : cA + (size_t)(t + 2) * kstep; const char* b2 = last ? nB : cB + (size_t)(t + 2) * kstep;
            const char* a3 = a2 + kstep; const char* b3 = b2 + kstep;
            if (last && has_next) S.a_ready(nxt);
            if constexpr (SP2) {
            PG8_LDB(B0, 0, 0); PG8_LDB(B1, 0, 1); PG8_SCHED; PG8_LDA(At, 0, 0); PG8_STAGE(PG8_SA(1, 1), a1 + hstep, voffA);
            PG8_WAIT_V(8); PG8_WAIT_L(0); PG8_BAR; PG8_MMA(0, 0, At, B0); PG8_MMA(0, 1, At, B1); PG8_BAR; PG8_SCHED;
            PG8_LDA(At, 0, 1); PG8_STAGE(PG8_SB(0, 0), b2, voffB); PG8_STAGE(PG8_SB(0, 1), b2 + hstep, voffB); PG8_STAGE(PG8_SA(0, 0), a2, voffA);
            PG8_WAIT_V(8); PG8_WAIT_L(0); PG8_BAR; PG8_MMA(1, 0, At, B0); PG8_MMA(1, 1, At, B1); PG8_BAR; PG8_SCHED;
            PG8_LDB(B0, 1, 0); PG8_LDB(B1, 1, 1); PG8_SCHED; PG8_LDA(At, 1, 0); PG8_STAGE(PG8_SA(0, 1), a2 + hstep, voffA);
            PG8_WAIT_V(8); PG8_WAIT_L(0); PG8_BAR; PG8_MMA(0, 0, At, B0); PG8_MMA(0, 1, At, B1); PG8_BAR; PG8_SCHED;
            PG8_LDA(At, 1, 1); PG8_STAGE(PG8_SB(1, 0), b3, voffB); PG8_STAGE(PG8_SB(1, 1), b3 + hstep, voffB); PG8_STAGE(PG8_SA(1, 0), a3, voffA);
            PG8_WAIT_V(8); PG8_WAIT_L(0); PG8_BAR; PG8_MMA(1, 0, At, B0); PG8_MMA(1, 1, At, B1); PG8_BAR; PG8_SCHED;
            } else {
            PG8_LDB(B0, 0, 0); PG8_SCHED; PG8_LDA(At, 0, 0); PG8_STAGE(PG8_SA(1, 1), a1 + hstep, voffA);
            PG8_WAIT_L(8); PG8_BAR; PG8_WAIT_L(0); PG8_MMA(0, 0, At, B0); PG8_BAR; PG8_SCHED;
            PG8_LDB(B1, 0, 1); PG8_STAGE(PG8_SB(0, 0), b2, voffB);
            PG8_BAR; PG8_WAIT_L(0); PG8_MMA(0, 1, At, B1); PG8_BAR;
            PG8_LDA(At, 0, 1); PG8_STAGE(PG8_SA(0, 0), a2, voffA);
            PG8_BAR; PG8_WAIT_L(0); PG8_MMA(1, 0, At, B0); PG8_BAR; PG8_SCHED;
            PG8_STAGE(PG8_SB(0, 1), b2 + hstep, voffB);
            PG8_WAIT_V(6); PG8_BAR; PG8_MMA(1, 1, At, B1); PG8_BAR;
            PG8_LDB(B0, 1, 0); PG8_SCHED; PG8_LDA(At, 1, 0); PG8_STAGE(PG8_SA(0, 1), a2 + hstep, voffA);
            PG8_WAIT_L(8); PG8_BAR; PG8_WAIT_L(0); PG8_MMA(0, 0, At, B0); PG8_BAR; PG8_SCHED;
            PG8_LDB(B1, 1, 1); PG8_STAGE(PG8_SB(1, 0), b3, voffB);
            PG8_BAR; PG8_WAIT_L(0); PG8_MMA(0, 1, At, B1); PG8_BAR;
            PG8_LDA(At, 1, 1); PG8_STAGE(PG8_SA(1, 0), a3, voffA);
            PG8_BAR; PG8_WAIT_L(0); PG8_MMA(1, 0, At, B0); PG8_BAR; PG8_SCHED;
            PG8_STAGE(PG8_SB(1, 1), b3 + hstep, voffB);
            PG8_WAIT_V(6); PG8_BAR; PG8_MMA(1, 1, At, B1); PG8_BAR;
            }
        }
        if constexpr (ALIGN_EPI) { if (wr == 0) PG8_BAR; }
        if constexpr (!Epi::AFTER_DRAIN) { E(acc, cur, wr, wc, fr, fq); S.done(cur); }
        if (!has_next) break;
#pragma unroll
        for (int a = 0; a < 2; ++a)
#pragma unroll
            for (int b = 0; b < 2; ++b)
#pragma unroll
                for (int m = 0; m < 4; ++m)
#pragma unroll
                    for (int n = 0; n < 2; ++n) acc[a][b][m][n] = (f32x4){0.f, 0.f, 0.f, 0.f};
        cur = nxt; cA = nA; cB = nB; ++ui;
        if constexpr (ALIGN_EPI) { if (wr == 1) PG8_BAR; }
    }
    PG8_WAIT_V(0);
    if constexpr (!ALIGN_EPI) { if (wr == 0) PG8_BAR; }
    PG8_BAR;
    if constexpr (Epi::AFTER_DRAIN) { E.fused(acc, cur, wr, wc, fr, fq, lds, wid, lane); S.done(cur); }
#undef PG8_SA
#undef PG8_SB
#undef PG8_STAGE
#undef PG8_LDA
#undef PG8_LDB
#undef PG8_MMA
#undef PG8_WAIT_V
#undef PG8_WAIT_L
#undef PG8_BAR
#undef PG8_SCHED
}
}

#define LAS __attribute__((address_space(3)))
typedef unsigned short bf16;
typedef float f32x4 __attribute__((ext_vector_type(4)));
typedef unsigned u32x4 __attribute__((ext_vector_type(4)));
typedef unsigned u32x2 __attribute__((ext_vector_type(2)));
constexpr int NWAVES = 8, NTHR = 512;
constexpr int DM = 1024, NBATCH = 8, SEQ = 2048, MP = NBATCH * SEQ, DECB = 32, DECS = 8, MS = DECB * DECS, MT = MP + MS;
constexpr int NH = 12, HD = 64, DA = NH * HD;
constexpr int DSSM = 2048, NSH = 32, SHD = 64, NGRP = 8, DST = 128, DCONV = 4096;
constexpr int PAST = 16384, KVB = 2048;
constexpr int NIN = 11296, NPROJ = pg8::PROJ_PITCH, NPAD = 11520;
constexpr int C_Q = 0, C_K = 768, C_V = 1536, C_G = 2304, C_Z = 3072, C_XBC = 5120, C_GA = 9216, C_GB = 10240;
constexpr size_t MiB = 1u << 20;
constexpr size_t WS_ARGS = 1 * MiB - 4096, WS_PRM = 1 * MiB, WS_WIN = 2 * MiB, WS_WA = 26 * MiB, WS_WB = 28 * MiB, WS_WO = 32 * MiB, WS_HB = 36 * MiB, WS_DT = 70 * MiB, WS_PROJ = 74 * MiB,
                 WS_YA = 436 * MiB, WS_YS = 462 * MiB, WS_SSQ = 528 * MiB, WS_TMP = 534 * MiB, WS_MRG = 600 * MiB, WS_END = 666 * MiB;
constexpr size_t O_YP = 0, O_YS = O_YP + (size_t)MP * DM, O_KP = O_YS + (size_t)MS * DM, O_VP = O_KP + (size_t)MP * DA, O_CP = O_VP + (size_t)MP * DA,
                 O_SP = O_CP + (size_t)NBATCH * 3 * DCONV, O_KS = O_SP + (size_t)NBATCH * NSH * SHD * DST, O_VS = O_KS + (size_t)MS * DA, O_CS = O_VS + (size_t)MS * DA,
                 O_SS = O_CS + (size_t)DECB * 3 * DCONV, O_END = O_SS + (size_t)DECB * NSH * SHD * DST;
constexpr int LDS_BYTES = 148480, LDS_MISC = 147456;
constexpr size_t WS_BAR = 0, BAR_ZERO_BYTES = 16384;
constexpr int PR_CONVW = 0, PR_CONVB = 16384, PR_DTB = 20480, PR_ALOG = 20512, PR_DSKIP = 20544, PR_RELB = 20576, PR_FNORM = 20992, PR_END = 22016;

struct Args {
    const float *x_prompt, *x_sample, *cache_k, *cache_v, *state_conv, *state_ssm, *norm_g, *w_in, *conv_w, *conv_b, *dt_bias, *a_log, *d_skip, *ssm_norm, *w_a, *w_b, *w_out, *rel_bias, *final_norm;
    float* out; unsigned char* ws;
    int ph_lo, ph_hi, probe, pad_;
};

__device__ __forceinline__ float bf2f(bf16 b) { return __uint_as_float(((unsigned)b) << 16); }
__device__ __forceinline__ unsigned f2bf(float f) { unsigned u = __float_as_uint(f); return (u + 0x7fffu + ((u >> 16) & 1u)) >> 16; }
typedef float f32x2_t __attribute__((ext_vector_type(2))); typedef __bf16 bf16x2_t __attribute__((ext_vector_type(2)));
__device__ __forceinline__ unsigned pk2(float lo, float hi) { const f32x2_t v = {lo, hi}; return __builtin_bit_cast(unsigned, __builtin_convertvector(v, bf16x2_t)); }
__device__ __forceinline__ float sigmoidf_(float x) { return 1.f / (1.f + __expf(-x)); }
__device__ __forceinline__ float siluf_(float x) { return x / (1.f + __expf(-x)); }
__device__ __forceinline__ float softplusf_(float x) { return fmaxf(x, 0.f) + log1pf(__expf(-fabsf(x))); }
__device__ __forceinline__ float wave_sum(float v) {
#pragma unroll
    for (int o = 1; o < 64; o <<= 1) v += __shfl_xor(v, o);
    return v;
}
__device__ __forceinline__ float wave_max(float v) {
#pragma unroll
    for (int o = 1; o < 64; o <<= 1) v = fmaxf(v, __shfl_xor(v, o));
    return v;
}
__device__ __forceinline__ int t5_bucket(int off) {
    if (off < 16) return off;
    return 16 + (off >= 22) + (off >= 30) + (off >= 40) + (off >= 54) + (off >= 73) + (off >= 99) + (off >= 134) + (off >= 182) + (off >= 246) + (off >= 332) + (off >= 450) + (off >= 609) + (off >= 825) + (off >= 1117) + (off >= 1513);
}
__device__ __forceinline__ const float* ld_ptr(const unsigned char* ws, int idx) { const unsigned long long v = ((const unsigned long long*)(ws + WS_ARGS))[idx];
    const unsigned lo = __builtin_amdgcn_readfirstlane((unsigned)v), hi = __builtin_amdgcn_readfirstlane((unsigned)(v >> 32)); return (const float*)(((unsigned long long)hi << 32) | lo); }
#define LDS_WAIT() asm volatile("s_waitcnt lgkmcnt(0)" ::: "memory")
typedef short bf16x8 __attribute__((ext_vector_type(8)));
typedef short s16x4 __attribute__((ext_vector_type(4)));
constexpr int AT_ST = 0, AT_STROW = 272, AT_ML = 69632, AT_BIAS = 71680, AT_V = 73728, AT_VROW = 144, AT_VBYTES = 32 * AT_VROW, AT_VWAVE = 2 * AT_VBYTES;
constexpr float LOG2E = 1.4426950408889634f;
__device__ __forceinline__ s16x4 lds_tr16(LAS const unsigned char* p) { return __builtin_bit_cast(s16x4, __builtin_amdgcn_ds_read_tr16_b64_v4i16((LAS s16x4*)p)); }

struct AttnQK { bf16x8 q[2]; bf16x8 k[9][2]; };
__device__ __forceinline__ void attn_load_qk(const bf16* base, int P0, int stride, int lane, int probe, AttnQK& qk) {
    const int c = lane & 15, rq = lane >> 4;
    { const bf16* qp = base + (size_t)(P0 + stride * c) * NPROJ + C_Q + rq * 8; qk.q[0] = *(const bf16x8*)qp; qk.q[1] = *(const bf16x8*)(qp + 32); }
#pragma unroll
    for (int kt = 0; kt < 9; ++kt) {
        int kpos = P0 + stride * (16 * kt + c - 128); kpos = kpos < 0 ? 0 : kpos;
        const bf16* kp = base + (size_t)kpos * NPROJ + C_K + rq * 8; qk.k[kt][0] = *(const bf16x8*)kp; qk.k[kt][1] = *(const bf16x8*)(kp + 32); }
}
template <bool SAMP, bool PRE = false> __device__ __forceinline__ void attn_item(const bf16* base, const float* ck, const float* cv, int P0, int stride, const LAS float* biasr  , LAS unsigned char* vst, int lane, float& m_out, float& l_out, f32x4 (&o)[4], int probe, AttnQK& pre, bool has_next, int P0n, int striden) {
    const int c = lane & 15, rq = lane >> 4;
    bf16x8 qf[2];
    if (PRE) { qf[0] = pre.q[0]; qf[1] = pre.q[1]; } else
    { int qrow = P0 + stride * c; if (SAMP) { qrow -= KVB; qrow = qrow > DECS - 1 ? DECS - 1 : qrow; }
      const bf16* qp = base + (size_t)qrow * NPROJ + C_Q + rq * 8; qf[0] = *(const bf16x8*)qp; qf[1] = *(const bf16x8*)(qp + 32); }
    u32x4 vh[SAMP ? 1 : 2][4]; f32x4 vq[SAMP ? 2 : 1][SAMP ? 8 : 1];
#define AT_STEP_VALID0(ks) (((P0 + stride * (16 * ((2 * (ks) + 1 < 9) ? 2 * (ks) + 1 : 8) + 15 - 128)) >= 0) && !(probe & 32))
    if (!SAMP) {
#pragma unroll
        for (int ks = 0; ks < 2; ++ks) {
#pragma unroll
            for (int i = 0; i < 4; ++i) { int kpos = P0 + stride * (32 * ks + 8 * i + (lane >> 3) - 128); kpos = kpos < 0 ? 0 : (kpos > SEQ - 1 ? SEQ - 1 : kpos);
                vh[ks][i] = *(const u32x4*)(base + (size_t)kpos * NPROJ + C_V + (lane & 7) * 8); } }
    } else {
#pragma unroll
        for (int i = 0; i < 4; ++i) { int kpos = P0 + stride * (8 * i + (lane >> 3)) - KVB; kpos = kpos < 0 ? 0 : (kpos > DECS - 1 ? DECS - 1 : kpos);
            vh[0][i] = *(const u32x4*)(base + (size_t)kpos * NPROJ + C_V + (lane & 7) * 8); }
    }
#undef AT_STEP_VALID0
    const int kmin = (128 - P0 / stride) > 0 ? (128 - P0 / stride) : 0, lo = c > kmin ? c : kmin, hi = c + 128;
    const LAS float* bp = biasr + (4 * rq - c);
    f32x4 sc[9];
#pragma unroll
    for (int kt = 0; kt < 9; ++kt) {
        const bool tile_valid = ((P0 + stride * (16 * kt + 15 - 128)) >= 0) && !(probe & 16);
        int kpos = P0 + stride * (16 * kt + c - 128); kpos = kpos < 0 ? 0 : kpos;
        bf16x8 k0, k1;
        {
            if (SAMP && kt < 8) { const float* kp = ck + (size_t)kpos * (NH * HD) + rq * 8;
                const f32x4 a0 = *(const f32x4*)kp, a1 = *(const f32x4*)(kp + 4), b0 = *(const f32x4*)(kp + 32), b1 = *(const f32x4*)(kp + 36);
                u32x4 w0, w1; w0.x = pk2(a0[0], a0[1]); w0.y = pk2(a0[2], a0[3]); w0.z = pk2(a1[0], a1[1]); w0.w = pk2(a1[2], a1[3]); w1.x = pk2(b0[0], b0[1]); w1.y = pk2(b0[2], b0[3]); w1.z = pk2(b1[0], b1[1]); w1.w = pk2(b1[2], b1[3]);
                k0 = __builtin_bit_cast(bf16x8, w0); k1 = __builtin_bit_cast(bf16x8, w1);
            } else if (PRE) { k0 = pre.k[kt][0]; k1 = pre.k[kt][1];
            } else { if (SAMP) { kpos -= KVB; kpos = kpos > DECS - 1 ? DECS - 1 : kpos; }
                const bf16* kp = base + (size_t)kpos * NPROJ + C_K + rq * 8; k0 = *(const bf16x8*)kp; k1 = *(const bf16x8*)(kp + 32); }
        }
        if (tile_valid) {
            f32x4 acc = {0.f, 0.f, 0.f, 0.f};
            acc = __builtin_amdgcn_mfma_f32_16x16x32_bf16(k0, qf[0], acc, 0, 0, 0);
            acc = __builtin_amdgcn_mfma_f32_16x16x32_bf16(k1, qf[1], acc, 0, 0, 0);
            const LAS float* bt = bp + 16 * kt;
            if (kt >= 1 && kt <= 7 && 16 * kt >= kmin) {
#pragma unroll
                for (int j = 0; j < 4; ++j) sc[kt][j] = acc[j] * (0.125f * LOG2E) + bt[j];
            } else {
#pragma unroll
                for (int j = 0; j < 4; ++j) { const int kidx = 16 * kt + 4 * rq + j; const bool valid = (unsigned)(kidx - lo) <= (unsigned)(hi - lo);
                    sc[kt][j] = valid ? acc[j] * (0.125f * LOG2E) + bt[j] : -INFINITY; }
            }
        } else sc[kt] = (f32x4){-INFINITY, -INFINITY, -INFINITY, -INFINITY};
        if (SAMP && (kt == 2 || kt == 5)) __builtin_amdgcn_sched_barrier(0);
    }
    if (PRE) { __builtin_amdgcn_sched_barrier(0); attn_load_qk(base, P0n, striden, lane, probe, pre); __builtin_amdgcn_sched_barrier(0); }
    if (SAMP) {
        __builtin_amdgcn_sched_barrier(0);
#pragma unroll
        for (int ks = 0; ks < 2; ++ks)
#pragma unroll
            for (int i = 0; i < 8; ++i) { int kpos = P0 + stride * (32 * ks + 4 * i + (lane >> 4) - 128); kpos = kpos < 0 ? 0 : kpos;
                vq[ks][i] = *(const f32x4*)(cv + (size_t)kpos * (NH * HD) + (lane & 15) * 4); }
    }
    float m = -INFINITY;
#pragma unroll
    for (int kt = 0; kt < 9; ++kt) m = fmaxf(fmaxf(fmaxf(m, sc[kt][0]), fmaxf(sc[kt][1], sc[kt][2])), sc[kt][3]);
    m = fmaxf(m, __shfl_xor(m, 16)); m = fmaxf(m, __shfl_xor(m, 32));
    float l = 0.f;
#pragma unroll
    for (int kt = 0; kt < 9; ++kt)
#pragma unroll
        for (int j = 0; j < 4; ++j) { const float p = __builtin_amdgcn_exp2f(sc[kt][j] - m); sc[kt][j] = p; l += p; }
    l += __shfl_xor(l, 16); l += __shfl_xor(l, 32);
#pragma unroll
    for (int dt = 0; dt < 4; ++dt) o[dt] = (f32x4){0.f, 0.f, 0.f, 0.f};
    LAS const unsigned char* vr = vst + (4 * rq + ((lane & 15) >> 2)) * AT_VROW + (lane & 3) * 8;
#define AT_STEP_VALID(ks) (((P0 + stride * (16 * ((2 * (ks) + 1 < 9) ? 2 * (ks) + 1 : 8) + 15 - 128)) >= 0) && !(probe & 32))
#define AT_VWRITE(ks) do { { LAS unsigned char* vb_ = vst + ((ks) & 1) * AT_VBYTES; \
        if (SAMP && (ks) < 4) { _Pragma("unroll") for (int i = 0; i < 8; ++i) { const f32x4 v = vq[(ks) & 1][i]; u32x2 w; w.x = pk2(v[0], v[1]); w.y = pk2(v[2], v[3]); *(LAS u32x2*)(vb_ + (4 * i + (lane >> 4)) * AT_VROW + (lane & 15) * 8) = w; } } \
        else { _Pragma("unroll") for (int i = 0; i < 4; ++i) *(LAS u32x4*)(vb_ + (8 * i + (lane >> 3)) * AT_VROW + (lane & 7) * 16) = vh[SAMP ? 0 : ((ks) & 1)][i]; } } } while (0)
#define AT_VLOADF(ks) do { { _Pragma("unroll") for (int i = 0; i < 8; ++i) { int kpos = P0 + stride * (32 * (ks) + 4 * i + (lane >> 4) - 128); kpos = kpos < 0 ? 0 : kpos; \
        vq[(ks) & 1][i] = *(const f32x4*)(cv + (size_t)kpos * (NH * HD) + (lane & 15) * 4); } } } while (0)
    AT_VWRITE(0);
#define AT_VLOADH(ks) do { { _Pragma("unroll") for (int i = 0; i < 4; ++i) { int kpos = P0 + stride * (32 * (ks) + 8 * i + (lane >> 3) - 128); kpos = kpos < 0 ? 0 : (kpos > SEQ - 1 ? SEQ - 1 : kpos); \
        vh[(ks) & 1][i] = *(const u32x4*)(base + (size_t)kpos * NPROJ + C_V + (lane & 7) * 8); } } } while (0)
    if (!SAMP) AT_VLOADH(2);
#pragma unroll
    for (int ks = 0; ks < 5; ++ks) {
        if (SAMP && ks + 2 < 4) {   }
        if (ks + 1 < 5) AT_VWRITE(ks + 1);
        if (!SAMP && ks + 3 < 5) AT_VLOADH(ks + 3);
        if (SAMP && ks + 2 < 4) AT_VLOADF(ks + 2);
        if (AT_STEP_VALID(ks)) {
            bf16x8 pb;
            { const f32x4 pa = sc[2 * ks]; const f32x4 pz = (2 * ks + 1 < 9) ? sc[(2 * ks + 1 < 9) ? 2 * ks + 1 : 8] : (f32x4){0.f, 0.f, 0.f, 0.f};
              u32x4 w; w.x = pk2(pa[0], pa[1]); w.y = pk2(pa[2], pa[3]); w.z = pk2(pz[0], pz[1]); w.w = pk2(pz[2], pz[3]); pb = __builtin_bit_cast(bf16x8, w); }
            LAS const unsigned char* vrb = vr + (ks & 1) * AT_VBYTES;
#pragma unroll
            for (int dt = 0; dt < 4; ++dt) { const s16x4 lo = lds_tr16(vrb + dt * 32), hi = lds_tr16(vrb + dt * 32 + 16 * AT_VROW);
                const bf16x8 vf = (bf16x8){lo[0], lo[1], lo[2], lo[3], hi[0], hi[1], hi[2], hi[3]};
                o[dt] = __builtin_amdgcn_mfma_f32_16x16x32_bf16(vf, pb, o[dt], 0, 0, 0); }
        }
    }
#undef AT_VWRITE
#undef AT_VLOADF
#undef AT_VLOADH
#undef AT_STEP_VALID
    m_out = m; l_out = l;
}
__device__ __forceinline__ void attn_merge(int mode, LAS unsigned char* lds, int ql, int lane, float m, float l, f32x4 (&o)[4], const bf16* gp  , bf16* yp  ) {
    const int rq = lane >> 4;
    LAS float* ml = (LAS float*)(lds + AT_ML) + ql * 2; LAS unsigned char* st = lds + AT_ST + ql * AT_STROW + rq * 16;
    if (mode == 0) {
#pragma unroll
        for (int dt = 0; dt < 4; ++dt) *(LAS f32x4*)(st + dt * 64) = o[dt];
        if (rq == 0) { ml[0] = m; ml[1] = l; }
    } else {
        const float M = ml[0], L = ml[1]; const float Mn = fmaxf(M, m), ca = __builtin_amdgcn_exp2f(M - Mn), cb = __builtin_amdgcn_exp2f(m - Mn); const float Ln = L * ca + l * cb;
        f32x4 on[4];
#pragma unroll
        for (int dt = 0; dt < 4; ++dt) on[dt] = *(LAS const f32x4*)(st + dt * 64) * ca + o[dt] * cb;
        if (mode == 1) {
            LDS_WAIT(); asm volatile("" ::: "memory");
#pragma unroll
            for (int dt = 0; dt < 4; ++dt) *(LAS f32x4*)(st + dt * 64) = on[dt];
            if (rq == 0) { ml[0] = Mn; ml[1] = Ln; }
        } else {
            const float inv = 1.f / Ln;
#pragma unroll
            for (int dt = 0; dt < 4; ++dt) { const u32x2 g = *(const u32x2*)(gp + 16 * dt + 4 * rq);
                const float g0 = __uint_as_float(g.x << 16), g1 = __uint_as_float(g.x & 0xffff0000u), g2 = __uint_as_float(g.y << 16), g3 = __uint_as_float(g.y & 0xffff0000u);
                u32x2 w; w.x = pk2(on[dt][0] * inv * siluf_(g0), on[dt][1] * inv * siluf_(g1)); w.y = pk2(on[dt][2] * inv * siluf_(g2), on[dt][3] * inv * siluf_(g3));
                *(u32x2*)(yp + 16 * dt + 4 * rq) = w; }
        }
    }
}
__device__ __forceinline__ void attn_unit(const unsigned char* ws, LAS unsigned char* lds, int b, int h, int s, int wave, int lane, int probe) {
    const bf16* proj = (const bf16*)(ws + WS_PROJ); bf16* ya = probe ? (bf16*)(ws + WS_TMP) : (bf16*)(ws + WS_YA); const float* prm = (const float*)(ws + WS_PRM);
    const bf16* base = proj + (size_t)b * SEQ * NPROJ + h * HD;
    LAS float* bias2 = (LAS float*)(lds + AT_BIAS); LAS unsigned char* vst = lds + AT_V + wave * AT_VWAVE;
    for (int idx = threadIdx.x; idx < 3 * 160; idx += NTHR) { const int g = idx / 160, i = idx - g * 160 - 16; bias2[idx] = (i >= 0 && i <= 128) ? prm[PR_RELB + t5_bucket((128 - i) << (2 * g)) * NH + h] * LOG2E : 0.f; }
    const int c = lane & 15;
#define AT_ITEM_PARAMS(it_, q0_, st_) do { const int id_ = 2 * wave + ((it_) & 1), md_ = (it_) >> 1; \
        if (md_ == 0) { q0_ = id_; st_ = 16; } else if (md_ == 1) { q0_ = (id_ >> 2) + 64 * (id_ & 3); st_ = 4; } else { q0_ = 16 * id_; st_ = 1; } } while (0)
    AttnQK qk; int q0, stride; AT_ITEM_PARAMS(0, q0, stride);
    attn_load_qk(base, s + q0, stride, lane, probe, qk);
#pragma unroll 1
    for (int it = 0; it < 6; ++it) {
        if ((it & 1) == 0) __syncthreads();
        const int mode = it >> 1;
        int q0n, striden; AT_ITEM_PARAMS((it + 1 < 6 ? it + 1 : 0), q0n, striden);
        float m, l; f32x4 o[4];
        attn_item<false, true>(base, nullptr, nullptr, s + q0, stride, bias2 + (2 - mode) * 160 + 16, vst, lane, m, l, o, probe, qk, it + 1 < 6, s + q0n, striden);
        const int ql = q0 + stride * c; const size_t row = (size_t)b * SEQ + s + ql;
        if (!(probe & 64)) attn_merge(mode, lds, ql, lane, m, l, o, proj + row * NPROJ + C_G + h * HD, ya + row * DA + h * HD);
        q0 = q0n; stride = striden;
    }
#undef AT_ITEM_PARAMS
    __syncthreads();
}

constexpr int AS_SLOT = 0, AS_SLOTF = 68;
__device__ __forceinline__ void attn_sample_unit(const unsigned char* ws, const float* cache_k, const float* cache_v, LAS unsigned char* lds, int sq, int h, int wave, int lane) {
    const bf16* proj = (const bf16*)(ws + WS_PROJ); bf16* ya = (bf16*)(ws + WS_YA); const float* prm = (const float*)(ws + WS_PRM);
    const bf16* base = proj + (size_t)(MP + sq * DECS) * NPROJ + h * HD; const float* ck = cache_k + ((size_t)sq * KVB * NH + h) * HD; const float* cv = cache_v + ((size_t)sq * KVB * NH + h) * HD;
    LAS float* bias2 = (LAS float*)(lds + AT_BIAS); LAS unsigned char* vst = lds + AT_V + wave * AT_VWAVE; LAS float* slots = (LAS float*)(lds + AS_SLOT);
    for (int idx = threadIdx.x; idx < 3 * 160; idx += NTHR) { const int g = idx / 160, i = idx - g * 160 - 16; bias2[idx] = (i >= 0 && i <= 128) ? prm[PR_RELB + t5_bucket((128 - i) << (2 * g)) * NH + h] * LOG2E : 0.f; }
    __syncthreads();
    const int c = lane & 15, rq = lane >> 4;
#pragma unroll 1
    for (int id = wave; id < 13; id += NWAVES) {
        const int g = id == 0 ? 0 : (id < 5 ? 1 : 2), r = id == 0 ? 0 : (id < 5 ? id - 1 : id - 5), stride = 1 << (2 * g), nq = (DECS - r + stride - 1) / stride;
        float m, l; f32x4 o[4];
        { AttnQK dummy; attn_item<true, false>(base, ck, cv, KVB + r, stride, bias2 + g * 160 + 16, vst, lane, m, l, o, 0, dummy, false, 0, 1); }
        if (c < nq) { LAS float* sl = slots + ((r + stride * c) * 3 + g) * AS_SLOTF;
#pragma unroll
            for (int dt = 0; dt < 4; ++dt) *(LAS f32x4*)(sl + 16 * dt + 4 * rq) = o[dt];
            if (rq == 0) { sl[64] = m; sl[65] = l; } }
    }
    __syncthreads();
    { const int i = threadIdx.x >> 6, d = lane; const LAS float* s0 = slots + (i * 3) * AS_SLOTF; const LAS float* s1 = s0 + AS_SLOTF; const LAS float* s2 = s1 + AS_SLOTF;
      const float m0 = s0[64], m1 = s1[64], m2 = s2[64], M = fmaxf(m0, fmaxf(m1, m2));
      const float c0 = __builtin_amdgcn_exp2f(m0 - M), c1 = __builtin_amdgcn_exp2f(m1 - M), c2 = __builtin_amdgcn_exp2f(m2 - M);
      const float L = s0[65] * c0 + s1[65] * c1 + s2[65] * c2, O = s0[d] * c0 + s1[d] * c1 + s2[d] * c2;
      const size_t row = (size_t)MP + sq * DECS + i; const float gv = bf2f(proj[row * NPROJ + C_G + h * HD + d]);
      ya[row * DA + h * HD + d] = (bf16)f2bf(O / L * siluf_(gv)); }
    __syncthreads();
}
constexpr int SD_BM = 0, SD_CM = 17408, SD_CS = 34816, SD_ROWN = 272, SD_BWT = 52224, SD_XT = 70656, SD_ROWS = 144, SD_YP = 79872, SD_YROW = 272, SD_AR = 114688, SD_CW = 115712;
__device__ __forceinline__ void ssd_dtarrays(LAS float* ar, float dtv, float Aneg, int lane) {
    asm volatile("" : "+v"(lane));
    float x = dtv * Aneg * LOG2E;
#pragma unroll
    for (int o = 1; o < 64; o <<= 1) { const float y = __shfl_up(x, o); if (lane >= o) x += y; }
    const float tot = __shfl(x, 63);
    ar[lane] = x; ar[64 + lane] = dtv; ar[128 + lane] = __builtin_amdgcn_exp2f(tot - x) * dtv; ar[192 + lane] = __builtin_amdgcn_exp2f(x);
}
__device__ __forceinline__ float silu_fast(float x) { return x * __builtin_amdgcn_rcpf(1.f + __builtin_amdgcn_exp2f(-x * LOG2E)); }
typedef float f32x2 __attribute__((ext_vector_type(2)));
__device__ __forceinline__ void ssd_conv_load(unsigned (&raw)[19], const bf16* proj, const bf16* zrow, size_t row0, int c0, int t0, int col) {
    const bf16* basep = proj + (row0 + (size_t)(c0 + t0)) * NPROJ + C_XBC + col;
#pragma unroll
    for (int k = 0; k < 19; ++k) { const int T = c0 + t0 - 3 + k; const bf16* rp = (T >= 0) ? basep + (ptrdiff_t)(k - 3) * NPROJ : zrow + col; raw[k] = *(const unsigned*)rp; }
}
template <int KIND> __device__ __forceinline__ void ssd_conv_compute(const unsigned (&raw)[19], LAS unsigned char* lds, int t0, int chl  , int ch) {
    const LAS float* ar = (const LAS float*)(lds + SD_AR); const LAS float* cw = (const LAS float*)(lds + SD_CW) + chl;
    f32x2 w[4];
#pragma unroll
    for (int tap = 0; tap < 4; ++tap) w[tap] = *(const LAS f32x2*)(cw + tap * 320);
    const f32x2 bb = *(const LAS f32x2*)(cw + 4 * 320);
#pragma unroll
    for (int blk = 0; blk < 2; ++blk) {
        float o0[8], o1[8];
#pragma unroll
        for (int tt = 0; tt < 8; ++tt) { const int t = blk * 8 + tt; f32x2 v = bb;
#pragma unroll
            for (int tap = 0; tap < 4; ++tap) v += w[tap] * (f32x2){__uint_as_float(raw[t + tap] << 16), __uint_as_float(raw[t + tap] & 0xffff0000u)};
            o0[tt] = silu_fast(v.x); o1[tt] = silu_fast(v.y); }
        const int s0 = t0 + blk * 8;
        if (KIND == 0) {
            u32x4 a, b; a.x = pk2(o0[0], o0[1]); a.y = pk2(o0[2], o0[3]); a.z = pk2(o0[4], o0[5]); a.w = pk2(o0[6], o0[7]); b.x = pk2(o1[0], o1[1]); b.y = pk2(o1[2], o1[3]); b.z = pk2(o1[4], o1[5]); b.w = pk2(o1[6], o1[7]);
            *(LAS u32x4*)(lds + SD_XT + ch * SD_ROWS + s0 * 2) = a; *(LAS u32x4*)(lds + SD_XT + (ch + 1) * SD_ROWS + s0 * 2) = b;
        } else if (KIND == 1) {
            float s0v[8], s1v[8];
#pragma unroll
            for (int tt = 0; tt < 8; ++tt) { *(LAS unsigned*)(lds + SD_BM + (s0 + tt) * SD_ROWN + ch * 2) = pk2(o0[tt], o1[tt]); const float ww = ar[128 + s0 + tt]; s0v[tt] = o0[tt] * ww; s1v[tt] = o1[tt] * ww; }
            u32x4 a, b; a.x = pk2(s0v[0], s0v[1]); a.y = pk2(s0v[2], s0v[3]); a.z = pk2(s0v[4], s0v[5]); a.w = pk2(s0v[6], s0v[7]); b.x = pk2(s1v[0], s1v[1]); b.y = pk2(s1v[2], s1v[3]); b.z = pk2(s1v[4], s1v[5]); b.w = pk2(s1v[6], s1v[7]);
            *(LAS u32x4*)(lds + SD_BWT + ch * SD_ROWS + s0 * 2) = a; *(LAS u32x4*)(lds + SD_BWT + (ch + 1) * SD_ROWS + s0 * 2) = b;
        } else {
#pragma unroll
            for (int tt = 0; tt < 8; ++tt) { *(LAS unsigned*)(lds + SD_CM + (s0 + tt) * SD_ROWN + ch * 2) = pk2(o0[tt], o1[tt]); const float e = ar[192 + s0 + tt];
                *(LAS unsigned*)(lds + SD_CS + (s0 + tt) * SD_ROWN + ch * 2) = pk2(o0[tt] * e, o1[tt] * e); }
        }
    }
}
__device__ __forceinline__ bf16x8 cat8(s16x4 a, s16x4 b) { return (bf16x8){a[0], a[1], a[2], a[3], b[0], b[1], b[2], b[3]}; }
#define SD_SCHED() __builtin_amdgcn_sched_barrier(0)
template <int HH> __device__ __forceinline__ void ssd_mfma_step(LAS unsigned char* lds, f32x4 (&Hacc)[4], int pt, int c, int rq, float Dk) {
    const LAS float* ar = (const LAS float*)(lds + SD_AR);
    constexpr int S0 = 2 * HH, S1 = 2 * HH + 1;
    const int p = 16 * pt + c;
    const LAS unsigned char* bmp = lds + SD_BM + (32 * HH + c) * SD_ROWN + 16 * rq; const LAS unsigned char* cmp_ = lds + SD_CM + c * SD_ROWN + 16 * rq;
    f32x4 g0[4], g1[4];
#pragma unroll
    for (int lt = 0; lt < 4; ++lt) { g0[lt] = (f32x4){0.f, 0.f, 0.f, 0.f}; g1[lt] = (f32x4){0.f, 0.f, 0.f, 0.f}; }
    bf16x8 fb[2][2], fc[2][4];
#define SD_LOADG(buf, ks) do { fb[buf][0] = *(LAS const bf16x8*)(bmp + 64 * (ks)); fb[buf][1] = *(LAS const bf16x8*)(bmp + 16 * SD_ROWN + 64 * (ks)); \
        _Pragma("unroll") for (int lt = S0; lt < 4; ++lt) fc[buf][lt] = *(LAS const bf16x8*)(cmp_ + 16 * lt * SD_ROWN + 64 * (ks)); } while (0)
    SD_LOADG(0, 0);
#pragma unroll
    for (int ks = 0; ks < 4; ++ks) {
        if (ks + 1 < 4) SD_LOADG((ks + 1) & 1, ks + 1);
        SD_SCHED();
#pragma unroll
        for (int lt = S0; lt < 4; ++lt) { g0[lt] = __builtin_amdgcn_mfma_f32_16x16x32_bf16(fb[ks & 1][0], fc[ks & 1][lt], g0[lt], 0, 0, 0);
            if (lt >= S1) g1[lt] = __builtin_amdgcn_mfma_f32_16x16x32_bf16(fb[ks & 1][1], fc[ks & 1][lt], g1[lt], 0, 0, 0); }
        SD_SCHED();
    }
#undef SD_LOADG
    bf16x8 csf[4][2];
#pragma unroll
    for (int lt = 0; lt < 4; ++lt)
#pragma unroll
        for (int k2 = 0; k2 < 2; ++k2) { const LAS unsigned char* cp = lds + SD_CS + (16 * lt + c) * SD_ROWN + (64 * HH + 32 * k2 + 4 * rq) * 2; csf[lt][k2] = cat8(*(LAS const s16x4*)cp, *(LAS const s16x4*)(cp + 32)); }
    const bf16x8 xb = cat8(*(LAS const s16x4*)(lds + SD_XT + p * SD_ROWS + (32 * HH + 4 * rq) * 2), *(LAS const s16x4*)(lds + SD_XT + p * SD_ROWS + (32 * HH + 16 + 4 * rq) * 2));
    const f32x4 as0 = *(LAS const f32x4*)(ar + 32 * HH + 4 * rq), as1 = *(LAS const f32x4*)(ar + 32 * HH + 16 + 4 * rq);
    const f32x4 dt0 = *(LAS const f32x4*)(ar + 64 + 32 * HH + 4 * rq), dt1 = *(LAS const f32x4*)(ar + 64 + 32 * HH + 16 + 4 * rq);
    float acl[4];
#pragma unroll
    for (int lt = 0; lt < 4; ++lt) acl[lt] = ar[16 * lt + c];
    const float dec = __builtin_amdgcn_exp2f(ar[63]);
    SD_SCHED();
    int dd = c - 4 * rq; asm volatile("" : "+v"(dd));
    bf16x8 hb[2];
#pragma unroll
    for (int k2 = 0; k2 < 2; ++k2) { u32x4 w; w.x = pk2(Hacc[2 * k2][0], Hacc[2 * k2][1]); w.y = pk2(Hacc[2 * k2][2], Hacc[2 * k2][3]); w.z = pk2(Hacc[2 * k2 + 1][0], Hacc[2 * k2 + 1][1]); w.w = pk2(Hacc[2 * k2 + 1][2], Hacc[2 * k2 + 1][3]); hb[k2] = __builtin_bit_cast(bf16x8, w); }
    bf16x8 mf[4];
#pragma unroll
    for (int lt = 0; lt < 4; ++lt) if (lt >= S0) {
        float m0[4], m1[4];
#pragma unroll
        for (int j = 0; j < 4; ++j) {
            float v0 = g0[lt][j] * __builtin_amdgcn_exp2f(fminf(acl[lt] - as0[j], 0.f)) * dt0[j];
            if (lt == S0) { v0 = (j <= dd) ? v0 : 0.f; v0 += (j == dd) ? Dk : 0.f; }
            m0[j] = v0;
            float v1 = 0.f;
            if (lt >= S1) { v1 = g1[lt][j] * __builtin_amdgcn_exp2f(fminf(acl[lt] - as1[j], 0.f)) * dt1[j]; if (lt == S1) { v1 = (j <= dd) ? v1 : 0.f; v1 += (j == dd) ? Dk : 0.f; } }
            m1[j] = v1; }
        u32x4 w; w.x = pk2(m0[0], m0[1]); w.y = pk2(m0[2], m0[3]); w.z = pk2(m1[0], m1[1]); w.w = pk2(m1[2], m1[3]); mf[lt] = __builtin_bit_cast(bf16x8, w);
    }
    SD_SCHED();
    f32x4 y[4];
#pragma unroll
    for (int lt = 0; lt < 4; ++lt) y[lt] = __builtin_amdgcn_mfma_f32_16x16x32_bf16(csf[lt][0], hb[0], (f32x4){0.f, 0.f, 0.f, 0.f}, 0, 0, 0);
#pragma unroll
    for (int lt = 0; lt < 4; ++lt) y[lt] = __builtin_amdgcn_mfma_f32_16x16x32_bf16(csf[lt][1], hb[1], y[lt], 0, 0, 0);
    SD_SCHED();
    bf16x8 bwf[4][2], xn[2];
#pragma unroll
    for (int k2 = 0; k2 < 2; ++k2) xn[k2] = *(LAS const bf16x8*)(lds + SD_XT + p * SD_ROWS + (8 * rq + 32 * k2) * 2);
#pragma unroll
    for (int nt = 0; nt < 4; ++nt)
#pragma unroll
        for (int k2 = 0; k2 < 2; ++k2) bwf[nt][k2] = *(LAS const bf16x8*)(lds + SD_BWT + (64 * HH + 16 * nt + c) * SD_ROWS + (8 * rq + 32 * k2) * 2);
    SD_SCHED();
#pragma unroll
    for (int lt = 0; lt < 4; ++lt) if (lt >= S0) y[lt] = __builtin_amdgcn_mfma_f32_16x16x32_bf16(mf[lt], xb, y[lt], 0, 0, 0);
#pragma unroll
    for (int nt = 0; nt < 4; ++nt) Hacc[nt] = Hacc[nt] * dec;
#pragma unroll
    for (int k2 = 0; k2 < 2; ++k2)
#pragma unroll
        for (int nt = 0; nt < 4; ++nt) Hacc[nt] = __builtin_amdgcn_mfma_f32_16x16x32_bf16(bwf[nt][k2], xn[k2], Hacc[nt], 0, 0, 0);
#pragma unroll
    for (int lt = 0; lt < 4; ++lt)
#pragma unroll
        for (int j = 0; j < 4; ++j) *(LAS float*)(lds + SD_YP + HH * (64 * SD_YROW) + (16 * lt + 4 * rq + j) * SD_YROW + p * 4) = y[lt][j];
}
__device__ __forceinline__ void ssd_mfma_unit(const unsigned char* ws, float* out, bf16* ys, float* ssq, int probe, LAS unsigned char* lds, int b, int hd, int wave, int lane) {
    const bf16* proj = (const bf16*)(ws + WS_PROJ); const float* dtb = (const float*)(ws + WS_DT); const float* prm = (const float*)(ws + WS_PRM);
    const int tid = threadIdx.x, c = lane & 15, rq = lane >> 4, pt = wave & 3, hh = wave >> 2, grp = hd >> 2;
    const size_t row0 = (size_t)b * SEQ; const bf16* zrow = (const bf16*)(ws + WS_WIN) + (size_t)NIN * DM;
    const float Aneg = -__expf(prm[PR_ALOG + hd]), Dk = prm[PR_DSKIP + hd];
    LAS float* ar = (LAS float*)(lds + SD_AR);
    f32x4 Hacc[4];
#pragma unroll
    for (int nt = 0; nt < 4; ++nt) Hacc[nt] = (f32x4){0.f, 0.f, 0.f, 0.f};
    const int kindA = wave < 2 ? 0 : (wave < 6 ? 1 : 2);
    const int tA = kindA == 0 ? tid : (kindA == 1 ? tid - 128 : tid - 384), pairA = kindA == 0 ? (tA & 31) : (tA & 63), runA = kindA == 0 ? (tA >> 5) : (tA >> 6);
    const int colA = kindA == 0 ? hd * 64 + 2 * pairA : (kindA == 1 ? DSSM + grp * DST + 2 * pairA : DSSM + NGRP * DST + grp * DST + 2 * pairA);
    const int tB = tid + 128, pairB = tB & 63, runB = tB >> 6, colB = DSSM + NGRP * DST + grp * DST + 2 * pairB;
    unsigned rawA[19], rawB[19];
    ssd_conv_load(rawA, proj, zrow, row0, 0, 16 * runA, colA);
    if (wave < 2) ssd_conv_load(rawB, proj, zrow, row0, 0, 16 * runB, colB);
    float dtn = (wave == 7) ? dtb[(row0 + lane) * 32 + hd] : 0.f;
    __syncthreads();
    for (int idx = tid; idx < 5 * 320; idx += NTHR) { const int t5 = idx / 320, chl = idx - t5 * 320; const int col = chl < 64 ? hd * 64 + chl : (chl < 192 ? DSSM + grp * DST + (chl - 64) : DSSM + NGRP * DST + grp * DST + (chl - 192));
        ((LAS float*)(lds + SD_CW))[idx] = t5 < 4 ? prm[PR_CONVW + t5 * DCONV + col] : prm[PR_CONVB + col]; }
    if (wave == 7) { ssd_dtarrays(ar, dtn, Aneg, lane); dtn = dtb[(row0 + 64 + lane) * 32 + hd]; }
    __syncthreads();
    const int el = tid >> 3, ep0 = (tid & 7) * 8;
#pragma unroll 1
    for (int c0 = 0; c0 < SEQ; c0 += 64) {
        const bool more = c0 + 64 < SEQ;
        const u32x4 zreg = *(const u32x4*)(proj + (row0 + c0 + el) * NPROJ + C_Z + hd * 64 + ep0);
        if (!(probe & 2)) {
        if (kindA == 0) ssd_conv_compute<0>(rawA, lds, 16 * runA, 2 * pairA, 2 * pairA); else if (kindA == 1) ssd_conv_compute<1>(rawA, lds, 16 * runA, 64 + 2 * pairA, 2 * pairA); else ssd_conv_compute<2>(rawA, lds, 16 * runA, 192 + 2 * pairA, 2 * pairA);
        if (more) ssd_conv_load(rawA, proj, zrow, row0, c0 + 64, 16 * runA, colA);
        if (wave < 2) { ssd_conv_compute<2>(rawB, lds, 16 * runB, 192 + 2 * pairB, 2 * pairB); if (more) ssd_conv_load(rawB, proj, zrow, row0, c0 + 64, 16 * runB, colB); }
        }
        __syncthreads();
        if (!(probe & 4)) { if (hh == 0) ssd_mfma_step<0>(lds, Hacc, pt, c, rq, Dk); else ssd_mfma_step<1>(lds, Hacc, pt, c, rq, Dk); }
        __syncthreads();
        if (!(probe & 8)) {
            const size_t row = row0 + c0 + el;
            const LAS float* y0 = (const LAS float*)(lds + SD_YP + el * SD_YROW + ep0 * 4); const LAS float* y1 = (const LAS float*)(lds + SD_YP + 64 * SD_YROW + el * SD_YROW + ep0 * 4);
            const f32x4 a0 = *(const LAS f32x4*)y0 + *(const LAS f32x4*)y1, a1 = *(const LAS f32x4*)(y0 + 4) + *(const LAS f32x4*)(y1 + 4);
            const u32x4 z = zreg;
            float v[8];
            v[0] = a0[0] * silu_fast(__uint_as_float(z.x << 16)); v[1] = a0[1] * silu_fast(__uint_as_float(z.x & 0xffff0000u)); v[2] = a0[2] * silu_fast(__uint_as_float(z.y << 16)); v[3] = a0[3] * silu_fast(__uint_as_float(z.y & 0xffff0000u));
            v[4] = a1[0] * silu_fast(__uint_as_float(z.z << 16)); v[5] = a1[1] * silu_fast(__uint_as_float(z.z & 0xffff0000u)); v[6] = a1[2] * silu_fast(__uint_as_float(z.w << 16)); v[7] = a1[3] * silu_fast(__uint_as_float(z.w & 0xffff0000u));
            u32x4 w; w.x = pk2(v[0], v[1]); w.y = pk2(v[2], v[3]); w.z = pk2(v[4], v[5]); w.w = pk2(v[6], v[7]);
            *(u32x4*)(ys + row * DSSM + hd * 64 + ep0) = w;
            float ss = (v[0] * v[0] + v[1] * v[1]) + (v[2] * v[2] + v[3] * v[3]) + (v[4] * v[4] + v[5] * v[5]) + (v[6] * v[6] + v[7] * v[7]);
            ss += __shfl_xor(ss, 1); ss += __shfl_xor(ss, 2); ss += __shfl_xor(ss, 4);
            if ((tid & 7) == 0) ssq[row * NSH + hd] = ss;
            if (wave == 7 && more) { ssd_dtarrays(ar, dtn, Aneg, lane); const int cn = c0 + 128 < SEQ ? c0 + 128 : c0; dtn = dtb[(row0 + cn + lane) * 32 + hd]; }
        }
        __syncthreads();
    }
    float* dst = out + O_SP + ((size_t)(b * NSH + hd) * SHD + 16 * pt + c) * DST + 64 * hh + 4 * rq;
#pragma unroll
    for (int nt = 0; nt < 4; ++nt) *(f32x4*)(dst + 16 * nt) = Hacc[nt];
}
constexpr int SS_TEAM = 12288;
constexpr int SS_X = 0, SS_B = 2048, SS_C = 6144, SS_DT = 10240, SS_Y = 10304, SS_BYTES = 12352;
__device__ __forceinline__ void ssd_sample_teams(const unsigned char* ws, float* out, const float* state_conv, const float* state_ssm, LAS unsigned char* lds, int item0  , int nitems) {
    const bf16* proj = (const bf16*)(ws + WS_PROJ); const float* dtb = (const float*)(ws + WS_DT); const float* prm = (const float*)(ws + WS_PRM); bf16* ys = (bf16*)(ws + WS_YS); float* ssq = (float*)(ws + WS_SSQ);
    const int tid = threadIdx.x, team = tid >> 7, t = tid & 127, p = t >> 1, nh = t & 1;
    const int item = item0 + team; const bool act = team < nitems;
    const int sq = act ? item / NSH : 0, hd = act ? item % NSH : 0, grp = hd >> 2; const size_t row0 = (size_t)MP + sq * DECS;
    LAS unsigned char* tl = lds + team * SS_BYTES;
    LAS float* xs = (LAS float*)(tl + SS_X); LAS float* Bs = (LAS float*)(tl + SS_B); LAS float* Cs = (LAS float*)(tl + SS_C); LAS float* dts = (LAS float*)(tl + SS_DT); LAS float* yb = (LAS float*)(tl + SS_Y);
    f32x4 h[16];
    { const f32x4* s4 = (const f32x4*)(state_ssm + ((size_t)(sq * NSH + hd) * SHD + p) * DST + 64 * nh);
#pragma unroll
      for (int j = 0; j < 16; ++j) h[j] = s4[j]; }
    const float Aneg = -__expf(prm[PR_ALOG + hd]), Dk = prm[PR_DSKIP + hd];
#pragma unroll 1
    for (int c = t; c < 320; c += 128) {
        const int xc = c < 64 ? hd * 64 + c : (c < 192 ? DSSM + grp * DST + (c - 64) : DSSM + NGRP * DST + grp * DST + (c - 192));
        float w[4], raw[11];
#pragma unroll
        for (int tap = 0; tap < 4; ++tap) w[tap] = prm[PR_CONVW + tap * DCONV + xc];
        const float bias = prm[PR_CONVB + xc];
#pragma unroll
        for (int k = 0; k < 3; ++k) raw[k] = state_conv[(size_t)(sq * 3 + k) * DCONV + xc];
#pragma unroll
        for (int k = 0; k < DECS; ++k) raw[3 + k] = bf2f(proj[(row0 + k) * NPROJ + C_XBC + xc]);
        LAS float* dstp = c < 64 ? xs + c : (c < 192 ? Bs + (c - 64) : Cs + (c - 192)); const int dstride = c < 64 ? 64 : 128;
#pragma unroll
        for (int tk = 0; tk < DECS; ++tk) { const float acc = bias + w[0] * raw[tk] + w[1] * raw[tk + 1] + w[2] * raw[tk + 2] + w[3] * raw[tk + 3]; dstp[tk * dstride] = siluf_(acc); }
    }
    if (t < DECS) { const float dtv = dtb[(row0 + t) * 32 + hd]; dts[t] = dtv; dts[8 + t] = __expf(dtv * Aneg); }
    __syncthreads();
#pragma unroll 1
    for (int tk = 0; tk < DECS; ++tk) {
        const float dA = dts[8 + tk], xv = xs[tk * 64 + p], dtx = dts[tk] * xv;
        const LAS f32x4* b4 = (const LAS f32x4*)(Bs + tk * 128 + 64 * nh); const LAS f32x4* c4 = (const LAS f32x4*)(Cs + tk * 128 + 64 * nh);
        f32x4 a4 = {0.f, 0.f, 0.f, 0.f};
#pragma unroll
        for (int j = 0; j < 16; ++j) { h[j] = h[j] * dA + b4[j] * dtx; a4 += h[j] * c4[j]; }
        float acc = (a4[0] + a4[1]) + (a4[2] + a4[3]);
        acc += __shfl_xor(acc, 1);
        if (nh == 0) yb[tk * 64 + p] = acc + Dk * xv;
    }
    if (act) { f32x4* d4 = (f32x4*)(out + O_SS + ((size_t)(sq * NSH + hd) * SHD + p) * DST + 64 * nh);
#pragma unroll
        for (int j = 0; j < 16; ++j) d4[j] = h[j]; }
    __syncthreads();
    { const int tk = t >> 4, p0 = (t & 15) * 4; const size_t row = row0 + tk;
      const f32x4 yv = *(const LAS f32x4*)(yb + tk * 64 + p0); const u32x2 z = *(const u32x2*)(proj + row * NPROJ + C_Z + hd * 64 + p0);
      const float v0 = yv[0] * siluf_(__uint_as_float(z.x << 16)), v1 = yv[1] * siluf_(__uint_as_float(z.x & 0xffff0000u)), v2 = yv[2] * siluf_(__uint_as_float(z.y << 16)), v3 = yv[3] * siluf_(__uint_as_float(z.y & 0xffff0000u));
      float ss = (v0 * v0 + v1 * v1) + (v2 * v2 + v3 * v3);
      ss += __shfl_xor(ss, 1); ss += __shfl_xor(ss, 2); ss += __shfl_xor(ss, 4); ss += __shfl_xor(ss, 8);
      if (act) { u32x2 w; w.x = pk2(v0, v1); w.y = pk2(v2, v3); *(u32x2*)(ys + row * DSSM + hd * 64 + p0) = w; if ((t & 15) == 0) ssq[row * NSH + hd] = ss; } }
    __syncthreads();
}
template <int NKS  > __device__ __forceinline__ f32x2 skinny_tile(const bf16* A, const bf16* Wt, int tile, LAS unsigned char* lds, int wave, int lane) {
    constexpr int K = 256 * NKS;
    const int c = lane & 15, rq = lane >> 4, rb = tile >> 4, cb = tile & 15, k0 = wave * (32 * NKS);
    const bf16* ap = A + (size_t)(16 * rb + c) * K + k0 + 8 * rq; const bf16* wp = Wt + (size_t)(64 * cb + c) * K + k0 + 8 * rq;
    f32x4 acc[4];
#pragma unroll
    for (int nt = 0; nt < 4; ++nt) acc[nt] = (f32x4){0.f, 0.f, 0.f, 0.f};
#pragma unroll
    for (int ks = 0; ks < NKS; ++ks) { const bf16x8 af = *(const bf16x8*)(ap + 32 * ks);
#pragma unroll
        for (int nt = 0; nt < 4; ++nt) acc[nt] = __builtin_amdgcn_mfma_f32_16x16x32_bf16(af, *(const bf16x8*)(wp + (size_t)(16 * nt) * K + 32 * ks), acc[nt], 0, 0, 0); }
    LAS float* P = (LAS float*)lds;
#pragma unroll
    for (int nt = 0; nt < 4; ++nt)
#pragma unroll
        for (int j = 0; j < 4; ++j) P[(wave * 16 + 4 * rq + j) * 64 + 16 * nt + c] = acc[nt][j];
    __syncthreads();
    const int tid = threadIdx.x; f32x2 r = {0.f, 0.f};
#pragma unroll
    for (int w = 0; w < 8; ++w) r += *(const LAS f32x2*)(P + (w * 16 + (tid >> 5)) * 64 + 2 * (tid & 31));
    __syncthreads();
    return r;
}
__device__ __forceinline__ void skinny_p3(const unsigned char* ws, LAS unsigned char* lds, int G, int wave, int lane) {
    const bf16* proj = (const bf16*)(ws + WS_PROJ); const bf16* ya = (const bf16*)(ws + WS_YA) + (size_t)MP * DA; const bf16* ysn = (const bf16*)(ws + WS_YS) + (size_t)MP * DSSM; bf16* mrg = (bf16*)(ws + WS_MRG);
    for (int tile = blockIdx.x; tile < 256; tile += G) {
        const size_t row = (size_t)MP + 16 * (tile >> 4) + (threadIdx.x >> 5); const int col = 64 * (tile & 15) + 2 * (threadIdx.x & 31);
        const f32x2 a = skinny_tile<3>(ya, (const bf16*)(ws + WS_WA), tile, lds, wave, lane);
        const f32x2 b = skinny_tile<8>(ysn, (const bf16*)(ws + WS_WB), tile, lds, wave, lane);
        const unsigned ga = *(const unsigned*)(proj + row * NPROJ + C_GA + col), gb = *(const unsigned*)(proj + row * NPROJ + C_GB + col);
        const float m0 = sigmoidf_(__uint_as_float(ga << 16)) * a.x + sigmoidf_(__uint_as_float(gb << 16)) * b.x, m1 = sigmoidf_(__uint_as_float(ga & 0xffff0000u)) * a.y + sigmoidf_(__uint_as_float(gb & 0xffff0000u)) * b.y;
        *(unsigned*)(mrg + row * DM + col) = pk2(m0, m1);
    }
}
__device__ __forceinline__ void skinny_p4(const unsigned char* ws, const float* x_sample, float* out, LAS unsigned char* lds, int G, int wave, int lane) {
    const bf16* mrg = (const bf16*)(ws + WS_MRG) + (size_t)MP * DM;
    for (int tile = blockIdx.x; tile < 256; tile += G) {
        const int r = 16 * (tile >> 4) + (threadIdx.x >> 5), col = 64 * (tile & 15) + 2 * (threadIdx.x & 31);
        const f32x2 o = skinny_tile<4>(mrg, (const bf16*)(ws + WS_WO), tile, lds, wave, lane);
        const f32x2 xv = *(const f32x2*)(x_sample + (size_t)r * DM + col);
        *(f32x2*)(out + O_YS + (size_t)r * DM + col) = xv + o;
    }
}
__device__ __forceinline__ void p0_transpose_item(const float* W, int K, int N, bf16* WT, int k0, int n0, int dst_row0, const float* kscale, LAS float* scr, int lane) {
#pragma unroll 8
    for (int i = 0; i < 32; ++i) { const int kk = 2 * i + (lane >> 5); float v = W[(size_t)(k0 + kk) * N + n0 + (lane & 31)]; if (kscale) v *= kscale[k0 + kk]; scr[kk * 33 + (lane & 31)] = v; }
    LDS_WAIT(); asm volatile("" ::: "memory");
    const int c = lane & 7;
#pragma unroll
    for (int j = 0; j < 4; ++j) { const int n = (lane >> 3) + 8 * j; const LAS float* s = scr + (8 * c) * 33 + n;
        u32x4 o; o.x = pk2(s[0 * 33], s[1 * 33]); o.y = pk2(s[2 * 33], s[3 * 33]); o.z = pk2(s[4 * 33], s[5 * 33]); o.w = pk2(s[6 * 33], s[7 * 33]);
        *(u32x4*)(WT + (size_t)(dst_row0 + n) * K + k0 + 8 * c) = o; }
    LDS_WAIT(); asm volatile("" ::: "memory");
}
__device__ __forceinline__ void p0_prologue(const Args& a, LAS unsigned char* lds, int gw, int NGW, int wave, int lane) {
    bf16* win_t = (bf16*)(a.ws + WS_WIN); bf16* wa_t = (bf16*)(a.ws + WS_WA); bf16* wb_t = (bf16*)(a.ws + WS_WB); bf16* wo_t = (bf16*)(a.ws + WS_WO); bf16* hb = (bf16*)(a.ws + WS_HB);
    LAS float* scr = (LAS float*)(lds + wave * 16384);
    constexpr int I_IN = (DM / 64) * (NIN / 32), I_A = (DA / 64) * (DM / 32), I_B = (DSSM / 64) * (DM / 32), I_O = (DM / 64) * (DM / 32);
    for (int it = gw; it < I_IN + I_A + I_B + I_O; it += NGW) {
        int r = it;
        if (r < I_IN) { const int nblk = NIN / 32, kb = r / nblk, nb = r % nblk, n0 = nb * 32; const int dst = (n0 < 9216) ? n0 : (n0 == 9216 ? 11264 : n0 - 32);
            p0_transpose_item(a.w_in, DM, NIN, win_t, kb * 64, n0, dst, nullptr, scr, lane); continue; } r -= I_IN;
        if (r < I_A) { const int nblk = DM / 32, kb = r / nblk, nb = r % nblk; p0_transpose_item(a.w_a, DA, DM, wa_t, kb * 64, nb * 32, nb * 32, nullptr, scr, lane); continue; } r -= I_A;
        if (r < I_B) { const int nblk = DM / 32, kb = r / nblk, nb = r % nblk; p0_transpose_item(a.w_b, DSSM, DM, wb_t, kb * 64, nb * 32, nb * 32, a.ssm_norm, scr, lane); continue; } r -= I_B;
        { const int nblk = DM / 32, kb = r / nblk, nb = r % nblk; p0_transpose_item(a.w_out, DM, DM, wo_t, kb * 64, nb * 32, nb * 32, nullptr, scr, lane); }
    }
    { float* prm = (float*)(a.ws + WS_PRM); const int gt = gw * 64 + lane, NGT = NGW * 64;
      for (int i = gt; i < PR_END; i += NGT) { float v = 0.f;
          if (i < PR_CONVB) v = a.conv_w[i]; else if (i < PR_DTB) v = a.conv_b[i - PR_CONVB]; else if (i < PR_ALOG) v = a.dt_bias[i - PR_DTB]; else if (i < PR_DSKIP) v = a.a_log[i - PR_ALOG];
          else if (i < PR_RELB) v = a.d_skip[i - PR_DSKIP]; else if (i < PR_RELB + 384) v = a.rel_bias[i - PR_RELB]; else if (i >= PR_FNORM) v = a.final_norm[i - PR_FNORM];
          prm[i] = v; } }
    { u32x4* z = (u32x4*)(win_t + (size_t)11296 * DM); const int n16 = 224 * DM * 2 / 16; for (int i = gw * 64 + lane; i < n16; i += NGW * 64) z[i] = (u32x4){0u, 0u, 0u, 0u}; }
    for (int m = gw; m < MT; m += NGW) {
        const float* xrow = (m < MP) ? a.x_prompt + (size_t)m * DM : a.x_sample + (size_t)(m - MP) * DM;
        const f32x4* xr = (const f32x4*)xrow + lane; const f32x4* gr = (const f32x4*)a.norm_g + lane;
        f32x4 v[4]; float s = 0.f;
#pragma unroll
        for (int j = 0; j < 4; ++j) { v[j] = xr[64 * j]; s += (v[j].x * v[j].x + v[j].y * v[j].y) + (v[j].z * v[j].z + v[j].w * v[j].w); }
        const float rstd = rsqrtf(wave_sum(s) * (1.f / DM) + 1e-6f);
        unsigned long long* o8 = (unsigned long long*)(hb + (size_t)m * DM) + lane;
#pragma unroll
        for (int j = 0; j < 4; ++j) { const f32x4 g = gr[64 * j]; o8[64 * j] = (unsigned long long)pk2(v[j].x * rstd * g.x, v[j].y * rstd * g.y) | ((unsigned long long)pk2(v[j].z * rstd * g.z, v[j].w * rstd * g.w) << 32); }
    }
}

template <bool SAMP> __device__ __forceinline__ const void* kv_ptr(const Args& a, const bf16* proj, int colkv, const float* cache, int seq, int tpos, int off, int h, bool& valid, bool& isf32) {
    if (!SAMP) { const int kt = tpos - off; valid = kt >= 0; isf32 = false; return proj + (size_t)(seq * SEQ + (valid ? kt : 0)) * NPROJ + colkv + h * HD; }
    const int idx = KVB + tpos - off; valid = true;
    if (idx >= KVB) { isf32 = false; return proj + (size_t)(MP + seq * DECS + (idx - KVB)) * NPROJ + colkv + h * HD; }
    isf32 = true; return cache + ((size_t)(seq * KVB + idx) * NH + h) * HD;
}
template <bool SAMP> __device__ __forceinline__ void attn_slow_item(const Args& a, const bf16* proj, bf16* ya, LAS float* sl, int row, int h, int lane) {
    const float* prm = (const float*)(a.ws + WS_PRM);
    const int seq = SAMP ? (row - MP) / DECS : row / SEQ, tpos = SAMP ? (row - MP) % DECS : row % SEQ;
    float q[64];
    { const u32x4* qp = (const u32x4*)(proj + (size_t)row * NPROJ + C_Q + h * HD);
#pragma unroll
      for (int i = 0; i < 8; ++i) { const u32x4 w = qp[i]; q[8 * i + 0] = __uint_as_float(w.x << 16); q[8 * i + 1] = __uint_as_float(w.x & 0xffff0000u); q[8 * i + 2] = __uint_as_float(w.y << 16); q[8 * i + 3] = __uint_as_float(w.y & 0xffff0000u);
          q[8 * i + 4] = __uint_as_float(w.z << 16); q[8 * i + 5] = __uint_as_float(w.z & 0xffff0000u); q[8 * i + 6] = __uint_as_float(w.w << 16); q[8 * i + 7] = __uint_as_float(w.w & 0xffff0000u); } }
    float mx = -INFINITY;
#pragma unroll 1
    for (int e = lane; e < 387; e += 64) {
        float sc = -INFINITY;
        const int g = e / 129, j = e - g * 129, off = j << (2 * g); bool valid, isf32;
        const void* kp = kv_ptr<SAMP>(a, proj, C_K, a.cache_k, seq, tpos, off, h, valid, isf32);
        if (valid) { float d = 0.f;
            if (isf32) { const f32x4* k4 = (const f32x4*)kp;
#pragma unroll
                for (int i = 0; i < 16; ++i) { const f32x4 kk = k4[i]; d += q[4 * i] * kk.x + q[4 * i + 1] * kk.y + q[4 * i + 2] * kk.z + q[4 * i + 3] * kk.w; } }
            else { const u32x4* k4 = (const u32x4*)kp;
#pragma unroll
                for (int i = 0; i < 8; ++i) { const u32x4 w = k4[i];
                    d += q[8 * i + 0] * __uint_as_float(w.x << 16) + q[8 * i + 1] * __uint_as_float(w.x & 0xffff0000u) + q[8 * i + 2] * __uint_as_float(w.y << 16) + q[8 * i + 3] * __uint_as_float(w.y & 0xffff0000u)
                       + q[8 * i + 4] * __uint_as_float(w.z << 16) + q[8 * i + 5] * __uint_as_float(w.z & 0xffff0000u) + q[8 * i + 6] * __uint_as_float(w.w << 16) + q[8 * i + 7] * __uint_as_float(w.w & 0xffff0000u); } }
            sc = d * 0.125f + prm[PR_RELB + t5_bucket(off) * NH + h]; }
        sl[e] = sc; mx = fmaxf(mx, sc);
    }
    mx = wave_max(mx);
    float sum = 0.f;
#pragma unroll 1
    for (int e = lane; e < 387; e += 64) { const float sc = sl[e]; const float pe = (sc == -INFINITY) ? 0.f : __expf(sc - mx); sl[e] = pe; sum += pe; }
    sum = wave_sum(sum);
    LDS_WAIT(); asm volatile("" ::: "memory");
    float o = 0.f;
#pragma unroll 4
    for (int e = 0; e < 387; ++e) {
        const int g = e / 129, j = e - g * 129, off = j << (2 * g); bool valid, isf32;
        const void* vp = kv_ptr<SAMP>(a, proj, C_V, a.cache_v, seq, tpos, off, h, valid, isf32);
        const float pe = sl[e];
        if (valid) { const float vv = isf32 ? ((const float*)vp)[lane] : bf2f(((const bf16*)vp)[lane]); o += pe * vv; }
    }
    LDS_WAIT(); asm volatile("" ::: "memory");
    const float gv = bf2f(proj[(size_t)row * NPROJ + C_G + h * HD + lane]);
    ya[(size_t)row * DA + h * HD + lane] = (bf16)f2bf(o / sum * siluf_(gv));
}

__device__ __forceinline__ void ssd_slow_item(const Args& a, LAS unsigned char* lds, int item) {
    const bf16* proj = (const bf16*)(a.ws + WS_PROJ); const float* dtb = (const float*)(a.ws + WS_DT); bf16* ys = (bf16*)(a.ws + WS_YS); float* ssq = (float*)(a.ws + WS_SSQ);
    const int tid = threadIdx.x, lane = tid & 63, wid = tid >> 6;
    const bool samp = item >= NBATCH * NSH; const int it2 = samp ? item - NBATCH * NSH : item; const int sq = it2 / NSH, hd = it2 % NSH, grp = hd / 4;
    const int L = samp ? DECS : SEQ, row0 = samp ? MP + sq * DECS : sq * SEQ;
    const int p = tid >> 3, n0 = (tid & 7) * 16;
    float h[16];
    if (samp) { const f32x4* s4 = (const f32x4*)(a.state_ssm + ((size_t)(sq * NSH + hd) * SHD + p) * DST + n0);
#pragma unroll
        for (int j = 0; j < 4; ++j) { const f32x4 v = s4[j]; h[4 * j] = v.x; h[4 * j + 1] = v.y; h[4 * j + 2] = v.z; h[4 * j + 3] = v.w; } }
    else {
#pragma unroll
        for (int j = 0; j < 16; ++j) h[j] = 0.f; }
    const float* prm = (const float*)(a.ws + WS_PRM);
    const float Aneg = -__expf(prm[PR_ALOG + hd]), Dk = prm[PR_DSKIP + hd];
    LAS float* xs = (LAS float*)lds;
    LAS float* Bs = xs + 64 * 64;
    LAS float* Cs = Bs + 64 * 128;
    LAS float* dts = Cs + 64 * 128;
    LAS float* dAs = dts + 64;
    LAS float* yb = dAs + 64;
    for (int c0 = 0; c0 < L; c0 += 64) {
        const int tc = (L - c0) < 64 ? (L - c0) : 64;
        for (int idx = tid; idx < tc * 320; idx += NTHR) {
            const int t = idx / 320, c = idx - t * 320;
            const int xc = c < 64 ? hd * 64 + c : (c < 192 ? DSSM + grp * DST + (c - 64) : DSSM + NGRP * DST + grp * DST + (c - 192));
            float acc = prm[PR_CONVB + xc];
#pragma unroll
            for (int tap = 0; tap < 4; ++tap) { const int tt = c0 + t - 3 + tap; float v;
                if (tt >= 0) v = bf2f(proj[(size_t)(row0 + tt) * NPROJ + C_XBC + xc]);
                else v = samp ? a.state_conv[(size_t)(sq * 3 + 3 + tt) * DCONV + xc] : 0.f;
                acc += prm[PR_CONVW + tap * DCONV + xc] * v; }
            const float val = siluf_(acc);
            if (c < 64) xs[t * 64 + c] = val; else if (c < 192) Bs[t * 128 + (c - 64)] = val; else Cs[t * 128 + (c - 192)] = val;
        }
        if (tid < tc) { const float dtv = dtb[(size_t)(row0 + c0 + tid) * 32 + hd]; dts[tid] = dtv; dAs[tid] = __expf(dtv * Aneg); }
        __syncthreads();
        for (int t = 0; t < tc; ++t) {
            const float dA = dAs[t], xv = xs[t * 64 + p], dtx = dts[t] * xv; float acc = 0.f;
            const LAS f32x4* b4 = (const LAS f32x4*)(Bs + t * 128 + n0); const LAS f32x4* c4 = (const LAS f32x4*)(Cs + t * 128 + n0);
#pragma unroll
            for (int j = 0; j < 4; ++j) { const f32x4 bb = b4[j], cc = c4[j];
                h[4 * j] = dA * h[4 * j] + dtx * bb.x; h[4 * j + 1] = dA * h[4 * j + 1] + dtx * bb.y; h[4 * j + 2] = dA * h[4 * j + 2] + dtx * bb.z; h[4 * j + 3] = dA * h[4 * j + 3] + dtx * bb.w;
                acc += h[4 * j] * cc.x + h[4 * j + 1] * cc.y + h[4 * j + 2] * cc.z + h[4 * j + 3] * cc.w; }
            acc += __shfl_xor(acc, 1); acc += __shfl_xor(acc, 2); acc += __shfl_xor(acc, 4);
            if ((tid & 7) == 0) yb[t * 64 + p] = acc + Dk * xv;
        }
        __syncthreads();
        for (int t = wid; t < tc; t += NWAVES) {
            const int row = row0 + c0 + t; const float z = bf2f(proj[(size_t)row * NPROJ + C_Z + hd * 64 + lane]);
            const float val = yb[t * 64 + lane] * siluf_(z);
            ys[(size_t)row * DSSM + hd * 64 + lane] = (bf16)f2bf(val);
            const float ss = wave_sum(val * val); if (lane == 0) ssq[(size_t)row * NSH + hd] = ss;
        }
        __syncthreads();
    }
    float* dst = a.out + (samp ? O_SS : O_SP) + ((size_t)(sq * NSH + hd) * SHD + p) * DST + n0;
#pragma unroll
    for (int j = 0; j < 4; ++j) ((f32x4*)dst)[j] = (f32x4){h[4 * j], h[4 * j + 1], h[4 * j + 2], h[4 * j + 3]};
}

__device__ __forceinline__ void p2_ssd_prompt(const Args& a, LAS unsigned char* lds, int G, int wave, int lane) {
    for (int item = blockIdx.x; item < NBATCH * NSH; item += G) ssd_mfma_unit(a.ws, a.probe ? (float*)(a.ws + WS_TMP) - O_SP : a.out, a.probe ? (bf16*)(a.ws + WS_MRG) - 0 : (bf16*)(a.ws + WS_YS), a.probe ? (float*)(a.ws + WS_SSQ) + (size_t)MT * NSH : (float*)(a.ws + WS_SSQ), a.probe, lds, item / NSH, item % NSH, wave, lane);
}
__device__ __forceinline__ void p2_ssd_sample(const Args& a, LAS unsigned char* lds, int G) {
    for (int i0 = blockIdx.x * 4; i0 < DECB * NSH; i0 += G * 4) { const int n = DECB * NSH - i0; ssd_sample_teams(a.ws, a.out, a.state_conv, a.state_ssm, lds, i0, n < 4 ? n : 4); }
}
__device__ __forceinline__ void p2_attn_prompt(const Args& a, LAS unsigned char* lds, int G, int wave, int lane) {
    for (int k = 0; ; ++k) { const int v = (G == 256) ? (k < 3 ? (int)((blockIdx.x % 8) * 96 + (blockIdx.x / 8) + 32 * k) : 768) : (int)(blockIdx.x + k * G); if (v >= 768) break;
        const int bh = v >> 3, sb = v & 7; attn_unit(a.ws, lds, bh / NH, bh % NH, sb * 256, wave, lane, a.probe); }
}
__device__ __forceinline__ void p2_attn_sample(const Args& a, LAS unsigned char* lds, int G, int wave, int lane) {
    const bf16* proj = (const bf16*)(a.ws + WS_PROJ);
    for (int u = blockIdx.x; u < DECB * NH; u += G) attn_sample_unit(a.ws, a.cache_k, a.cache_v, lds, u / NH, u % NH, wave, lane);
    const int gt = blockIdx.x * NTHR + threadIdx.x, NGT = G * NTHR;
    for (int i = gt; i < (NBATCH + DECB) * 3 * DCONV; i += NGT) { const int c = i % DCONV, r = (i / DCONV) % 3, sq = i / (3 * DCONV);
        if (sq < NBATCH) a.out[O_CP + (size_t)(sq * 3 + r) * DCONV + c] = bf2f(proj[(size_t)(sq * SEQ + SEQ - 3 + r) * NPROJ + C_XBC + c]);
        else { const int s2 = sq - NBATCH; a.out[O_CS + (size_t)(s2 * 3 + r) * DCONV + c] = bf2f(proj[(size_t)(MP + s2 * DECS + DECS - 3 + r) * NPROJ + C_XBC + c]); } }
}
__device__ __forceinline__ void p25_norm(const Args& a, int gw, int NGW, int lane) {
    bf16* ys = (bf16*)(a.ws + WS_YS); const float* ssq = (const float*)(a.ws + WS_SSQ);
    for (int m = gw; m < MT; m += NGW) {
        const float sv = (lane < 32) ? ssq[(size_t)m * NSH + lane] : 0.f;
        float gs = sv + __shfl_xor(sv, 1); gs += __shfl_xor(gs, 2);
        const float rstd = rsqrtf(gs * (1.f / 256.f) + 1e-5f);
        u32x4* r4 = (u32x4*)(ys + (size_t)m * DSSM);
#pragma unroll
        for (int j = 0; j < 4; ++j) { const int ci = j * 64 + lane, g = ci >> 5; const float sc = __shfl(rstd, 4 * g); u32x4 w = r4[ci];
            w.x = pk2(__uint_as_float(w.x << 16) * sc, __uint_as_float(w.x & 0xffff0000u) * sc); w.y = pk2(__uint_as_float(w.y << 16) * sc, __uint_as_float(w.y & 0xffff0000u) * sc);
            w.z = pk2(__uint_as_float(w.z << 16) * sc, __uint_as_float(w.z & 0xffff0000u) * sc); w.w = pk2(__uint_as_float(w.w << 16) * sc, __uint_as_float(w.w & 0xffff0000u) * sc); r4[ci] = w; }
    }
}
__device__ __forceinline__ void p5_final_norm(const Args& a, int gw, int NGW, int lane) {
    for (int m = gw; m < MT; m += NGW) {
        f32x4* xr = (f32x4*)(a.out + (size_t)m * DM) + lane; const f32x4* gr = (const f32x4*)((const float*)(a.ws + WS_PRM) + PR_FNORM) + lane;
        f32x4 v[4]; float s = 0.f;
#pragma unroll
        for (int j = 0; j < 4; ++j) { v[j] = xr[64 * j]; s += (v[j].x * v[j].x + v[j].y * v[j].y) + (v[j].z * v[j].z + v[j].w * v[j].w); }
        const float rstd = rsqrtf(wave_sum(s) * (1.f / DM) + 1e-6f);
#pragma unroll
        for (int j = 0; j < 4; ++j) { const f32x4 g = gr[64 * j]; xr[64 * j] = v[j] * rstd * g; }
    }
}
#define XB_TMO      128
#define XB_XCNT(j)  (256  + 64 * (j))
#define XB_XSUB(j)  (1280 + 64 * (j))
#define XB_XGEN(j)  (2304 + 64 * (j))
#define XB_TOP      3328
#define XB_TOPGEN   3392
#define XCD_BAR_WORDS 3456
#define XB_SPIN_CAP (1u << 18)

__device__ __forceinline__ unsigned xb_ld(unsigned* p)              { return __hip_atomic_load(p, __ATOMIC_RELAXED, __HIP_MEMORY_SCOPE_AGENT); }
__device__ __forceinline__ unsigned xb_add(unsigned* p, unsigned v) { return __hip_atomic_fetch_add(p, v, __ATOMIC_RELAXED, __HIP_MEMORY_SCOPE_AGENT); }
__device__ __forceinline__ unsigned xb_xcc_id() { return (unsigned)__builtin_amdgcn_s_getreg((3 << 11) | 20) & 0xFu; }
#define XB_SPIN(cond, bar) do { unsigned _sp = 0; while (cond) { __builtin_amdgcn_s_sleep(1); \
    if ((++_sp & 255u) == 0u) { if (xb_ld(&(bar)[XB_TMO])) break; if (_sp > XB_SPIN_CAP) { atomicAdd(&(bar)[XB_TMO], 1u); break; } } } } while (0)

struct XcdBarrier {
    unsigned* bar; unsigned x;
    volatile LAS unsigned* st;
};

__device__ __forceinline__ XcdBarrier xcd_barrier_post(unsigned* bar, volatile LAS unsigned* st) {
    XcdBarrier b; b.bar = bar; b.x = xb_xcc_id(); b.st = st;
    if (threadIdx.x == 0) (void)xb_add(&bar[XB_XCNT(b.x)], 1u);
    return b;
}
__device__ __forceinline__ void xcd_barrier_complete(unsigned* bar, unsigned x, unsigned& nloc, unsigned& nx) {
    const unsigned G = gridDim.x * gridDim.y * gridDim.z;
    unsigned sum, cnt, mine, sp = 0u;
    for (;;) {
        sum = 0u; cnt = 0u; mine = 0u;
#pragma unroll
        for (unsigned j = 0; j < 16; ++j) { const unsigned c = xb_ld(&bar[XB_XCNT(j)]); sum += c; cnt += (c > 0u) ? 1u : 0u; mine = (j == x) ? c : mine; }
        if (sum == G) break;
        __builtin_amdgcn_s_sleep(1);
        if ((++sp & 255u) == 0u) { if (xb_ld(&bar[XB_TMO])) break; if (sp > XB_SPIN_CAP) { atomicAdd(&bar[XB_TMO], 1u); break; } }
    }
    nloc = mine > 0u ? mine : 1u; nx = cnt > 0u ? cnt : 1u;
}

__device__ __forceinline__ void xcd_barrier(const XcdBarrier& b) {
    asm volatile("s_waitcnt vmcnt(0)" ::: "memory");
    __syncthreads();
    if (threadIdx.x == 0) {
        unsigned* bar = b.bar;
        __builtin_amdgcn_s_waitcnt(0);
        unsigned nloc = b.st[0], nx = b.st[1];
        if (nloc == 0u) { xcd_barrier_complete(bar, b.x, nloc, nx); b.st[0] = nloc; b.st[1] = nx; }
        const unsigned old = xb_add(&bar[XB_XSUB(b.x)], 1u);
        const unsigned gen = old / nloc;
        if (old + 1u == (gen + 1u) * nloc) {
            __builtin_amdgcn_fence(__ATOMIC_RELEASE, "agent");
            asm volatile("s_waitcnt vmcnt(0)" ::: "memory");
            const unsigned og = xb_add(&bar[XB_TOP], 1u);
            const unsigned tg = og / nx;
            if (og + 1u == (tg + 1u) * nx) xb_add(&bar[XB_TOPGEN], 1u);
            else XB_SPIN(xb_ld(&bar[XB_TOPGEN]) == tg, bar);
            __builtin_amdgcn_fence(__ATOMIC_ACQUIRE, "agent");
            xb_add(&bar[XB_XGEN(b.x)], 1u);
            asm volatile("s_waitcnt vmcnt(0)" ::: "memory");
        } else {
            XB_SPIN(xb_ld(&bar[XB_XGEN(b.x)]) == gen, bar);
            __builtin_amdgcn_fence(__ATOMIC_ACQUIRE, "agent");
            asm volatile("s_waitcnt vmcnt(0)" ::: "memory");
        }
    }
    __syncthreads();
}

#define GEMM_PHASE(EpiT, Aptr, Bptr, Mrows, Ncols, Kdim, Eobj) do { pg8::Gemm g_{(const pg8::bf16_t*)(Aptr), (const pg8::bf16_t*)(Bptr), (Mrows), (Ncols), (Kdim)}; pg8::StaticOrder S_; S_.init((Mrows), (Ncols), G, (int)blockIdx.x); \
    pg8::gemm_phase<EpiT, pg8::StaticOrder, true, true>(lds, g_, S_, (Eobj)); } while (0)

constexpr int NPHASE = 10;
__global__ void __launch_bounds__(NTHR, 2) fwd_megakernel(Args a) {
    extern __shared__ __attribute__((aligned(16))) unsigned char lds_raw[];
    LAS unsigned char* lds = (LAS unsigned char*)lds_raw;
    cg::grid_group grid = cg::this_grid();
    const int tid = threadIdx.x, lane = tid & 63, wave = __builtin_amdgcn_readfirstlane(tid >> 6);
    const int G = gridDim.x, gw = blockIdx.x * NWAVES + wave, NGW = G * NWAVES;
    unsigned char* ws = a.ws;

#define IN(k) (a.ph_lo <= (k) && (k) < a.ph_hi)
    { volatile LAS unsigned* st0 = (volatile LAS unsigned*)(lds + LDS_MISC); if (tid < 2) st0[tid] = 0u; }
    __syncthreads();
    const XcdBarrier bar = xcd_barrier_post((unsigned*)(ws + WS_BAR), (volatile LAS unsigned*)(lds + LDS_MISC));
    if (a.ph_hi > 1000) grid.sync();
#define SEAM(k) do { if (IN(k) && IN((k) + 1)) xcd_barrier(bar); } while (0)
    if (IN(0)) {
        p0_prologue(a, lds, gw, NGW, wave, lane);
        if (blockIdx.x == 0 && tid == 0) { const float** pp = (const float**)(ws + WS_ARGS); pp[0] = a.x_prompt; pp[1] = a.x_sample; pp[2] = a.cache_k; pp[3] = a.cache_v; pp[4] = a.state_conv; pp[5] = a.state_ssm; }
    }
    SEAM(0);
    if (IN(1)) { pg8::EpiInProj E{(pg8::bf16_t*)(ws + WS_PROJ), (float*)(ws + WS_DT), (const float*)(ws + WS_PRM) + PR_DTB, a.out + O_KP, a.out + O_VP, a.out + O_KS, a.out + O_VS};
      GEMM_PHASE(pg8::EpiInProj, ws + WS_HB, ws + WS_WIN, MT, NPAD, DM, E); }
    SEAM(1);
    if (IN(2)) { Args b{}; b.ws = ws; b.out = a.out; b.probe = a.probe; p2_ssd_prompt(b, lds, G, wave, lane); }
    if (IN(3)) { Args b{}; b.ws = ws; b.out = a.out; b.state_conv = ld_ptr(ws, 4); b.state_ssm = ld_ptr(ws, 5); p2_ssd_sample(b, lds, G); }
    if (IN(4)) { Args b{}; b.ws = ws; b.out = a.out; b.probe = a.probe; p2_attn_prompt(b, lds, G, wave, lane); }
    if (IN(5)) { Args b{}; b.ws = ws; b.out = a.out; b.cache_k = ld_ptr(ws, 2); b.cache_v = ld_ptr(ws, 3); p2_attn_sample(b, lds, G, wave, lane); }
    SEAM(5);
    if (IN(6)) p25_norm(a, gw, NGW, lane);
    SEAM(6);
    if (IN(7)) {
    skinny_p3(ws, lds, G, wave, lane);
    { pg8::EpiGateA E{(const pg8::bf16_t*)(ws + WS_PROJ), (float*)(ws + WS_TMP)}; GEMM_PHASE(pg8::EpiGateA, ws + WS_YA, ws + WS_WA, MP, DM, DA, E); }
    { pg8::EpiGateB E{(const pg8::bf16_t*)(ws + WS_PROJ), (const float*)(ws + WS_TMP), (pg8::bf16_t*)(ws + WS_MRG)}; GEMM_PHASE(pg8::EpiGateB, ws + WS_YS, ws + WS_WB, MP, DM, DSSM, E); }
    }
    SEAM(7);
    if (IN(8)) { skinny_p4(ws, ld_ptr(ws, 1), a.out, lds, G, wave, lane); pg8::EpiOut E{ld_ptr(ws, 0), ld_ptr(ws, 1), a.out + O_YP}; GEMM_PHASE(pg8::EpiOut, ws + WS_MRG, ws + WS_WO, MP, DM, DM, E); }
    SEAM(8);
    if (IN(9)) p5_final_norm(a, gw, NGW, lane);
#undef IN
#undef SEAM
}

extern "C" void kernel_launch(void* const* d_in, const int* in_sizes, int n_in, void* d_out, int out_size, void* d_ws, size_t ws_size, hipStream_t stream) {
    static int grid_blocks = 0;
    if (grid_blocks == 0) {
        if (n_in != 19 || (size_t)out_size != O_END || ws_size < WS_END) { fprintf(stderr, "kernel_launch: unexpected shapes: n_in %d out %d (want %zu) ws %zu (want >= %zu)\n", n_in, out_size, (size_t)O_END, ws_size, (size_t)WS_END); grid_blocks = -1; return; }
        int dev = 0, cus = 0, per_cu = 0;
        hipGetDevice(&dev); hipDeviceGetAttribute(&cus, hipDeviceAttributeMultiprocessorCount, dev);
        if (hipFuncSetAttribute((const void*)fwd_megakernel, hipFuncAttributeMaxDynamicSharedMemorySize, LDS_BYTES) != hipSuccess) { fprintf(stderr, "kernel_launch: hipFuncSetAttribute failed\n"); grid_blocks = -1; return; }
        if (hipOccupancyMaxActiveBlocksPerMultiprocessor(&per_cu, (const void*)fwd_megakernel, NTHR, LDS_BYTES) != hipSuccess || per_cu < 1) { fprintf(stderr, "kernel_launch: occupancy query failed (%d)\n", per_cu); (void)hipGetLastError(); per_cu = 1; }
        if (per_cu > 1) per_cu = 1;
        grid_blocks = cus * per_cu;
        fprintf(stderr, "kernel_launch: grid %d (cus %d)\n", grid_blocks, cus);
    }
    if (grid_blocks < 0) return;
    Args a{};
    a.x_prompt = (const float*)d_in[0]; a.x_sample = (const float*)d_in[1]; a.cache_k = (const float*)d_in[2]; a.cache_v = (const float*)d_in[3]; a.state_conv = (const float*)d_in[4]; a.state_ssm = (const float*)d_in[5];
    a.norm_g = (const float*)d_in[6]; a.w_in = (const float*)d_in[7]; a.conv_w = (const float*)d_in[8]; a.conv_b = (const float*)d_in[9]; a.dt_bias = (const float*)d_in[10]; a.a_log = (const float*)d_in[11];
    a.d_skip = (const float*)d_in[12]; a.ssm_norm = (const float*)d_in[13]; a.w_a = (const float*)d_in[14]; a.w_b = (const float*)d_in[15]; a.w_out = (const float*)d_in[16]; a.rel_bias = (const float*)d_in[17]; a.final_norm = (const float*)d_in[18];
    a.out = (float*)d_out; a.ws = (unsigned char*)d_ws;
#ifndef PROBE_LO
    const int ranges[1][2] = {{0, NPHASE}}; const int nr = 1;
#else
    const int ranges[2][2] = {{0, NPHASE}, {PROBE_LO, PROBE_HI}}; const int nr = 2;
#endif
    for (int r = 0; r < nr; ++r) {
        a.ph_lo = ranges[r][0]; a.ph_hi = ranges[r][1];
#ifdef PROBE_FLAGS
        a.probe = r ? PROBE_FLAGS : 0;
#endif
        (void)hipMemsetAsync((char*)d_ws + WS_BAR, 0, BAR_ZERO_BYTES, stream);
        void* args[] = {&a};
        hipError_t e = hipLaunchCooperativeKernel((const void*)fwd_megakernel, dim3(grid_blocks), dim3(NTHR), args, LDS_BYTES, stream);
        if (e != hipSuccess) fprintf(stderr, "kernel_launch: cooperative launch failed: %s (grid %d)\n", hipGetErrorString(e), grid_blocks);
    }
}
```

```cpp
#include <hip/hip_runtime.h>
#include <hip/hip_cooperative_groups.h>
#include <cstdio>
#include <cstdint>
namespace cg = cooperative_groups;
namespace pg8 {
#define PG8_LAS __attribute__((address_space(3)))
typedef unsigned short bf16_t;
typedef short bf16x8 __attribute__((ext_vector_type(8)));
typedef float f32x4 __attribute__((ext_vector_type(4)));
typedef unsigned u32x4 __attribute__((ext_vector_type(4)));
constexpr int BM = 256, BK = 64, HALF = 128, HTB = HALF * BK * 2  , STAGE_BYTES = 8 * HTB, NXCD = 8, WGM = 8;

__host__ __device__ __forceinline__ int lds_byte(int r, int c) { const int st = (r >> 4) * 2 + (c >> 5), rr = r & 15, cc = c & 31, ob = rr * 64 + cc * 2; return st * 1024 + (ob ^ (((ob >> 9) & 1) << 5)); }
__host__ __device__ __forceinline__ void stage_rc(int b, int& R, int& C) { const int st = b / 1024, sb = b % 1024, swz = sb ^ (((sb >> 9) & 1) << 5); R = (st >> 1) * 16 + swz / 64; C = (st & 1) * 32 + (swz % 64) / 2; }
__host__ __device__ __forceinline__ int perm32(int rho) { const int n = rho >> 4, i = rho & 15; return 8 * (i >> 2) + 4 * n + (i & 3); }

struct Unit { int pm, pn, which; };
struct Gemm { const bf16_t* A; const bf16_t* Bt; int M, N, K; const bf16_t* A2 = nullptr; const bf16_t* Bt2 = nullptr; int K0 = 0, K1 = 0; };

struct StaticOrder {
    int nM, nN, nwg, G, c;
    __host__ __device__ void init(int M, int N, int G_, int c_) { nM = M / BM; nN = N / BM; nwg = nM * nN; G = G_; c = c_; }
    __host__ __device__ bool next(int i, Unit& u) const {
        const long L = (long)i * G + c; if (L >= nwg) return false;
        int wgid = (int)L; { const int q = nwg / NXCD, r = nwg % NXCD, xcd = wgid % NXCD, off = wgid / NXCD; wgid = (xcd < r ? xcd * (q + 1) : r * (q + 1) + (xcd - r) * q) + off; }
        const int nig = WGM * nN, gid = wgid / nig, fm = gid * WGM, gsz = (nM - fm) < WGM ? (nM - fm) : WGM;
        u.pm = fm + ((wgid % nig) % gsz); u.pn = (wgid % nig) / gsz; u.which = 0; return true;
    }
    __device__ __forceinline__ void a_ready(const Unit&) const {}
    __device__ __forceinline__ void done(const Unit&) const {}
};
struct ChainOrder : StaticOrder {
    __host__ __device__ bool next(int i, Unit& u) const { if (!StaticOrder::next(i >> 1, u)) return false; u.which = i & 1; return true; }
};

constexpr int PROJ_PITCH = 11328;
__device__ __forceinline__ unsigned cvt_pk_bf16(float lo, float hi) { unsigned r; asm volatile("v_cvt_pk_bf16_f32 %0, %1, %2" : "=v"(r) : "v"(lo), "v"(hi)); return r; }
__device__ __forceinline__ float e_bf2f(unsigned short b) { return __uint_as_float(((unsigned)b) << 16); }
__device__ __forceinline__ float e_sigmoid(float x) { return 1.f / (1.f + __expf(-x)); }
__device__ __forceinline__ float e_softplus(float x) { return fmaxf(x, 0.f) + log1pf(__expf(-fabsf(x))); }

struct EpiInProj {
    static constexpr bool PERM = true, AFTER_DRAIN = false, ROWSCALE = false;
    bf16_t* proj; float* dt; const float* dt_bias; float* kp; float* vp; float* ks; float* vs; int skip;
    __device__ __forceinline__ void operator()(const f32x4 (&acc)[2][2][4][2], const Unit& u, int wr, int wc, int fr, int fq) const {
        if (skip) return;
        const int row0 = u.pm * BM + wr * 64 + fr;
        if (u.pn < 44) {
            const int col0 = u.pn * BM + wc * 32 + 8 * fq;
            const bool isk = (u.pn >= 3 && u.pn < 6), isv = (u.pn >= 6 && u.pn < 9);
            const int secc = u.pn < 12 ? (u.pn / 3) * 768 : (u.pn < 20 ? 3072 : (u.pn < 36 ? 5120 : (u.pn < 40 ? 9216 : 10240))), secw = u.pn < 12 ? 768 : (u.pn < 20 ? 2048 : (u.pn < 36 ? 4096 : 1024)); const size_t secofs = (size_t)16640 * secc;
#pragma unroll
            for (int ai = 0; ai < 2; ++ai)
#pragma unroll
                for (int m = 0; m < 4; ++m) { const int row = row0 + ai * HALF + m * 16; bf16_t* rowp = proj + secofs + (size_t)row * secw + (col0 - secc);
#pragma unroll
                    for (int bj = 0; bj < 2; ++bj) { const f32x4 v0 = acc[ai][bj][m][0], v1 = acc[ai][bj][m][1];
                        u32x4 w; w.x = cvt_pk_bf16(v0[0], v0[1]); w.y = cvt_pk_bf16(v0[2], v0[3]); w.z = cvt_pk_bf16(v1[0], v1[1]); w.w = cvt_pk_bf16(v1[2], v1[3]);
                        *(u32x4*)(rowp + bj * HALF) = w;
                        if (isk || isv) { const int c = col0 + bj * HALF - (isk ? 768 : 1536);
                            float* dst = (u.pm < 64) ? ((isk ? kp : vp) + (size_t)row * 768 + c) : ((isk ? ks : vs) + (size_t)(row - 16384) * 768 + c);
                            *(f32x4*)dst = v0; *(f32x4*)(dst + 4) = v1; } } }
        } else if (wc == 0) {
            const f32x4 b0 = *(const f32x4*)(dt_bias + 8 * fq), b1 = *(const f32x4*)(dt_bias + 8 * fq + 4);
#pragma unroll
            for (int ai = 0; ai < 2; ++ai)
#pragma unroll
                for (int m = 0; m < 4; ++m) { const int row = row0 + ai * HALF + m * 16; const f32x4 v0 = acc[ai][0][m][0] + b0, v1 = acc[ai][0][m][1] + b1;
                    f32x4 o0, o1;
#pragma unroll
                    for (int j = 0; j < 4; ++j) { o0[j] = e_softplus(v0[j]); o1[j] = e_softplus(v1[j]); }
                    float* dst = dt + (size_t)row * 32 + 8 * fq; *(f32x4*)dst = o0; *(f32x4*)(dst + 4) = o1; }
        }
    }
};
struct EpiGateA {
    static constexpr bool PERM = true, AFTER_DRAIN = false, ROWSCALE = false;
    const bf16_t* proj; float* tmp;
    __device__ __forceinline__ void operator()(const f32x4 (&acc)[2][2][4][2], const Unit& u, int wr, int wc, int fr, int fq) const {
        const int row0 = u.pm * BM + wr * 64 + fr, col0 = u.pn * BM + wc * 32 + 8 * fq;
#pragma unroll
        for (int ai = 0; ai < 2; ++ai)
#pragma unroll
            for (int m = 0; m < 4; ++m) { const int row = row0 + ai * HALF + m * 16;
#pragma unroll
                for (int bj = 0; bj < 2; ++bj) { const int c = col0 + bj * HALF; const u32x4 g = *(const u32x4*)(proj + (size_t)16640 * 9216 + (size_t)row * 1024 + c);
                    const f32x4 v0 = acc[ai][bj][m][0], v1 = acc[ai][bj][m][1]; f32x4 o0, o1;
                    o0[0] = e_sigmoid(__uint_as_float(g.x << 16)) * v0[0]; o0[1] = e_sigmoid(__uint_as_float(g.x & 0xffff0000u)) * v0[1];
                    o0[2] = e_sigmoid(__uint_as_float(g.y << 16)) * v0[2]; o0[3] = e_sigmoid(__uint_as_float(g.y & 0xffff0000u)) * v0[3];
                    o1[0] = e_sigmoid(__uint_as_float(g.z << 16)) * v1[0]; o1[1] = e_sigmoid(__uint_as_float(g.z & 0xffff0000u)) * v1[1];
                    o1[2] = e_sigmoid(__uint_as_float(g.w << 16)) * v1[2]; o1[3] = e_sigmoid(__uint_as_float(g.w & 0xffff0000u)) * v1[3];
                    float* dst = tmp + (size_t)row * 1024 + c; *(f32x4*)dst = o0; *(f32x4*)(dst + 4) = o1; } }
    }
};
struct EpiGateB {
    static constexpr bool PERM = true, AFTER_DRAIN = false, ROWSCALE = false;
    const bf16_t* proj; const float* tmp; bf16_t* mrg;
    __device__ __forceinline__ void operator()(const f32x4 (&acc)[2][2][4][2], const Unit& u, int wr, int wc, int fr, int fq) const {
        const int row0 = u.pm * BM + wr * 64 + fr, col0 = u.pn * BM + wc * 32 + 8 * fq;
#pragma unroll
        for (int ai = 0; ai < 2; ++ai)
#pragma unroll
            for (int m = 0; m < 4; ++m) { const int row = row0 + ai * HALF + m * 16;
#pragma unroll
                for (int bj = 0; bj < 2; ++bj) { const int c = col0 + bj * HALF; const u32x4 g = *(const u32x4*)(proj + (size_t)16640 * 10240 + (size_t)row * 1024 + c);
                    const float* src = tmp + (size_t)row * 1024 + c; const f32x4 t0 = *(const f32x4*)src, t1 = *(const f32x4*)(src + 4);
                    const f32x4 v0 = acc[ai][bj][m][0], v1 = acc[ai][bj][m][1]; f32x4 o0, o1;
                    o0[0] = t0[0] + e_sigmoid(__uint_as_float(g.x << 16)) * v0[0]; o0[1] = t0[1] + e_sigmoid(__uint_as_float(g.x & 0xffff0000u)) * v0[1];
                    o0[2] = t0[2] + e_sigmoid(__uint_as_float(g.y << 16)) * v0[2]; o0[3] = t0[3] + e_sigmoid(__uint_as_float(g.y & 0xffff0000u)) * v0[3];
                    o1[0] = t1[0] + e_sigmoid(__uint_as_float(g.z << 16)) * v1[0]; o1[1] = t1[1] + e_sigmoid(__uint_as_float(g.z & 0xffff0000u)) * v1[1];
                    o1[2] = t1[2] + e_sigmoid(__uint_as_float(g.w << 16)) * v1[2]; o1[3] = t1[3] + e_sigmoid(__uint_as_float(g.w & 0xffff0000u)) * v1[3];
                    u32x4 w; w.x = cvt_pk_bf16(o0[0], o0[1]); w.y = cvt_pk_bf16(o0[2], o0[3]); w.z = cvt_pk_bf16(o1[0], o1[1]); w.w = cvt_pk_bf16(o1[2], o1[3]);
                    *(u32x4*)(mrg + (size_t)row * 1024 + c) = w; } }
    }
};
struct EpiGateAB {
    static constexpr bool PERM = true, AFTER_DRAIN = false, ROWSCALE = true;
    EpiGateA ea; EpiGateB eb;
    __device__ __forceinline__ void rowscale(f32x4 (&acc)[2][2][4][2], PG8_LAS unsigned char* lds, int gidx, int wr, int fr) const {
        const PG8_LAS float* RS = (const PG8_LAS float*)(lds + 131072);
#pragma unroll
        for (int ai = 0; ai < 2; ++ai)
#pragma unroll
            for (int m = 0; m < 4; ++m) { const float s = RS[(ai * HALF + wr * 64 + m * 16 + fr) * 8 + gidx];
#pragma unroll
                for (int bj = 0; bj < 2; ++bj)
#pragma unroll
                    for (int n = 0; n < 2; ++n) acc[ai][bj][m][n] = acc[ai][bj][m][n] * s; }
    }
    __device__ __forceinline__ void operator()(const f32x4 (&acc)[2][2][4][2], const Unit& u, int wr, int wc, int fr, int fq) const { if (u.which == 0) ea(acc, u, wr, wc, fr, fq); else eb(acc, u, wr, wc, fr, fq); }
};
struct EpiOut {
    static constexpr bool PERM = false, AFTER_DRAIN = false, ROWSCALE = false;
    const float* xp; const float* xs; float* out;
    __device__ __forceinline__ void operator()(const f32x4 (&acc)[2][2][4][2], const Unit& u, int wr, int wc, int fr, int fq) const {
        const int row0 = u.pm * BM + wr * 64 + fr, col0 = u.pn * BM + wc * 32 + 4 * fq;
#pragma unroll
        for (int ai = 0; ai < 2; ++ai)
#pragma unroll
            for (int m = 0; m < 4; ++m) { const int row = row0 + ai * HALF + m * 16;
                const float* xr = (u.pm < 64) ? xp + (size_t)row * 1024 : xs + (size_t)(row - 16384) * 1024; float* orow = out + (size_t)row * 1024;
#pragma unroll
                for (int bj = 0; bj < 2; ++bj)
#pragma unroll
                    for (int n = 0; n < 2; ++n) { const int c = col0 + bj * HALF + n * 16; *(f32x4*)(orow + c) = *(const f32x4*)(xr + c) + acc[ai][bj][m][n]; } }
    }
};

template <class Epi, class Sched, bool ALIGN_EPI = false, bool SP2 = false>
__device__ __forceinline__ void gemm_phase(PG8_LAS unsigned char* lds, const Gemm g, const Sched& S, const Epi& E) {
    int tid_ = threadIdx.x; asm volatile("" : "+v"(tid_));
    const int tid = tid_, wid = __builtin_amdgcn_readfirstlane(tid >> 6), lane = tid & 63, wr = wid >> 2, wc = wid & 3, fr = lane & 15, fq = lane >> 4;
    const int K = g.K;
    const int nt0 = (g.K0 ? g.K0 : K) / BK, nt1 = g.K1 / BK;
    unsigned voffA[2], voffB[2];
#pragma unroll
    for (int i = 0; i < 2; ++i) { int R, C; stage_rc(tid * 16 + i * 8192, R, C); const int Rb = Epi::PERM ? ((R & ~31) + perm32(R & 31)) : R;
        voffA[i] = (unsigned)(R * K + C) * 2u; voffB[i] = (unsigned)(Rb * K + C) * 2u; }
    const size_t kstep = (size_t)(BK * 2);
    const size_t hstep = (size_t)HALF * K * 2;
    const size_t tstep = 2 * hstep;
    const unsigned ldsw = (unsigned)wid * 1024u;
    const int aoff = lds_byte(wr * 64 + fr, fq * 8), boff = lds_byte(wc * 32 + fr, fq * 8);
#define PG8_SA(b, h) (((b) * 2 + (h)) * HTB)
#define PG8_SB(b, h) ((4 + (b) * 2 + (h)) * HTB)
#define PG8_STAGE(bufoff, gbase, voff) do { _Pragma("unroll") for (int _i = 0; _i < 2; ++_i) \
        __builtin_amdgcn_global_load_lds((const unsigned*)((const char*)(gbase) + (voff)[_i]), (PG8_LAS unsigned*)(lds + (bufoff) + ldsw + _i * 8192), 16, 0, 0); } while (0)
#define PG8_LDA(dst, b, h) do { _Pragma("unroll") for (int m = 0; m < 4; ++m) _Pragma("unroll") for (int k = 0; k < 2; ++k) dst[m][k] = *(const PG8_LAS bf16x8*)(lds + PG8_SA(b, h) + aoff + m * 2048 + k * 1024); } while (0)
#define PG8_LDB(dst, b, h) do { _Pragma("unroll") for (int n = 0; n < 2; ++n) _Pragma("unroll") for (int k = 0; k < 2; ++k) dst[n][k] = *(const PG8_LAS bf16x8*)(lds + PG8_SB(b, h) + boff + n * 2048 + k * 1024); } while (0)
#define PG8_MMA(ai, bj, At, Bt) do { __builtin_amdgcn_s_setprio(1); _Pragma("unroll") for (int m = 0; m < 4; ++m) _Pragma("unroll") for (int n = 0; n < 2; ++n) _Pragma("unroll") for (int k = 0; k < 2; ++k) \
        acc[ai][bj][m][n] = __builtin_amdgcn_mfma_f32_16x16x32_bf16(Bt[n][k], At[m][k], acc[ai][bj][m][n], 0, 0, 0); __builtin_amdgcn_s_setprio(0); } while (0)
#define PG8_WAIT_V(n) asm volatile("s_waitcnt vmcnt(" #n ")" ::: "memory")
#define PG8_WAIT_L(n) asm volatile("s_waitcnt lgkmcnt(" #n ")" ::: "memory")
#define PG8_BAR __builtin_amdgcn_s_barrier()
#define PG8_SCHED __builtin_amdgcn_sched_barrier(0)
    Unit cur, nxt; int ui = 0;
    if (!S.next(0, cur)) return;
    f32x4 acc[2][2][4][2];
#pragma unroll
    for (int a = 0; a < 2; ++a)
#pragma unroll
        for (int b = 0; b < 2; ++b)
#pragma unroll
            for (int m = 0; m < 4; ++m)
#pragma unroll
                for (int n = 0; n < 2; ++n) acc[a][b][m][n] = (f32x4){0.f, 0.f, 0.f, 0.f};
    bf16x8 At[4][2], B0[2][2], B1[2][2];
    const char* cA = (const char*)(cur.which ? g.A2 : g.A) + (size_t)cur.pm * tstep; const char* cB = (const char*)(cur.which ? g.Bt2 : g.Bt) + (size_t)cur.pn * tstep;
    S.a_ready(cur);
    if constexpr (SP2) {
        PG8_STAGE(PG8_SB(0, 0), cB, voffB); PG8_STAGE(PG8_SB(0, 1), cB + hstep, voffB); PG8_STAGE(PG8_SA(0, 0), cA, voffA); PG8_STAGE(PG8_SA(0, 1), cA + hstep, voffA);
        if (wr == 1) PG8_BAR;
        PG8_WAIT_V(2); PG8_BAR;
        PG8_STAGE(PG8_SB(1, 0), cB + kstep, voffB); PG8_STAGE(PG8_SA(1, 0), cA + kstep, voffA); PG8_STAGE(PG8_SB(1, 1), cB + hstep + kstep, voffB);
        PG8_WAIT_V(6); PG8_BAR;
    } else {
        PG8_STAGE(PG8_SB(0, 0), cB, voffB); PG8_STAGE(PG8_SA(0, 0), cA, voffA); PG8_STAGE(PG8_SB(0, 1), cB + hstep, voffB); PG8_STAGE(PG8_SA(0, 1), cA + hstep, voffA);
        if (wr == 1) PG8_BAR;
        PG8_WAIT_V(4); PG8_BAR;
        PG8_STAGE(PG8_SB(1, 0), cB + kstep, voffB); PG8_STAGE(PG8_SA(1, 0), cA + kstep, voffA); PG8_STAGE(PG8_SB(1, 1), cB + hstep + kstep, voffB);
        PG8_WAIT_V(6); PG8_BAR;
    }
    for (;;) {
        const bool has_next = S.next(ui + 1, nxt);
        const char* nA = has_next ? (const char*)(nxt.which ? g.A2 : g.A) + (size_t)nxt.pm * tstep : cA; const char* nB = has_next ? (const char*)(nxt.which ? g.Bt2 : g.Bt) + (size_t)nxt.pn * tstep : cB;
        const int nt = cur.which ? nt1 : nt0;
        for (int t = 0; t < nt; t += 2) {
            const bool last = (t == nt - 2);
            const char* a1 = cA + (size_t)(t + 1) * kstep;
            const char* a2 = last ? nA : cA + (size_t)(t + 2) * kstep; const char* b2 = last ? nB : cB + (size_t)(t + 2) * kstep;
            const char* a3 = a2 + kstep; const char* b3 = b2 + kstep;
            if (last && has_next) S.a_ready(nxt);
            if constexpr (SP2) {
            PG8_LDB(B0, 0, 0); PG8_LDB(B1, 0, 1); PG8_SCHED; PG8_LDA(At, 0, 0); PG8_STAGE(PG8_SA(1, 1), a1 + hstep, voffA);
            PG8_WAIT_V(8); PG8_WAIT_L(0); PG8_BAR; PG8_MMA(0, 0, At, B0); PG8_MMA(0, 1, At, B1); PG8_BAR; PG8_SCHED;
            PG8_LDA(At, 0, 1); PG8_STAGE(PG8_SB(0, 0), b2, voffB); PG8_STAGE(PG8_SB(0, 1), b2 + hstep, voffB); PG8_STAGE(PG8_SA(0, 0), a2, voffA);
            PG8_WAIT_V(8); PG8_WAIT_L(0); PG8_BAR; PG8_MMA(1, 0, At, B0); PG8_MMA(1, 1, At, B1); PG8_BAR; PG8_SCHED;
            PG8_LDB(B0, 1, 0); PG8_LDB(B1, 1, 1); PG8_SCHED; PG8_LDA(At, 1, 0); PG8_STAGE(PG8_SA(0, 1), a2 + hstep, voffA);
            PG8_WAIT_V(8); PG8_WAIT_L(0); PG8_BAR; PG8_MMA(0, 0, At, B0); PG8_MMA(0, 1, At, B1); PG8_BAR; PG8_SCHED;
            PG8_LDA(At, 1, 1); PG8_STAGE(PG8_SB(1, 0), b3, voffB); PG8_STAGE(PG8_SB(1, 1), b3 + hstep, voffB); PG8_STAGE(PG8_SA(1, 0), a3, voffA);
            PG8_WAIT_V(8); PG8_WAIT_L(0); PG8_BAR; PG8_MMA(1, 0, At, B0); PG8_MMA(1, 1, At, B1); PG8_BAR; PG8_SCHED;
            } else {
            PG8_LDB(B0, 0, 0); PG8_SCHED; PG8_LDA(At, 0, 0); PG8_STAGE(PG8_SA(1, 1), a1 + hstep, voffA);
            PG8_WAIT_L(8); PG8_BAR; PG8_WAIT_L(0); PG8_MMA(0, 0, At, B0); PG8_BAR; PG8_SCHED;
            PG8_LDB(B1, 0, 1); PG8_STAGE(PG8_SB(0, 0), b2, voffB);
            PG8_BAR; PG8_WAIT_L(0); PG8_MMA(0, 1, At, B1); PG8_BAR;
            PG8_LDA(At, 0, 1); PG8_STAGE(PG8_SA(0, 0), a2, voffA);
            PG8_BAR; PG8_WAIT_L(0); PG8_MMA(1, 0, At, B0); PG8_BAR; PG8_SCHED;
            PG8_STAGE(PG8_SB(0, 1), b2 + hstep, voffB);
            PG8_WAIT_V(6); PG8_BAR; PG8_MMA(1, 1, At, B1); PG8_BAR;
            PG8_LDB(B0, 1, 0); PG8_SCHED; PG8_LDA(At, 1, 0); PG8_STAGE(PG8_SA(0, 1), a2 + hstep, voffA);
            PG8_WAIT_L(8); PG8_BAR; PG8_WAIT_L(0); PG8_MMA(0, 0, At, B0); PG8_BAR; PG8_SCHED;
            PG8_LDB(B1, 1, 1); PG8_STAGE(PG8_SB(1, 0), b3, voffB);
            PG8_BAR; PG8_WAIT_L(0); PG8_MMA(0, 1, At, B1); PG8_BAR;
            PG8_LDA(At, 1, 1); PG8_STAGE(PG8_SA(1, 0), a3, voffA);
            PG8_BAR; PG8_WAIT_L(0); PG8_MMA(1, 0, At, B0); PG8_BAR; PG8_SCHED;
            PG8_STAGE(PG8_SB(1, 1), b3 + hstep, voffB);
            PG8_WAIT_V(6); PG8_BAR; PG8_MMA(1, 1, At, B1); PG8_BAR;
            }
            if constexpr (Epi::ROWSCALE) { if (cur.which == 1 && ((t + 2) & 3) == 0) E.rowscale(acc, lds, ((t + 2) >> 2) - 1, wr, fr); }
        }
        if constexpr (ALIGN_EPI) { if (wr == 0) PG8_BAR; }
        if constexpr (!Epi::AFTER_DRAIN) { E(acc, cur, wr, wc, fr, fq); S.done(cur); }
        if (!has_next) break;
#pragma unroll
        for (int a = 0; a < 2; ++a)
#pragma unroll
            for (int b = 0; b < 2; ++b)
#pragma unroll
                for (int m = 0; m < 4; ++m)
#pragma unroll
                    for (int n = 0; n < 2; ++n) acc[a][b][m][n] = (f32x4){0.f, 0.f, 0.f, 0.f};
        cur = nxt; cA = nA; cB = nB; ++ui;
        if constexpr (ALIGN_EPI) { if (wr == 1) PG8_BAR; }
    }
    PG8_WAIT_V(0);
    if constexpr (!ALIGN_EPI) { if (wr == 0) PG8_BAR; }
    PG8_BAR;
    if constexpr (Epi::AFTER_DRAIN) { E.fused(acc, cur, wr, wc, fr, fq, lds, wid, lane); S.done(cur); }
#undef PG8_SA
#undef PG8_SB
#undef PG8_STAGE
#undef PG8_LDA
#undef PG8_LDB
#undef PG8_MMA
#undef PG8_WAIT_V
#undef PG8_WAIT_L
#undef PG8_BAR
#undef PG8_SCHED
}
}

#define LAS __attribute__((address_space(3)))
typedef unsigned short bf16;
typedef float f32x4 __attribute__((ext_vector_type(4)));
typedef unsigned u32x4 __attribute__((ext_vector_type(4)));
typedef unsigned u32x2 __attribute__((ext_vector_type(2)));
constexpr int NWAVES = 8, NTHR = 512;
constexpr int DM = 1024, NBATCH = 8, SEQ = 2048, MP = NBATCH * SEQ, DECB = 32, DECS = 8, MS = DECB * DECS, MT = MP + MS;
constexpr int NH = 12, HD = 64, DA = NH * HD, YA_PITCH = 2048;
constexpr int DSSM = 2048, NSH = 32, SHD = 64, NGRP = 8, DST = 128, DCONV = 4096;
constexpr int PAST = 16384, KVB = 2048;
constexpr int NIN = 11296, NPROJ = pg8::PROJ_PITCH, NPAD = 11520;
constexpr int C_Q = 0, C_K = 768, C_V = 1536, C_G = 2304, C_Z = 3072, C_XBC = 5120, C_GA = 9216, C_GB = 10240;
constexpr int W_Q = 768, W_K = 768, W_V = 768, W_G = 768, W_Z = 2048, W_XBC = 4096, W_GA = 1024, W_GB = 1024;
constexpr size_t SO_Q = (size_t)MT * C_Q, SO_K = (size_t)MT * C_K, SO_V = (size_t)MT * C_V, SO_G = (size_t)MT * C_G, SO_Z = (size_t)MT * C_Z, SO_XBC = (size_t)MT * C_XBC, SO_GA = (size_t)MT * C_GA, SO_GB = (size_t)MT * C_GB;
constexpr size_t MiB = 1u << 20;
constexpr size_t WS_ARGS = 1 * MiB - 4096, WS_PRM = 1 * MiB, WS_WIN = 2 * MiB, WS_WA = 26 * MiB, WS_WB = 28 * MiB, WS_WO = 32 * MiB, WS_HB = 36 * MiB, WS_DT = 70 * MiB, WS_PROJ = 74 * MiB,
                 WS_YS = 462 * MiB, WS_SSQ = 528 * MiB, WS_TMP = 534 * MiB, WS_MRG = 600 * MiB, WS_YA = 634 * MiB, WS_WA2 = 700 * MiB, WS_END = 704 * MiB;
constexpr size_t O_YP = 0, O_YS = O_YP + (size_t)MP * DM, O_KP = O_YS + (size_t)MS * DM, O_VP = O_KP + (size_t)MP * DA, O_CP = O_VP + (size_t)MP * DA,
                 O_SP = O_CP + (size_t)NBATCH * 3 * DCONV, O_KS = O_SP + (size_t)NBATCH * NSH * SHD * DST, O_VS = O_KS + (size_t)MS * DA, O_CS = O_VS + (size_t)MS * DA,
                 O_SS = O_CS + (size_t)DECB * 3 * DCONV, O_END = O_SS + (size_t)DECB * NSH * SHD * DST;
constexpr int LDS_BYTES = 148480, LDS_MISC = 147456;
constexpr size_t WS_BAR = 0, BAR_ZERO_BYTES = 16384;
constexpr int PR_CONVW = 0, PR_CONVB = 16384, PR_DTB = 20480, PR_ALOG = 20512, PR_DSKIP = 20544, PR_RELB = 20576, PR_FNORM = 20992, PR_END = 22016;

struct Args {
    const float *x_prompt, *x_sample, *cache_k, *cache_v, *state_conv, *state_ssm, *norm_g, *w_in, *conv_w, *conv_b, *dt_bias, *a_log, *d_skip, *ssm_norm, *w_a, *w_b, *w_out, *rel_bias, *final_norm;
    float* out; unsigned char* ws;
    int ph_lo, ph_hi, probe, pad_;
};

__device__ __forceinline__ float bf2f(bf16 b) { return __uint_as_float(((unsigned)b) << 16); }
__device__ __forceinline__ unsigned f2bf(float f) { unsigned u = __float_as_uint(f); return (u + 0x7fffu + ((u >> 16) & 1u)) >> 16; }
typedef float f32x2_t __attribute__((ext_vector_type(2))); typedef __bf16 bf16x2_t __attribute__((ext_vector_type(2)));
__device__ __forceinline__ unsigned pk2(float lo, float hi) { const f32x2_t v = {lo, hi}; return __builtin_bit_cast(unsigned, __builtin_convertvector(v, bf16x2_t)); }
__device__ __forceinline__ float sigmoidf_(float x) { return 1.f / (1.f + __expf(-x)); }
__device__ __forceinline__ float siluf_(float x) { return x / (1.f + __expf(-x)); }
__device__ __forceinline__ float softplusf_(float x) { return fmaxf(x, 0.f) + log1pf(__expf(-fabsf(x))); }
__device__ __forceinline__ float wave_sum(float v) {
#pragma unroll
    for (int o = 1; o < 64; o <<= 1) v += __shfl_xor(v, o);
    return v;
}
__device__ __forceinline__ float wave_max(float v) {
#pragma unroll
    for (int o = 1; o < 64; o <<= 1) v = fmaxf(v, __shfl_xor(v, o));
    return v;
}
__device__ __forceinline__ int t5_bucket(int off) {
    if (off < 16) return off;
    return 16 + (off >= 22) + (off >= 30) + (off >= 40) + (off >= 54) + (off >= 73) + (off >= 99) + (off >= 134) + (off >= 182) + (off >= 246) + (off >= 332) + (off >= 450) + (off >= 609) + (off >= 825) + (off >= 1117) + (off >= 1513);
}
__device__ __forceinline__ const float* ld_ptr(const unsigned char* ws, int idx) { const unsigned long long v = ((const unsigned long long*)(ws + WS_ARGS))[idx];
    const unsigned lo = __builtin_amdgcn_readfirstlane((unsigned)v), hi = __builtin_amdgcn_readfirstlane((unsigned)(v >> 32)); return (const float*)(((unsigned long long)hi << 32) | lo); }
#define LDS_WAIT() asm volatile("s_waitcnt lgkmcnt(0)" ::: "memory")
typedef short bf16x8 __attribute__((ext_vector_type(8)));
typedef short s16x4 __attribute__((ext_vector_type(4)));
constexpr int AT_ST = 0, AT_STROW = 272, AT_ML = 69632, AT_BIAS = 71680, AT_V = 73728, AT_VROW = 144, AT_VBYTES = 32 * AT_VROW, AT_VWAVE = 2 * AT_VBYTES;
constexpr float LOG2E = 1.4426950408889634f;
__device__ __forceinline__ s16x4 lds_tr16(LAS const unsigned char* p) { return __builtin_bit_cast(s16x4, __builtin_amdgcn_ds_read_tr16_b64_v4i16((LAS s16x4*)p)); }

constexpr bool AT_PRE = false;
struct AttnQK { bf16x8 q[2]; bf16x8 k[9][2]; };
__device__ __forceinline__ void attn_load_qk(const bf16* base, int P0, int stride, int lane, int probe, AttnQK& qk) {
    const int c = lane & 15, rq = lane >> 4;
    { const bf16* qp = base + (size_t)(P0 + stride * c) * W_Q + SO_Q + rq * 8; qk.q[0] = *(const bf16x8*)qp; qk.q[1] = *(const bf16x8*)(qp + 32); }
#pragma unroll
    for (int kt = 0; kt < 9; ++kt) {
        int kpos = P0 + stride * (16 * kt + c - 128); kpos = kpos < 0 ? 0 : kpos; if (probe & 512) kpos = 0;
        const bf16* kp = base + (size_t)kpos * W_K + SO_K + rq * 8; qk.k[kt][0] = *(const bf16x8*)kp; qk.k[kt][1] = *(const bf16x8*)(kp + 32); }
}
template <bool SAMP, int PMODE = 0  > __device__ __forceinline__ void attn_item(const bf16* base, const float* ck, const float* cv, int P0, int stride, const LAS float* biasr  , LAS unsigned char* vst, int lane, float& m_out, float& l_out, f32x4 (&o)[4], int probe, AttnQK& pre, bool has_next, int P0n, int striden) {
    constexpr bool PRE = PMODE != 0;
    const int c = lane & 15, rq = lane >> 4;
    bf16x8 qf[2];
    if (PRE) { qf[0] = pre.q[0]; qf[1] = pre.q[1]; } else
    { int qrow = P0 + stride * c; if (SAMP) { qrow -= KVB; qrow = qrow > DECS - 1 ? DECS - 1 : qrow; }
      const bf16* qp = base + (size_t)qrow * W_Q + SO_Q + rq * 8; qf[0] = *(const bf16x8*)qp; qf[1] = *(const bf16x8*)(qp + 32); }
    constexpr int VD = SAMP ? 1 : (PMODE == 1 ? 2 : 5);
    u32x4 vh[VD][4]; f32x4 vq[SAMP ? 2 : 1][SAMP ? 8 : 1];
#define AT_STEP_VALID0(ks) (((P0 + stride * (16 * ((2 * (ks) + 1 < 9) ? 2 * (ks) + 1 : 8) + 15 - 128)) >= 0) && !(probe & 32))
    if (!SAMP) {
#pragma unroll
        for (int ks = 0; ks < VD; ++ks) {
#pragma unroll
            for (int i = 0; i < 4; ++i) { int kpos = P0 + stride * (32 * ks + 8 * i + (lane >> 3) - 128); kpos = kpos < 0 ? 0 : (kpos > SEQ - 1 ? SEQ - 1 : kpos); if (probe & 512) kpos = 0;
                vh[ks][i] = *(const u32x4*)(base + (size_t)kpos * W_V + SO_V + (lane & 7) * 8); } }
    } else {
#pragma unroll
        for (int i = 0; i < 4; ++i) { int kpos = P0 + stride * (8 * i + (lane >> 3)) - KVB; kpos = kpos < 0 ? 0 : (kpos > DECS - 1 ? DECS - 1 : kpos);
            vh[0][i] = *(const u32x4*)(base + (size_t)kpos * W_V + SO_V + (lane & 7) * 8); }
    }
#undef AT_STEP_VALID0
    const int kmin = (128 - P0 / stride) > 0 ? (128 - P0 / stride) : 0, lo = c > kmin ? c : kmin, hi = c + 128;
    const LAS float* bp = biasr + (4 * rq - c);
    f32x4 sc[9];
#pragma unroll
    for (int kt = 0; kt < 9; ++kt) {
        const bool tile_valid = ((P0 + stride * (16 * kt + 15 - 128)) >= 0) && !(probe & 16);
        int kpos = P0 + stride * (16 * kt + c - 128); kpos = kpos < 0 ? 0 : kpos;
        bf16x8 k0, k1;
        {
            if (SAMP && kt < 8) { const float* kp = ck + (size_t)kpos * (NH * HD) + rq * 8;
                const f32x4 a0 = *(const f32x4*)kp, a1 = *(const f32x4*)(kp + 4), b0 = *(const f32x4*)(kp + 32), b1 = *(const f32x4*)(kp + 36);
                u32x4 w0, w1; w0.x = pk2(a0[0], a0[1]); w0.y = pk2(a0[2], a0[3]); w0.z = pk2(a1[0], a1[1]); w0.w = pk2(a1[2], a1[3]); w1.x = pk2(b0[0], b0[1]); w1.y = pk2(b0[2], b0[3]); w1.z = pk2(b1[0], b1[1]); w1.w = pk2(b1[2], b1[3]);
                k0 = __builtin_bit_cast(bf16x8, w0); k1 = __builtin_bit_cast(bf16x8, w1);
            } else if (PRE) { k0 = pre.k[kt][0]; k1 = pre.k[kt][1];
            } else { if (SAMP) { kpos -= KVB; kpos = kpos > DECS - 1 ? DECS - 1 : kpos; }
                const bf16* kp = base + (size_t)kpos * W_K + SO_K + rq * 8; k0 = *(const bf16x8*)kp; k1 = *(const bf16x8*)(kp + 32); }
        }
        if (tile_valid) {
            f32x4 acc = {0.f, 0.f, 0.f, 0.f};
            acc = __builtin_amdgcn_mfma_f32_16x16x32_bf16(k0, qf[0], acc, 0, 0, 0);
            acc = __builtin_amdgcn_mfma_f32_16x16x32_bf16(k1, qf[1], acc, 0, 0, 0);
            const LAS float* bt = bp + 16 * kt;
            if (kt >= 1 && kt <= 7 && 16 * kt >= kmin) {
#pragma unroll
                for (int j = 0; j < 4; ++j) sc[kt][j] = acc[j] * (0.125f * LOG2E) + bt[j];
            } else {
#pragma unroll
                for (int j = 0; j < 4; ++j) { const int kidx = 16 * kt + 4 * rq + j; const bool valid = (unsigned)(kidx - lo) <= (unsigned)(hi - lo);
                    sc[kt][j] = valid ? acc[j] * (0.125f * LOG2E) + bt[j] : -INFINITY; }
            }
        } else sc[kt] = (f32x4){-INFINITY, -INFINITY, -INFINITY, -INFINITY};
        if (SAMP && (kt == 2 || kt == 5)) __builtin_amdgcn_sched_barrier(0);
    }
    if (PMODE == 1) { __builtin_amdgcn_sched_barrier(0); attn_load_qk(base, P0n, striden, lane, probe, pre); __builtin_amdgcn_sched_barrier(0); }
    if (SAMP) {
        __builtin_amdgcn_sched_barrier(0);
#pragma unroll
        for (int ks = 0; ks < 2; ++ks)
#pragma unroll
            for (int i = 0; i < 8; ++i) { int kpos = P0 + stride * (32 * ks + 4 * i + (lane >> 4) - 128); kpos = kpos < 0 ? 0 : kpos;
                vq[ks][i] = *(const f32x4*)(cv + (size_t)kpos * (NH * HD) + (lane & 15) * 4); }
    }
    float m = -INFINITY;
#pragma unroll
    for (int kt = 0; kt < 9; ++kt) m = fmaxf(fmaxf(fmaxf(m, sc[kt][0]), fmaxf(sc[kt][1], sc[kt][2])), sc[kt][3]);
    m = fmaxf(m, __shfl_xor(m, 16)); m = fmaxf(m, __shfl_xor(m, 32));
    float l = 0.f;
#pragma unroll
    for (int kt = 0; kt < 9; ++kt)
#pragma unroll
        for (int j = 0; j < 4; ++j) { const float p = __builtin_amdgcn_exp2f(sc[kt][j] - m); sc[kt][j] = p; l += p; }
    l += __shfl_xor(l, 16); l += __shfl_xor(l, 32);
#pragma unroll
    for (int dt = 0; dt < 4; ++dt) o[dt] = (f32x4){0.f, 0.f, 0.f, 0.f};
    LAS const unsigned char* vr = vst + (4 * rq + ((lane & 15) >> 2)) * AT_VROW + (lane & 3) * 8;
#define AT_STEP_VALID(ks) (((P0 + stride * (16 * ((2 * (ks) + 1 < 9) ? 2 * (ks) + 1 : 8) + 15 - 128)) >= 0) && !(probe & 32))
#define AT_VWRITE(ks) do { { LAS unsigned char* vb_ = vst + ((ks) & 1) * AT_VBYTES; \
        if (SAMP && (ks) < 4) { _Pragma("unroll") for (int i = 0; i < 8; ++i) { const f32x4 v = vq[(ks) & 1][i]; u32x2 w; w.x = pk2(v[0], v[1]); w.y = pk2(v[2], v[3]); *(LAS u32x2*)(vb_ + (4 * i + (lane >> 4)) * AT_VROW + (lane & 15) * 8) = w; } } \
        else { _Pragma("unroll") for (int i = 0; i < 4; ++i) *(LAS u32x4*)(vb_ + (8 * i + (lane >> 3)) * AT_VROW + (lane & 7) * 16) = vh[SAMP ? 0 : ((ks) % VD)][i]; } } } while (0)
#define AT_VLOADF(ks) do { { _Pragma("unroll") for (int i = 0; i < 8; ++i) { int kpos = P0 + stride * (32 * (ks) + 4 * i + (lane >> 4) - 128); kpos = kpos < 0 ? 0 : kpos; \
        vq[(ks) & 1][i] = *(const f32x4*)(cv + (size_t)kpos * (NH * HD) + (lane & 15) * 4); } } } while (0)
    AT_VWRITE(0);
#define AT_VLOADH(ks) do { { _Pragma("unroll") for (int i = 0; i < 4; ++i) { int kpos = P0 + stride * (32 * (ks) + 8 * i + (lane >> 3) - 128); kpos = kpos < 0 ? 0 : (kpos > SEQ - 1 ? SEQ - 1 : kpos); if (probe & 512) kpos = 0; \
        vh[(ks) % VD][i] = *(const u32x4*)(base + (size_t)kpos * W_V + SO_V + (lane & 7) * 8); } } } while (0)
    if (!SAMP && VD < 5) AT_VLOADH(VD);
#pragma unroll
    for (int ks = 0; ks < 5; ++ks) {
        if (SAMP && ks + 2 < 4) {   }
        if (ks + 1 < 5) AT_VWRITE(ks + 1);
        if (!SAMP && ks + 1 + VD < 5) AT_VLOADH(ks + 1 + VD);
        if (SAMP && ks + 2 < 4) AT_VLOADF(ks + 2);
        if (AT_STEP_VALID(ks)) {
            bf16x8 pb;
            { const f32x4 pa = sc[2 * ks]; const f32x4 pz = (2 * ks + 1 < 9) ? sc[(2 * ks + 1 < 9) ? 2 * ks + 1 : 8] : (f32x4){0.f, 0.f, 0.f, 0.f};
              u32x4 w; w.x = pk2(pa[0], pa[1]); w.y = pk2(pa[2], pa[3]); w.z = pk2(pz[0], pz[1]); w.w = pk2(pz[2], pz[3]); pb = __builtin_bit_cast(bf16x8, w); }
            LAS const unsigned char* vrb = vr + (ks & 1) * AT_VBYTES;
#pragma unroll
            for (int dt = 0; dt < 4; ++dt) { const s16x4 lo = lds_tr16(vrb + dt * 32), hi = lds_tr16(vrb + dt * 32 + 16 * AT_VROW);
                const bf16x8 vf = (bf16x8){lo[0], lo[1], lo[2], lo[3], hi[0], hi[1], hi[2], hi[3]};
                o[dt] = __builtin_amdgcn_mfma_f32_16x16x32_bf16(vf, pb, o[dt], 0, 0, 0); }
        }
    }
#undef AT_VWRITE
#undef AT_VLOADF
#undef AT_VLOADH
#undef AT_STEP_VALID
    m_out = m; l_out = l;
}
__device__ __forceinline__ void attn_merge(int mode, LAS unsigned char* lds, int ql, int lane, float m, float l, f32x4 (&o)[4], const bf16* gp  , bf16* yp  ) {
    const int rq = lane >> 4;
    LAS float* ml = (LAS float*)(lds + AT_ML) + ql * 2; LAS unsigned char* st = lds + AT_ST + ql * AT_STROW + rq * 16;
    if (mode == 0) {
#pragma unroll
        for (int dt = 0; dt < 4; ++dt) *(LAS f32x4*)(st + dt * 64) = o[dt];
        if (rq == 0) { ml[0] = m; ml[1] = l; }
    } else {
        const float M = ml[0], L = ml[1]; const float Mn = fmaxf(M, m), ca = __builtin_amdgcn_exp2f(M - Mn), cb = __builtin_amdgcn_exp2f(m - Mn); const float Ln = L * ca + l * cb;
        f32x4 on[4];
#pragma unroll
        for (int dt = 0; dt < 4; ++dt) on[dt] = *(LAS const f32x4*)(st + dt * 64) * ca + o[dt] * cb;
        if (mode == 1) {
            LDS_WAIT(); asm volatile("" ::: "memory");
#pragma unroll
            for (int dt = 0; dt < 4; ++dt) *(LAS f32x4*)(st + dt * 64) = on[dt];
            if (rq == 0) { ml[0] = Mn; ml[1] = Ln; }
        } else {
            const float inv = 1.f / Ln;
#pragma unroll
            for (int dt = 0; dt < 4; ++dt) { const u32x2 g = *(const u32x2*)(gp + 16 * dt + 4 * rq);
                const float g0 = __uint_as_float(g.x << 16), g1 = __uint_as_float(g.x & 0xffff0000u), g2 = __uint_as_float(g.y << 16), g3 = __uint_as_float(g.y & 0xffff0000u);
                u32x2 w; w.x = pk2(on[dt][0] * inv * siluf_(g0), on[dt][1] * inv * siluf_(g1)); w.y = pk2(on[dt][2] * inv * siluf_(g2), on[dt][3] * inv * siluf_(g3));
                *(u32x2*)(yp + 16 * dt + 4 * rq) = w; }
        }
    }
}
__device__ __forceinline__ void attn_unit(const unsigned char* ws, LAS unsigned char* lds, int b, int h, int s, int wave, int lane, int probe) {
    const bf16* proj = (const bf16*)(ws + WS_PROJ); bf16* ya = probe ? (bf16*)(ws + WS_TMP) : (bf16*)(ws + WS_YA); const float* prm = (const float*)(ws + WS_PRM);
    const bf16* base = proj + (size_t)b * SEQ * W_Q + h * HD;
    LAS float* bias2 = (LAS float*)(lds + AT_BIAS); LAS unsigned char* vst = lds + AT_V + wave * AT_VWAVE;
    for (int idx = threadIdx.x; idx < 3 * 160; idx += NTHR) { const int g = idx / 160, i = idx - g * 160 - 16; bias2[idx] = (i >= 0 && i <= 128) ? prm[PR_RELB + t5_bucket((128 - i) << (2 * g)) * NH + h] * LOG2E : 0.f; }
    const int c = lane & 15;
#define AT_ITEM_PARAMS(it_, q0_, st_) do { const int id_ = 2 * wave + ((it_) & 1), md_ = (it_) >> 1; \
        if (md_ == 0) { q0_ = id_; st_ = 16; } else if (md_ == 1) { q0_ = (id_ >> 2) + 64 * (id_ & 3); st_ = 4; } else { q0_ = 16 * id_; st_ = 1; } } while (0)
    AttnQK qk; int q0, stride; AT_ITEM_PARAMS(0, q0, stride);
    if (AT_PRE) attn_load_qk(base, s + q0, stride, lane, probe, qk);
#pragma unroll 1
    for (int it = 0; it < ((probe & 8192) ? 2 : 6); ++it) {
        if ((it & 1) == 0) __syncthreads();
        const int mode = it >> 1;
        int q0n, striden; AT_ITEM_PARAMS((it + 1 < 6 ? it + 1 : 0), q0n, striden);
        float m, l; f32x4 o[4];
        if (!AT_PRE) attn_load_qk(base, s + q0, stride, lane, probe, qk);
        attn_item<false, AT_PRE ? 1 : 2>(base, nullptr, nullptr, s + q0, stride, bias2 + (2 - mode) * 160 + 16, vst, lane, m, l, o, probe, qk, it + 1 < 6, s + q0n, striden);
        const int ql = q0 + stride * c; const size_t row = (size_t)b * SEQ + s + ql;
        if (!(probe & 64)) attn_merge(mode, lds, ql, lane, m, l, o, proj + row * W_G + SO_G + h * HD, ya + row * YA_PITCH + h * HD);
        q0 = q0n; stride = striden;
    }
#undef AT_ITEM_PARAMS
    __syncthreads();
}

constexpr int AS_SLOT = 0, AS_SLOTF = 68;
__device__ __forceinline__ void attn_sample_unit(const unsigned char* ws, const float* cache_k, const float* cache_v, LAS unsigned char* lds, int sq, int h, int wave, int lane) {
    const bf16* proj = (const bf16*)(ws + WS_PROJ); bf16* ya = (bf16*)(ws + WS_YA); const float* prm = (const float*)(ws + WS_PRM);
    const bf16* base = proj + (size_t)(MP + sq * DECS) * W_Q + h * HD; const float* ck = cache_k + ((size_t)sq * KVB * NH + h) * HD; const float* cv = cache_v + ((size_t)sq * KVB * NH + h) * HD;
    LAS float* bias2 = (LAS float*)(lds + AT_BIAS); LAS unsigned char* vst = lds + AT_V + wave * AT_VWAVE; LAS float* slots = (LAS float*)(lds + AS_SLOT);
    for (int idx = threadIdx.x; idx < 3 * 160; idx += NTHR) { const int g = idx / 160, i = idx - g * 160 - 16; bias2[idx] = (i >= 0 && i <= 128) ? prm[PR_RELB + t5_bucket((128 - i) << (2 * g)) * NH + h] * LOG2E : 0.f; }
    __syncthreads();
    const int c = lane & 15, rq = lane >> 4;
#pragma unroll 1
    for (int id = wave; id < 13; id += NWAVES) {
        const int g = id == 0 ? 0 : (id < 5 ? 1 : 2), r = id == 0 ? 0 : (id < 5 ? id - 1 : id - 5), stride = 1 << (2 * g), nq = (DECS - r + stride - 1) / stride;
        float m, l; f32x4 o[4];
        { AttnQK dummy; attn_item<true, 0>(base, ck, cv, KVB + r, stride, bias2 + g * 160 + 16, vst, lane, m, l, o, 0, dummy, false, 0, 1); }
        if (c < nq) { LAS float* sl = slots + ((r + stride * c) * 3 + g) * AS_SLOTF;
#pragma unroll
            for (int dt = 0; dt < 4; ++dt) *(LAS f32x4*)(sl + 16 * dt + 4 * rq) = o[dt];
            if (rq == 0) { sl[64] = m; sl[65] = l; } }
    }
    __syncthreads();
    { const int i = threadIdx.x >> 6, d = lane; const LAS float* s0 = slots + (i * 3) * AS_SLOTF; const LAS float* s1 = s0 + AS_SLOTF; const LAS float* s2 = s1 + AS_SLOTF;
      const float m0 = s0[64], m1 = s1[64], m2 = s2[64], M = fmaxf(m0, fmaxf(m1, m2));
      const float c0 = __builtin_amdgcn_exp2f(m0 - M), c1 = __builtin_amdgcn_exp2f(m1 - M), c2 = __builtin_amdgcn_exp2f(m2 - M);
      const float L = s0[65] * c0 + s1[65] * c1 + s2[65] * c2, O = s0[d] * c0 + s1[d] * c1 + s2[d] * c2;
      const size_t row = (size_t)MP + sq * DECS + i; const float gv = bf2f(proj[row * W_G + SO_G + h * HD + d]);
      ya[row * YA_PITCH + h * HD + d] = (bf16)f2bf(O / L * siluf_(gv)); }
    __syncthreads();
}
constexpr int SD_BM = 0, SD_CM = 17408, SD_CS = 34816, SD_ROWN = 272, SD_BWT = 52224, SD_XT = 70656, SD_ROWS = 144, SD_YP = 79872, SD_YROW = 272, SD_AR = 114688, SD_CW = 115712;
__device__ __forceinline__ void ssd_dtarrays(LAS float* ar, float dtv, float Aneg, int lane) {
    asm volatile("" : "+v"(lane));
    float x = dtv * Aneg * LOG2E;
#pragma unroll
    for (int o = 1; o < 64; o <<= 1) { const float y = __shfl_up(x, o); if (lane >= o) x += y; }
    const float tot = __shfl(x, 63);
    ar[lane] = x; ar[64 + lane] = dtv; ar[128 + lane] = __builtin_amdgcn_exp2f(tot - x) * dtv; ar[192 + lane] = __builtin_amdgcn_exp2f(x);
}
__device__ __forceinline__ float silu_fast(float x) { return x * __builtin_amdgcn_rcpf(1.f + __builtin_amdgcn_exp2f(-x * LOG2E)); }
typedef float f32x2 __attribute__((ext_vector_type(2)));
__device__ __forceinline__ void ssd_conv_load(unsigned (&raw)[19], const bf16* proj, const bf16* zrow, size_t row0, int c0, int t0, int col) {
    const bf16* basep = proj + (row0 + (size_t)(c0 + t0)) * W_XBC + SO_XBC + col;
#pragma unroll
    for (int k = 0; k < 19; ++k) { const int T = c0 + t0 - 3 + k; const bf16* rp = (T >= 0) ? basep + (ptrdiff_t)(k - 3) * W_XBC : zrow + col; raw[k] = *(const unsigned*)rp; }
}
template <int KIND> __device__ __forceinline__ void ssd_conv_compute(const unsigned (&raw)[19], LAS unsigned char* lds, int t0, int chl  , int ch) {
    const LAS float* ar = (const LAS float*)(lds + SD_AR); const LAS float* cw = (const LAS float*)(lds + SD_CW) + chl;
    f32x2 w[4];
#pragma unroll
    for (int tap = 0; tap < 4; ++tap) w[tap] = *(const LAS f32x2*)(cw + tap * 320);
    const f32x2 bb = *(const LAS f32x2*)(cw + 4 * 320);
#pragma unroll
    for (int blk = 0; blk < 2; ++blk) {
        float o0[8], o1[8];
#pragma unroll
        for (int tt = 0; tt < 8; ++tt) { const int t = blk * 8 + tt; f32x2 v = bb;
#pragma unroll
            for (int tap = 0; tap < 4; ++tap) v += w[tap] * (f32x2){__uint_as_float(raw[t + tap] << 16), __uint_as_float(raw[t + tap] & 0xffff0000u)};
            o0[tt] = silu_fast(v.x); o1[tt] = silu_fast(v.y); }
        const int s0 = t0 + blk * 8;
        if (KIND == 0) {
            u32x4 a, b; a.x = pk2(o0[0], o0[1]); a.y = pk2(o0[2], o0[3]); a.z = pk2(o0[4], o0[5]); a.w = pk2(o0[6], o0[7]); b.x = pk2(o1[0], o1[1]); b.y = pk2(o1[2], o1[3]); b.z = pk2(o1[4], o1[5]); b.w = pk2(o1[6], o1[7]);
            *(LAS u32x4*)(lds + SD_XT + ch * SD_ROWS + s0 * 2) = a; *(LAS u32x4*)(lds + SD_XT + (ch + 1) * SD_ROWS + s0 * 2) = b;
        } else if (KIND == 1) {
            float s0v[8], s1v[8];
#pragma unroll
            for (int tt = 0; tt < 8; ++tt) { *(LAS unsigned*)(lds + SD_BM + (s0 + tt) * SD_ROWN + ch * 2) = pk2(o0[tt], o1[tt]); const float ww = ar[128 + s0 + tt]; s0v[tt] = o0[tt] * ww; s1v[tt] = o1[tt] * ww; }
            u32x4 a, b; a.x = pk2(s0v[0], s0v[1]); a.y = pk2(s0v[2], s0v[3]); a.z = pk2(s0v[4], s0v[5]); a.w = pk2(s0v[6], s0v[7]); b.x = pk2(s1v[0], s1v[1]); b.y = pk2(s1v[2], s1v[3]); b.z = pk2(s1v[4], s1v[5]); b.w = pk2(s1v[6], s1v[7]);
            *(LAS u32x4*)(lds + SD_BWT + ch * SD_ROWS + s0 * 2) = a; *(LAS u32x4*)(lds + SD_BWT + (ch + 1) * SD_ROWS + s0 * 2) = b;
        } else {
#pragma unroll
            for (int tt = 0; tt < 8; ++tt) { *(LAS unsigned*)(lds + SD_CM + (s0 + tt) * SD_ROWN + ch * 2) = pk2(o0[tt], o1[tt]); const float e = ar[192 + s0 + tt];
                *(LAS unsigned*)(lds + SD_CS + (s0 + tt) * SD_ROWN + ch * 2) = pk2(o0[tt] * e, o1[tt] * e); }
        }
    }
}
__device__ __forceinline__ bf16x8 cat8(s16x4 a, s16x4 b) { return (bf16x8){a[0], a[1], a[2], a[3], b[0], b[1], b[2], b[3]}; }
#define SD_SCHED() __builtin_amdgcn_sched_barrier(0)
template <int HH> __device__ __forceinline__ void ssd_mfma_step(LAS unsigned char* lds, f32x4 (&Hacc)[4], int pt, int c, int rq, float Dk) {
    const LAS float* ar = (const LAS float*)(lds + SD_AR);
    constexpr int S0 = 2 * HH, S1 = 2 * HH + 1;
    const int p = 16 * pt + c;
    const LAS unsigned char* bmp = lds + SD_BM + (32 * HH + c) * SD_ROWN + 16 * rq; const LAS unsigned char* cmp_ = lds + SD_CM + c * SD_ROWN + 16 * rq;
    f32x4 g0[4], g1[4];
#pragma unroll
    for (int lt = 0; lt < 4; ++lt) { g0[lt] = (f32x4){0.f, 0.f, 0.f, 0.f}; g1[lt] = (f32x4){0.f, 0.f, 0.f, 0.f}; }
    bf16x8 fb[2][2], fc[2][4];
#define SD_LOADG(buf, ks) do { fb[buf][0] = *(LAS const bf16x8*)(bmp + 64 * (ks)); fb[buf][1] = *(LAS const bf16x8*)(bmp + 16 * SD_ROWN + 64 * (ks)); \
        _Pragma("unroll") for (int lt = S0; lt < 4; ++lt) fc[buf][lt] = *(LAS const bf16x8*)(cmp_ + 16 * lt * SD_ROWN + 64 * (ks)); } while (0)
    SD_LOADG(0, 0);
#pragma unroll
    for (int ks = 0; ks < 4; ++ks) {
        if (ks + 1 < 4) SD_LOADG((ks + 1) & 1, ks + 1);
        SD_SCHED();
#pragma unroll
        for (int lt = S0; lt < 4; ++lt) { g0[lt] = __builtin_amdgcn_mfma_f32_16x16x32_bf16(fb[ks & 1][0], fc[ks & 1][lt], g0[lt], 0, 0, 0);
            if (lt >= S1) g1[lt] = __builtin_amdgcn_mfma_f32_16x16x32_bf16(fb[ks & 1][1], fc[ks & 1][lt], g1[lt], 0, 0, 0); }
        SD_SCHED();
    }
#undef SD_LOADG
    bf16x8 csf[4][2];
#pragma unroll
    for (int lt = 0; lt < 4; ++lt)
#pragma unroll
        for (int k2 = 0; k2 < 2; ++k2) { const LAS unsigned char* cp = lds + SD_CS + (16 * lt + c) * SD_ROWN + (64 * HH + 32 * k2 + 4 * rq) * 2; csf[lt][k2] = cat8(*(LAS const s16x4*)cp, *(LAS const s16x4*)(cp + 32)); }
    const bf16x8 xb = cat8(*(LAS const s16x4*)(lds + SD_XT + p * SD_ROWS + (32 * HH + 4 * rq) * 2), *(LAS const s16x4*)(lds + SD_XT + p * SD_ROWS + (32 * HH + 16 + 4 * rq) * 2));
    const f32x4 as0 = *(LAS const f32x4*)(ar + 32 * HH + 4 * rq), as1 = *(LAS const f32x4*)(ar + 32 * HH + 16 + 4 * rq);
    const f32x4 dt0 = *(LAS const f32x4*)(ar + 64 + 32 * HH + 4 * rq), dt1 = *(LAS const f32x4*)(ar + 64 + 32 * HH + 16 + 4 * rq);
    float acl[4];
#pragma unroll
    for (int lt = 0; lt < 4; ++lt) acl[lt] = ar[16 * lt + c];
    const float dec = __builtin_amdgcn_exp2f(ar[63]);
    SD_SCHED();
    int dd = c - 4 * rq; asm volatile("" : "+v"(dd));
    bf16x8 hb[2];
#pragma unroll
    for (int k2 = 0; k2 < 2; ++k2) { u32x4 w; w.x = pk2(Hacc[2 * k2][0], Hacc[2 * k2][1]); w.y = pk2(Hacc[2 * k2][2], Hacc[2 * k2][3]); w.z = pk2(Hacc[2 * k2 + 1][0], Hacc[2 * k2 + 1][1]); w.w = pk2(Hacc[2 * k2 + 1][2], Hacc[2 * k2 + 1][3]); hb[k2] = __builtin_bit_cast(bf16x8, w); }
    bf16x8 mf[4];
#pragma unroll
    for (int lt = 0; lt < 4; ++lt) if (lt >= S0) {
        float m0[4], m1[4];
#pragma unroll
        for (int j = 0; j < 4; ++j) {
            float v0 = g0[lt][j] * __builtin_amdgcn_exp2f(fminf(acl[lt] - as0[j], 0.f)) * dt0[j];
            if (lt == S0) { v0 = (j <= dd) ? v0 : 0.f; v0 += (j == dd) ? Dk : 0.f; }
            m0[j] = v0;
            float v1 = 0.f;
            if (lt >= S1) { v1 = g1[lt][j] * __builtin_amdgcn_exp2f(fminf(acl[lt] - as1[j], 0.f)) * dt1[j]; if (lt == S1) { v1 = (j <= dd) ? v1 : 0.f; v1 += (j == dd) ? Dk : 0.f; } }
            m1[j] = v1; }
        u32x4 w; w.x = pk2(m0[0], m0[1]); w.y = pk2(m0[2], m0[3]); w.z = pk2(m1[0], m1[1]); w.w = pk2(m1[2], m1[3]); mf[lt] = __builtin_bit_cast(bf16x8, w);
    }
    SD_SCHED();
    f32x4 y[4];
#pragma unroll
    for (int lt = 0; lt < 4; ++lt) y[lt] = __builtin_amdgcn_mfma_f32_16x16x32_bf16(csf[lt][0], hb[0], (f32x4){0.f, 0.f, 0.f, 0.f}, 0, 0, 0);
#pragma unroll
    for (int lt = 0; lt < 4; ++lt) y[lt] = __builtin_amdgcn_mfma_f32_16x16x32_bf16(csf[lt][1], hb[1], y[lt], 0, 0, 0);
    SD_SCHED();
    bf16x8 bwf[4][2], xn[2];
#pragma unroll
    for (int k2 = 0; k2 < 2; ++k2) xn[k2] = *(LAS const bf16x8*)(lds + SD_XT + p * SD_ROWS + (8 * rq + 32 * k2) * 2);
#pragma unroll
    for (int nt = 0; nt < 4; ++nt)
#pragma unroll
        for (int k2 = 0; k2 < 2; ++k2) bwf[nt][k2] = *(LAS const bf16x8*)(lds + SD_BWT + (64 * HH + 16 * nt + c) * SD_ROWS + (8 * rq + 32 * k2) * 2);
    SD_SCHED();
#pragma unroll
    for (int lt = 0; lt < 4; ++lt) if (lt >= S0) y[lt] = __builtin_amdgcn_mfma_f32_16x16x32_bf16(mf[lt], xb, y[lt], 0, 0, 0);
#pragma unroll
    for (int nt = 0; nt < 4; ++nt) Hacc[nt] = Hacc[nt] * dec;
#pragma unroll
    for (int k2 = 0; k2 < 2; ++k2)
#pragma unroll
        for (int nt = 0; nt < 4; ++nt) Hacc[nt] = __builtin_amdgcn_mfma_f32_16x16x32_bf16(bwf[nt][k2], xn[k2], Hacc[nt], 0, 0, 0);
#pragma unroll
    for (int lt = 0; lt < 4; ++lt)
#pragma unroll
        for (int j = 0; j < 4; ++j) *(LAS float*)(lds + SD_YP + HH * (64 * SD_YROW) + (16 * lt + 4 * rq + j) * SD_YROW + p * 4) = y[lt][j];
}
__device__ __forceinline__ void ssd_mfma_unit(const unsigned char* ws, float* out, bf16* ys, float* ssq, int probe, LAS unsigned char* lds, int b, int hd, int wave, int lane) {
    const bf16* proj = (const bf16*)(ws + WS_PROJ); const float* dtb = (const float*)(ws + WS_DT); const float* prm = (const float*)(ws + WS_PRM);
    const int tid = threadIdx.x, c = lane & 15, rq = lane >> 4, pt = wave & 3, hh = wave >> 2, grp = hd >> 2;
    const size_t row0 = (size_t)b * SEQ; const bf16* zrow = (const bf16*)(ws + WS_WIN) + (size_t)NIN * DM;
    const float Aneg = -__expf(prm[PR_ALOG + hd]), Dk = prm[PR_DSKIP + hd];
    LAS float* ar = (LAS float*)(lds + SD_AR);
    f32x4 Hacc[4];
#pragma unroll
    for (int nt = 0; nt < 4; ++nt) Hacc[nt] = (f32x4){0.f, 0.f, 0.f, 0.f};
    const int kindA = wave < 2 ? 0 : (wave < 6 ? 1 : 2);
    const int tA = kindA == 0 ? tid : (kindA == 1 ? tid - 128 : tid - 384), pairA = kindA == 0 ? (tA & 31) : (tA & 63), runA = kindA == 0 ? (tA >> 5) : (tA >> 6);
    const int colA = kindA == 0 ? hd * 64 + 2 * pairA : (kindA == 1 ? DSSM + grp * DST + 2 * pairA : DSSM + NGRP * DST + grp * DST + 2 * pairA);
    const int tB = tid + 128, pairB = tB & 63, runB = tB >> 6, colB = DSSM + NGRP * DST + grp * DST + 2 * pairB;
    unsigned rawA[19], rawB[19];
    ssd_conv_load(rawA, proj, zrow, row0, 0, 16 * runA, colA);
    if (wave < 2) ssd_conv_load(rawB, proj, zrow, row0, 0, 16 * runB, colB);
    float dtn = (wave == 7) ? dtb[(row0 + lane) * 32 + hd] : 0.f;
    __syncthreads();
    for (int idx = tid; idx < 5 * 320; idx += NTHR) { const int t5 = idx / 320, chl = idx - t5 * 320; const int col = chl < 64 ? hd * 64 + chl : (chl < 192 ? DSSM + grp * DST + (chl - 64) : DSSM + NGRP * DST + grp * DST + (chl - 192));
        ((LAS float*)(lds + SD_CW))[idx] = t5 < 4 ? prm[PR_CONVW + t5 * DCONV + col] : prm[PR_CONVB + col]; }
    if (wave == 7) { ssd_dtarrays(ar, dtn, Aneg, lane); dtn = dtb[(row0 + 64 + lane) * 32 + hd]; }
    __syncthreads();
    const int el = tid >> 3, ep0 = (tid & 7) * 8;
#pragma unroll 1
    for (int c0 = 0; c0 < SEQ; c0 += 64) {
        const bool more = c0 + 64 < SEQ;
        const u32x4 zreg = *(const u32x4*)(proj + (row0 + c0 + el) * W_Z + SO_Z + hd * 64 + ep0);
        if (!(probe & 2)) {
        if (kindA == 0) ssd_conv_compute<0>(rawA, lds, 16 * runA, 2 * pairA, 2 * pairA); else if (kindA == 1) ssd_conv_compute<1>(rawA, lds, 16 * runA, 64 + 2 * pairA, 2 * pairA); else ssd_conv_compute<2>(rawA, lds, 16 * runA, 192 + 2 * pairA, 2 * pairA);
        if (more) ssd_conv_load(rawA, proj, zrow, row0, c0 + 64, 16 * runA, colA);
        if (wave < 2) { ssd_conv_compute<2>(rawB, lds, 16 * runB, 192 + 2 * pairB, 2 * pairB); if (more) ssd_conv_load(rawB, proj, zrow, row0, c0 + 64, 16 * runB, colB); }
        }
        __syncthreads();
        if (!(probe & 4)) { if (hh == 0) ssd_mfma_step<0>(lds, Hacc, pt, c, rq, Dk); else ssd_mfma_step<1>(lds, Hacc, pt, c, rq, Dk); }
        __syncthreads();
        if (!(probe & 8)) {
            const size_t row = row0 + c0 + el;
            const LAS float* y0 = (const LAS float*)(lds + SD_YP + el * SD_YROW + ep0 * 4); const LAS float* y1 = (const LAS float*)(lds + SD_YP + 64 * SD_YROW + el * SD_YROW + ep0 * 4);
            const f32x4 a0 = *(const LAS f32x4*)y0 + *(const LAS f32x4*)y1, a1 = *(const LAS f32x4*)(y0 + 4) + *(const LAS f32x4*)(y1 + 4);
            const u32x4 z = zreg;
            float v[8];
            v[0] = a0[0] * silu_fast(__uint_as_float(z.x << 16)); v[1] = a0[1] * silu_fast(__uint_as_float(z.x & 0xffff0000u)); v[2] = a0[2] * silu_fast(__uint_as_float(z.y << 16)); v[3] = a0[3] * silu_fast(__uint_as_float(z.y & 0xffff0000u));
            v[4] = a1[0] * silu_fast(__uint_as_float(z.z << 16)); v[5] = a1[1] * silu_fast(__uint_as_float(z.z & 0xffff0000u)); v[6] = a1[2] * silu_fast(__uint_as_float(z.w << 16)); v[7] = a1[3] * silu_fast(__uint_as_float(z.w & 0xffff0000u));
            u32x4 w; w.x = pk2(v[0], v[1]); w.y = pk2(v[2], v[3]); w.z = pk2(v[4], v[5]); w.w = pk2(v[6], v[7]);
            *(u32x4*)(ys + row * DSSM + hd * 64 + ep0) = w;
            float ss = (v[0] * v[0] + v[1] * v[1]) + (v[2] * v[2] + v[3] * v[3]) + (v[4] * v[4] + v[5] * v[5]) + (v[6] * v[6] + v[7] * v[7]);
            ss += __shfl_xor(ss, 1); ss += __shfl_xor(ss, 2); ss += __shfl_xor(ss, 4);
            if ((tid & 7) == 0) ssq[row * NSH + hd] = ss;
            if (wave == 7 && more) { ssd_dtarrays(ar, dtn, Aneg, lane); const int cn = c0 + 128 < SEQ ? c0 + 128 : c0; dtn = dtb[(row0 + cn + lane) * 32 + hd]; }
        }
        __syncthreads();
    }
    float* dst = out + O_SP + ((size_t)(b * NSH + hd) * SHD + 16 * pt + c) * DST + 64 * hh + 4 * rq;
#pragma unroll
    for (int nt = 0; nt < 4; ++nt) *(f32x4*)(dst + 16 * nt) = Hacc[nt];
}
constexpr int SS_TEAM = 12288;
constexpr int SS_X = 0, SS_B = 2048, SS_C = 6144, SS_DT = 10240, SS_Y = 10304, SS_BYTES = 12352;
__device__ __forceinline__ void ssd_sample_teams(const unsigned char* ws, float* out, const float* state_conv, const float* state_ssm, LAS unsigned char* lds, int item0  , int nitems) {
    const bf16* proj = (const bf16*)(ws + WS_PROJ); const float* dtb = (const float*)(ws + WS_DT); const float* prm = (const float*)(ws + WS_PRM); bf16* ys = (bf16*)(ws + WS_YS); float* ssq = (float*)(ws + WS_SSQ);
    const int tid = threadIdx.x, team = tid >> 7, t = tid & 127, p = t >> 1, nh = t & 1;
    const int item = item0 + team; const bool act = team < nitems;
    const int sq = act ? item / NSH : 0, hd = act ? item % NSH : 0, grp = hd >> 2; const size_t row0 = (size_t)MP + sq * DECS;
    LAS unsigned char* tl = lds + team * SS_BYTES;
    LAS float* xs = (LAS float*)(tl + SS_X); LAS float* Bs = (LAS float*)(tl + SS_B); LAS float* Cs = (LAS float*)(tl + SS_C); LAS float* dts = (LAS float*)(tl + SS_DT); LAS float* yb = (LAS float*)(tl + SS_Y);
    f32x4 h[16];
    { const f32x4* s4 = (const f32x4*)(state_ssm + ((size_t)(sq * NSH + hd) * SHD + p) * DST + 64 * nh);
#pragma unroll
      for (int j = 0; j < 16; ++j) h[j] = s4[j]; }
    const float Aneg = -__expf(prm[PR_ALOG + hd]), Dk = prm[PR_DSKIP + hd];
#pragma unroll 1
    for (int c = t; c < 320; c += 128) {
        const int xc = c < 64 ? hd * 64 + c : (c < 192 ? DSSM + grp * DST + (c - 64) : DSSM + NGRP * DST + grp * DST + (c - 192));
        float w[4], raw[11];
#pragma unroll
        for (int tap = 0; tap < 4; ++tap) w[tap] = prm[PR_CONVW + tap * DCONV + xc];
        const float bias = prm[PR_CONVB + xc];
#pragma unroll
        for (int k = 0; k < 3; ++k) raw[k] = state_conv[(size_t)(sq * 3 + k) * DCONV + xc];
#pragma unroll
        for (int k = 0; k < DECS; ++k) raw[3 + k] = bf2f(proj[(row0 + k) * W_XBC + SO_XBC + xc]);
        LAS float* dstp = c < 64 ? xs + c : (c < 192 ? Bs + (c - 64) : Cs + (c - 192)); const int dstride = c < 64 ? 64 : 128;
#pragma unroll
        for (int tk = 0; tk < DECS; ++tk) { const float acc = bias + w[0] * raw[tk] + w[1] * raw[tk + 1] + w[2] * raw[tk + 2] + w[3] * raw[tk + 3]; dstp[tk * dstride] = siluf_(acc); }
    }
    if (t < DECS) { const float dtv = dtb[(row0 + t) * 32 + hd]; dts[t] = dtv; dts[8 + t] = __expf(dtv * Aneg); }
    __syncthreads();
#pragma unroll 1
    for (int tk = 0; tk < DECS; ++tk) {
        const float dA = dts[8 + tk], xv = xs[tk * 64 + p], dtx = dts[tk] * xv;
        const LAS f32x4* b4 = (const LAS f32x4*)(Bs + tk * 128 + 64 * nh); const LAS f32x4* c4 = (const LAS f32x4*)(Cs + tk * 128 + 64 * nh);
        f32x4 a4 = {0.f, 0.f, 0.f, 0.f};
#pragma unroll
        for (int j = 0; j < 16; ++j) { h[j] = h[j] * dA + b4[j] * dtx; a4 += h[j] * c4[j]; }
        float acc = (a4[0] + a4[1]) + (a4[2] + a4[3]);
        acc += __shfl_xor(acc, 1);
        if (nh == 0) yb[tk * 64 + p] = acc + Dk * xv;
    }
    if (act) { f32x4* d4 = (f32x4*)(out + O_SS + ((size_t)(sq * NSH + hd) * SHD + p) * DST + 64 * nh);
#pragma unroll
        for (int j = 0; j < 16; ++j) d4[j] = h[j]; }
    __syncthreads();
    { const int tk = t >> 4, p0 = (t & 15) * 4; const size_t row = row0 + tk;
      const f32x4 yv = *(const LAS f32x4*)(yb + tk * 64 + p0); const u32x2 z = *(const u32x2*)(proj + row * W_Z + SO_Z + hd * 64 + p0);
      const float v0 = yv[0] * siluf_(__uint_as_float(z.x << 16)), v1 = yv[1] * siluf_(__uint_as_float(z.x & 0xffff0000u)), v2 = yv[2] * siluf_(__uint_as_float(z.y << 16)), v3 = yv[3] * siluf_(__uint_as_float(z.y & 0xffff0000u));
      float ss = (v0 * v0 + v1 * v1) + (v2 * v2 + v3 * v3);
      ss += __shfl_xor(ss, 1); ss += __shfl_xor(ss, 2); ss += __shfl_xor(ss, 4); ss += __shfl_xor(ss, 8);
      LAS float* ssl = (LAS float*)(lds + 4 * SS_BYTES);
      if ((t & 15) == 0) ssl[team * DECS + tk] = ss;
      __syncthreads();
      const float rstd = rsqrtf((ssl[tk] + ssl[DECS + tk] + ssl[2 * DECS + tk] + ssl[3 * DECS + tk]) * (1.f / 256.f) + 1e-5f);
      if (act) { u32x2 w; w.x = pk2(v0 * rstd, v1 * rstd); w.y = pk2(v2 * rstd, v3 * rstd); *(u32x2*)(ys + row * DSSM + hd * 64 + p0) = w; } }
    __syncthreads();
}
template <int NKS  , int PITCH  > __device__ __forceinline__ f32x2 skinny_tile(const bf16* A, const bf16* Wt, int tile, LAS unsigned char* lds, int wave, int lane) {
    constexpr int K = PITCH;
    const int c = lane & 15, rq = lane >> 4, rb = tile >> 4, cb = tile & 15, k0 = wave * (32 * NKS);
    const bf16* ap = A + (size_t)(16 * rb + c) * K + k0 + 8 * rq; const bf16* wp = Wt + (size_t)(64 * cb + c) * K + k0 + 8 * rq;
    f32x4 acc[4];
#pragma unroll
    for (int nt = 0; nt < 4; ++nt) acc[nt] = (f32x4){0.f, 0.f, 0.f, 0.f};
#pragma unroll
    for (int ks = 0; ks < NKS; ++ks) { const bf16x8 af = *(const bf16x8*)(ap + 32 * ks);
#pragma unroll
        for (int nt = 0; nt < 4; ++nt) acc[nt] = __builtin_amdgcn_mfma_f32_16x16x32_bf16(af, *(const bf16x8*)(wp + (size_t)(16 * nt) * K + 32 * ks), acc[nt], 0, 0, 0); }
    LAS float* P = (LAS float*)lds;
#pragma unroll
    for (int nt = 0; nt < 4; ++nt)
#pragma unroll
        for (int j = 0; j < 4; ++j) P[(wave * 16 + 4 * rq + j) * 64 + 16 * nt + c] = acc[nt][j];
    __syncthreads();
    const int tid = threadIdx.x; f32x2 r = {0.f, 0.f};
#pragma unroll
    for (int w = 0; w < 8; ++w) r += *(const LAS f32x2*)(P + (w * 16 + (tid >> 5)) * 64 + 2 * (tid & 31));
    __syncthreads();
    return r;
}
__device__ __forceinline__ void skinny_p3(const unsigned char* ws, LAS unsigned char* lds, int G, int wave, int lane) {
    const bf16* proj = (const bf16*)(ws + WS_PROJ); const bf16* ya = (const bf16*)(ws + WS_YA) + (size_t)MP * YA_PITCH; const bf16* ysn = (const bf16*)(ws + WS_YS) + (size_t)MP * DSSM; bf16* mrg = (bf16*)(ws + WS_MRG);
    for (int tile = blockIdx.x; tile < 256; tile += G) {
        const size_t row = (size_t)MP + 16 * (tile >> 4) + (threadIdx.x >> 5); const int col = 64 * (tile & 15) + 2 * (threadIdx.x & 31);
        const f32x2 a = skinny_tile<3, YA_PITCH>(ya, (const bf16*)(ws + WS_WA2), tile, lds, wave, lane);
        const f32x2 b = skinny_tile<8, DSSM>(ysn, (const bf16*)(ws + WS_WB), tile, lds, wave, lane);
        const unsigned ga = *(const unsigned*)(proj + row * W_GA + SO_GA + col), gb = *(const unsigned*)(proj + row * W_GB + SO_GB + col);
        const float m0 = sigmoidf_(__uint_as_float(ga << 16)) * a.x + sigmoidf_(__uint_as_float(gb << 16)) * b.x, m1 = sigmoidf_(__uint_as_float(ga & 0xffff0000u)) * a.y + sigmoidf_(__uint_as_float(gb & 0xffff0000u)) * b.y;
        *(unsigned*)(mrg + row * DM + col) = pk2(m0, m1);
    }
}
__device__ __forceinline__ void skinny_p4(const unsigned char* ws, const float* x_sample, float* out, LAS unsigned char* lds, int G, int wave, int lane) {
    const bf16* mrg = (const bf16*)(ws + WS_MRG) + (size_t)MP * DM;
    for (int tile = blockIdx.x; tile < 256; tile += G) {
        const int r = 16 * (tile >> 4) + (threadIdx.x >> 5), col = 64 * (tile & 15) + 2 * (threadIdx.x & 31);
        const f32x2 o = skinny_tile<4, DM>(mrg, (const bf16*)(ws + WS_WO), tile, lds, wave, lane);
        const f32x2 xv = *(const f32x2*)(x_sample + (size_t)r * DM + col);
        *(f32x2*)(out + O_YS + (size_t)r * DM + col) = xv + o;
    }
}
__device__ __forceinline__ void p0_transpose_item(const float* W, int K, int N, bf16* WT, int k0, int n0, int dst_row0, const float* kscale, LAS float* scr, int lane, int dpitch = 0) {
    if (dpitch == 0) dpitch = K;
#pragma unroll 8
    for (int i = 0; i < 32; ++i) { const int kk = 2 * i + (lane >> 5); float v = W[(size_t)(k0 + kk) * N + n0 + (lane & 31)]; if (kscale) v *= kscale[k0 + kk]; scr[kk * 33 + (lane & 31)] = v; }
    LDS_WAIT(); asm volatile("" ::: "memory");
    const int c = lane & 7;
#pragma unroll
    for (int j = 0; j < 4; ++j) { const int n = (lane >> 3) + 8 * j; const LAS float* s = scr + (8 * c) * 33 + n;
        u32x4 o; o.x = pk2(s[0 * 33], s[1 * 33]); o.y = pk2(s[2 * 33], s[3 * 33]); o.z = pk2(s[4 * 33], s[5 * 33]); o.w = pk2(s[6 * 33], s[7 * 33]);
        *(u32x4*)(WT + (size_t)(dst_row0 + n) * dpitch + k0 + 8 * c) = o; }
    LDS_WAIT(); asm volatile("" ::: "memory");
}
__device__ __forceinline__ void p0_prologue(const Args& a, LAS unsigned char* lds, int gw, int NGW, int wave, int lane) {
    bf16* win_t = (bf16*)(a.ws + WS_WIN); bf16* wa_t = (bf16*)(a.ws + WS_WA2); bf16* wb_t = (bf16*)(a.ws + WS_WB); bf16* wo_t = (bf16*)(a.ws + WS_WO); bf16* hb = (bf16*)(a.ws + WS_HB);
    LAS float* scr = (LAS float*)(lds + wave * 16384);
    constexpr int I_IN = (DM / 64) * (NIN / 32), I_A = (DA / 64) * (DM / 32), I_B = (DSSM / 64) * (DM / 32), I_O = (DM / 64) * (DM / 32);
    for (int it = gw; it < I_IN + I_A + I_B + I_O; it += NGW) {
        int r = it;
        if (r < I_IN) { const int nblk = NIN / 32, kb = r / nblk, nb = r % nblk, n0 = nb * 32; const int dst = (n0 < 9216) ? n0 : (n0 == 9216 ? 11264 : n0 - 32);
            p0_transpose_item(a.w_in, DM, NIN, win_t, kb * 64, n0, dst, nullptr, scr, lane); continue; } r -= I_IN;
        if (r < I_A) { const int nblk = DM / 32, kb = r / nblk, nb = r % nblk; p0_transpose_item(a.w_a, DA, DM, wa_t, kb * 64, nb * 32, nb * 32, nullptr, scr, lane, YA_PITCH); continue; } r -= I_A;
        if (r < I_B) { const int nblk = DM / 32, kb = r / nblk, nb = r % nblk; p0_transpose_item(a.w_b, DSSM, DM, wb_t, kb * 64, nb * 32, nb * 32, a.ssm_norm, scr, lane); continue; } r -= I_B;
        { const int nblk = DM / 32, kb = r / nblk, nb = r % nblk; p0_transpose_item(a.w_out, DM, DM, wo_t, kb * 64, nb * 32, nb * 32, nullptr, scr, lane); }
    }
    { float* prm = (float*)(a.ws + WS_PRM); const int gt = gw * 64 + lane, NGT = NGW * 64;
      for (int i = gt; i < PR_END; i += NGT) { float v = 0.f;
          if (i < PR_CONVB) v = a.conv_w[i]; else if (i < PR_DTB) v = a.conv_b[i - PR_CONVB]; else if (i < PR_ALOG) v = a.dt_bias[i - PR_DTB]; else if (i < PR_DSKIP) v = a.a_log[i - PR_ALOG];
          else if (i < PR_RELB) v = a.d_skip[i - PR_DSKIP]; else if (i < PR_RELB + 384) v = a.rel_bias[i - PR_RELB]; else if (i >= PR_FNORM) v = a.final_norm[i - PR_FNORM];
          prm[i] = v; } }
    { u32x4* z = (u32x4*)(win_t + (size_t)11296 * DM); const int n16 = 224 * DM * 2 / 16; for (int i = gw * 64 + lane; i < n16; i += NGW * 64) z[i] = (u32x4){0u, 0u, 0u, 0u}; }
    for (int m = gw; m < MT; m += NGW) {
        const float* xrow = (m < MP) ? a.x_prompt + (size_t)m * DM : a.x_sample + (size_t)(m - MP) * DM;
        const f32x4* xr = (const f32x4*)xrow + lane; const f32x4* gr = (const f32x4*)a.norm_g + lane;
        f32x4 v[4]; float s = 0.f;
#pragma unroll
        for (int j = 0; j < 4; ++j) { v[j] = xr[64 * j]; s += (v[j].x * v[j].x + v[j].y * v[j].y) + (v[j].z * v[j].z + v[j].w * v[j].w); }
        const float rstd = rsqrtf(wave_sum(s) * (1.f / DM) + 1e-6f);
        unsigned long long* o8 = (unsigned long long*)(hb + (size_t)m * DM) + lane;
#pragma unroll
        for (int j = 0; j < 4; ++j) { const f32x4 g = gr[64 * j]; o8[64 * j] = (unsigned long long)pk2(v[j].x * rstd * g.x, v[j].y * rstd * g.y) | ((unsigned long long)pk2(v[j].z * rstd * g.z, v[j].w * rstd * g.w) << 32); }
    }
}

template <bool SAMP> __device__ __forceinline__ const void* kv_ptr(const Args& a, const bf16* proj, int colkv, const float* cache, int seq, int tpos, int off, int h, bool& valid, bool& isf32) {
    if (!SAMP) { const int kt = tpos - off; valid = kt >= 0; isf32 = false; return proj + (size_t)(seq * SEQ + (valid ? kt : 0)) * W_K + colkv + h * HD; }
    const int idx = KVB + tpos - off; valid = true;
    if (idx >= KVB) { isf32 = false; return proj + (size_t)(MP + seq * DECS + (idx - KVB)) * W_K + colkv + h * HD; }
    isf32 = true; return cache + ((size_t)(seq * KVB + idx) * NH + h) * HD;
}
template <bool SAMP> __device__ __forceinline__ void attn_slow_item(const Args& a, const bf16* proj, bf16* ya, LAS float* sl, int row, int h, int lane) {
    const float* prm = (const float*)(a.ws + WS_PRM);
    const int seq = SAMP ? (row - MP) / DECS : row / SEQ, tpos = SAMP ? (row - MP) % DECS : row % SEQ;
    float q[64];
    { const u32x4* qp = (const u32x4*)(proj + (size_t)row * W_Q + SO_Q + h * HD);
#pragma unroll
      for (int i = 0; i < 8; ++i) { const u32x4 w = qp[i]; q[8 * i + 0] = __uint_as_float(w.x << 16); q[8 * i + 1] = __uint_as_float(w.x & 0xffff0000u); q[8 * i + 2] = __uint_as_float(w.y << 16); q[8 * i + 3] = __uint_as_float(w.y & 0xffff0000u);
          q[8 * i + 4] = __uint_as_float(w.z << 16); q[8 * i + 5] = __uint_as_float(w.z & 0xffff0000u); q[8 * i + 6] = __uint_as_float(w.w << 16); q[8 * i + 7] = __uint_as_float(w.w & 0xffff0000u); } }
    float mx = -INFINITY;
#pragma unroll 1
    for (int e = lane; e < 387; e += 64) {
        float sc = -INFINITY;
        const int g = e / 129, j = e - g * 129, off = j << (2 * g); bool valid, isf32;
        const void* kp = kv_ptr<SAMP>(a, proj, C_K, a.cache_k, seq, tpos, off, h, valid, isf32);
        if (valid) { float d = 0.f;
            if (isf32) { const f32x4* k4 = (const f32x4*)kp;
#pragma unroll
                for (int i = 0; i < 16; ++i) { const f32x4 kk = k4[i]; d += q[4 * i] * kk.x + q[4 * i + 1] * kk.y + q[4 * i + 2] * kk.z + q[4 * i + 3] * kk.w; } }
            else { const u32x4* k4 = (const u32x4*)kp;
#pragma unroll
                for (int i = 0; i < 8; ++i) { const u32x4 w = k4[i];
                    d += q[8 * i + 0] * __uint_as_float(w.x << 16) + q[8 * i + 1] * __uint_as_float(w.x & 0xffff0000u) + q[8 * i + 2] * __uint_as_float(w.y << 16) + q[8 * i + 3] * __uint_as_float(w.y & 0xffff0000u)
                       + q[8 * i + 4] * __uint_as_float(w.z << 16) + q[8 * i + 5] * __uint_as_float(w.z & 0xffff0000u) + q[8 * i + 6] * __uint_as_float(w.w << 16) + q[8 * i + 7] * __uint_as_float(w.w & 0xffff0000u); } }
            sc = d * 0.125f + prm[PR_RELB + t5_bucket(off) * NH + h]; }
        sl[e] = sc; mx = fmaxf(mx, sc);
    }
    mx = wave_max(mx);
    float sum = 0.f;
#pragma unroll 1
    for (int e = lane; e < 387; e += 64) { const float sc = sl[e]; const float pe = (sc == -INFINITY) ? 0.f : __expf(sc - mx); sl[e] = pe; sum += pe; }
    sum = wave_sum(sum);
    LDS_WAIT(); asm volatile("" ::: "memory");
    float o = 0.f;
#pragma unroll 4
    for (int e = 0; e < 387; ++e) {
        const int g = e / 129, j = e - g * 129, off = j << (2 * g); bool valid, isf32;
        const void* vp = kv_ptr<SAMP>(a, proj, C_V, a.cache_v, seq, tpos, off, h, valid, isf32);
        const float pe = sl[e];
        if (valid) { const float vv = isf32 ? ((const float*)vp)[lane] : bf2f(((const bf16*)vp)[lane]); o += pe * vv; }
    }
    LDS_WAIT(); asm volatile("" ::: "memory");
    const float gv = bf2f(proj[(size_t)row * W_G + SO_G + h * HD + lane]);
    ya[(size_t)row * YA_PITCH + h * HD + lane] = (bf16)f2bf(o / sum * siluf_(gv));
}

__device__ __forceinline__ void ssd_slow_item(const Args& a, LAS unsigned char* lds, int item) {
    const bf16* proj = (const bf16*)(a.ws + WS_PROJ); const float* dtb = (const float*)(a.ws + WS_DT); bf16* ys = (bf16*)(a.ws + WS_YS); float* ssq = (float*)(a.ws + WS_SSQ);
    const int tid = threadIdx.x, lane = tid & 63, wid = tid >> 6;
    const bool samp = item >= NBATCH * NSH; const int it2 = samp ? item - NBATCH * NSH : item; const int sq = it2 / NSH, hd = it2 % NSH, grp = hd / 4;
    const int L = samp ? DECS : SEQ, row0 = samp ? MP + sq * DECS : sq * SEQ;
    const int p = tid >> 3, n0 = (tid & 7) * 16;
    float h[16];
    if (samp) { const f32x4* s4 = (const f32x4*)(a.state_ssm + ((size_t)(sq * NSH + hd) * SHD + p) * DST + n0);
#pragma unroll
        for (int j = 0; j < 4; ++j) { const f32x4 v = s4[j]; h[4 * j] = v.x; h[4 * j + 1] = v.y; h[4 * j + 2] = v.z; h[4 * j + 3] = v.w; } }
    else {
#pragma unroll
        for (int j = 0; j < 16; ++j) h[j] = 0.f; }
    const float* prm = (const float*)(a.ws + WS_PRM);
    const float Aneg = -__expf(prm[PR_ALOG + hd]), Dk = prm[PR_DSKIP + hd];
    LAS float* xs = (LAS float*)lds;
    LAS float* Bs = xs + 64 * 64;
    LAS float* Cs = Bs + 64 * 128;
    LAS float* dts = Cs + 64 * 128;
    LAS float* dAs = dts + 64;
    LAS float* yb = dAs + 64;
    for (int c0 = 0; c0 < L; c0 += 64) {
        const int tc = (L - c0) < 64 ? (L - c0) : 64;
        for (int idx = tid; idx < tc * 320; idx += NTHR) {
            const int t = idx / 320, c = idx - t * 320;
            const int xc = c < 64 ? hd * 64 + c : (c < 192 ? DSSM + grp * DST + (c - 64) : DSSM + NGRP * DST + grp * DST + (c - 192));
            float acc = prm[PR_CONVB + xc];
#pragma unroll
            for (int tap = 0; tap < 4; ++tap) { const int tt = c0 + t - 3 + tap; float v;
                if (tt >= 0) v = bf2f(proj[(size_t)(row0 + tt) * W_XBC + SO_XBC + xc]);
                else v = samp ? a.state_conv[(size_t)(sq * 3 + 3 + tt) * DCONV + xc] : 0.f;
                acc += prm[PR_CONVW + tap * DCONV + xc] * v; }
            const float val = siluf_(acc);
            if (c < 64) xs[t * 64 + c] = val; else if (c < 192) Bs[t * 128 + (c - 64)] = val; else Cs[t * 128 + (c - 192)] = val;
        }
        if (tid < tc) { const float dtv = dtb[(size_t)(row0 + c0 + tid) * 32 + hd]; dts[tid] = dtv; dAs[tid] = __expf(dtv * Aneg); }
        __syncthreads();
        for (int t = 0; t < tc; ++t) {
            const float dA = dAs[t], xv = xs[t * 64 + p], dtx = dts[t] * xv; float acc = 0.f;
            const LAS f32x4* b4 = (const LAS f32x4*)(Bs + t * 128 + n0); const LAS f32x4* c4 = (const LAS f32x4*)(Cs + t * 128 + n0);
#pragma unroll
            for (int j = 0; j < 4; ++j) { const f32x4 bb = b4[j], cc = c4[j];
                h[4 * j] = dA * h[4 * j] + dtx * bb.x; h[4 * j + 1] = dA * h[4 * j + 1] + dtx * bb.y; h[4 * j + 2] = dA * h[4 * j + 2] + dtx * bb.z; h[4 * j + 3] = dA * h[4 * j + 3] + dtx * bb.w;
                acc += h[4 * j] * cc.x + h[4 * j + 1] * cc.y + h[4 * j + 2] * cc.z + h[4 * j + 3] * cc.w; }
            acc += __shfl_xor(acc, 1); acc += __shfl_xor(acc, 2); acc += __shfl_xor(acc, 4);
            if ((tid & 7) == 0) yb[t * 64 + p] = acc + Dk * xv;
        }
        __syncthreads();
        for (int t = wid; t < tc; t += NWAVES) {
            const int row = row0 + c0 + t; const float z = bf2f(proj[(size_t)row * W_Z + SO_Z + hd * 64 + lane]);
            const float val = yb[t * 64 + lane] * siluf_(z);
            ys[(size_t)row * DSSM + hd * 64 + lane] = (bf16)f2bf(val);
            const float ss = wave_sum(val * val); if (lane == 0) ssq[(size_t)row * NSH + hd] = ss;
        }
        __syncthreads();
    }
    float* dst = a.out + (samp ? O_SS : O_SP) + ((size_t)(sq * NSH + hd) * SHD + p) * DST + n0;
#pragma unroll
    for (int j = 0; j < 4; ++j) ((f32x4*)dst)[j] = (f32x4){h[4 * j], h[4 * j + 1], h[4 * j + 2], h[4 * j + 3]};
}

__device__ __forceinline__ void p2_ssd_prompt(const Args& a, LAS unsigned char* lds, int G, int wave, int lane) {
    for (int item = blockIdx.x; item < NBATCH * NSH; item += G) ssd_mfma_unit(a.ws, a.probe ? (float*)(a.ws + WS_TMP) - O_SP : a.out, a.probe ? (bf16*)(a.ws + WS_MRG) - 0 : (bf16*)(a.ws + WS_YS), a.probe ? (float*)(a.ws + WS_SSQ) + (size_t)MT * NSH : (float*)(a.ws + WS_SSQ), a.probe, lds, item / NSH, item % NSH, wave, lane);
}
__device__ __forceinline__ void p2_ssd_sample(const Args& a, LAS unsigned char* lds, int G) {
    for (int i0 = blockIdx.x * 4; i0 < DECB * NSH; i0 += G * 4) { const int n = DECB * NSH - i0; ssd_sample_teams(a.ws, a.out, a.state_conv, a.state_ssm, lds, i0, n < 4 ? n : 4); }
}
__device__ __forceinline__ void p2_attn_prompt(const Args& a, LAS unsigned char* lds, int G, int wave, int lane, int vb) {
    for (int k = 0; ; ++k) { const int v = (G == 256) ? (k < 3 ? (int)((vb % 8) * 96 + (vb / 8) + 32 * k) : 768) : (int)(blockIdx.x + k * G); if (v >= 768 || ((a.probe & 4096) && k >= 1)) break;
        const int bh = v >> 3, sb = v & 7; attn_unit(a.ws, lds, bh / NH, bh % NH, sb * 256, wave, lane, a.probe); }
}
__device__ __forceinline__ void p2_attn_sample(const Args& a, LAS unsigned char* lds, int G, int wave, int lane) {
    const bf16* proj = (const bf16*)(a.ws + WS_PROJ);
    for (int u = blockIdx.x; u < DECB * NH; u += G) attn_sample_unit(a.ws, a.cache_k, a.cache_v, lds, u / NH, u % NH, wave, lane);
    const int gt = blockIdx.x * NTHR + threadIdx.x, NGT = G * NTHR;
    for (int i = gt; i < (NBATCH + DECB) * 3 * DCONV; i += NGT) { const int c = i % DCONV, r = (i / DCONV) % 3, sq = i / (3 * DCONV);
        if (sq < NBATCH) a.out[O_CP + (size_t)(sq * 3 + r) * DCONV + c] = bf2f(proj[(size_t)(sq * SEQ + SEQ - 3 + r) * W_XBC + SO_XBC + c]);
        else { const int s2 = sq - NBATCH; a.out[O_CS + (size_t)(s2 * 3 + r) * DCONV + c] = bf2f(proj[(size_t)(MP + s2 * DECS + DECS - 3 + r) * W_XBC + SO_XBC + c]); } }
}
__device__ __forceinline__ void p25_norm(const Args& a, int gw, int NGW, int lane) {
    bf16* ys = (bf16*)(a.ws + WS_YS); const float* ssq = (const float*)(a.ws + WS_SSQ);
    for (int m = gw; m < MT; m += NGW) {
        const float sv = (lane < 32) ? ssq[(size_t)m * NSH + lane] : 0.f;
        float gs = sv + __shfl_xor(sv, 1); gs += __shfl_xor(gs, 2);
        const float rstd = rsqrtf(gs * (1.f / 256.f) + 1e-5f);
        u32x4* r4 = (u32x4*)(ys + (size_t)m * DSSM);
#pragma unroll
        for (int j = 0; j < 4; ++j) { const int ci = j * 64 + lane, g = ci >> 5; const float sc = __shfl(rstd, 4 * g); u32x4 w = r4[ci];
            w.x = pk2(__uint_as_float(w.x << 16) * sc, __uint_as_float(w.x & 0xffff0000u) * sc); w.y = pk2(__uint_as_float(w.y << 16) * sc, __uint_as_float(w.y & 0xffff0000u) * sc);
            w.z = pk2(__uint_as_float(w.z << 16) * sc, __uint_as_float(w.z & 0xffff0000u) * sc); w.w = pk2(__uint_as_float(w.w << 16) * sc, __uint_as_float(w.w & 0xffff0000u) * sc); r4[ci] = w; }
    }
}
__device__ __forceinline__ void p5_final_norm(const Args& a, int gw, int NGW, int lane) {
    for (int m = gw; m < MT; m += NGW) {
        f32x4* xr = (f32x4*)(a.out + (size_t)m * DM) + lane; const f32x4* gr = (const f32x4*)((const float*)(a.ws + WS_PRM) + PR_FNORM) + lane;
        f32x4 v[4]; float s = 0.f;
#pragma unroll
        for (int j = 0; j < 4; ++j) { v[j] = xr[64 * j]; s += (v[j].x * v[j].x + v[j].y * v[j].y) + (v[j].z * v[j].z + v[j].w * v[j].w); }
        const float rstd = rsqrtf(wave_sum(s) * (1.f / DM) + 1e-6f);
#pragma unroll
        for (int j = 0; j < 4; ++j) { const f32x4 g = gr[64 * j]; xr[64 * j] = v[j] * rstd * g; }
    }
}
#define XB_TMO      128
#define XB_XCNT(j)  (256  + 64 * (j))
#define XB_XSUB(j)  (1280 + 64 * (j))
#define XB_XGEN(j)  (2304 + 64 * (j))
#define XB_TOP      3328
#define XB_TOPGEN   3392
#define XCD_BAR_WORDS 3456
#define XB_SPIN_CAP (1u << 18)

__device__ __forceinline__ unsigned xb_ld(unsigned* p)              { return __hip_atomic_load(p, __ATOMIC_RELAXED, __HIP_MEMORY_SCOPE_AGENT); }
__device__ __forceinline__ unsigned xb_add(unsigned* p, unsigned v) { return __hip_atomic_fetch_add(p, v, __ATOMIC_RELAXED, __HIP_MEMORY_SCOPE_AGENT); }
__device__ __forceinline__ unsigned xb_xcc_id() { return (unsigned)__builtin_amdgcn_s_getreg((3 << 11) | 20) & 0xFu; }
#define XB_SPIN(cond, bar) do { unsigned _sp = 0; while (cond) { __builtin_amdgcn_s_sleep(1); \
    if ((++_sp & 255u) == 0u) { if (xb_ld(&(bar)[XB_TMO])) break; if (_sp > XB_SPIN_CAP) { atomicAdd(&(bar)[XB_TMO], 1u); break; } } } } while (0)

struct XcdBarrier {
    unsigned* bar; unsigned x;
    volatile LAS unsigned* st;
};

__device__ __forceinline__ XcdBarrier xcd_barrier_post(unsigned* bar, volatile LAS unsigned* st) {
    XcdBarrier b; b.bar = bar; b.x = xb_xcc_id(); b.st = st;
    if (threadIdx.x == 0) st[2] = xb_add(&bar[XB_XCNT(b.x)], 1u);
    return b;
}
__device__ __forceinline__ void xcd_barrier_complete(unsigned* bar, unsigned x, unsigned& nloc, unsigned& nx) {
    const unsigned G = gridDim.x * gridDim.y * gridDim.z;
    unsigned sum, cnt, mine, sp = 0u;
    for (;;) {
        sum = 0u; cnt = 0u; mine = 0u;
#pragma unroll
        for (unsigned j = 0; j < 16; ++j) { const unsigned c = xb_ld(&bar[XB_XCNT(j)]); sum += c; cnt += (c > 0u) ? 1u : 0u; mine = (j == x) ? c : mine; }
        if (sum == G) break;
        __builtin_amdgcn_s_sleep(1);
        if ((++sp & 255u) == 0u) { if (xb_ld(&bar[XB_TMO])) break; if (sp > XB_SPIN_CAP) { atomicAdd(&bar[XB_TMO], 1u); break; } }
    }
    nloc = mine > 0u ? mine : 1u; nx = cnt > 0u ? cnt : 1u;
}

__device__ __forceinline__ void xcd_barrier(const XcdBarrier& b) {
    asm volatile("s_waitcnt vmcnt(0)" ::: "memory");
    __syncthreads();
    if (threadIdx.x == 0) {
        unsigned* bar = b.bar;
        __builtin_amdgcn_s_waitcnt(0);
        unsigned nloc = b.st[0], nx = b.st[1];
        if (nloc == 0u) { xcd_barrier_complete(bar, b.x, nloc, nx); b.st[0] = nloc; b.st[1] = nx; }
        const unsigned old = xb_add(&bar[XB_XSUB(b.x)], 1u);
        const unsigned gen = old / nloc;
        if (old + 1u == (gen + 1u) * nloc) {
            __builtin_amdgcn_fence(__ATOMIC_RELEASE, "agent");
            asm volatile("s_waitcnt vmcnt(0)" ::: "memory");
            const unsigned og = xb_add(&bar[XB_TOP], 1u);
            const unsigned tg = og / nx;
            if (og + 1u == (tg + 1u) * nx) xb_add(&bar[XB_TOPGEN], 1u);
            else XB_SPIN(xb_ld(&bar[XB_TOPGEN]) == tg, bar);
            __builtin_amdgcn_fence(__ATOMIC_ACQUIRE, "agent");
            xb_add(&bar[XB_XGEN(b.x)], 1u);
            asm volatile("s_waitcnt vmcnt(0)" ::: "memory");
        } else {
            XB_SPIN(xb_ld(&bar[XB_XGEN(b.x)]) == gen, bar);
            __builtin_amdgcn_fence(__ATOMIC_ACQUIRE, "agent");
            asm volatile("s_waitcnt vmcnt(0)" ::: "memory");
        }
    }
    __syncthreads();
}

#define GEMM_PHASE(EpiT, Aptr, Bptr, Mrows, Ncols, Kdim, Eobj) do { pg8::Gemm g_{(const pg8::bf16_t*)(Aptr), (const pg8::bf16_t*)(Bptr), (Mrows), (Ncols), (Kdim)}; pg8::StaticOrder S_; S_.init((Mrows), (Ncols), G, vb); \
    pg8::gemm_phase<EpiT, pg8::StaticOrder, true, true>(lds, g_, S_, (Eobj)); } while (0)

constexpr int NPHASE = 10;
__global__ void __launch_bounds__(NTHR, 2) fwd_megakernel(Args a) {
    extern __shared__ __attribute__((aligned(16))) unsigned char lds_raw[];
    LAS unsigned char* lds = (LAS unsigned char*)lds_raw;
    cg::grid_group grid = cg::this_grid();
    const int tid = threadIdx.x, lane = tid & 63, wave = __builtin_amdgcn_readfirstlane(tid >> 6);
    const int G = gridDim.x, gw = blockIdx.x * NWAVES + wave, NGW = G * NWAVES;
    unsigned char* ws = a.ws;

#define IN(k) (a.ph_lo <= (k) && (k) < a.ph_hi)
    { volatile LAS unsigned* st0 = (volatile LAS unsigned*)(lds + LDS_MISC); if (tid < 4) st0[tid] = 0u; }
    __syncthreads();
    const XcdBarrier bar = xcd_barrier_post((unsigned*)(ws + WS_BAR), (volatile LAS unsigned*)(lds + LDS_MISC));
    if (a.ph_hi > 1000) grid.sync();
#define SEAM(k) do { if (IN(k) && IN((k) + 1)) xcd_barrier(bar); } while (0)
    if (IN(0)) {
        p0_prologue(a, lds, gw, NGW, wave, lane);
        if (blockIdx.x == 0 && tid == 0) { const float** pp = (const float**)(ws + WS_ARGS); pp[0] = a.x_prompt; pp[1] = a.x_sample; pp[2] = a.cache_k; pp[3] = a.cache_v; pp[4] = a.state_conv; pp[5] = a.state_ssm; }
    }
    SEAM(0);
    int vb = (int)blockIdx.x;
    if (IN(0) && IN(1)) {
        volatile LAS unsigned* st0 = (volatile LAS unsigned*)(lds + LDS_MISC);
        if (tid == 0) { unsigned ok = (G == 256) ? 1u : 0u; const unsigned* bw = (const unsigned*)(ws + WS_BAR);
            for (unsigned j = 0; j < 16; ++j) { const unsigned cnt = xb_ld((unsigned*)&bw[XB_XCNT(j)]); if (cnt != (j < 8 ? 32u : 0u)) ok = 0u; }
            st0[3] = ok ? (st0[2] * 8u + bar.x) : (unsigned)blockIdx.x; }
        __syncthreads();
        vb = (int)__builtin_amdgcn_readfirstlane((int)st0[3]);
    }
    if (IN(1)) { pg8::EpiInProj E{(pg8::bf16_t*)(ws + WS_PROJ), (float*)(ws + WS_DT), (const float*)(ws + WS_PRM) + PR_DTB, a.out + O_KP, a.out + O_VP, a.out + O_KS, a.out + O_VS, a.probe & 256};
      GEMM_PHASE(pg8::EpiInProj, ws + WS_HB, ws + WS_WIN, MT, NPAD, DM, E); }
    SEAM(1);
    if (IN(2)) { Args b{}; b.ws = ws; b.out = a.out; b.probe = a.probe; p2_ssd_prompt(b, lds, G, wave, lane); }
    if (IN(3)) { Args b{}; b.ws = ws; b.out = a.out; b.state_conv = ld_ptr(ws, 4); b.state_ssm = ld_ptr(ws, 5); p2_ssd_sample(b, lds, G); }
    if (IN(4)) { Args b{}; b.ws = ws; b.out = a.out; b.probe = a.probe; p2_attn_prompt(b, lds, G, wave, lane, vb); }
    if (IN(5)) { Args b{}; b.ws = ws; b.out = a.out; b.cache_k = ld_ptr(ws, 2); b.cache_v = ld_ptr(ws, 3); p2_attn_sample(b, lds, G, wave, lane); }
    if (IN(5) && IN(7)) xcd_barrier(bar);
    if (IN(7)) {
    skinny_p3(ws, lds, G, wave, lane);
    { pg8::EpiGateAB E{{(const pg8::bf16_t*)(ws + WS_PROJ), (float*)(ws + WS_TMP)}, {(const pg8::bf16_t*)(ws + WS_PROJ), (const float*)(ws + WS_TMP), (pg8::bf16_t*)(ws + WS_MRG)}};
      pg8::Gemm g_{(const pg8::bf16_t*)(ws + WS_YA), (const pg8::bf16_t*)(ws + WS_WA2), MP, DM, YA_PITCH, (const pg8::bf16_t*)(ws + WS_YS), (const pg8::bf16_t*)(ws + WS_WB), DA, DSSM};
      pg8::ChainOrder S_; S_.init(MP, DM, G, vb);
      { pg8::Unit u0; if (S_.next(0, u0) && tid < 256) {
            const f32x4* sq = (const f32x4*)((const float*)(ws + WS_SSQ) + (size_t)(u0.pm * 256 + tid) * NSH); float rs[8];
#pragma unroll
            for (int g8 = 0; g8 < 8; ++g8) { const f32x4 v = sq[g8]; rs[g8] = rsqrtf(((v[0] + v[1]) + (v[2] + v[3])) * (1.f / 256.f) + 1e-5f); }
            LAS float* RS = (LAS float*)(lds + 131072) + tid * 8;
#pragma unroll
            for (int g8 = 0; g8 < 8; ++g8) RS[g8] = g8 < 7 ? rs[g8] / rs[g8 + 1] : rs[7]; }
        __syncthreads(); }
      pg8::gemm_phase<pg8::EpiGateAB, pg8::ChainOrder, true, true>(lds, g_, S_, E); }
    }
    SEAM(7);
    if (IN(8)) { skinny_p4(ws, ld_ptr(ws, 1), a.out, lds, G, wave, lane); pg8::EpiOut E{ld_ptr(ws, 0), ld_ptr(ws, 1), a.out + O_YP}; GEMM_PHASE(pg8::EpiOut, ws + WS_MRG, ws + WS_WO, MP, DM, DM, E); }
    SEAM(8);
    if (IN(9)) p5_final_norm(a, gw, NGW, lane);
#undef IN
#undef SEAM
}

extern "C" void kernel_launch(void* const* d_in, const int* in_sizes, int n_in, void* d_out, int out_size, void* d_ws, size_t ws_size, hipStream_t stream) {
    static int grid_blocks = 0;
    if (grid_blocks == 0) {
        if (n_in != 19 || (size_t)out_size != O_END || ws_size < WS_END) { fprintf(stderr, "kernel_launch: unexpected shapes: n_in %d out %d (want %zu) ws %zu (want >= %zu)\n", n_in, out_size, (size_t)O_END, ws_size, (size_t)WS_END); grid_blocks = -1; return; }
        int dev = 0, cus = 0, per_cu = 0;
        hipGetDevice(&dev); hipDeviceGetAttribute(&cus, hipDeviceAttributeMultiprocessorCount, dev);
        if (hipFuncSetAttribute((const void*)fwd_megakernel, hipFuncAttributeMaxDynamicSharedMemorySize, LDS_BYTES) != hipSuccess) { fprintf(stderr, "kernel_launch: hipFuncSetAttribute failed\n"); grid_blocks = -1; return; }
        if (hipOccupancyMaxActiveBlocksPerMultiprocessor(&per_cu, (const void*)fwd_megakernel, NTHR, LDS_BYTES) != hipSuccess || per_cu < 1) { fprintf(stderr, "kernel_launch: occupancy query failed (%d)\n", per_cu); (void)hipGetLastError(); per_cu = 1; }
        if (per_cu > 1) per_cu = 1;
        grid_blocks = cus * per_cu;
        fprintf(stderr, "kernel_launch: grid %d (cus %d)\n", grid_blocks, cus);
    }
    if (grid_blocks < 0) return;
    Args a{};
    a.x_prompt = (const float*)d_in[0]; a.x_sample = (const float*)d_in[1]; a.cache_k = (const float*)d_in[2]; a.cache_v = (const float*)d_in[3]; a.state_conv = (const float*)d_in[4]; a.state_ssm = (const float*)d_in[5];
    a.norm_g = (const float*)d_in[6]; a.w_in = (const float*)d_in[7]; a.conv_w = (const float*)d_in[8]; a.conv_b = (const float*)d_in[9]; a.dt_bias = (const float*)d_in[10]; a.a_log = (const float*)d_in[11];
    a.d_skip = (const float*)d_in[12]; a.ssm_norm = (const float*)d_in[13]; a.w_a = (const float*)d_in[14]; a.w_b = (const float*)d_in[15]; a.w_out = (const float*)d_in[16]; a.rel_bias = (const float*)d_in[17]; a.final_norm = (const float*)d_in[18];
    a.out = (float*)d_out; a.ws = (unsigned char*)d_ws;
#ifndef PROBE_LO
    const int ranges[1][2] = {{0, NPHASE}}; const int nr = 1;
#else
    const int ranges[2][2] = {{0, NPHASE}, {PROBE_LO, PROBE_HI}}; const int nr = 2;
#endif
    for (int r = 0; r < nr; ++r) {
        a.ph_lo = ranges[r][0]; a.ph_hi = ranges[r][1];
#ifdef PROBE_FLAGS
        a.probe = r ? PROBE_FLAGS : 0;
#endif
        (void)hipMemsetAsync((char*)d_ws + WS_BAR, 0, BAR_ZERO_BYTES, stream);
        void* args[] = {&a};
        hipError_t e = hipLaunchCooperativeKernel((const void*)fwd_megakernel, dim3(grid_blocks), dim3(NTHR), args, LDS_BYTES, stream);
        if (e != hipSuccess) fprintf(stderr, "kernel_launch: cooperative launch failed: %s (grid %d)\n", hipGetErrorString(e), grid_blocks);
    }
}
```

```cpp
#include <hip/hip_runtime.h>
#include <hip/hip_cooperative_groups.h>
#include <cstdio>
#include <cstdint>
namespace cg = cooperative_groups;
namespace pg8 {
#define PG8_LAS __attribute__((address_space(3)))
typedef unsigned short bf16_t;
typedef short bf16x8 __attribute__((ext_vector_type(8)));
typedef float f32x4 __attribute__((ext_vector_type(4)));
typedef unsigned u32x4 __attribute__((ext_vector_type(4)));
constexpr int BM = 256, BK = 64, HALF = 128, HTB = HALF * BK * 2  , STAGE_BYTES = 8 * HTB, NXCD = 8, WGM = 4;

__host__ __device__ __forceinline__ int lds_byte(int r, int c) { const int st = (r >> 4) * 2 + (c >> 5), rr = r & 15, cc = c & 31, ob = rr * 64 + cc * 2; return st * 1024 + (ob ^ (((ob >> 9) & 1) << 5)); }
__host__ __device__ __forceinline__ void stage_rc(int b, int& R, int& C) { const int st = b / 1024, sb = b % 1024, swz = sb ^ (((sb >> 9) & 1) << 5); R = (st >> 1) * 16 + swz / 64; C = (st & 1) * 32 + (swz % 64) / 2; }
__host__ __device__ __forceinline__ int perm32(int rho) { const int n = rho >> 4, i = rho & 15; return 8 * (i >> 2) + 4 * n + (i & 3); }

struct Unit { int pm, pn, which; };
struct Gemm { const bf16_t* A; const bf16_t* Bt; int M, N, K; const bf16_t* A2 = nullptr; const bf16_t* Bt2 = nullptr; int K0 = 0, K1 = 0; };

struct StaticOrder {
    int nM, nN, nwg, G, c;
    __host__ __device__ void init(int M, int N, int G_, int c_) { nM = M / BM; nN = N / BM; nwg = nM * nN; G = G_; c = c_; }
    __host__ __device__ bool next(int i, Unit& u) const {
        const long L = (long)i * G + c; if (L >= nwg) return false;
        int wgid = (int)L; { const int q = nwg / NXCD, r = nwg % NXCD, xcd = wgid % NXCD, off = wgid / NXCD; wgid = (xcd < r ? xcd * (q + 1) : r * (q + 1) + (xcd - r) * q) + off; }
        const int nig = WGM * nN, gid = wgid / nig, fm = gid * WGM, gsz = (nM - fm) < WGM ? (nM - fm) : WGM;
        u.pm = fm + ((wgid % nig) % gsz); u.pn = (wgid % nig) / gsz; u.which = 0; return true;
    }
    __device__ __forceinline__ void a_ready(const Unit&) const {}
    __device__ __forceinline__ void done(const Unit&) const {}
};
struct ChainOrder : StaticOrder {
    __host__ __device__ bool next(int i, Unit& u) const { if (!StaticOrder::next(i >> 1, u)) return false; u.which = i & 1; return true; }
};

constexpr int PROJ_PITCH = 11328;
__device__ __forceinline__ unsigned cvt_pk_bf16(float lo, float hi) { unsigned r; asm volatile("v_cvt_pk_bf16_f32 %0, %1, %2" : "=v"(r) : "v"(lo), "v"(hi)); return r; }
__device__ __forceinline__ float e_bf2f(unsigned short b) { return __uint_as_float(((unsigned)b) << 16); }
__device__ __forceinline__ float e_sigmoid(float x) { return 1.f / (1.f + __expf(-x)); }
__device__ __forceinline__ float e_softplus(float x) { return fmaxf(x, 0.f) + log1pf(__expf(-fabsf(x))); }

struct EpiInProj {
    static constexpr bool PERM = true, AFTER_DRAIN = false, ROWSCALE = false;
    bf16_t* proj; float* dt; const float* dt_bias; float* kp; float* vp; float* ks; float* vs; int skip;
    __device__ __forceinline__ void operator()(const f32x4 (&acc)[2][2][4][2], const Unit& u, int wr, int wc, int fr, int fq) const {
        if (skip) return;
        const int row0 = u.pm * BM + wr * 64 + fr;
        if (u.pn < 44) {
            const int col0 = u.pn * BM + wc * 32 + 8 * fq;
            const bool isk = (u.pn >= 3 && u.pn < 6), isv = (u.pn >= 6 && u.pn < 9);
            const int secc = u.pn < 12 ? (u.pn / 3) * 768 : (u.pn < 20 ? 3072 : (u.pn < 36 ? 5120 : (u.pn < 40 ? 9216 : 10240))), secw = u.pn < 12 ? 768 : (u.pn < 20 ? 2048 : (u.pn < 36 ? 4096 : 1024)); const size_t secofs = (size_t)16640 * secc;
#pragma unroll
            for (int ai = 0; ai < 2; ++ai)
#pragma unroll
                for (int m = 0; m < 4; ++m) { const int row = row0 + ai * HALF + m * 16; bf16_t* rowp = proj + secofs + (size_t)row * secw + (col0 - secc);
#pragma unroll
                    for (int bj = 0; bj < 2; ++bj) { const f32x4 v0 = acc[ai][bj][m][0], v1 = acc[ai][bj][m][1];
                        u32x4 w; w.x = cvt_pk_bf16(v0[0], v0[1]); w.y = cvt_pk_bf16(v0[2], v0[3]); w.z = cvt_pk_bf16(v1[0], v1[1]); w.w = cvt_pk_bf16(v1[2], v1[3]);
                        *(u32x4*)(rowp + bj * HALF) = w;
                        if (isk || isv) { const int c = col0 + bj * HALF - (isk ? 768 : 1536);
                            float* dst = (u.pm < 64) ? ((isk ? kp : vp) + (size_t)row * 768 + c) : ((isk ? ks : vs) + (size_t)(row - 16384) * 768 + c);
                            *(f32x4*)dst = v0; *(f32x4*)(dst + 4) = v1; } } }
        } else if (wc == 0) {
            const f32x4 b0 = *(const f32x4*)(dt_bias + 8 * fq), b1 = *(const f32x4*)(dt_bias + 8 * fq + 4);
#pragma unroll
            for (int ai = 0; ai < 2; ++ai)
#pragma unroll
                for (int m = 0; m < 4; ++m) { const int row = row0 + ai * HALF + m * 16; const f32x4 v0 = acc[ai][0][m][0] + b0, v1 = acc[ai][0][m][1] + b1;
                    f32x4 o0, o1;
#pragma unroll
                    for (int j = 0; j < 4; ++j) { o0[j] = e_softplus(v0[j]); o1[j] = e_softplus(v1[j]); }
                    float* dst = dt + (size_t)row * 32 + 8 * fq; *(f32x4*)dst = o0; *(f32x4*)(dst + 4) = o1; }
        }
    }
};
struct EpiGateA {
    static constexpr bool PERM = true, AFTER_DRAIN = false, ROWSCALE = false;
    const bf16_t* proj; float* tmp;
    __device__ __forceinline__ void operator()(const f32x4 (&acc)[2][2][4][2], const Unit& u, int wr, int wc, int fr, int fq) const {
        const int row0 = u.pm * BM + wr * 64 + fr, col0 = u.pn * BM + wc * 32 + 8 * fq;
#pragma unroll
        for (int ai = 0; ai < 2; ++ai)
#pragma unroll
            for (int m = 0; m < 4; ++m) { const int row = row0 + ai * HALF + m * 16;
#pragma unroll
                for (int bj = 0; bj < 2; ++bj) { const int c = col0 + bj * HALF; const u32x4 g = *(const u32x4*)(proj + (size_t)16640 * 9216 + (size_t)row * 1024 + c);
                    const f32x4 v0 = acc[ai][bj][m][0], v1 = acc[ai][bj][m][1]; f32x4 o0, o1;
                    o0[0] = e_sigmoid(__uint_as_float(g.x << 16)) * v0[0]; o0[1] = e_sigmoid(__uint_as_float(g.x & 0xffff0000u)) * v0[1];
                    o0[2] = e_sigmoid(__uint_as_float(g.y << 16)) * v0[2]; o0[3] = e_sigmoid(__uint_as_float(g.y & 0xffff0000u)) * v0[3];
                    o1[0] = e_sigmoid(__uint_as_float(g.z << 16)) * v1[0]; o1[1] = e_sigmoid(__uint_as_float(g.z & 0xffff0000u)) * v1[1];
                    o1[2] = e_sigmoid(__uint_as_float(g.w << 16)) * v1[2]; o1[3] = e_sigmoid(__uint_as_float(g.w & 0xffff0000u)) * v1[3];
                    float* dst = tmp + (size_t)row * 1024 + c; *(f32x4*)dst = o0; *(f32x4*)(dst + 4) = o1; } }
    }
};
struct EpiGateB {
    static constexpr bool PERM = true, AFTER_DRAIN = false, ROWSCALE = false;
    const bf16_t* proj; const float* tmp; bf16_t* mrg;
    __device__ __forceinline__ void operator()(const f32x4 (&acc)[2][2][4][2], const Unit& u, int wr, int wc, int fr, int fq) const {
        const int row0 = u.pm * BM + wr * 64 + fr, col0 = u.pn * BM + wc * 32 + 8 * fq;
#pragma unroll
        for (int ai = 0; ai < 2; ++ai)
#pragma unroll
            for (int m = 0; m < 4; ++m) { const int row = row0 + ai * HALF + m * 16;
#pragma unroll
                for (int bj = 0; bj < 2; ++bj) { const int c = col0 + bj * HALF; const u32x4 g = *(const u32x4*)(proj + (size_t)16640 * 10240 + (size_t)row * 1024 + c);
                    const float* src = tmp + (size_t)row * 1024 + c; const f32x4 t0 = *(const f32x4*)src, t1 = *(const f32x4*)(src + 4);
                    const f32x4 v0 = acc[ai][bj][m][0], v1 = acc[ai][bj][m][1]; f32x4 o0, o1;
                    o0[0] = t0[0] + e_sigmoid(__uint_as_float(g.x << 16)) * v0[0]; o0[1] = t0[1] + e_sigmoid(__uint_as_float(g.x & 0xffff0000u)) * v0[1];
                    o0[2] = t0[2] + e_sigmoid(__uint_as_float(g.y << 16)) * v0[2]; o0[3] = t0[3] + e_sigmoid(__uint_as_float(g.y & 0xffff0000u)) * v0[3];
                    o1[0] = t1[0] + e_sigmoid(__uint_as_float(g.z << 16)) * v1[0]; o1[1] = t1[1] + e_sigmoid(__uint_as_float(g.z & 0xffff0000u)) * v1[1];
                    o1[2] = t1[2] + e_sigmoid(__uint_as_float(g.w << 16)) * v1[2]; o1[3] = t1[3] + e_sigmoid(__uint_as_float(g.w & 0xffff0000u)) * v1[3];
                    u32x4 w; w.x = cvt_pk_bf16(o0[0], o0[1]); w.y = cvt_pk_bf16(o0[2], o0[3]); w.z = cvt_pk_bf16(o1[0], o1[1]); w.w = cvt_pk_bf16(o1[2], o1[3]);
                    *(u32x4*)(mrg + (size_t)row * 1024 + c) = w; } }
    }
};
struct EpiGateAB {
    static constexpr bool PERM = true, AFTER_DRAIN = false, ROWSCALE = true;
    EpiGateA ea; EpiGateB eb;
    __device__ __forceinline__ void rowscale(f32x4 (&acc)[2][2][4][2], PG8_LAS unsigned char* lds, int gidx, int wr, int fr) const {
        const PG8_LAS float* RS = (const PG8_LAS float*)(lds + 131072);
#pragma unroll
        for (int ai = 0; ai < 2; ++ai)
#pragma unroll
            for (int m = 0; m < 4; ++m) { const float s = RS[(ai * HALF + wr * 64 + m * 16 + fr) * 8 + gidx];
#pragma unroll
                for (int bj = 0; bj < 2; ++bj)
#pragma unroll
                    for (int n = 0; n < 2; ++n) acc[ai][bj][m][n] = acc[ai][bj][m][n] * s; }
    }
    __device__ __forceinline__ void operator()(const f32x4 (&acc)[2][2][4][2], const Unit& u, int wr, int wc, int fr, int fq) const { if (u.which == 0) ea(acc, u, wr, wc, fr, fq); else eb(acc, u, wr, wc, fr, fq); }
};
struct EpiOut {
    static constexpr bool PERM = false, AFTER_DRAIN = false, ROWSCALE = false;
    const float* xp; const float* xs; float* out;
    __device__ __forceinline__ void operator()(const f32x4 (&acc)[2][2][4][2], const Unit& u, int wr, int wc, int fr, int fq) const {
        const int row0 = u.pm * BM + wr * 64 + fr, col0 = u.pn * BM + wc * 32 + 4 * fq;
#pragma unroll
        for (int ai = 0; ai < 2; ++ai)
#pragma unroll
            for (int m = 0; m < 4; ++m) { const int row = row0 + ai * HALF + m * 16;
                const float* xr = (u.pm < 64) ? xp + (size_t)row * 1024 : xs + (size_t)(row - 16384) * 1024; float* orow = out + (size_t)row * 1024;
#pragma unroll
                for (int bj = 0; bj < 2; ++bj)
#pragma unroll
                    for (int n = 0; n < 2; ++n) { const int c = col0 + bj * HALF + n * 16; *(f32x4*)(orow + c) = *(const f32x4*)(xr + c) + acc[ai][bj][m][n]; } }
    }
};

template <class Epi, class Sched, bool ALIGN_EPI = false, bool SP2 = false>
__device__ __forceinline__ void gemm_phase(PG8_LAS unsigned char* lds, const Gemm g, const Sched& S, const Epi& E) {
    int tid_ = threadIdx.x; asm volatile("" : "+v"(tid_));
    const int tid = tid_, wid = __builtin_amdgcn_readfirstlane(tid >> 6), lane = tid & 63, wr = wid >> 2, wc = wid & 3, fr = lane & 15, fq = lane >> 4;
    const int K = g.K;
    const int nt0 = (g.K0 ? g.K0 : K) / BK, nt1 = g.K1 / BK;
    unsigned voffA[2], voffB[2];
#pragma unroll
    for (int i = 0; i < 2; ++i) { int R, C; stage_rc(tid * 16 + i * 8192, R, C); const int Rb = Epi::PERM ? ((R & ~31) + perm32(R & 31)) : R;
        voffA[i] = (unsigned)(R * K + C) * 2u; voffB[i] = (unsigned)(Rb * K + C) * 2u; }
    const size_t kstep = (size_t)(BK * 2);
    const size_t hstep = (size_t)HALF * K * 2;
    const size_t tstep = 2 * hstep;
    const unsigned ldsw = (unsigned)wid * 1024u;
    const int aoff = lds_byte(wr * 64 + fr, fq * 8), boff = lds_byte(wc * 32 + fr, fq * 8);
#define PG8_SA(b, h) (((b) * 2 + (h)) * HTB)
#define PG8_SB(b, h) ((4 + (b) * 2 + (h)) * HTB)
#define PG8_STAGE(bufoff, gbase, voff) do { _Pragma("unroll") for (int _i = 0; _i < 2; ++_i) \
        __builtin_amdgcn_global_load_lds((const unsigned*)((const char*)(gbase) + (voff)[_i]), (PG8_LAS unsigned*)(lds + (bufoff) + ldsw + _i * 8192), 16, 0, 0); } while (0)
#define PG8_LDA(dst, b, h) do { _Pragma("unroll") for (int m = 0; m < 4; ++m) _Pragma("unroll") for (int k = 0; k < 2; ++k) dst[m][k] = *(const PG8_LAS bf16x8*)(lds + PG8_SA(b, h) + aoff + m * 2048 + k * 1024); } while (0)
#define PG8_LDB(dst, b, h) do { _Pragma("unroll") for (int n = 0; n < 2; ++n) _Pragma("unroll") for (int k = 0; k < 2; ++k) dst[n][k] = *(const PG8_LAS bf16x8*)(lds + PG8_SB(b, h) + boff + n * 2048 + k * 1024); } while (0)
#define PG8_MMA(ai, bj, At, Bt) do { __builtin_amdgcn_s_setprio(1); _Pragma("unroll") for (int m = 0; m < 4; ++m) _Pragma("unroll") for (int n = 0; n < 2; ++n) _Pragma("unroll") for (int k = 0; k < 2; ++k) \
        acc[ai][bj][m][n] = __builtin_amdgcn_mfma_f32_16x16x32_bf16(Bt[n][k], At[m][k], acc[ai][bj][m][n], 0, 0, 0); __builtin_amdgcn_s_setprio(0); } while (0)
#define PG8_WAIT_V(n) asm volatile("s_waitcnt vmcnt(" #n ")" ::: "memory")
#define PG8_WAIT_L(n) asm volatile("s_waitcnt lgkmcnt(" #n ")" ::: "memory")
#define PG8_BAR __builtin_amdgcn_s_barrier()
#define PG8_SCHED __builtin_amdgcn_sched_barrier(0)
    Unit cur, nxt; int ui = 0;
    if (!S.next(0, cur)) return;
    f32x4 acc[2][2][4][2];
#pragma unroll
    for (int a = 0; a < 2; ++a)
#pragma unroll
        for (int b = 0; b < 2; ++b)
#pragma unroll
            for (int m = 0; m < 4; ++m)
#pragma unroll
                for (int n = 0; n < 2; ++n) acc[a][b][m][n] = (f32x4){0.f, 0.f, 0.f, 0.f};
    bf16x8 At[4][2], B0[2][2], B1[2][2];
    const char* cA = (const char*)(cur.which ? g.A2 : g.A) + (size_t)cur.pm * tstep; const char* cB = (const char*)(cur.which ? g.Bt2 : g.Bt) + (size_t)cur.pn * tstep;
    S.a_ready(cur);
    if constexpr (SP2) {
        PG8_STAGE(PG8_SB(0, 0), cB, voffB); PG8_STAGE(PG8_SB(0, 1), cB + hstep, voffB); PG8_STAGE(PG8_SA(0, 0), cA, voffA); PG8_STAGE(PG8_SA(0, 1), cA + hstep, voffA);
        if (wr == 1) PG8_BAR;
        PG8_WAIT_V(2); PG8_BAR;
        PG8_STAGE(PG8_SB(1, 0), cB + kstep, voffB); PG8_STAGE(PG8_SA(1, 0), cA + kstep, voffA); PG8_STAGE(PG8_SB(1, 1), cB + hstep + kstep, voffB);
        PG8_WAIT_V(6); PG8_BAR;
    } else {
        PG8_STAGE(PG8_SB(0, 0), cB, voffB); PG8_STAGE(PG8_SA(0, 0), cA, voffA); PG8_STAGE(PG8_SB(0, 1), cB + hstep, voffB); PG8_STAGE(PG8_SA(0, 1), cA + hstep, voffA);
        if (wr == 1) PG8_BAR;
        PG8_WAIT_V(4); PG8_BAR;
        PG8_STAGE(PG8_SB(1, 0), cB + kstep, voffB); PG8_STAGE(PG8_SA(1, 0), cA + kstep, voffA); PG8_STAGE(PG8_SB(1, 1), cB + hstep + kstep, voffB);
        PG8_WAIT_V(6); PG8_BAR;
    }
    for (;;) {
        const bool has_next = S.next(ui + 1, nxt);
        const char* nA = has_next ? (const char*)(nxt.which ? g.A2 : g.A) + (size_t)nxt.pm * tstep : cA; const char* nB = has_next ? (const char*)(nxt.which ? g.Bt2 : g.Bt) + (size_t)nxt.pn * tstep : cB;
        const int nt = cur.which ? nt1 : nt0;
        for (int t = 0; t < nt; t += 2) {
            const bool last = (t == nt - 2);
            const char* a1 = cA + (size_t)(t + 1) * kstep;
            const char* a2 = last ? nA : cA + (size_t)(t + 2) * kstep; const char* b2 = last ? nB : cB + (size_t)(t + 2) * kstep;
            const char* a3 = a2 + kstep; const char* b3 = b2 + kstep;
            if (last && has_next) S.a_ready(nxt);
            if constexpr (SP2) {
            PG8_LDB(B0, 0, 0); PG8_LDB(B1, 0, 1); PG8_SCHED; PG8_LDA(At, 0, 0); PG8_STAGE(PG8_SA(1, 1), a1 + hstep, voffA);
            PG8_WAIT_V(8); PG8_WAIT_L(0); PG8_BAR; PG8_MMA(0, 0, At, B0); PG8_MMA(0, 1, At, B1); PG8_BAR; PG8_SCHED;
            PG8_LDA(At, 0, 1); PG8_STAGE(PG8_SB(0, 0), b2, voffB); PG8_STAGE(PG8_SB(0, 1), b2 + hstep, voffB); PG8_STAGE(PG8_SA(0, 0), a2, voffA);
            PG8_WAIT_V(8); PG8_WAIT_L(0); PG8_BAR; PG8_MMA(1, 0, At, B0); PG8_MMA(1, 1, At, B1); PG8_BAR; PG8_SCHED;
            PG8_LDB(B0, 1, 0); PG8_LDB(B1, 1, 1); PG8_SCHED; PG8_LDA(At, 1, 0); PG8_STAGE(PG8_SA(0, 1), a2 + hstep, voffA);
            PG8_WAIT_V(8); PG8_WAIT_L(0); PG8_BAR; PG8_MMA(0, 0, At, B0); PG8_MMA(0, 1, At, B1); PG8_BAR; PG8_SCHED;
            PG8_LDA(At, 1, 1); PG8_STAGE(PG8_SB(1, 0), b3, voffB); PG8_STAGE(PG8_SB(1, 1), b3 + hstep, voffB); PG8_STAGE(PG8_SA(1, 0), a3, voffA);
            PG8_WAIT_V(8); PG8_WAIT_L(0); PG8_BAR; PG8_MMA(1, 0, At, B0); PG8_MMA(1, 1, At, B1); PG8_BAR; PG8_SCHED;
            } else {
            PG8_LDB(B0, 0, 0); PG8_SCHED; PG8_LDA(At, 0, 0); PG8_STAGE(PG8_SA(1, 1), a1 + hstep, voffA);
            PG8_WAIT_L(8); PG8_BAR; PG8_WAIT_L(0); PG8_MMA(0, 0, At, B0); PG8_BAR; PG8_SCHED;
            PG8_LDB(B1, 0, 1); PG8_STAGE(PG8_SB(0, 0), b2, voffB);
            PG8_BAR; PG8_WAIT_L(0); PG8_MMA(0, 1, At, B1); PG8_BAR;
            PG8_LDA(At, 0, 1); PG8_STAGE(PG8_SA(0, 0), a2, voffA);
            PG8_BAR; PG8_WAIT_L(0); PG8_MMA(1, 0, At, B0); PG8_BAR; PG8_SCHED;
            PG8_STAGE(PG8_SB(0, 1), b2 + hstep, voffB);
            PG8_WAIT_V(6); PG8_BAR; PG8_MMA(1, 1, At, B1); PG8_BAR;
            PG8_LDB(B0, 1, 0); PG8_SCHED; PG8_LDA(At, 1, 0); PG8_STAGE(PG8_SA(0, 1), a2 + hstep, voffA);
            PG8_WAIT_L(8); PG8_BAR; PG8_WAIT_L(0); PG8_MMA(0, 0, At, B0); PG8_BAR; PG8_SCHED;
            PG8_LDB(B1, 1, 1); PG8_STAGE(PG8_SB(1, 0), b3, voffB);
            PG8_BAR; PG8_WAIT_L(0); PG8_MMA(0, 1, At, B1); PG8_BAR;
            PG8_LDA(At, 1, 1); PG8_STAGE(PG8_SA(1, 0), a3, voffA);
            PG8_BAR; PG8_WAIT_L(0); PG8_MMA(1, 0, At, B0); PG8_BAR; PG8_SCHED;
            PG8_STAGE(PG8_SB(1, 1), b3 + hstep, voffB);
            PG8_WAIT_V(6); PG8_BAR; PG8_MMA(1, 1, At, B1); PG8_BAR;
            }
            if constexpr (Epi::ROWSCALE) { if (cur.which == 1 && ((t + 2) & 3) == 0) E.rowscale(acc, lds, ((t + 2) >> 2) - 1, wr, fr); }
        }
        if constexpr (ALIGN_EPI) { if (wr == 0) PG8_BAR; }
        if constexpr (!Epi::AFTER_DRAIN) { E(acc, cur, wr, wc, fr, fq); S.done(cur); }
        if (!has_next) break;
#pragma unroll
        for (int a = 0; a < 2; ++a)
#pragma unroll
            for (int b = 0; b < 2; ++b)
#pragma unroll
                for (int m = 0; m < 4; ++m)
#pragma unroll
                    for (int n = 0; n < 2; ++n) acc[a][b][m][n] = (f32x4){0.f, 0.f, 0.f, 0.f};
        cur = nxt; cA = nA; cB = nB; ++ui;
        if constexpr (ALIGN_EPI) { if (wr == 1) PG8_BAR; }
    }
    PG8_WAIT_V(0);
    if constexpr (!ALIGN_EPI) { if (wr == 0) PG8_BAR; }
    PG8_BAR;
    if constexpr (Epi::AFTER_DRAIN) { E.fused(acc, cur, wr, wc, fr, fq, lds, wid, lane); S.done(cur); }
#undef PG8_SA
#undef PG8_SB
#undef PG8_STAGE
#undef PG8_LDA
#undef PG8_LDB
#undef PG8_MMA
#undef PG8_WAIT_V
#undef PG8_WAIT_L
#undef PG8_BAR
#undef PG8_SCHED
}
}

#define LAS __attribute__((address_space(3)))
typedef unsigned short bf16;
typedef float f32x4 __attribute__((ext_vector_type(4)));
typedef unsigned u32x4 __attribute__((ext_vector_type(4)));
typedef unsigned u32x2 __attribute__((ext_vector_type(2)));
constexpr int NWAVES = 8, NTHR = 512;
constexpr int DM = 1024, NBATCH = 8, SEQ = 2048, MP = NBATCH * SEQ, DECB = 32, DECS = 8, MS = DECB * DECS, MT = MP + MS;
constexpr int NH = 12, HD = 64, DA = NH * HD, YA_PITCH = 2048;
constexpr int DSSM = 2048, NSH = 32, SHD = 64, NGRP = 8, DST = 128, DCONV = 4096;
constexpr int PAST = 16384, KVB = 2048;
constexpr int NIN = 11296, NPROJ = pg8::PROJ_PITCH, NPAD = 11520;
constexpr int C_Q = 0, C_K = 768, C_V = 1536, C_G = 2304, C_Z = 3072, C_XBC = 5120, C_GA = 9216, C_GB = 10240;
constexpr int W_Q = 768, W_K = 768, W_V = 768, W_G = 768, W_Z = 2048, W_XBC = 4096, W_GA = 1024, W_GB = 1024;
constexpr size_t SO_Q = (size_t)MT * C_Q, SO_K = (size_t)MT * C_K, SO_V = (size_t)MT * C_V, SO_G = (size_t)MT * C_G, SO_Z = (size_t)MT * C_Z, SO_XBC = (size_t)MT * C_XBC, SO_GA = (size_t)MT * C_GA, SO_GB = (size_t)MT * C_GB;
constexpr size_t MiB = 1u << 20;
constexpr size_t WS_ARGS = 1 * MiB - 4096, WS_PRM = 1 * MiB, WS_WIN = 2 * MiB, WS_WA = 26 * MiB, WS_WB = 28 * MiB, WS_WO = 32 * MiB, WS_HB = 36 * MiB, WS_DT = 70 * MiB, WS_PROJ = 74 * MiB,
                 WS_YS = 462 * MiB, WS_SSQ = 528 * MiB, WS_TMP = 534 * MiB, WS_MRG = 600 * MiB, WS_YA = 634 * MiB, WS_WA2 = 700 * MiB, WS_END = 704 * MiB;
constexpr size_t O_YP = 0, O_YS = O_YP + (size_t)MP * DM, O_KP = O_YS + (size_t)MS * DM, O_VP = O_KP + (size_t)MP * DA, O_CP = O_VP + (size_t)MP * DA,
                 O_SP = O_CP + (size_t)NBATCH * 3 * DCONV, O_KS = O_SP + (size_t)NBATCH * NSH * SHD * DST, O_VS = O_KS + (size_t)MS * DA, O_CS = O_VS + (size_t)MS * DA,
                 O_SS = O_CS + (size_t)DECB * 3 * DCONV, O_END = O_SS + (size_t)DECB * NSH * SHD * DST;
constexpr int LDS_BYTES = 148480, LDS_MISC = 147456;
constexpr size_t WS_BAR = 0, BAR_ZERO_BYTES = 16384;
constexpr int PR_CONVW = 0, PR_CONVB = 16384, PR_DTB = 20480, PR_ALOG = 20512, PR_DSKIP = 20544, PR_RELB = 20576, PR_FNORM = 20992, PR_END = 22016;

struct Args {
    const float *x_prompt, *x_sample, *cache_k, *cache_v, *state_conv, *state_ssm, *norm_g, *w_in, *conv_w, *conv_b, *dt_bias, *a_log, *d_skip, *ssm_norm, *w_a, *w_b, *w_out, *rel_bias, *final_norm;
    float* out; unsigned char* ws;
    int ph_lo, ph_hi, probe, pad_;
};

__device__ __forceinline__ float bf2f(bf16 b) { return __uint_as_float(((unsigned)b) << 16); }
__device__ __forceinline__ unsigned f2bf(float f) { unsigned u = __float_as_uint(f); return (u + 0x7fffu + ((u >> 16) & 1u)) >> 16; }
typedef float f32x2_t __attribute__((ext_vector_type(2))); typedef __bf16 bf16x2_t __attribute__((ext_vector_type(2)));
__device__ __forceinline__ unsigned pk2(float lo, float hi) { const f32x2_t v = {lo, hi}; return __builtin_bit_cast(unsigned, __builtin_convertvector(v, bf16x2_t)); }
__device__ __forceinline__ float sigmoidf_(float x) { return 1.f / (1.f + __expf(-x)); }
__device__ __forceinline__ float siluf_(float x) { return x / (1.f + __expf(-x)); }
__device__ __forceinline__ float softplusf_(float x) { return fmaxf(x, 0.f) + log1pf(__expf(-fabsf(x))); }
__device__ __forceinline__ float wave_sum(float v) {
#pragma unroll
    for (int o = 1; o < 64; o <<= 1) v += __shfl_xor(v, o);
    return v;
}
__device__ __forceinline__ float wave_max(float v) {
#pragma unroll
    for (int o = 1; o < 64; o <<= 1) v = fmaxf(v, __shfl_xor(v, o));
    return v;
}
__device__ __forceinline__ int t5_bucket(int off) {
    if (off < 16) return off;
    return 16 + (off >= 22) + (off >= 30) + (off >= 40) + (off >= 54) + (off >= 73) + (off >= 99) + (off >= 134) + (off >= 182) + (off >= 246) + (off >= 332) + (off >= 450) + (off >= 609) + (off >= 825) + (off >= 1117) + (off >= 1513);
}
__device__ __forceinline__ const float* ld_ptr(const unsigned char* ws, int idx) { const unsigned long long v = ((const unsigned long long*)(ws + WS_ARGS))[idx];
    const unsigned lo = __builtin_amdgcn_readfirstlane((unsigned)v), hi = __builtin_amdgcn_readfirstlane((unsigned)(v >> 32)); return (const float*)(((unsigned long long)hi << 32) | lo); }
#define LDS_WAIT() asm volatile("s_waitcnt lgkmcnt(0)" ::: "memory")
typedef short bf16x8 __attribute__((ext_vector_type(8)));
typedef short s16x4 __attribute__((ext_vector_type(4)));
constexpr int AT_ST = 0, AT_STROW = 272, AT_ML = 69632, AT_BIAS = 71680, AT_V = 73728, AT_VROW = 144, AT_VBYTES = 32 * AT_VROW, AT_VWAVE = 2 * AT_VBYTES;
constexpr float LOG2E = 1.4426950408889634f;
__device__ __forceinline__ s16x4 lds_tr16(LAS const unsigned char* p) { return __builtin_bit_cast(s16x4, __builtin_amdgcn_ds_read_tr16_b64_v4i16((LAS s16x4*)p)); }

constexpr bool AT_PRE = false;
struct AttnQK { bf16x8 q[2]; bf16x8 k[9][2]; };
__device__ __forceinline__ void attn_load_qk(const bf16* base, int P0, int stride, int lane, int probe, AttnQK& qk) {
    const int c = lane & 15, rq = lane >> 4;
    { const bf16* qp = base + (size_t)(P0 + stride * c) * W_Q + SO_Q + rq * 8; qk.q[0] = *(const bf16x8*)qp; qk.q[1] = *(const bf16x8*)(qp + 32); }
#pragma unroll
    for (int kt = 0; kt < 9; ++kt) {
        int kpos = P0 + stride * (16 * kt + c - 128); kpos = kpos < 0 ? 0 : kpos; if (probe & 512) kpos = 0;
        const bf16* kp = base + (size_t)kpos * W_K + SO_K + rq * 8; qk.k[kt][0] = *(const bf16x8*)kp; qk.k[kt][1] = *(const bf16x8*)(kp + 32); }
}
template <bool SAMP, int PMODE = 0  > __device__ __forceinline__ void attn_item(const bf16* base, const float* ck, const float* cv, int P0, int stride, const LAS float* biasr  , LAS unsigned char* vst, int lane, float& m_out, float& l_out, f32x4 (&o)[4], int probe, AttnQK& pre, bool has_next, int P0n, int striden) {
    constexpr bool PRE = PMODE != 0;
    const int c = lane & 15, rq = lane >> 4;
    bf16x8 qf[2];
    if (PRE) { qf[0] = pre.q[0]; qf[1] = pre.q[1]; } else
    { int qrow = P0 + stride * c; if (SAMP) { qrow -= KVB; qrow = qrow > DECS - 1 ? DECS - 1 : qrow; }
      const bf16* qp = base + (size_t)qrow * W_Q + SO_Q + rq * 8; qf[0] = *(const bf16x8*)qp; qf[1] = *(const bf16x8*)(qp + 32); }
    constexpr int VD = SAMP ? 1 : (PMODE == 1 ? 2 : 5);
    u32x4 vh[VD][4]; f32x4 vq[SAMP ? 2 : 1][SAMP ? 8 : 1];
#define AT_STEP_VALID0(ks) (((P0 + stride * (16 * ((2 * (ks) + 1 < 9) ? 2 * (ks) + 1 : 8) + 15 - 128)) >= 0) && !(probe & 32))
    if (!SAMP) {
#pragma unroll
        for (int ks = 0; ks < VD; ++ks) {
#pragma unroll
            for (int i = 0; i < 4; ++i) { int kpos = P0 + stride * (32 * ks + 8 * i + (lane >> 3) - 128); kpos = kpos < 0 ? 0 : (kpos > SEQ - 1 ? SEQ - 1 : kpos); if (probe & 512) kpos = 0;
                vh[ks][i] = *(const u32x4*)(base + (size_t)kpos * W_V + SO_V + (lane & 7) * 8); } }
    } else {
#pragma unroll
        for (int i = 0; i < 4; ++i) { int kpos = P0 + stride * (8 * i + (lane >> 3)) - KVB; kpos = kpos < 0 ? 0 : (kpos > DECS - 1 ? DECS - 1 : kpos);
            vh[0][i] = *(const u32x4*)(base + (size_t)kpos * W_V + SO_V + (lane & 7) * 8); }
    }
#undef AT_STEP_VALID0
    const int kmin = (128 - P0 / stride) > 0 ? (128 - P0 / stride) : 0, lo = c > kmin ? c : kmin, hi = c + 128;
    const LAS float* bp = biasr + (4 * rq - c);
    f32x4 sc[9];
#pragma unroll
    for (int kt = 0; kt < 9; ++kt) {
        const bool tile_valid = ((P0 + stride * (16 * kt + 15 - 128)) >= 0) && !(probe & 16);
        int kpos = P0 + stride * (16 * kt + c - 128); kpos = kpos < 0 ? 0 : kpos;
        bf16x8 k0, k1;
        {
            if (SAMP && kt < 8) { const float* kp = ck + (size_t)kpos * (NH * HD) + rq * 8;
                const f32x4 a0 = *(const f32x4*)kp, a1 = *(const f32x4*)(kp + 4), b0 = *(const f32x4*)(kp + 32), b1 = *(const f32x4*)(kp + 36);
                u32x4 w0, w1; w0.x = pk2(a0[0], a0[1]); w0.y = pk2(a0[2], a0[3]); w0.z = pk2(a1[0], a1[1]); w0.w = pk2(a1[2], a1[3]); w1.x = pk2(b0[0], b0[1]); w1.y = pk2(b0[2], b0[3]); w1.z = pk2(b1[0], b1[1]); w1.w = pk2(b1[2], b1[3]);
                k0 = __builtin_bit_cast(bf16x8, w0); k1 = __builtin_bit_cast(bf16x8, w1);
            } else if (PRE) { k0 = pre.k[kt][0]; k1 = pre.k[kt][1];
            } else { if (SAMP) { kpos -= KVB; kpos = kpos > DECS - 1 ? DECS - 1 : kpos; }
                const bf16* kp = base + (size_t)kpos * W_K + SO_K + rq * 8; k0 = *(const bf16x8*)kp; k1 = *(const bf16x8*)(kp + 32); }
        }
        if (tile_valid) {
            f32x4 acc = {0.f, 0.f, 0.f, 0.f};
            acc = __builtin_amdgcn_mfma_f32_16x16x32_bf16(k0, qf[0], acc, 0, 0, 0);
            acc = __builtin_amdgcn_mfma_f32_16x16x32_bf16(k1, qf[1], acc, 0, 0, 0);
            const LAS float* bt = bp + 16 * kt;
            if (kt >= 1 && kt <= 7 && 16 * kt >= kmin) {
#pragma unroll
                for (int j = 0; j < 4; ++j) sc[kt][j] = acc[j] * (0.125f * LOG2E) + bt[j];
            } else {
#pragma unroll
                for (int j = 0; j < 4; ++j) { const int kidx = 16 * kt + 4 * rq + j; const bool valid = (unsigned)(kidx - lo) <= (unsigned)(hi - lo);
                    sc[kt][j] = valid ? acc[j] * (0.125f * LOG2E) + bt[j] : -INFINITY; }
            }
        } else sc[kt] = (f32x4){-INFINITY, -INFINITY, -INFINITY, -INFINITY};
        if (SAMP && (kt == 2 || kt == 5)) __builtin_amdgcn_sched_barrier(0);
    }
    if (PMODE == 1) { __builtin_amdgcn_sched_barrier(0); attn_load_qk(base, P0n, striden, lane, probe, pre); __builtin_amdgcn_sched_barrier(0); }
    if (SAMP) {
        __builtin_amdgcn_sched_barrier(0);
#pragma unroll
        for (int ks = 0; ks < 2; ++ks)
#pragma unroll
            for (int i = 0; i < 8; ++i) { int kpos = P0 + stride * (32 * ks + 4 * i + (lane >> 4) - 128); kpos = kpos < 0 ? 0 : kpos;
                vq[ks][i] = *(const f32x4*)(cv + (size_t)kpos * (NH * HD) + (lane & 15) * 4); }
    }
    float m = -INFINITY;
#pragma unroll
    for (int kt = 0; kt < 9; ++kt) m = fmaxf(fmaxf(fmaxf(m, sc[kt][0]), fmaxf(sc[kt][1], sc[kt][2])), sc[kt][3]);
    m = fmaxf(m, __shfl_xor(m, 16)); m = fmaxf(m, __shfl_xor(m, 32));
    float l = 0.f;
#pragma unroll
    for (int kt = 0; kt < 9; ++kt)
#pragma unroll
        for (int j = 0; j < 4; ++j) { const float p = __builtin_amdgcn_exp2f(sc[kt][j] - m); sc[kt][j] = p; l += p; }
    l += __shfl_xor(l, 16); l += __shfl_xor(l, 32);
#pragma unroll
    for (int dt = 0; dt < 4; ++dt) o[dt] = (f32x4){0.f, 0.f, 0.f, 0.f};
    LAS const unsigned char* vr = vst + (4 * rq + ((lane & 15) >> 2)) * AT_VROW + (lane & 3) * 8;
#define AT_STEP_VALID(ks) (((P0 + stride * (16 * ((2 * (ks) + 1 < 9) ? 2 * (ks) + 1 : 8) + 15 - 128)) >= 0) && !(probe & 32))
#define AT_VWRITE(ks) do { { LAS unsigned char* vb_ = vst + ((ks) & 1) * AT_VBYTES; \
        if (SAMP && (ks) < 4) { _Pragma("unroll") for (int i = 0; i < 8; ++i) { const f32x4 v = vq[(ks) & 1][i]; u32x2 w; w.x = pk2(v[0], v[1]); w.y = pk2(v[2], v[3]); *(LAS u32x2*)(vb_ + (4 * i + (lane >> 4)) * AT_VROW + (lane & 15) * 8) = w; } } \
        else { _Pragma("unroll") for (int i = 0; i < 4; ++i) *(LAS u32x4*)(vb_ + (8 * i + (lane >> 3)) * AT_VROW + (lane & 7) * 16) = vh[SAMP ? 0 : ((ks) % VD)][i]; } } } while (0)
#define AT_VLOADF(ks) do { { _Pragma("unroll") for (int i = 0; i < 8; ++i) { int kpos = P0 + stride * (32 * (ks) + 4 * i + (lane >> 4) - 128); kpos = kpos < 0 ? 0 : kpos; \
        vq[(ks) & 1][i] = *(const f32x4*)(cv + (size_t)kpos * (NH * HD) + (lane & 15) * 4); } } } while (0)
    AT_VWRITE(0);
#define AT_VLOADH(ks) do { { _Pragma("unroll") for (int i = 0; i < 4; ++i) { int kpos = P0 + stride * (32 * (ks) + 8 * i + (lane >> 3) - 128); kpos = kpos < 0 ? 0 : (kpos > SEQ - 1 ? SEQ - 1 : kpos); if (probe & 512) kpos = 0; \
        vh[(ks) % VD][i] = *(const u32x4*)(base + (size_t)kpos * W_V + SO_V + (lane & 7) * 8); } } } while (0)
    if (!SAMP && VD < 5) AT_VLOADH(VD);
#pragma unroll
    for (int ks = 0; ks < 5; ++ks) {
        if (SAMP && ks + 2 < 4) {   }
        if (ks + 1 < 5) AT_VWRITE(ks + 1);
        if (!SAMP && ks + 1 + VD < 5) AT_VLOADH(ks + 1 + VD);
        if (SAMP && ks + 2 < 4) AT_VLOADF(ks + 2);
        if (AT_STEP_VALID(ks)) {
            bf16x8 pb;
            { const f32x4 pa = sc[2 * ks]; const f32x4 pz = (2 * ks + 1 < 9) ? sc[(2 * ks + 1 < 9) ? 2 * ks + 1 : 8] : (f32x4){0.f, 0.f, 0.f, 0.f};
              u32x4 w; w.x = pk2(pa[0], pa[1]); w.y = pk2(pa[2], pa[3]); w.z = pk2(pz[0], pz[1]); w.w = pk2(pz[2], pz[3]); pb = __builtin_bit_cast(bf16x8, w); }
            LAS const unsigned char* vrb = vr + (ks & 1) * AT_VBYTES;
#pragma unroll
            for (int dt = 0; dt < 4; ++dt) { const s16x4 lo = lds_tr16(vrb + dt * 32), hi = lds_tr16(vrb + dt * 32 + 16 * AT_VROW);
                const bf16x8 vf = (bf16x8){lo[0], lo[1], lo[2], lo[3], hi[0], hi[1], hi[2], hi[3]};
                o[dt] = __builtin_amdgcn_mfma_f32_16x16x32_bf16(vf, pb, o[dt], 0, 0, 0); }
        }
    }
#undef AT_VWRITE
#undef AT_VLOADF
#undef AT_VLOADH
#undef AT_STEP_VALID
    m_out = m; l_out = l;
}
__device__ __forceinline__ void attn_merge(int mode, LAS unsigned char* lds, int ql, int lane, float m, float l, f32x4 (&o)[4], const bf16* gp  , bf16* yp  ) {
    const int rq = lane >> 4;
    LAS float* ml = (LAS float*)(lds + AT_ML) + ql * 2; LAS unsigned char* st = lds + AT_ST + ql * AT_STROW + rq * 16;
    if (mode == 0) {
#pragma unroll
        for (int dt = 0; dt < 4; ++dt) *(LAS f32x4*)(st + dt * 64) = o[dt];
        if (rq == 0) { ml[0] = m; ml[1] = l; }
    } else {
        const float M = ml[0], L = ml[1]; const float Mn = fmaxf(M, m), ca = __builtin_amdgcn_exp2f(M - Mn), cb = __builtin_amdgcn_exp2f(m - Mn); const float Ln = L * ca + l * cb;
        f32x4 on[4];
#pragma unroll
        for (int dt = 0; dt < 4; ++dt) on[dt] = *(LAS const f32x4*)(st + dt * 64) * ca + o[dt] * cb;
        if (mode == 1) {
            LDS_WAIT(); asm volatile("" ::: "memory");
#pragma unroll
            for (int dt = 0; dt < 4; ++dt) *(LAS f32x4*)(st + dt * 64) = on[dt];
            if (rq == 0) { ml[0] = Mn; ml[1] = Ln; }
        } else {
            const float inv = 1.f / Ln;
#pragma unroll
            for (int dt = 0; dt < 4; ++dt) { const u32x2 g = *(const u32x2*)(gp + 16 * dt + 4 * rq);
                const float g0 = __uint_as_float(g.x << 16), g1 = __uint_as_float(g.x & 0xffff0000u), g2 = __uint_as_float(g.y << 16), g3 = __uint_as_float(g.y & 0xffff0000u);
                u32x2 w; w.x = pk2(on[dt][0] * inv * siluf_(g0), on[dt][1] * inv * siluf_(g1)); w.y = pk2(on[dt][2] * inv * siluf_(g2), on[dt][3] * inv * siluf_(g3));
                *(u32x2*)(yp + 16 * dt + 4 * rq) = w; }
        }
    }
}
__device__ __forceinline__ void attn_unit(const unsigned char* ws, LAS unsigned char* lds, int b, int h, int s, int wave, int lane, int probe) {
    const bf16* proj = (const bf16*)(ws + WS_PROJ); bf16* ya = probe ? (bf16*)(ws + WS_TMP) : (bf16*)(ws + WS_YA); const float* prm = (const float*)(ws + WS_PRM);
    const bf16* base = proj + (size_t)b * SEQ * W_Q + h * HD;
    LAS float* bias2 = (LAS float*)(lds + AT_BIAS); LAS unsigned char* vst = lds + AT_V + wave * AT_VWAVE;
    for (int idx = threadIdx.x; idx < 3 * 160; idx += NTHR) { const int g = idx / 160, i = idx - g * 160 - 16; bias2[idx] = (i >= 0 && i <= 128) ? prm[PR_RELB + t5_bucket((128 - i) << (2 * g)) * NH + h] * LOG2E : 0.f; }
    const int c = lane & 15;
#define AT_ITEM_PARAMS(it_, q0_, st_) do { const int id_ = 2 * wave + ((it_) & 1), md_ = (it_) >> 1; \
        if (md_ == 0) { q0_ = id_; st_ = 16; } else if (md_ == 1) { q0_ = (id_ >> 2) + 64 * (id_ & 3); st_ = 4; } else { q0_ = 16 * id_; st_ = 1; } } while (0)
    AttnQK qk; int q0, stride; AT_ITEM_PARAMS(0, q0, stride);
    if (AT_PRE) attn_load_qk(base, s + q0, stride, lane, probe, qk);
#pragma unroll 1
    for (int it = 0; it < ((probe & 8192) ? 2 : 6); ++it) {
        if ((it & 1) == 0) __syncthreads();
        const int mode = it >> 1;
        int q0n, striden; AT_ITEM_PARAMS((it + 1 < 6 ? it + 1 : 0), q0n, striden);
        float m, l; f32x4 o[4];
        if (!AT_PRE) attn_load_qk(base, s + q0, stride, lane, probe, qk);
        attn_item<false, AT_PRE ? 1 : 2>(base, nullptr, nullptr, s + q0, stride, bias2 + (2 - mode) * 160 + 16, vst, lane, m, l, o, probe, qk, it + 1 < 6, s + q0n, striden);
        const int ql = q0 + stride * c; const size_t row = (size_t)b * SEQ + s + ql;
        if (!(probe & 64)) attn_merge(mode, lds, ql, lane, m, l, o, proj + row * W_G + SO_G + h * HD, ya + row * YA_PITCH + h * HD);
        q0 = q0n; stride = striden;
    }
#undef AT_ITEM_PARAMS
    __syncthreads();
}

constexpr int AS_SLOT = 0, AS_SLOTF = 68;
__device__ __forceinline__ void attn_sample_unit(const unsigned char* ws, const float* cache_k, const float* cache_v, LAS unsigned char* lds, int sq, int h, int wave, int lane) {
    const bf16* proj = (const bf16*)(ws + WS_PROJ); bf16* ya = (bf16*)(ws + WS_YA); const float* prm = (const float*)(ws + WS_PRM);
    const bf16* base = proj + (size_t)(MP + sq * DECS) * W_Q + h * HD; const float* ck = cache_k + ((size_t)sq * KVB * NH + h) * HD; const float* cv = cache_v + ((size_t)sq * KVB * NH + h) * HD;
    LAS float* bias2 = (LAS float*)(lds + AT_BIAS); LAS unsigned char* vst = lds + AT_V + wave * AT_VWAVE; LAS float* slots = (LAS float*)(lds + AS_SLOT);
    for (int idx = threadIdx.x; idx < 3 * 160; idx += NTHR) { const int g = idx / 160, i = idx - g * 160 - 16; bias2[idx] = (i >= 0 && i <= 128) ? prm[PR_RELB + t5_bucket((128 - i) << (2 * g)) * NH + h] * LOG2E : 0.f; }
    __syncthreads();
    const int c = lane & 15, rq = lane >> 4;
#pragma unroll 1
    for (int id = wave; id < 13; id += NWAVES) {
        const int g = id == 0 ? 0 : (id < 5 ? 1 : 2), r = id == 0 ? 0 : (id < 5 ? id - 1 : id - 5), stride = 1 << (2 * g), nq = (DECS - r + stride - 1) / stride;
        float m, l; f32x4 o[4];
        { AttnQK dummy; attn_item<true, 0>(base, ck, cv, KVB + r, stride, bias2 + g * 160 + 16, vst, lane, m, l, o, 0, dummy, false, 0, 1); }
        if (c < nq) { LAS float* sl = slots + ((r + stride * c) * 3 + g) * AS_SLOTF;
#pragma unroll
            for (int dt = 0; dt < 4; ++dt) *(LAS f32x4*)(sl + 16 * dt + 4 * rq) = o[dt];
            if (rq == 0) { sl[64] = m; sl[65] = l; } }
    }
    __syncthreads();
    { const int i = threadIdx.x >> 6, d = lane; const LAS float* s0 = slots + (i * 3) * AS_SLOTF; const LAS float* s1 = s0 + AS_SLOTF; const LAS float* s2 = s1 + AS_SLOTF;
      const float m0 = s0[64], m1 = s1[64], m2 = s2[64], M = fmaxf(m0, fmaxf(m1, m2));
      const float c0 = __builtin_amdgcn_exp2f(m0 - M), c1 = __builtin_amdgcn_exp2f(m1 - M), c2 = __builtin_amdgcn_exp2f(m2 - M);
      const float L = s0[65] * c0 + s1[65] * c1 + s2[65] * c2, O = s0[d] * c0 + s1[d] * c1 + s2[d] * c2;
      const size_t row = (size_t)MP + sq * DECS + i; const float gv = bf2f(proj[row * W_G + SO_G + h * HD + d]);
      ya[row * YA_PITCH + h * HD + d] = (bf16)f2bf(O / L * siluf_(gv)); }
    __syncthreads();
}
constexpr int SD_BM = 0, SD_CM = 17408, SD_CS = 34816, SD_ROWN = 272, SD_BWT = 52224, SD_XT = 70656, SD_ROWS = 144, SD_YP = 79872, SD_YROW = 272, SD_AR = 114688, SD_CW = 115712;
__device__ __forceinline__ void ssd_dtarrays(LAS float* ar, float dtv, float Aneg, int lane) {
    asm volatile("" : "+v"(lane));
    float x = dtv * Aneg * LOG2E;
#pragma unroll
    for (int o = 1; o < 64; o <<= 1) { const float y = __shfl_up(x, o); if (lane >= o) x += y; }
    const float tot = __shfl(x, 63);
    ar[lane] = x; ar[64 + lane] = dtv; ar[128 + lane] = __builtin_amdgcn_exp2f(tot - x) * dtv; ar[192 + lane] = __builtin_amdgcn_exp2f(x);
}
__device__ __forceinline__ float silu_fast(float x) { return x * __builtin_amdgcn_rcpf(1.f + __builtin_amdgcn_exp2f(-x * LOG2E)); }
typedef float f32x2 __attribute__((ext_vector_type(2)));
__device__ __forceinline__ void ssd_conv_load(unsigned (&raw)[19], const bf16* proj, const bf16* zrow, size_t row0, int c0, int t0, int col) {
    const bf16* basep = proj + (row0 + (size_t)(c0 + t0)) * W_XBC + SO_XBC + col;
#pragma unroll
    for (int k = 0; k < 19; ++k) { const int T = c0 + t0 - 3 + k; const bf16* rp = (T >= 0) ? basep + (ptrdiff_t)(k - 3) * W_XBC : zrow + col; raw[k] = *(const unsigned*)rp; }
}
template <int KIND> __device__ __forceinline__ void ssd_conv_compute(const unsigned (&raw)[19], LAS unsigned char* lds, int t0, int chl  , int ch) {
    const LAS float* ar = (const LAS float*)(lds + SD_AR); const LAS float* cw = (const LAS float*)(lds + SD_CW) + chl;
    f32x2 w[4];
#pragma unroll
    for (int tap = 0; tap < 4; ++tap) w[tap] = *(const LAS f32x2*)(cw + tap * 320);
    const f32x2 bb = *(const LAS f32x2*)(cw + 4 * 320);
#pragma unroll
    for (int blk = 0; blk < 2; ++blk) {
        float o0[8], o1[8];
#pragma unroll
        for (int tt = 0; tt < 8; ++tt) { const int t = blk * 8 + tt; f32x2 v = bb;
#pragma unroll
            for (int tap = 0; tap < 4; ++tap) v += w[tap] * (f32x2){__uint_as_float(raw[t + tap] << 16), __uint_as_float(raw[t + tap] & 0xffff0000u)};
            o0[tt] = silu_fast(v.x); o1[tt] = silu_fast(v.y); }
        const int s0 = t0 + blk * 8;
        if (KIND == 0) {
            u32x4 a, b; a.x = pk2(o0[0], o0[1]); a.y = pk2(o0[2], o0[3]); a.z = pk2(o0[4], o0[5]); a.w = pk2(o0[6], o0[7]); b.x = pk2(o1[0], o1[1]); b.y = pk2(o1[2], o1[3]); b.z = pk2(o1[4], o1[5]); b.w = pk2(o1[6], o1[7]);
            *(LAS u32x4*)(lds + SD_XT + ch * SD_ROWS + s0 * 2) = a; *(LAS u32x4*)(lds + SD_XT + (ch + 1) * SD_ROWS + s0 * 2) = b;
        } else if (KIND == 1) {
            float s0v[8], s1v[8];
#pragma unroll
            for (int tt = 0; tt < 8; ++tt) { *(LAS unsigned*)(lds + SD_BM + (s0 + tt) * SD_ROWN + ch * 2) = pk2(o0[tt], o1[tt]); const float ww = ar[128 + s0 + tt]; s0v[tt] = o0[tt] * ww; s1v[tt] = o1[tt] * ww; }
            u32x4 a, b; a.x = pk2(s0v[0], s0v[1]); a.y = pk2(s0v[2], s0v[3]); a.z = pk2(s0v[4], s0v[5]); a.w = pk2(s0v[6], s0v[7]); b.x = pk2(s1v[0], s1v[1]); b.y = pk2(s1v[2], s1v[3]); b.z = pk2(s1v[4], s1v[5]); b.w = pk2(s1v[6], s1v[7]);
            *(LAS u32x4*)(lds + SD_BWT + ch * SD_ROWS + s0 * 2) = a; *(LAS u32x4*)(lds + SD_BWT + (ch + 1) * SD_ROWS + s0 * 2) = b;
        } else {
#pragma unroll
            for (int tt = 0; tt < 8; ++tt) { *(LAS unsigned*)(lds + SD_CM + (s0 + tt) * SD_ROWN + ch * 2) = pk2(o0[tt], o1[tt]); const float e = ar[192 + s0 + tt];
                *(LAS unsigned*)(lds + SD_CS + (s0 + tt) * SD_ROWN + ch * 2) = pk2(o0[tt] * e, o1[tt] * e); }
        }
    }
}
__device__ __forceinline__ bf16x8 cat8(s16x4 a, s16x4 b) { return (bf16x8){a[0], a[1], a[2], a[3], b[0], b[1], b[2], b[3]}; }
#define SD_SCHED() __builtin_amdgcn_sched_barrier(0)
template <int HH> __device__ __forceinline__ void ssd_mfma_step(LAS unsigned char* lds, f32x4 (&Hacc)[4], int pt, int c, int rq, float Dk) {
    const LAS float* ar = (const LAS float*)(lds + SD_AR);
    constexpr int S0 = 2 * HH, S1 = 2 * HH + 1;
    const int p = 16 * pt + c;
    const LAS unsigned char* bmp = lds + SD_BM + (32 * HH + c) * SD_ROWN + 16 * rq; const LAS unsigned char* cmp_ = lds + SD_CM + c * SD_ROWN + 16 * rq;
    f32x4 g0[4], g1[4];
#pragma unroll
    for (int lt = 0; lt < 4; ++lt) { g0[lt] = (f32x4){0.f, 0.f, 0.f, 0.f}; g1[lt] = (f32x4){0.f, 0.f, 0.f, 0.f}; }
    bf16x8 fb[2][2], fc[2][4];
#define SD_LOADG(buf, ks) do { fb[buf][0] = *(LAS const bf16x8*)(bmp + 64 * (ks)); fb[buf][1] = *(LAS const bf16x8*)(bmp + 16 * SD_ROWN + 64 * (ks)); \
        _Pragma("unroll") for (int lt = S0; lt < 4; ++lt) fc[buf][lt] = *(LAS const bf16x8*)(cmp_ + 16 * lt * SD_ROWN + 64 * (ks)); } while (0)
    SD_LOADG(0, 0);
#pragma unroll
    for (int ks = 0; ks < 4; ++ks) {
        if (ks + 1 < 4) SD_LOADG((ks + 1) & 1, ks + 1);
        SD_SCHED();
#pragma unroll
        for (int lt = S0; lt < 4; ++lt) { g0[lt] = __builtin_amdgcn_mfma_f32_16x16x32_bf16(fb[ks & 1][0], fc[ks & 1][lt], g0[lt], 0, 0, 0);
            if (lt >= S1) g1[lt] = __builtin_amdgcn_mfma_f32_16x16x32_bf16(fb[ks & 1][1], fc[ks & 1][lt], g1[lt], 0, 0, 0); }
        SD_SCHED();
    }
#undef SD_LOADG
    bf16x8 csf[4][2];
#pragma unroll
    for (int lt = 0; lt < 4; ++lt)
#pragma unroll
        for (int k2 = 0; k2 < 2; ++k2) { const LAS unsigned char* cp = lds + SD_CS + (16 * lt + c) * SD_ROWN + (64 * HH + 32 * k2 + 4 * rq) * 2; csf[lt][k2] = cat8(*(LAS const s16x4*)cp, *(LAS const s16x4*)(cp + 32)); }
    const bf16x8 xb = cat8(*(LAS const s16x4*)(lds + SD_XT + p * SD_ROWS + (32 * HH + 4 * rq) * 2), *(LAS const s16x4*)(lds + SD_XT + p * SD_ROWS + (32 * HH + 16 + 4 * rq) * 2));
    const f32x4 as0 = *(LAS const f32x4*)(ar + 32 * HH + 4 * rq), as1 = *(LAS const f32x4*)(ar + 32 * HH + 16 + 4 * rq);
    const f32x4 dt0 = *(LAS const f32x4*)(ar + 64 + 32 * HH + 4 * rq), dt1 = *(LAS const f32x4*)(ar + 64 + 32 * HH + 16 + 4 * rq);
    float acl[4];
#pragma unroll
    for (int lt = 0; lt < 4; ++lt) acl[lt] = ar[16 * lt + c];
    const float dec = __builtin_amdgcn_exp2f(ar[63]);
    SD_SCHED();
    int dd = c - 4 * rq; asm volatile("" : "+v"(dd));
    bf16x8 hb[2];
#pragma unroll
    for (int k2 = 0; k2 < 2; ++k2) { u32x4 w; w.x = pk2(Hacc[2 * k2][0], Hacc[2 * k2][1]); w.y = pk2(Hacc[2 * k2][2], Hacc[2 * k2][3]); w.z = pk2(Hacc[2 * k2 + 1][0], Hacc[2 * k2 + 1][1]); w.w = pk2(Hacc[2 * k2 + 1][2], Hacc[2 * k2 + 1][3]); hb[k2] = __builtin_bit_cast(bf16x8, w); }
    bf16x8 mf[4];
#pragma unroll
    for (int lt = 0; lt < 4; ++lt) if (lt >= S0) {
        float m0[4], m1[4];
#pragma unroll
        for (int j = 0; j < 4; ++j) {
            float v0 = g0[lt][j] * __builtin_amdgcn_exp2f(fminf(acl[lt] - as0[j], 0.f)) * dt0[j];
            if (lt == S0) { v0 = (j <= dd) ? v0 : 0.f; v0 += (j == dd) ? Dk : 0.f; }
            m0[j] = v0;
            float v1 = 0.f;
            if (lt >= S1) { v1 = g1[lt][j] * __builtin_amdgcn_exp2f(fminf(acl[lt] - as1[j], 0.f)) * dt1[j]; if (lt == S1) { v1 = (j <= dd) ? v1 : 0.f; v1 += (j == dd) ? Dk : 0.f; } }
            m1[j] = v1; }
        u32x4 w; w.x = pk2(m0[0], m0[1]); w.y = pk2(m0[2], m0[3]); w.z = pk2(m1[0], m1[1]); w.w = pk2(m1[2], m1[3]); mf[lt] = __builtin_bit_cast(bf16x8, w);
    }
    SD_SCHED();
    f32x4 y[4];
#pragma unroll
    for (int lt = 0; lt < 4; ++lt) y[lt] = __builtin_amdgcn_mfma_f32_16x16x32_bf16(csf[lt][0], hb[0], (f32x4){0.f, 0.f, 0.f, 0.f}, 0, 0, 0);
#pragma unroll
    for (int lt = 0; lt < 4; ++lt) y[lt] = __builtin_amdgcn_mfma_f32_16x16x32_bf16(csf[lt][1], hb[1], y[lt], 0, 0, 0);
    SD_SCHED();
    bf16x8 bwf[4][2], xn[2];
#pragma unroll
    for (int k2 = 0; k2 < 2; ++k2) xn[k2] = *(LAS const bf16x8*)(lds + SD_XT + p * SD_ROWS + (8 * rq + 32 * k2) * 2);
#pragma unroll
    for (int nt = 0; nt < 4; ++nt)
#pragma unroll
        for (int k2 = 0; k2 < 2; ++k2) bwf[nt][k2] = *(LAS const bf16x8*)(lds + SD_BWT + (64 * HH + 16 * nt + c) * SD_ROWS + (8 * rq + 32 * k2) * 2);
    SD_SCHED();
#pragma unroll
    for (int lt = 0; lt < 4; ++lt) if (lt >= S0) y[lt] = __builtin_amdgcn_mfma_f32_16x16x32_bf16(mf[lt], xb, y[lt], 0, 0, 0);
#pragma unroll
    for (int nt = 0; nt < 4; ++nt) Hacc[nt] = Hacc[nt] * dec;
#pragma unroll
    for (int k2 = 0; k2 < 2; ++k2)
#pragma unroll
        for (int nt = 0; nt < 4; ++nt) Hacc[nt] = __builtin_amdgcn_mfma_f32_16x16x32_bf16(bwf[nt][k2], xn[k2], Hacc[nt], 0, 0, 0);
#pragma unroll
    for (int lt = 0; lt < 4; ++lt)
#pragma unroll
        for (int j = 0; j < 4; ++j) *(LAS float*)(lds + SD_YP + HH * (64 * SD_YROW) + (16 * lt + 4 * rq + j) * SD_YROW + p * 4) = y[lt][j];
}
__device__ __forceinline__ void ssd_mfma_unit(const unsigned char* ws, float* out, bf16* ys, float* ssq, int probe, LAS unsigned char* lds, int b, int hd, int wave, int lane) {
    const bf16* proj = (const bf16*)(ws + WS_PROJ); const float* dtb = (const float*)(ws + WS_DT); const float* prm = (const float*)(ws + WS_PRM);
    const int tid = threadIdx.x, c = lane & 15, rq = lane >> 4, pt = wave & 3, hh = wave >> 2, grp = hd >> 2;
    const size_t row0 = (size_t)b * SEQ; const bf16* zrow = (const bf16*)(ws + WS_WIN) + (size_t)NIN * DM;
    const float Aneg = -__expf(prm[PR_ALOG + hd]), Dk = prm[PR_DSKIP + hd];
    LAS float* ar = (LAS float*)(lds + SD_AR);
    f32x4 Hacc[4];
#pragma unroll
    for (int nt = 0; nt < 4; ++nt) Hacc[nt] = (f32x4){0.f, 0.f, 0.f, 0.f};
    const int kindA = wave < 2 ? 0 : (wave < 6 ? 1 : 2);
    const int tA = kindA == 0 ? tid : (kindA == 1 ? tid - 128 : tid - 384), pairA = kindA == 0 ? (tA & 31) : (tA & 63), runA = kindA == 0 ? (tA >> 5) : (tA >> 6);
    const int colA = kindA == 0 ? hd * 64 + 2 * pairA : (kindA == 1 ? DSSM + grp * DST + 2 * pairA : DSSM + NGRP * DST + grp * DST + 2 * pairA);
    const int tB = tid + 128, pairB = tB & 63, runB = tB >> 6, colB = DSSM + NGRP * DST + grp * DST + 2 * pairB;
    unsigned rawA[19], rawB[19];
    ssd_conv_load(rawA, proj, zrow, row0, 0, 16 * runA, colA);
    if (wave < 2) ssd_conv_load(rawB, proj, zrow, row0, 0, 16 * runB, colB);
    float dtn = (wave == 7) ? dtb[(row0 + lane) * 32 + hd] : 0.f;
    __syncthreads();
    for (int idx = tid; idx < 5 * 320; idx += NTHR) { const int t5 = idx / 320, chl = idx - t5 * 320; const int col = chl < 64 ? hd * 64 + chl : (chl < 192 ? DSSM + grp * DST + (chl - 64) : DSSM + NGRP * DST + grp * DST + (chl - 192));
        ((LAS float*)(lds + SD_CW))[idx] = t5 < 4 ? prm[PR_CONVW + t5 * DCONV + col] : prm[PR_CONVB + col]; }
    if (wave == 7) { ssd_dtarrays(ar, dtn, Aneg, lane); dtn = dtb[(row0 + 64 + lane) * 32 + hd]; }
    __syncthreads();
    const int el = tid >> 3, ep0 = (tid & 7) * 8;
#pragma unroll 1
    for (int c0 = 0; c0 < SEQ; c0 += 64) {
        const bool more = c0 + 64 < SEQ;
        const u32x4 zreg = *(const u32x4*)(proj + (row0 + c0 + el) * W_Z + SO_Z + hd * 64 + ep0);
        if (!(probe & 2)) {
        if (kindA == 0) ssd_conv_compute<0>(rawA, lds, 16 * runA, 2 * pairA, 2 * pairA); else if (kindA == 1) ssd_conv_compute<1>(rawA, lds, 16 * runA, 64 + 2 * pairA, 2 * pairA); else ssd_conv_compute<2>(rawA, lds, 16 * runA, 192 + 2 * pairA, 2 * pairA);
        if (more) ssd_conv_load(rawA, proj, zrow, row0, c0 + 64, 16 * runA, colA);
        if (wave < 2) { ssd_conv_compute<2>(rawB, lds, 16 * runB, 192 + 2 * pairB, 2 * pairB); if (more) ssd_conv_load(rawB, proj, zrow, row0, c0 + 64, 16 * runB, colB); }
        }
        __syncthreads();
        if (!(probe & 4)) { if (hh == 0) ssd_mfma_step<0>(lds, Hacc, pt, c, rq, Dk); else ssd_mfma_step<1>(lds, Hacc, pt, c, rq, Dk); }
        __syncthreads();
        if (!(probe & 8)) {
            const size_t row = row0 + c0 + el;
            const LAS float* y0 = (const LAS float*)(lds + SD_YP + el * SD_YROW + ep0 * 4); const LAS float* y1 = (const LAS float*)(lds + SD_YP + 64 * SD_YROW + el * SD_YROW + ep0 * 4);
            const f32x4 a0 = *(const LAS f32x4*)y0 + *(const LAS f32x4*)y1, a1 = *(const LAS f32x4*)(y0 + 4) + *(const LAS f32x4*)(y1 + 4);
            const u32x4 z = zreg;
            float v[8];
            v[0] = a0[0] * silu_fast(__uint_as_float(z.x << 16)); v[1] = a0[1] * silu_fast(__uint_as_float(z.x & 0xffff0000u)); v[2] = a0[2] * silu_fast(__uint_as_float(z.y << 16)); v[3] = a0[3] * silu_fast(__uint_as_float(z.y & 0xffff0000u));
            v[4] = a1[0] * silu_fast(__uint_as_float(z.z << 16)); v[5] = a1[1] * silu_fast(__uint_as_float(z.z & 0xffff0000u)); v[6] = a1[2] * silu_fast(__uint_as_float(z.w << 16)); v[7] = a1[3] * silu_fast(__uint_as_float(z.w & 0xffff0000u));
            u32x4 w; w.x = pk2(v[0], v[1]); w.y = pk2(v[2], v[3]); w.z = pk2(v[4], v[5]); w.w = pk2(v[6], v[7]);
            *(u32x4*)(ys + row * DSSM + hd * 64 + ep0) = w;
            float ss = (v[0] * v[0] + v[1] * v[1]) + (v[2] * v[2] + v[3] * v[3]) + (v[4] * v[4] + v[5] * v[5]) + (v[6] * v[6] + v[7] * v[7]);
            ss += __shfl_xor(ss, 1); ss += __shfl_xor(ss, 2); ss += __shfl_xor(ss, 4);
            if ((tid & 7) == 0) ssq[row * NSH + hd] = ss;
            if (wave == 7 && more) { ssd_dtarrays(ar, dtn, Aneg, lane); const int cn = c0 + 128 < SEQ ? c0 + 128 : c0; dtn = dtb[(row0 + cn + lane) * 32 + hd]; }
        }
        __syncthreads();
    }
    float* dst = out + O_SP + ((size_t)(b * NSH + hd) * SHD + 16 * pt + c) * DST + 64 * hh + 4 * rq;
#pragma unroll
    for (int nt = 0; nt < 4; ++nt) *(f32x4*)(dst + 16 * nt) = Hacc[nt];
}
constexpr int SS_TEAM = 12288;
constexpr int SS_X = 0, SS_B = 2048, SS_C = 6144, SS_DT = 10240, SS_Y = 10304, SS_BYTES = 12352;
__device__ __forceinline__ void ssd_sample_teams(const unsigned char* ws, float* out, const float* state_conv, const float* state_ssm, LAS unsigned char* lds, int item0  , int nitems) {
    const bf16* proj = (const bf16*)(ws + WS_PROJ); const float* dtb = (const float*)(ws + WS_DT); const float* prm = (const float*)(ws + WS_PRM); bf16* ys = (bf16*)(ws + WS_YS); float* ssq = (float*)(ws + WS_SSQ);
    const int tid = threadIdx.x, team = tid >> 7, t = tid & 127, p = t >> 1, nh = t & 1;
    const int item = item0 + team; const bool act = team < nitems;
    const int sq = act ? item / NSH : 0, hd = act ? item % NSH : 0, grp = hd >> 2; const size_t row0 = (size_t)MP + sq * DECS;
    LAS unsigned char* tl = lds + team * SS_BYTES;
    LAS float* xs = (LAS float*)(tl + SS_X); LAS float* Bs = (LAS float*)(tl + SS_B); LAS float* Cs = (LAS float*)(tl + SS_C); LAS float* dts = (LAS float*)(tl + SS_DT); LAS float* yb = (LAS float*)(tl + SS_Y);
    f32x4 h[16];
    { const f32x4* s4 = (const f32x4*)(state_ssm + ((size_t)(sq * NSH + hd) * SHD + p) * DST + 64 * nh);
#pragma unroll
      for (int j = 0; j < 16; ++j) h[j] = s4[j]; }
    const float Aneg = -__expf(prm[PR_ALOG + hd]), Dk = prm[PR_DSKIP + hd];
#pragma unroll 1
    for (int c = t; c < 320; c += 128) {
        const int xc = c < 64 ? hd * 64 + c : (c < 192 ? DSSM + grp * DST + (c - 64) : DSSM + NGRP * DST + grp * DST + (c - 192));
        float w[4], raw[11];
#pragma unroll
        for (int tap = 0; tap < 4; ++tap) w[tap] = prm[PR_CONVW + tap * DCONV + xc];
        const float bias = prm[PR_CONVB + xc];
#pragma unroll
        for (int k = 0; k < 3; ++k) raw[k] = state_conv[(size_t)(sq * 3 + k) * DCONV + xc];
#pragma unroll
        for (int k = 0; k < DECS; ++k) raw[3 + k] = bf2f(proj[(row0 + k) * W_XBC + SO_XBC + xc]);
        LAS float* dstp = c < 64 ? xs + c : (c < 192 ? Bs + (c - 64) : Cs + (c - 192)); const int dstride = c < 64 ? 64 : 128;
#pragma unroll
        for (int tk = 0; tk < DECS; ++tk) { const float acc = bias + w[0] * raw[tk] + w[1] * raw[tk + 1] + w[2] * raw[tk + 2] + w[3] * raw[tk + 3]; dstp[tk * dstride] = siluf_(acc); }
    }
    if (t < DECS) { const float dtv = dtb[(row0 + t) * 32 + hd]; dts[t] = dtv; dts[8 + t] = __expf(dtv * Aneg); }
    __syncthreads();
#pragma unroll 1
    for (int tk = 0; tk < DECS; ++tk) {
        const float dA = dts[8 + tk], xv = xs[tk * 64 + p], dtx = dts[tk] * xv;
        const LAS f32x4* b4 = (const LAS f32x4*)(Bs + tk * 128 + 64 * nh); const LAS f32x4* c4 = (const LAS f32x4*)(Cs + tk * 128 + 64 * nh);
        f32x4 a4 = {0.f, 0.f, 0.f, 0.f};
#pragma unroll
        for (int j = 0; j < 16; ++j) { h[j] = h[j] * dA + b4[j] * dtx; a4 += h[j] * c4[j]; }
        float acc = (a4[0] + a4[1]) + (a4[2] + a4[3]);
        acc += __shfl_xor(acc, 1);
        if (nh == 0) yb[tk * 64 + p] = acc + Dk * xv;
    }
    if (act) { f32x4* d4 = (f32x4*)(out + O_SS + ((size_t)(sq * NSH + hd) * SHD + p) * DST + 64 * nh);
#pragma unroll
        for (int j = 0; j < 16; ++j) d4[j] = h[j]; }
    __syncthreads();
    { const int tk = t >> 4, p0 = (t & 15) * 4; const size_t row = row0 + tk;
      const f32x4 yv = *(const LAS f32x4*)(yb + tk * 64 + p0); const u32x2 z = *(const u32x2*)(proj + row * W_Z + SO_Z + hd * 64 + p0);
      const float v0 = yv[0] * siluf_(__uint_as_float(z.x << 16)), v1 = yv[1] * siluf_(__uint_as_float(z.x & 0xffff0000u)), v2 = yv[2] * siluf_(__uint_as_float(z.y << 16)), v3 = yv[3] * siluf_(__uint_as_float(z.y & 0xffff0000u));
      float ss = (v0 * v0 + v1 * v1) + (v2 * v2 + v3 * v3);
      ss += __shfl_xor(ss, 1); ss += __shfl_xor(ss, 2); ss += __shfl_xor(ss, 4); ss += __shfl_xor(ss, 8);
      LAS float* ssl = (LAS float*)(lds + 4 * SS_BYTES);
      if ((t & 15) == 0) ssl[team * DECS + tk] = ss;
      __syncthreads();
      const float rstd = rsqrtf((ssl[tk] + ssl[DECS + tk] + ssl[2 * DECS + tk] + ssl[3 * DECS + tk]) * (1.f / 256.f) + 1e-5f);
      if (act) { u32x2 w; w.x = pk2(v0 * rstd, v1 * rstd); w.y = pk2(v2 * rstd, v3 * rstd); *(u32x2*)(ys + row * DSSM + hd * 64 + p0) = w; } }
    __syncthreads();
}
template <int NKS  , int PITCH  > __device__ __forceinline__ f32x2 skinny_tile(const bf16* A, const bf16* Wt, int tile, LAS unsigned char* lds, int wave, int lane) {
    constexpr int K = PITCH;
    const int c = lane & 15, rq = lane >> 4, rb = tile >> 4, cb = tile & 15, k0 = wave * (32 * NKS);
    const bf16* ap = A + (size_t)(16 * rb + c) * K + k0 + 8 * rq; const bf16* wp = Wt + (size_t)(64 * cb + c) * K + k0 + 8 * rq;
    f32x4 acc[4];
#pragma unroll
    for (int nt = 0; nt < 4; ++nt) acc[nt] = (f32x4){0.f, 0.f, 0.f, 0.f};
#pragma unroll
    for (int ks = 0; ks < NKS; ++ks) { const bf16x8 af = *(const bf16x8*)(ap + 32 * ks);
#pragma unroll
        for (int nt = 0; nt < 4; ++nt) acc[nt] = __builtin_amdgcn_mfma_f32_16x16x32_bf16(af, *(const bf16x8*)(wp + (size_t)(16 * nt) * K + 32 * ks), acc[nt], 0, 0, 0); }
    LAS float* P = (LAS float*)lds;
#pragma unroll
    for (int nt = 0; nt < 4; ++nt)
#pragma unroll
        for (int j = 0; j < 4; ++j) P[(wave * 16 + 4 * rq + j) * 64 + 16 * nt + c] = acc[nt][j];
    __syncthreads();
    const int tid = threadIdx.x; f32x2 r = {0.f, 0.f};
#pragma unroll
    for (int w = 0; w < 8; ++w) r += *(const LAS f32x2*)(P + (w * 16 + (tid >> 5)) * 64 + 2 * (tid & 31));
    __syncthreads();
    return r;
}
__device__ __forceinline__ void skinny_p3(const unsigned char* ws, LAS unsigned char* lds, int G, int wave, int lane) {
    const bf16* proj = (const bf16*)(ws + WS_PROJ); const bf16* ya = (const bf16*)(ws + WS_YA) + (size_t)MP * YA_PITCH; const bf16* ysn = (const bf16*)(ws + WS_YS) + (size_t)MP * DSSM; bf16* mrg = (bf16*)(ws + WS_MRG);
    for (int tile = blockIdx.x; tile < 256; tile += G) {
        const size_t row = (size_t)MP + 16 * (tile >> 4) + (threadIdx.x >> 5); const int col = 64 * (tile & 15) + 2 * (threadIdx.x & 31);
        const f32x2 a = skinny_tile<3, YA_PITCH>(ya, (const bf16*)(ws + WS_WA2), tile, lds, wave, lane);
        const f32x2 b = skinny_tile<8, DSSM>(ysn, (const bf16*)(ws + WS_WB), tile, lds, wave, lane);
        const unsigned ga = *(const unsigned*)(proj + row * W_GA + SO_GA + col), gb = *(const unsigned*)(proj + row * W_GB + SO_GB + col);
        const float m0 = sigmoidf_(__uint_as_float(ga << 16)) * a.x + sigmoidf_(__uint_as_float(gb << 16)) * b.x, m1 = sigmoidf_(__uint_as_float(ga & 0xffff0000u)) * a.y + sigmoidf_(__uint_as_float(gb & 0xffff0000u)) * b.y;
        *(unsigned*)(mrg + row * DM + col) = pk2(m0, m1);
    }
}
__device__ __forceinline__ void skinny_p4(const unsigned char* ws, const float* x_sample, float* out, LAS unsigned char* lds, int G, int wave, int lane) {
    const bf16* mrg = (const bf16*)(ws + WS_MRG) + (size_t)MP * DM;
    for (int tile = blockIdx.x; tile < 256; tile += G) {
        const int r = 16 * (tile >> 4) + (threadIdx.x >> 5), col = 64 * (tile & 15) + 2 * (threadIdx.x & 31);
        const f32x2 o = skinny_tile<4, DM>(mrg, (const bf16*)(ws + WS_WO), tile, lds, wave, lane);
        const f32x2 xv = *(const f32x2*)(x_sample + (size_t)r * DM + col);
        *(f32x2*)(out + O_YS + (size_t)r * DM + col) = xv + o;
    }
}
__device__ __forceinline__ void p0_transpose_item(const float* W, int K, int N, bf16* WT, int k0, int n0, int dst_row0, const float* kscale, LAS float* scr, int lane, int dpitch = 0) {
    if (dpitch == 0) dpitch = K;
#pragma unroll 8
    for (int i = 0; i < 32; ++i) { const int kk = 2 * i + (lane >> 5); float v = W[(size_t)(k0 + kk) * N + n0 + (lane & 31)]; if (kscale) v *= kscale[k0 + kk]; scr[kk * 33 + (lane & 31)] = v; }
    LDS_WAIT(); asm volatile("" ::: "memory");
    const int c = lane & 7;
#pragma unroll
    for (int j = 0; j < 4; ++j) { const int n = (lane >> 3) + 8 * j; const LAS float* s = scr + (8 * c) * 33 + n;
        u32x4 o; o.x = pk2(s[0 * 33], s[1 * 33]); o.y = pk2(s[2 * 33], s[3 * 33]); o.z = pk2(s[4 * 33], s[5 * 33]); o.w = pk2(s[6 * 33], s[7 * 33]);
        *(u32x4*)(WT + (size_t)(dst_row0 + n) * dpitch + k0 + 8 * c) = o; }
    LDS_WAIT(); asm volatile("" ::: "memory");
}
__device__ __forceinline__ void p0_prologue(const Args& a, LAS unsigned char* lds, int gw, int NGW, int wave, int lane) {
    bf16* win_t = (bf16*)(a.ws + WS_WIN); bf16* wa_t = (bf16*)(a.ws + WS_WA2); bf16* wb_t = (bf16*)(a.ws + WS_WB); bf16* wo_t = (bf16*)(a.ws + WS_WO); bf16* hb = (bf16*)(a.ws + WS_HB);
    LAS float* scr = (LAS float*)(lds + wave * 16384);
    constexpr int I_IN = (DM / 64) * (NIN / 32), I_A = (DA / 64) * (DM / 32), I_B = (DSSM / 64) * (DM / 32), I_O = (DM / 64) * (DM / 32);
    for (int it = gw; it < I_IN + I_A + I_B + I_O; it += NGW) {
        int r = it;
        if (r < I_IN) { const int nblk = NIN / 32, kb = r / nblk, nb = r % nblk, n0 = nb * 32; const int dst = (n0 < 9216) ? n0 : (n0 == 9216 ? 11264 : n0 - 32);
            p0_transpose_item(a.w_in, DM, NIN, win_t, kb * 64, n0, dst, nullptr, scr, lane); continue; } r -= I_IN;
        if (r < I_A) { const int nblk = DM / 32, kb = r / nblk, nb = r % nblk; p0_transpose_item(a.w_a, DA, DM, wa_t, kb * 64, nb * 32, nb * 32, nullptr, scr, lane, YA_PITCH); continue; } r -= I_A;
        if (r < I_B) { const int nblk = DM / 32, kb = r / nblk, nb = r % nblk; p0_transpose_item(a.w_b, DSSM, DM, wb_t, kb * 64, nb * 32, nb * 32, a.ssm_norm, scr, lane); continue; } r -= I_B;
        { const int nblk = DM / 32, kb = r / nblk, nb = r % nblk; p0_transpose_item(a.w_out, DM, DM, wo_t, kb * 64, nb * 32, nb * 32, nullptr, scr, lane); }
    }
    { float* prm = (float*)(a.ws + WS_PRM); const int gt = gw * 64 + lane, NGT = NGW * 64;
      for (int i = gt; i < PR_END; i += NGT) { float v = 0.f;
          if (i < PR_CONVB) v = a.conv_w[i]; else if (i < PR_DTB) v = a.conv_b[i - PR_CONVB]; else if (i < PR_ALOG) v = a.dt_bias[i - PR_DTB]; else if (i < PR_DSKIP) v = a.a_log[i - PR_ALOG];
          else if (i < PR_RELB) v = a.d_skip[i - PR_DSKIP]; else if (i < PR_RELB + 384) v = a.rel_bias[i - PR_RELB]; else if (i >= PR_FNORM) v = a.final_norm[i - PR_FNORM];
          prm[i] = v; } }
    { u32x4* z = (u32x4*)(win_t + (size_t)11296 * DM); const int n16 = 224 * DM * 2 / 16; for (int i = gw * 64 + lane; i < n16; i += NGW * 64) z[i] = (u32x4){0u, 0u, 0u, 0u}; }
    for (int m = gw; m < MT; m += NGW) {
        const float* xrow = (m < MP) ? a.x_prompt + (size_t)m * DM : a.x_sample + (size_t)(m - MP) * DM;
        const f32x4* xr = (const f32x4*)xrow + lane; const f32x4* gr = (const f32x4*)a.norm_g + lane;
        f32x4 v[4]; float s = 0.f;
#pragma unroll
        for (int j = 0; j < 4; ++j) { v[j] = xr[64 * j]; s += (v[j].x * v[j].x + v[j].y * v[j].y) + (v[j].z * v[j].z + v[j].w * v[j].w); }
        const float rstd = rsqrtf(wave_sum(s) * (1.f / DM) + 1e-6f);
        unsigned long long* o8 = (unsigned long long*)(hb + (size_t)m * DM) + lane;
#pragma unroll
        for (int j = 0; j < 4; ++j) { const f32x4 g = gr[64 * j]; o8[64 * j] = (unsigned long long)pk2(v[j].x * rstd * g.x, v[j].y * rstd * g.y) | ((unsigned long long)pk2(v[j].z * rstd * g.z, v[j].w * rstd * g.w) << 32); }
    }
}

template <bool SAMP> __device__ __forceinline__ const void* kv_ptr(const Args& a, const bf16* proj, int colkv, const float* cache, int seq, int tpos, int off, int h, bool& valid, bool& isf32) {
    if (!SAMP) { const int kt = tpos - off; valid = kt >= 0; isf32 = false; return proj + (size_t)(seq * SEQ + (valid ? kt : 0)) * W_K + colkv + h * HD; }
    const int idx = KVB + tpos - off; valid = true;
    if (idx >= KVB) { isf32 = false; return proj + (size_t)(MP + seq * DECS + (idx - KVB)) * W_K + colkv + h * HD; }
    isf32 = true; return cache + ((size_t)(seq * KVB + idx) * NH + h) * HD;
}
template <bool SAMP> __device__ __forceinline__ void attn_slow_item(const Args& a, const bf16* proj, bf16* ya, LAS float* sl, int row, int h, int lane) {
    const float* prm = (const float*)(a.ws + WS_PRM);
    const int seq = SAMP ? (row - MP) / DECS : row / SEQ, tpos = SAMP ? (row - MP) % DECS : row % SEQ;
    float q[64];
    { const u32x4* qp = (const u32x4*)(proj + (size_t)row * W_Q + SO_Q + h * HD);
#pragma unroll
      for (int i = 0; i < 8; ++i) { const u32x4 w = qp[i]; q[8 * i + 0] = __uint_as_float(w.x << 16); q[8 * i + 1] = __uint_as_float(w.x & 0xffff0000u); q[8 * i + 2] = __uint_as_float(w.y << 16); q[8 * i + 3] = __uint_as_float(w.y & 0xffff0000u);
          q[8 * i + 4] = __uint_as_float(w.z << 16); q[8 * i + 5] = __uint_as_float(w.z & 0xffff0000u); q[8 * i + 6] = __uint_as_float(w.w << 16); q[8 * i + 7] = __uint_as_float(w.w & 0xffff0000u); } }
    float mx = -INFINITY;
#pragma unroll 1
    for (int e = lane; e < 387; e += 64) {
        float sc = -INFINITY;
        const int g = e / 129, j = e - g * 129, off = j << (2 * g); bool valid, isf32;
        const void* kp = kv_ptr<SAMP>(a, proj, C_K, a.cache_k, seq, tpos, off, h, valid, isf32);
        if (valid) { float d = 0.f;
            if (isf32) { const f32x4* k4 = (const f32x4*)kp;
#pragma unroll
                for (int i = 0; i < 16; ++i) { const f32x4 kk = k4[i]; d += q[4 * i] * kk.x + q[4 * i + 1] * kk.y + q[4 * i + 2] * kk.z + q[4 * i + 3] * kk.w; } }
            else { const u32x4* k4 = (const u32x4*)kp;
#pragma unroll
                for (int i = 0; i < 8; ++i) { const u32x4 w = k4[i];
                    d += q[8 * i + 0] * __uint_as_float(w.x << 16) + q[8 * i + 1] * __uint_as_float(w.x & 0xffff0000u) + q[8 * i + 2] * __uint_as_float(w.y << 16) + q[8 * i + 3] * __uint_as_float(w.y & 0xffff0000u)
                       + q[8 * i + 4] * __uint_as_float(w.z << 16) + q[8 * i + 5] * __uint_as_float(w.z & 0xffff0000u) + q[8 * i + 6] * __uint_as_float(w.w << 16) + q[8 * i + 7] * __uint_as_float(w.w & 0xffff0000u); } }
            sc = d * 0.125f + prm[PR_RELB + t5_bucket(off) * NH + h]; }
        sl[e] = sc; mx = fmaxf(mx, sc);
    }
    mx = wave_max(mx);
    float sum = 0.f;
#pragma unroll 1
    for (int e = lane; e < 387; e += 64) { const float sc = sl[e]; const float pe = (sc == -INFINITY) ? 0.f : __expf(sc - mx); sl[e] = pe; sum += pe; }
    sum = wave_sum(sum);
    LDS_WAIT(); asm volatile("" ::: "memory");
    float o = 0.f;
#pragma unroll 4
    for (int e = 0; e < 387; ++e) {
        const int g = e / 129, j = e - g * 129, off = j << (2 * g); bool valid, isf32;
        const void* vp = kv_ptr<SAMP>(a, proj, C_V, a.cache_v, seq, tpos, off, h, valid, isf32);
        const float pe = sl[e];
        if (valid) { const float vv = isf32 ? ((const float*)vp)[lane] : bf2f(((const bf16*)vp)[lane]); o += pe * vv; }
    }
    LDS_WAIT(); asm volatile("" ::: "memory");
    const float gv = bf2f(proj[(size_t)row * W_G + SO_G + h * HD + lane]);
    ya[(size_t)row * YA_PITCH + h * HD + lane] = (bf16)f2bf(o / sum * siluf_(gv));
}

__device__ __forceinline__ void ssd_slow_item(const Args& a, LAS unsigned char* lds, int item) {
    const bf16* proj = (const bf16*)(a.ws + WS_PROJ); const float* dtb = (const float*)(a.ws + WS_DT); bf16* ys = (bf16*)(a.ws + WS_YS); float* ssq = (float*)(a.ws + WS_SSQ);
    const int tid = threadIdx.x, lane = tid & 63, wid = tid >> 6;
    const bool samp = item >= NBATCH * NSH; const int it2 = samp ? item - NBATCH * NSH : item; const int sq = it2 / NSH, hd = it2 % NSH, grp = hd / 4;
    const int L = samp ? DECS : SEQ, row0 = samp ? MP + sq * DECS : sq * SEQ;
    const int p = tid >> 3, n0 = (tid & 7) * 16;
    float h[16];
    if (samp) { const f32x4* s4 = (const f32x4*)(a.state_ssm + ((size_t)(sq * NSH + hd) * SHD + p) * DST + n0);
#pragma unroll
        for (int j = 0; j < 4; ++j) { const f32x4 v = s4[j]; h[4 * j] = v.x; h[4 * j + 1] = v.y; h[4 * j + 2] = v.z; h[4 * j + 3] = v.w; } }
    else {
#pragma unroll
        for (int j = 0; j < 16; ++j) h[j] = 0.f; }
    const float* prm = (const float*)(a.ws + WS_PRM);
    const float Aneg = -__expf(prm[PR_ALOG + hd]), Dk = prm[PR_DSKIP + hd];
    LAS float* xs = (LAS float*)lds;
    LAS float* Bs = xs + 64 * 64;
    LAS float* Cs = Bs + 64 * 128;
    LAS float* dts = Cs + 64 * 128;
    LAS float* dAs = dts + 64;
    LAS float* yb = dAs + 64;
    for (int c0 = 0; c0 < L; c0 += 64) {
        const int tc = (L - c0) < 64 ? (L - c0) : 64;
        for (int idx = tid; idx < tc * 320; idx += NTHR) {
            const int t = idx / 320, c = idx - t * 320;
            const int xc = c < 64 ? hd * 64 + c : (c < 192 ? DSSM + grp * DST + (c - 64) : DSSM + NGRP * DST + grp * DST + (c - 192));
            float acc = prm[PR_CONVB + xc];
#pragma unroll
            for (int tap = 0; tap < 4; ++tap) { const int tt = c0 + t - 3 + tap; float v;
                if (tt >= 0) v = bf2f(proj[(size_t)(row0 + tt) * W_XBC + SO_XBC + xc]);
                else v = samp ? a.state_conv[(size_t)(sq * 3 + 3 + tt) * DCONV + xc] : 0.f;
                acc += prm[PR_CONVW + tap * DCONV + xc] * v; }
            const float val = siluf_(acc);
            if (c < 64) xs[t * 64 + c] = val; else if (c < 192) Bs[t * 128 + (c - 64)] = val; else Cs[t * 128 + (c - 192)] = val;
        }
        if (tid < tc) { const float dtv = dtb[(size_t)(row0 + c0 + tid) * 32 + hd]; dts[tid] = dtv; dAs[tid] = __expf(dtv * Aneg); }
        __syncthreads();
        for (int t = 0; t < tc; ++t) {
            const float dA = dAs[t], xv = xs[t * 64 + p], dtx = dts[t] * xv; float acc = 0.f;
            const LAS f32x4* b4 = (const LAS f32x4*)(Bs + t * 128 + n0); const LAS f32x4* c4 = (const LAS f32x4*)(Cs + t * 128 + n0);
#pragma unroll
            for (int j = 0; j < 4; ++j) { const f32x4 bb = b4[j], cc = c4[j];
                h[4 * j] = dA * h[4 * j] + dtx * bb.x; h[4 * j + 1] = dA * h[4 * j + 1] + dtx * bb.y; h[4 * j + 2] = dA * h[4 * j + 2] + dtx * bb.z; h[4 * j + 3] = dA * h[4 * j + 3] + dtx * bb.w;
                acc += h[4 * j] * cc.x + h[4 * j + 1] * cc.y + h[4 * j + 2] * cc.z + h[4 * j + 3] * cc.w; }
            acc += __shfl_xor(acc, 1); acc += __shfl_xor(acc, 2); acc += __shfl_xor(acc, 4);
            if ((tid & 7) == 0) yb[t * 64 + p] = acc + Dk * xv;
        }
        __syncthreads();
        for (int t = wid; t < tc; t += NWAVES) {
            const int row = row0 + c0 + t; const float z = bf2f(proj[(size_t)row * W_Z + SO_Z + hd * 64 + lane]);
            const float val = yb[t * 64 + lane] * siluf_(z);
            ys[(size_t)row * DSSM + hd * 64 + lane] = (bf16)f2bf(val);
            const float ss = wave_sum(val * val); if (lane == 0) ssq[(size_t)row * NSH + hd] = ss;
        }
        __syncthreads();
    }
    float* dst = a.out + (samp ? O_SS : O_SP) + ((size_t)(sq * NSH + hd) * SHD + p) * DST + n0;
#pragma unroll
    for (int j = 0; j < 4; ++j) ((f32x4*)dst)[j] = (f32x4){h[4 * j], h[4 * j + 1], h[4 * j + 2], h[4 * j + 3]};
}

__device__ __forceinline__ void p2_ssd_prompt(const Args& a, LAS unsigned char* lds, int G, int wave, int lane) {
    for (int item = blockIdx.x; item < NBATCH * NSH; item += G) ssd_mfma_unit(a.ws, a.probe ? (float*)(a.ws + WS_TMP) - O_SP : a.out, a.probe ? (bf16*)(a.ws + WS_MRG) - 0 : (bf16*)(a.ws + WS_YS), a.probe ? (float*)(a.ws + WS_SSQ) + (size_t)MT * NSH : (float*)(a.ws + WS_SSQ), a.probe, lds, item / NSH, item % NSH, wave, lane);
}
__device__ __forceinline__ void p2_ssd_sample(const Args& a, LAS unsigned char* lds, int G) {
    for (int i0 = blockIdx.x * 4; i0 < DECB * NSH; i0 += G * 4) { const int n = DECB * NSH - i0; ssd_sample_teams(a.ws, a.out, a.state_conv, a.state_ssm, lds, i0, n < 4 ? n : 4); }
}
__device__ __forceinline__ void p2_attn_prompt(const Args& a, LAS unsigned char* lds, int G, int wave, int lane, int vb) {
    for (int k = 0; ; ++k) { const int v = (G == 256) ? (k < 3 ? (int)((vb % 8) * 96 + (vb / 8) + 32 * k) : 768) : (int)(blockIdx.x + k * G); if (v >= 768 || ((a.probe & 4096) && k >= 1)) break;
        const int bh = v >> 3, sb = v & 7; attn_unit(a.ws, lds, bh / NH, bh % NH, sb * 256, wave, lane, a.probe); }
}
__device__ __forceinline__ void p2_attn_sample(const Args& a, LAS unsigned char* lds, int G, int wave, int lane) {
    const bf16* proj = (const bf16*)(a.ws + WS_PROJ);
    for (int u = blockIdx.x; u < DECB * NH; u += G) attn_sample_unit(a.ws, a.cache_k, a.cache_v, lds, u / NH, u % NH, wave, lane);
    const int gt = blockIdx.x * NTHR + threadIdx.x, NGT = G * NTHR;
    for (int i = gt; i < (NBATCH + DECB) * 3 * DCONV; i += NGT) { const int c = i % DCONV, r = (i / DCONV) % 3, sq = i / (3 * DCONV);
        if (sq < NBATCH) a.out[O_CP + (size_t)(sq * 3 + r) * DCONV + c] = bf2f(proj[(size_t)(sq * SEQ + SEQ - 3 + r) * W_XBC + SO_XBC + c]);
        else { const int s2 = sq - NBATCH; a.out[O_CS + (size_t)(s2 * 3 + r) * DCONV + c] = bf2f(proj[(size_t)(MP + s2 * DECS + DECS - 3 + r) * W_XBC + SO_XBC + c]); } }
}
__device__ __forceinline__ void p25_norm(const Args& a, int gw, int NGW, int lane) {
    bf16* ys = (bf16*)(a.ws + WS_YS); const float* ssq = (const float*)(a.ws + WS_SSQ);
    for (int m = gw; m < MT; m += NGW) {
        const float sv = (lane < 32) ? ssq[(size_t)m * NSH + lane] : 0.f;
        float gs = sv + __shfl_xor(sv, 1); gs += __shfl_xor(gs, 2);
        const float rstd = rsqrtf(gs * (1.f / 256.f) + 1e-5f);
        u32x4* r4 = (u32x4*)(ys + (size_t)m * DSSM);
#pragma unroll
        for (int j = 0; j < 4; ++j) { const int ci = j * 64 + lane, g = ci >> 5; const float sc = __shfl(rstd, 4 * g); u32x4 w = r4[ci];
            w.x = pk2(__uint_as_float(w.x << 16) * sc, __uint_as_float(w.x & 0xffff0000u) * sc); w.y = pk2(__uint_as_float(w.y << 16) * sc, __uint_as_float(w.y & 0xffff0000u) * sc);
            w.z = pk2(__uint_as_float(w.z << 16) * sc, __uint_as_float(w.z & 0xffff0000u) * sc); w.w = pk2(__uint_as_float(w.w << 16) * sc, __uint_as_float(w.w & 0xffff0000u) * sc); r4[ci] = w; }
    }
}
__device__ __forceinline__ void p5_final_norm(const Args& a, int gw, int NGW, int lane) {
    for (int m = gw; m < MT; m += NGW) {
        f32x4* xr = (f32x4*)(a.out + (size_t)m * DM) + lane; const f32x4* gr = (const f32x4*)((const float*)(a.ws + WS_PRM) + PR_FNORM) + lane;
        f32x4 v[4]; float s = 0.f;
#pragma unroll
        for (int j = 0; j < 4; ++j) { v[j] = xr[64 * j]; s += (v[j].x * v[j].x + v[j].y * v[j].y) + (v[j].z * v[j].z + v[j].w * v[j].w); }
        const float rstd = rsqrtf(wave_sum(s) * (1.f / DM) + 1e-6f);
#pragma unroll
        for (int j = 0; j < 4; ++j) { const f32x4 g = gr[64 * j]; xr[64 * j] = v[j] * rstd * g; }
    }
}
#define XB_TMO      128
#define XB_XCNT(j)  (256  + 64 * (j))
#define XB_XSUB(j)  (1280 + 64 * (j))
#define XB_XGEN(j)  (2304 + 64 * (j))
#define XB_TOP      3328
#define XB_TOPGEN   3392
#define XCD_BAR_WORDS 3456
#define XB_SPIN_CAP (1u << 18)

__device__ __forceinline__ unsigned xb_ld(unsigned* p)              { return __hip_atomic_load(p, __ATOMIC_RELAXED, __HIP_MEMORY_SCOPE_AGENT); }
__device__ __forceinline__ unsigned xb_add(unsigned* p, unsigned v) { return __hip_atomic_fetch_add(p, v, __ATOMIC_RELAXED, __HIP_MEMORY_SCOPE_AGENT); }
__device__ __forceinline__ unsigned xb_xcc_id() { return (unsigned)__builtin_amdgcn_s_getreg((3 << 11) | 20) & 0xFu; }
#define XB_SPIN(cond, bar) do { unsigned _sp = 0; while (cond) { __builtin_amdgcn_s_sleep(1); \
    if ((++_sp & 255u) == 0u) { if (xb_ld(&(bar)[XB_TMO])) break; if (_sp > XB_SPIN_CAP) { atomicAdd(&(bar)[XB_TMO], 1u); break; } } } } while (0)

struct XcdBarrier {
    unsigned* bar; unsigned x;
    volatile LAS unsigned* st;
};

__device__ __forceinline__ XcdBarrier xcd_barrier_post(unsigned* bar, volatile LAS unsigned* st) {
    XcdBarrier b; b.bar = bar; b.x = xb_xcc_id(); b.st = st;
    if (threadIdx.x == 0) st[2] = xb_add(&bar[XB_XCNT(b.x)], 1u);
    return b;
}
__device__ __forceinline__ void xcd_barrier_complete(unsigned* bar, unsigned x, unsigned& nloc, unsigned& nx) {
    const unsigned G = gridDim.x * gridDim.y * gridDim.z;
    unsigned sum, cnt, mine, sp = 0u;
    for (;;) {
        sum = 0u; cnt = 0u; mine = 0u;
#pragma unroll
        for (unsigned j = 0; j < 16; ++j) { const unsigned c = xb_ld(&bar[XB_XCNT(j)]); sum += c; cnt += (c > 0u) ? 1u : 0u; mine = (j == x) ? c : mine; }
        if (sum == G) break;
        __builtin_amdgcn_s_sleep(1);
        if ((++sp & 255u) == 0u) { if (xb_ld(&bar[XB_TMO])) break; if (sp > XB_SPIN_CAP) { atomicAdd(&bar[XB_TMO], 1u); break; } }
    }
    nloc = mine > 0u ? mine : 1u; nx = cnt > 0u ? cnt : 1u;
}

__device__ __forceinline__ void xcd_barrier(const XcdBarrier& b) {
    asm volatile("s_waitcnt vmcnt(0)" ::: "memory");
    __syncthreads();
    if (threadIdx.x == 0) {
        unsigned* bar = b.bar;
        __builtin_amdgcn_s_waitcnt(0);
        unsigned nloc = b.st[0], nx = b.st[1];
        if (nloc == 0u) { xcd_barrier_complete(bar, b.x, nloc, nx); b.st[0] = nloc; b.st[1] = nx; }
        const unsigned old = xb_add(&bar[XB_XSUB(b.x)], 1u);
        const unsigned gen = old / nloc;
        if (old + 1u == (gen + 1u) * nloc) {
            __builtin_amdgcn_fence(__ATOMIC_RELEASE, "agent");
            asm volatile("s_waitcnt vmcnt(0)" ::: "memory");
            const unsigned og = xb_add(&bar[XB_TOP], 1u);
            const unsigned tg = og / nx;
            if (og + 1u == (tg + 1u) * nx) xb_add(&bar[XB_TOPGEN], 1u);
            else XB_SPIN(xb_ld(&bar[XB_TOPGEN]) == tg, bar);
            __builtin_amdgcn_fence(__ATOMIC_ACQUIRE, "agent");
            xb_add(&bar[XB_XGEN(b.x)], 1u);
            asm volatile("s_waitcnt vmcnt(0)" ::: "memory");
        } else {
            XB_SPIN(xb_ld(&bar[XB_XGEN(b.x)]) == gen, bar);
            __builtin_amdgcn_fence(__ATOMIC_ACQUIRE, "agent");
            asm volatile("s_waitcnt vmcnt(0)" ::: "memory");
        }
    }
    __syncthreads();
}

#define GEMM_PHASE(EpiT, Aptr, Bptr, Mrows, Ncols, Kdim, Eobj) do { pg8::Gemm g_{(const pg8::bf16_t*)(Aptr), (const pg8::bf16_t*)(Bptr), (Mrows), (Ncols), (Kdim)}; pg8::StaticOrder S_; S_.init((Mrows), (Ncols), G, vb); \
    pg8::gemm_phase<EpiT, pg8::StaticOrder, true, true>(lds, g_, S_, (Eobj)); } while (0)

constexpr int NPHASE = 10;
__global__ void __launch_bounds__(NTHR, 2) fwd_megakernel(Args a) {
    extern __shared__ __attribute__((aligned(16))) unsigned char lds_raw[];
    LAS unsigned char* lds = (LAS unsigned char*)lds_raw;
    cg::grid_group grid = cg::this_grid();
    const int tid = threadIdx.x, lane = tid & 63, wave = __builtin_amdgcn_readfirstlane(tid >> 6);
    const int G = gridDim.x, gw = blockIdx.x * NWAVES + wave, NGW = G * NWAVES;
    unsigned char* ws = a.ws;

#define IN(k) (a.ph_lo <= (k) && (k) < a.ph_hi)
    { volatile LAS unsigned* st0 = (volatile LAS unsigned*)(lds + LDS_MISC); if (tid < 4) st0[tid] = 0u; }
    __syncthreads();
    const XcdBarrier bar = xcd_barrier_post((unsigned*)(ws + WS_BAR), (volatile LAS unsigned*)(lds + LDS_MISC));
    if (a.ph_hi > 1000) grid.sync();
#define SEAM(k) do { if (IN(k) && IN((k) + 1)) xcd_barrier(bar); } while (0)
    if (IN(0)) {
        p0_prologue(a, lds, gw, NGW, wave, lane);
        if (blockIdx.x == 0 && tid == 0) { const float** pp = (const float**)(ws + WS_ARGS); pp[0] = a.x_prompt; pp[1] = a.x_sample; pp[2] = a.cache_k; pp[3] = a.cache_v; pp[4] = a.state_conv; pp[5] = a.state_ssm; }
    }
    SEAM(0);
    int vb = (int)blockIdx.x;
    if (IN(0) && IN(1)) {
        volatile LAS unsigned* st0 = (volatile LAS unsigned*)(lds + LDS_MISC);
        if (tid == 0) { unsigned ok = (G == 256) ? 1u : 0u; const unsigned* bw = (const unsigned*)(ws + WS_BAR);
            for (unsigned j = 0; j < 16; ++j) { const unsigned cnt = xb_ld((unsigned*)&bw[XB_XCNT(j)]); if (cnt != (j < 8 ? 32u : 0u)) ok = 0u; }
            st0[3] = ok ? (st0[2] * 8u + bar.x) : (unsigned)blockIdx.x; }
        __syncthreads();
        vb = (int)__builtin_amdgcn_readfirstlane((int)st0[3]);
    }
    if (IN(1)) { pg8::EpiInProj E{(pg8::bf16_t*)(ws + WS_PROJ), (float*)(ws + WS_DT), (const float*)(ws + WS_PRM) + PR_DTB, a.out + O_KP, a.out + O_VP, a.out + O_KS, a.out + O_VS, a.probe & 256};
      GEMM_PHASE(pg8::EpiInProj, ws + WS_HB, ws + WS_WIN, MT, NPAD, DM, E); }
    SEAM(1);
    if (IN(2)) { Args b{}; b.ws = ws; b.out = a.out; b.probe = a.probe; p2_ssd_prompt(b, lds, G, wave, lane); }
    if (IN(3)) { Args b{}; b.ws = ws; b.out = a.out; b.state_conv = ld_ptr(ws, 4); b.state_ssm = ld_ptr(ws, 5); p2_ssd_sample(b, lds, G); }
    if (IN(4)) { Args b{}; b.ws = ws; b.out = a.out; b.probe = a.probe; p2_attn_prompt(b, lds, G, wave, lane, vb); }
    if (IN(5)) { Args b{}; b.ws = ws; b.out = a.out; b.cache_k = ld_ptr(ws, 2); b.cache_v = ld_ptr(ws, 3); p2_attn_sample(b, lds, G, wave, lane); }
    if (IN(5) && IN(7)) xcd_barrier(bar);
    if (IN(7)) {
    skinny_p3(ws, lds, G, wave, lane);
    { pg8::EpiGateAB E{{(const pg8::bf16_t*)(ws + WS_PROJ), (float*)(ws + WS_TMP)}, {(const pg8::bf16_t*)(ws + WS_PROJ), (const float*)(ws + WS_TMP), (pg8::bf16_t*)(ws + WS_MRG)}};
      pg8::Gemm g_{(const pg8::bf16_t*)(ws + WS_YA), (const pg8::bf16_t*)(ws + WS_WA2), MP, DM, YA_PITCH, (const pg8::bf16_t*)(ws + WS_YS), (const pg8::bf16_t*)(ws + WS_WB), DA, DSSM};
      pg8::ChainOrder S_; S_.init(MP, DM, G, vb);
      { pg8::Unit u0; if (S_.next(0, u0) && tid < 256) {
            const f32x4* sq = (const f32x4*)((const float*)(ws + WS_SSQ) + (size_t)(u0.pm * 256 + tid) * NSH); float rs[8];
#pragma unroll
            for (int g8 = 0; g8 < 8; ++g8) { const f32x4 v = sq[g8]; rs[g8] = rsqrtf(((v[0] + v[1]) + (v[2] + v[3])) * (1.f / 256.f) + 1e-5f); }
            LAS float* RS = (LAS float*)(lds + 131072) + tid * 8;
#pragma unroll
            for (int g8 = 0; g8 < 8; ++g8) RS[g8] = g8 < 7 ? rs[g8] / rs[g8 + 1] : rs[7]; }
        __syncthreads(); }
      pg8::gemm_phase<pg8::EpiGateAB, pg8::ChainOrder, true, true>(lds, g_, S_, E); }
    }
    SEAM(7);
    if (IN(8)) { skinny_p4(ws, ld_ptr(ws, 1), a.out, lds, G, wave, lane); pg8::EpiOut E{ld_ptr(ws, 0), ld_ptr(ws, 1), a.out + O_YP}; GEMM_PHASE(pg8::EpiOut, ws + WS_MRG, ws + WS_WO, MP, DM, DM, E); }
    SEAM(8);
    if (IN(9)) p5_final_norm(a, gw, NGW, lane);
#undef IN
#undef SEAM
}

extern "C" void kernel_launch(void* const* d_in, const int* in_sizes, int n_in, void* d_out, int out_size, void* d_ws, size_t ws_size, hipStream_t stream) {
    static int grid_blocks = 0;
    if (grid_blocks == 0) {
        if (n_in != 19 || (size_t)out_size != O_END || ws_size < WS_END) { fprintf(stderr, "kernel_launch: unexpected shapes: n_in %d out %d (want %zu) ws %zu (want >= %zu)\n", n_in, out_size, (size_t)O_END, ws_size, (size_t)WS_END); grid_blocks = -1; return; }
        int dev = 0, cus = 0, per_cu = 0;
        hipGetDevice(&dev); hipDeviceGetAttribute(&cus, hipDeviceAttributeMultiprocessorCount, dev);
        if (hipFuncSetAttribute((const void*)fwd_megakernel, hipFuncAttributeMaxDynamicSharedMemorySize, LDS_BYTES) != hipSuccess) { fprintf(stderr, "kernel_launch: hipFuncSetAttribute failed\n"); grid_blocks = -1; return; }
        if (hipOccupancyMaxActiveBlocksPerMultiprocessor(&per_cu, (const void*)fwd_megakernel, NTHR, LDS_BYTES) != hipSuccess || per_cu < 1) { fprintf(stderr, "kernel_launch: occupancy query failed (%d)\n", per_cu); (void)hipGetLastError(); per_cu = 1; }
        if (per_cu > 1) per_cu = 1;
        grid_blocks = cus * per_cu;
        fprintf(stderr, "kernel_launch: grid %d (cus %d)\n", grid_blocks, cus);
    }
    if (grid_blocks < 0) return;
    Args a{};
    a.x_prompt = (const float*)d_in[0]; a.x_sample = (const float*)d_in[1]; a.cache_k = (const float*)d_in[2]; a.cache_v = (const float*)d_in[3]; a.state_conv = (const float*)d_in[4]; a.state_ssm = (const float*)d_in[5];
    a.norm_g = (const float*)d_in[6]; a.w_in = (const float*)d_in[7]; a.conv_w = (const float*)d_in[8]; a.conv_b = (const float*)d_in[9]; a.dt_bias = (const float*)d_in[10]; a.a_log = (const float*)d_in[11];
    a.d_skip = (const float*)d_in[12]; a.ssm_norm = (const float*)d_in[13]; a.w_a = (const float*)d_in[14]; a.w_b = (const float*)d_in[15]; a.w_out = (const float*)d_in[16]; a.rel_bias = (const float*)d_in[17]; a.final_norm = (const float*)d_in[18];
    a.out = (float*)d_out; a.ws = (unsigned char*)d_ws;
#ifndef PROBE_LO
    const int ranges[1][2] = {{0, NPHASE}}; const int nr = 1;
#else
    const int ranges[2][2] = {{0, NPHASE}, {PROBE_LO, PROBE_HI}}; const int nr = 2;
#endif
    for (int r = 0; r < nr; ++r) {
        a.ph_lo = ranges[r][0]; a.ph_hi = ranges[r][1];
#ifdef PROBE_FLAGS
        a.probe = r ? PROBE_FLAGS : 0;
#endif
        (void)hipMemsetAsync((char*)d_ws + WS_BAR, 0, BAR_ZERO_BYTES, stream);
        void* args[] = {&a};
        hipError_t e = hipLaunchCooperativeKernel((const void*)fwd_megakernel, dim3(grid_blocks), dim3(NTHR), args, LDS_BYTES, stream);
        if (e != hipSuccess) fprintf(stderr, "kernel_launch: cooperative launch failed: %s (grid %d)\n", hipGetErrorString(e), grid_blocks);
    }
}
```
